# Optimizing an MI355X kernel written in HIP

```python
import math
import jax, jax.numpy as jnp
from jax import lax
import numpy as np

D_MODEL = 1024
BATCH = 1
SEQ = 16384
DEPTH = 1

CONV_DIM = 1024
CONV_WIDTH = 3
DIFF_HEADS = 8
DIFF_HEAD_DIM = 64
DIFF_V_DIM = 2 * DIFF_HEAD_DIM
Q_BLOCK = 128
N_BUCKETS = 32
MAX_DISTANCE = 128
MEM_LEN = 256
CROSS_HEADS = 4
CROSS_HEAD_DIM = D_MODEL // CROSS_HEADS
PEER_HEADS = 8
N_KEYS = 128
N_EXPERTS = N_KEYS * N_KEYS
PEER_TOPK = 16
PEER_DK = 256
PEER_DK_HALF = PEER_DK // 2
PEER_CHUNK = 128

IN_SPLITS = [CONV_DIM, CONV_DIM, CONV_DIM,
             DIFF_HEADS * 2 * DIFF_HEAD_DIM,
             DIFF_HEADS * 2 * DIFF_HEAD_DIM,
             DIFF_HEADS * DIFF_V_DIM,
             D_MODEL, D_MODEL]
IN_COLS = sum(IN_SPLITS)

kernel_name = "hybrid_conv_diffattn_peer_block"


def rmsnorm(x, g, eps=1e-6):
    x32 = x.astype(jnp.float32)
    y = x32 * lax.rsqrt(jnp.mean(x32 * x32, axis=-1, keepdims=True) + eps)
    return (y * g.astype(jnp.float32)).astype(x.dtype)


def t5_bucket(dist):
    n = jnp.maximum(dist, 0)
    max_exact = N_BUCKETS // 2
    nf = jnp.maximum(n, 1).astype(jnp.float32)
    large = max_exact + (jnp.log(nf / max_exact) / math.log(MAX_DISTANCE / max_exact)
                         * (N_BUCKETS - max_exact)).astype(jnp.int32)
    large = jnp.minimum(large, N_BUCKETS - 1)
    return jnp.where(n < max_exact, n, large)


def short_conv_mixer(b_gate, c_gate, xc, conv_w, w_out):
    u = c_gate * xc
    rhs = conv_w.reshape(CONV_WIDTH, 1, CONV_DIM).astype(u.dtype)
    conv = lax.conv_general_dilated(u, rhs, window_strides=(1,), padding=[(CONV_WIDTH - 1, 0)],
                                    dimension_numbers=('NWC', 'WIO', 'NWC'),
                                    feature_group_count=CONV_DIM)
    return (b_gate * conv) @ w_out


def diff_attention(q, k, v, rel_bias, lam, lam_init, subln_g):
    b, s = q.shape[0], q.shape[1]
    nb = s // Q_BLOCK
    scale = DIFF_HEAD_DIM ** -0.5
    qb = q.reshape(b, nb, Q_BLOCK, DIFF_HEADS, 2, DIFF_HEAD_DIM).swapaxes(0, 1)
    kpos = jnp.arange(s, dtype=jnp.int32)

    def block(args):
        qi, blk = args
        qpos = blk * Q_BLOCK + jnp.arange(Q_BLOCK, dtype=jnp.int32)
        rel = qpos[:, None] - kpos[None, :]
        bias = jnp.transpose(rel_bias[t5_bucket(rel)], (2, 0, 1)).astype(jnp.float32)
        logits = jnp.einsum('bqhcd,bkhcd->bhcqk', qi, k).astype(jnp.float32) * scale
        logits = logits + bias[None, :, None]
        logits = jnp.where(rel[None, None, None] >= 0, logits, -1e30)
        p = jax.nn.softmax(logits, axis=-1)
        a = p[:, :, 0] - lam * p[:, :, 1]
        return jnp.einsum('bhqk,bkhe->bqhe', a.astype(v.dtype), v)

    out = lax.map(block, (qb, jnp.arange(nb, dtype=jnp.int32)))
    out = out.swapaxes(0, 1).reshape(b, s, DIFF_HEADS, DIFF_V_DIM)
    out = rmsnorm(out, subln_g, eps=1e-5) * (1.0 - lam_init)
    return out.reshape(b, s, DIFF_HEADS * DIFF_V_DIM)


def cross_attention(h, m, w_cq, w_ckv, w_co):
    b, s, _ = h.shape
    q = (h @ w_cq).reshape(b, s, CROSS_HEADS, CROSS_HEAD_DIM)
    kv = (m @ w_ckv).reshape(b, m.shape[1], 2, CROSS_HEADS, CROSS_HEAD_DIM)
    k, v = kv[:, :, 0], kv[:, :, 1]
    logits = jnp.einsum('bshd,bmhd->bhsm', q, k).astype(jnp.float32) * (CROSS_HEAD_DIM ** -0.5)
    p = jax.nn.softmax(logits, axis=-1).astype(v.dtype)
    o = jnp.einsum('bhsm,bmhd->bshd', p, v).reshape(b, s, CROSS_HEADS * CROSS_HEAD_DIM)
    return o @ w_co


def peer_ffn(h, w_pq, sub_keys, peer_u, peer_v):
    b, s, d = h.shape
    hf = h.reshape(b * s // PEER_CHUNK, PEER_CHUNK, d)

    def chunk(hc):
        q = (hc @ w_pq).reshape(PEER_CHUNK, PEER_HEADS, 2, PEER_DK_HALF)
        sc = jnp.einsum('thcd,chnd->thcn', q, sub_keys).astype(jnp.float32)
        vals, idx = lax.top_k(sc, PEER_TOPK)
        cand = vals[:, :, 0, :, None] + vals[:, :, 1, None, :]
        cand_idx = idx[:, :, 0, :, None] * N_KEYS + idx[:, :, 1, None, :]
        top_s, top_c = lax.top_k(cand.reshape(PEER_CHUNK, PEER_HEADS, PEER_TOPK * PEER_TOPK), PEER_TOPK)
        experts = jnp.take_along_axis(
            cand_idx.reshape(PEER_CHUNK, PEER_HEADS, PEER_TOPK * PEER_TOPK), top_c, axis=-1)
        g = jax.nn.softmax(top_s, axis=-1)
        ue = peer_u[experts]
        ve = peer_v[experts]
        act = jax.nn.gelu(jnp.einsum('td,thkd->thk', hc, ue).astype(jnp.float32), approximate=False)
        return jnp.einsum('thk,thkd->td', (g * act).astype(ve.dtype), ve)

    return lax.map(chunk, hf).reshape(b, s, d)


def setup_inputs(seed: int = 0) -> dict:
    key = jax.random.key(seed)
    ks = jax.random.split(key, 32)
    f32 = jnp.float32
    D = D_MODEL

    def nrm(k, shape, scale):
        return jax.random.normal(k, shape, f32) * scale

    def gain(k, shape):
        return 1.0 + 0.02 * jax.random.normal(k, shape, f32)

    return {
        "x": nrm(ks[0], (BATCH, SEQ, D), 1.0),
        "mem": nrm(ks[1], (BATCH, MEM_LEN, D), 1.0),
        "norm_mix_g": gain(ks[2], (DEPTH, D)),
        "w_in": nrm(ks[3], (DEPTH, D, IN_COLS), D ** -0.5),
        "conv_w": nrm(ks[4], (DEPTH, CONV_WIDTH, CONV_DIM), CONV_WIDTH ** -0.5),
        "w_conv_out": nrm(ks[5], (DEPTH, CONV_DIM, D), CONV_DIM ** -0.5),
        "lambda_q1": nrm(ks[6], (DEPTH, DIFF_HEAD_DIM), 0.1),
        "lambda_k1": nrm(ks[7], (DEPTH, DIFF_HEAD_DIM), 0.1),
        "lambda_q2": nrm(ks[8], (DEPTH, DIFF_HEAD_DIM), 0.1),
        "lambda_k2": nrm(ks[9], (DEPTH, DIFF_HEAD_DIM), 0.1),
        "subln_g": gain(ks[10], (DEPTH, DIFF_V_DIM)),
        "w_attn_out": nrm(ks[11], (DEPTH, DIFF_HEADS * DIFF_V_DIM, D), (DIFF_HEADS * DIFF_V_DIM) ** -0.5),
        "w_mix_out": nrm(ks[12], (DEPTH, D, D), D ** -0.5),
        "rel_bias": nrm(ks[13], (N_BUCKETS, DIFF_HEADS), 0.5),
        "norm_cross_g": gain(ks[14], (DEPTH, D)),
        "norm_mem_g": gain(ks[15], (DEPTH, D)),
        "w_cq": nrm(ks[16], (DEPTH, D, CROSS_HEADS * CROSS_HEAD_DIM), D ** -0.5),
        "w_ckv": nrm(ks[17], (DEPTH, D, 2 * CROSS_HEADS * CROSS_HEAD_DIM), D ** -0.5),
        "w_co": nrm(ks[18], (DEPTH, CROSS_HEADS * CROSS_HEAD_DIM, D), (CROSS_HEADS * CROSS_HEAD_DIM) ** -0.5),
        "norm_ffn_g": gain(ks[19], (DEPTH, D)),
        "w_pq": nrm(ks[20], (DEPTH, D, PEER_HEADS * PEER_DK), D ** -0.5),
        "sub_keys": nrm(ks[21], (DEPTH, 2, PEER_HEADS, N_KEYS, PEER_DK_HALF), PEER_DK_HALF ** -0.5),
        "peer_u": nrm(ks[22], (DEPTH, N_EXPERTS, D), D ** -0.5),
        "peer_v": nrm(ks[23], (DEPTH, N_EXPERTS, D), D ** -0.5),
        "final_g": gain(ks[24], (D,)),
    }


def reference(x, mem, norm_mix_g, w_in, conv_w, w_conv_out, lambda_q1, lambda_k1, lambda_q2, lambda_k2,
              subln_g, w_attn_out, w_mix_out, rel_bias, norm_cross_g, norm_mem_g, w_cq, w_ckv, w_co,
              norm_ffn_g, w_pq, sub_keys, peer_u, peer_v, final_g):
    b, s, _ = x.shape
    split_points = list(np.cumsum(IN_SPLITS)[:-1])
    for l in range(DEPTH):
        h = rmsnorm(x, norm_mix_g[l])
        proj = h @ w_in[l]
        cb, cc, cx, q, k, v, gc, ga = jnp.split(proj, split_points, axis=-1)
        y_conv = short_conv_mixer(cb, cc, cx, conv_w[l], w_conv_out[l])
        lam_init = 0.8 - 0.6 * math.exp(-0.3 * l)
        lam = (jnp.exp(jnp.sum(lambda_q1[l] * lambda_k1[l]).astype(jnp.float32))
               - jnp.exp(jnp.sum(lambda_q2[l] * lambda_k2[l]).astype(jnp.float32)) + lam_init)
        q = q.reshape(b, s, DIFF_HEADS, 2, DIFF_HEAD_DIM)
        k = k.reshape(b, s, DIFF_HEADS, 2, DIFF_HEAD_DIM)
        v = v.reshape(b, s, DIFF_HEADS, DIFF_V_DIM)
        y_attn = diff_attention(q, k, v, rel_bias, lam, lam_init, subln_g[l]) @ w_attn_out[l]
        merged = jax.nn.sigmoid(gc) * y_conv + jax.nn.sigmoid(ga) * y_attn
        x = x + merged @ w_mix_out[l]
        hc = rmsnorm(x, norm_cross_g[l])
        m = rmsnorm(mem, norm_mem_g[l])
        x = x + cross_attention(hc, m, w_cq[l], w_ckv[l], w_co[l])
        hf = rmsnorm(x, norm_ffn_g[l])
        x = x + peer_ffn(hf, w_pq[l], sub_keys[l], peer_u[l], peer_v[l])
    return rmsnorm(x, final_g)
```

```cpp
#include <hip/hip_runtime.h>
#include <math.h>
#include <cstdio>
#include <cstdint>
namespace pg8 {
#define PG8_LAS __attribute__((address_space(3)))
typedef unsigned short bf16_t;
typedef short bf16x8 __attribute__((ext_vector_type(8)));
typedef float f32x4 __attribute__((ext_vector_type(4)));
typedef unsigned u32x4 __attribute__((ext_vector_type(4)));
constexpr int BM = 256, BK = 64, HALF = 128, HTB = HALF * BK * 2  , STAGE_BYTES = 8 * HTB, NXCD = 8, WGM = 8;

__host__ __device__ __forceinline__ int lds_byte(int r, int c) { const int st = (r >> 4) * 2 + (c >> 5), rr = r & 15, cc = c & 31, ob = rr * 64 + cc * 2; return st * 1024 + (ob ^ (((ob >> 9) & 1) << 5)); }
__host__ __device__ __forceinline__ void stage_rc(int b, int& R, int& C) { const int st = b / 1024, sb = b % 1024, swz = sb ^ (((sb >> 9) & 1) << 5); R = (st >> 1) * 16 + swz / 64; C = (st & 1) * 32 + (swz % 64) / 2; }
__host__ __device__ __forceinline__ int perm32(int rho) { const int n = rho >> 4, i = rho & 15; return 8 * (i >> 2) + 4 * n + (i & 3); }

struct Unit { int pm, pn; };
struct Gemm { const bf16_t* A; const bf16_t* Bt; int M, N, K, lda, ldb; };
struct Split { int ksplit; long long dA2, dB2; };

struct StaticOrder {
    int nM, nN, nwg, G, c;
    __host__ __device__ void init(int M, int N, int G_, int c_) { nM = M / BM; nN = N / BM; nwg = nM * nN; G = G_; c = c_; }
    __host__ __device__ bool next(int i, Unit& u) const {
        const long L = (long)i * G + c; if (L >= nwg) return false;
        int wgid = (int)L; { const int q = nwg / NXCD, r = nwg % NXCD, xcd = wgid % NXCD, off = wgid / NXCD; wgid = (xcd < r ? xcd * (q + 1) : r * (q + 1) + (xcd - r) * q) + off; }
        const int nig = WGM * nN, gid = wgid / nig, fm = gid * WGM, gsz = (nM - fm) < WGM ? (nM - fm) : WGM;
        u.pm = fm + ((wgid % nig) % gsz); u.pn = (wgid % nig) / gsz; return true;
    }
    __device__ __forceinline__ void a_ready(const Unit&) const {}
    __device__ __forceinline__ void done(const Unit&) const {}
};

typedef float f32x2 __attribute__((ext_vector_type(2)));
typedef __bf16 bf16x2v __attribute__((ext_vector_type(2)));
__device__ __forceinline__ unsigned cvt_pk_bf16(float lo, float hi) { const f32x2 v = {lo, hi}; const bf16x2v b = __builtin_convertvector(v, bf16x2v); return __builtin_bit_cast(unsigned, b); }
template <class Epi, class Sched, bool ALIGN_EPI = false, bool SP2 = false, bool SPLIT = false>
__device__ __forceinline__ void gemm_phase(int wv, PG8_LAS unsigned char* lds, const Gemm g, const Sched& S, const Epi& E, const Split sp = Split{0, 0, 0}) {
    int tid_; asm volatile("v_mbcnt_lo_u32_b32 %0, -1, 0\n\tv_mbcnt_hi_u32_b32 %0, -1, %0" : "=v"(tid_)); tid_ += wv * 64;
    const int tid = tid_, wid = __builtin_amdgcn_readfirstlane(tid >> 6), lane = tid & 63, wr = wid >> 2, wc = wid & 3, fr = lane & 15, fq = lane >> 4;
    const int K = g.K, nt = K / BK;
    unsigned voffA[2], voffB[2];
#pragma unroll
    for (int i = 0; i < 2; ++i) { int R, C; stage_rc(tid * 16 + i * 8192, R, C); const int Rb = Epi::PERM ? ((R & ~31) + perm32(R & 31)) : R;
        voffA[i] = (unsigned)(R * g.lda + C) * 2u; voffB[i] = (unsigned)(Rb * g.ldb + C) * 2u; }
    const size_t kstep = (size_t)(BK * 2);
    const size_t hstepA = (size_t)HALF * g.lda * 2, hstepB = (size_t)HALF * g.ldb * 2;
    const size_t tstepA = 2 * hstepA, tstepB = 2 * hstepB;
    const unsigned ldsw = (unsigned)wid * 1024u;
    const int aoff = lds_byte(wr * 64 + fr, fq * 8), boff = lds_byte(wc * 32 + fr, fq * 8);
#define PG8_SA(b, h) (((b) * 2 + (h)) * HTB)
#define PG8_SB(b, h) ((4 + (b) * 2 + (h)) * HTB)
#define PG8_STAGE(bufoff, gbase, voff) do { _Pragma("unroll") for (int _i = 0; _i < 2; ++_i) \
        __builtin_amdgcn_global_load_lds((const unsigned*)((const char*)(gbase) + (voff)[_i]), (PG8_LAS unsigned*)(lds + (bufoff) + ldsw + _i * 8192), 16, 0, 0); } while (0)
#define PG8_LDA(dst, b, h) do { _Pragma("unroll") for (int m = 0; m < 4; ++m) _Pragma("unroll") for (int k = 0; k < 2; ++k) dst[m][k] = *(const PG8_LAS bf16x8*)(lds + PG8_SA(b, h) + aoff + m * 2048 + k * 1024); } while (0)
#define PG8_LDB(dst, b, h) do { _Pragma("unroll") for (int n = 0; n < 2; ++n) _Pragma("unroll") for (int k = 0; k < 2; ++k) dst[n][k] = *(const PG8_LAS bf16x8*)(lds + PG8_SB(b, h) + boff + n * 2048 + k * 1024); } while (0)
#define PG8_MMA(ai, bj, At, Bt) do { __builtin_amdgcn_s_setprio(1); _Pragma("unroll") for (int m = 0; m < 4; ++m) _Pragma("unroll") for (int n = 0; n < 2; ++n) _Pragma("unroll") for (int k = 0; k < 2; ++k) \
        acc[ai][bj][m][n] = __builtin_amdgcn_mfma_f32_16x16x32_bf16(Bt[n][k], At[m][k], acc[ai][bj][m][n], 0, 0, 0); __builtin_amdgcn_s_setprio(0); } while (0)
#define PG8_WAIT_V(n) asm volatile("s_waitcnt vmcnt(" #n ")" ::: "memory")
#define PG8_WAIT_L(n) asm volatile("s_waitcnt lgkmcnt(" #n ")" ::: "memory")
#define PG8_BAR __builtin_amdgcn_s_barrier()
#define PG8_SCHED __builtin_amdgcn_sched_barrier(0)
    Unit cur, nxt; int ui = 0;
    if (!S.next(0, cur)) return;
    f32x4 acc[2][2][4][2];
#pragma unroll
    for (int a = 0; a < 2; ++a)
#pragma unroll
        for (int b = 0; b < 2; ++b)
#pragma unroll
            for (int m = 0; m < 4; ++m)
#pragma unroll
                for (int n = 0; n < 2; ++n) acc[a][b][m][n] = (f32x4){0.f, 0.f, 0.f, 0.f};
    bf16x8 At[4][2], B0[2][2], B1[2][2];
    const char* cA = (const char*)g.A + (size_t)cur.pm * tstepA; const char* cB = (const char*)g.Bt + (size_t)cur.pn * tstepB;
    S.a_ready(cur);
    if constexpr (SP2) {
        PG8_STAGE(PG8_SB(0, 0), cB, voffB); PG8_STAGE(PG8_SB(0, 1), cB + hstepB, voffB); PG8_STAGE(PG8_SA(0, 0), cA, voffA); PG8_STAGE(PG8_SA(0, 1), cA + hstepA, voffA);
        if (wr == 1) PG8_BAR;
        PG8_WAIT_V(2); PG8_BAR;
        PG8_STAGE(PG8_SB(1, 0), cB + kstep, voffB); PG8_STAGE(PG8_SA(1, 0), cA + kstep, voffA); PG8_STAGE(PG8_SB(1, 1), cB + hstepB + kstep, voffB);
        PG8_WAIT_V(6); PG8_BAR;
    } else {
        PG8_STAGE(PG8_SB(0, 0), cB, voffB); PG8_STAGE(PG8_SA(0, 0), cA, voffA); PG8_STAGE(PG8_SB(0, 1), cB + hstepB, voffB); PG8_STAGE(PG8_SA(0, 1), cA + hstepA, voffA);
        if (wr == 1) PG8_BAR;
        PG8_WAIT_V(4); PG8_BAR;
        PG8_STAGE(PG8_SB(1, 0), cB + kstep, voffB); PG8_STAGE(PG8_SA(1, 0), cA + kstep, voffA); PG8_STAGE(PG8_SB(1, 1), cB + hstepB + kstep, voffB);
        PG8_WAIT_V(6); PG8_BAR;
    }
    for (;;) {
        const bool has_next = S.next(ui + 1, nxt);
        const char* nA = has_next ? (const char*)g.A + (size_t)nxt.pm * tstepA : cA; const char* nB = has_next ? (const char*)g.Bt + (size_t)nxt.pn * tstepB : cB;
        for (int t = 0; t < nt; t += 2) {
            const bool last = (t == nt - 2);
            long long oa1 = 0, oa2 = 0, ob2 = 0;
            if constexpr (SPLIT) { if (t == sp.ksplit) E.mid(acc, cur, wr, wc, fr, fq);
                if (t >= sp.ksplit) oa1 = sp.dA2; if (t + 2 >= sp.ksplit) { oa2 = sp.dA2; ob2 = sp.dB2; } }
            const char* a1 = cA + (size_t)(t + 1) * kstep + oa1;
            const char* a2 = last ? nA : cA + (size_t)(t + 2) * kstep + oa2; const char* b2 = last ? nB : cB + (size_t)(t + 2) * kstep + ob2;
            const char* a3 = a2 + kstep; const char* b3 = b2 + kstep;
            if (last && has_next) S.a_ready(nxt);
            if constexpr (SP2) {
            PG8_LDB(B0, 0, 0); PG8_LDB(B1, 0, 1); PG8_SCHED; PG8_LDA(At, 0, 0); PG8_STAGE(PG8_SA(1, 1), a1 + hstepA, voffA);
            PG8_WAIT_V(8); PG8_WAIT_L(0); PG8_BAR; PG8_MMA(0, 0, At, B0); PG8_MMA(0, 1, At, B1); PG8_BAR; PG8_SCHED;
            PG8_LDA(At, 0, 1); PG8_STAGE(PG8_SB(0, 0), b2, voffB); PG8_STAGE(PG8_SB(0, 1), b2 + hstepB, voffB); PG8_STAGE(PG8_SA(0, 0), a2, voffA);
            PG8_WAIT_V(8); PG8_WAIT_L(0); PG8_BAR; PG8_MMA(1, 0, At, B0); PG8_MMA(1, 1, At, B1); PG8_BAR; PG8_SCHED;
            PG8_LDB(B0, 1, 0); PG8_LDB(B1, 1, 1); PG8_SCHED; PG8_LDA(At, 1, 0); PG8_STAGE(PG8_SA(0, 1), a2 + hstepA, voffA);
            PG8_WAIT_V(8); PG8_WAIT_L(0); PG8_BAR; PG8_MMA(0, 0, At, B0); PG8_MMA(0, 1, At, B1); PG8_BAR; PG8_SCHED;
            PG8_LDA(At, 1, 1); PG8_STAGE(PG8_SB(1, 0), b3, voffB); PG8_STAGE(PG8_SB(1, 1), b3 + hstepB, voffB); PG8_STAGE(PG8_SA(1, 0), a3, voffA);
            PG8_WAIT_V(8); PG8_WAIT_L(0); PG8_BAR; PG8_MMA(1, 0, At, B0); PG8_MMA(1, 1, At, B1); PG8_BAR; PG8_SCHED;
            } else {
            PG8_LDB(B0, 0, 0); PG8_SCHED; PG8_LDA(At, 0, 0); PG8_STAGE(PG8_SA(1, 1), a1 + hstepA, voffA);
            PG8_WAIT_L(8); PG8_BAR; PG8_WAIT_L(0); PG8_MMA(0, 0, At, B0); PG8_BAR; PG8_SCHED;
            PG8_LDB(B1, 0, 1); PG8_STAGE(PG8_SB(0, 0), b2, voffB);
            PG8_BAR; PG8_WAIT_L(0); PG8_MMA(0, 1, At, B1); PG8_BAR;
            PG8_LDA(At, 0, 1); PG8_STAGE(PG8_SA(0, 0), a2, voffA);
            PG8_BAR; PG8_WAIT_L(0); PG8_MMA(1, 0, At, B0); PG8_BAR; PG8_SCHED;
            PG8_STAGE(PG8_SB(0, 1), b2 + hstepB, voffB);
            PG8_WAIT_V(6); PG8_BAR; PG8_MMA(1, 1, At, B1); PG8_BAR;
            PG8_LDB(B0, 1, 0); PG8_SCHED; PG8_LDA(At, 1, 0); PG8_STAGE(PG8_SA(0, 1), a2 + hstepA, voffA);
            PG8_WAIT_L(8); PG8_BAR; PG8_WAIT_L(0); PG8_MMA(0, 0, At, B0); PG8_BAR; PG8_SCHED;
            PG8_LDB(B1, 1, 1); PG8_STAGE(PG8_SB(1, 0), b3, voffB);
            PG8_BAR; PG8_WAIT_L(0); PG8_MMA(0, 1, At, B1); PG8_BAR;
            PG8_LDA(At, 1, 1); PG8_STAGE(PG8_SA(1, 0), a3, voffA);
            PG8_BAR; PG8_WAIT_L(0); PG8_MMA(1, 0, At, B0); PG8_BAR; PG8_SCHED;
            PG8_STAGE(PG8_SB(1, 1), b3 + hstepB, voffB);
            PG8_WAIT_V(6); PG8_BAR; PG8_MMA(1, 1, At, B1); PG8_BAR;
            }
        }
        if constexpr (ALIGN_EPI) { if (wr == 0) PG8_BAR; }
        if constexpr (!Epi::AFTER_DRAIN) { E(acc, cur, wr, wc, fr, fq); S.done(cur); }
        if (!has_next) break;
#pragma unroll
        for (int a = 0; a < 2; ++a)
#pragma unroll
            for (int b = 0; b < 2; ++b)
#pragma unroll
                for (int m = 0; m < 4; ++m)
#pragma unroll
                    for (int n = 0; n < 2; ++n) acc[a][b][m][n] = (f32x4){0.f, 0.f, 0.f, 0.f};
        cur = nxt; cA = nA; cB = nB; ++ui;
        if constexpr (ALIGN_EPI) { if (wr == 1) PG8_BAR; }
    }
    PG8_WAIT_V(0);
    if constexpr (!ALIGN_EPI) { if (wr == 0) PG8_BAR; }
    PG8_BAR;
    if constexpr (Epi::AFTER_DRAIN) { E.fused(acc, cur, wr, wc, fr, fq, lds, wid, lane); S.done(cur); }
#undef PG8_SA
#undef PG8_SB
#undef PG8_STAGE
#undef PG8_LDA
#undef PG8_LDB
#undef PG8_MMA
#undef PG8_WAIT_V
#undef PG8_WAIT_L
#undef PG8_BAR
#undef PG8_SCHED
}
}


constexpr int S = 16384, D = 1024, NCOLS = 8192, MEMN = 256;
typedef unsigned short bf16;
typedef float f32x4 __attribute__((ext_vector_type(4)));
typedef unsigned u32x4 __attribute__((ext_vector_type(4)));
typedef unsigned u32x2 __attribute__((ext_vector_type(2)));
__device__ __forceinline__ void st16wt(void* p, u32x4 v) { asm volatile("global_store_dwordx4 %0, %1, off sc1\n\ts_nop 1" :: "v"(p), "v"(v) : "memory"); }
#define LAS __attribute__((address_space(3)))

__device__ const unsigned char T5_BUCKET[128] = {0, 1, 2, 3, 4, 5, 6, 7, 8, 9, 10, 11, 12, 13, 14, 15, 16, 16, 16, 17, 17, 18, 18, 18, 19, 19, 19, 20, 20, 20, 20, 21, 21, 21, 21, 22, 22, 22, 22, 22, 23, 23, 23, 23, 23, 23, 24, 24, 24, 24, 24, 24, 25, 25, 25, 25, 25, 25, 25, 26, 26, 26, 26, 26, 26, 26, 26, 27, 27, 27, 27, 27, 27, 27, 27, 27, 27, 28, 28, 28, 28, 28, 28, 28, 28, 28, 28, 29, 29, 29, 29, 29, 29, 29, 29, 29, 29, 29, 29, 30, 30, 30, 30, 30, 30, 30, 30, 30, 30, 30, 30, 30, 30, 31, 31, 31, 31, 31, 31, 31, 31, 31, 31, 31, 31, 31, 31, 31};

constexpr size_t MiB = 1u << 20;
constexpr size_t WS_CTL = 0, WS_KMAX = 32768  , WS_RSTD0 = 512 * 1024;
constexpr size_t WS_WT_IN = 1 * MiB, WS_WT_CONV = 17 * MiB, WS_WT_ATTN = 19 * MiB, WS_WT_MIX = 21 * MiB, WS_WT_CQ = 23 * MiB, WS_WT_CO = 25 * MiB, WS_WT_PQ = 27 * MiB;
constexpr size_t WS_SUBK = 31 * MiB, WS_KV = 32 * MiB, WS_SS1 = 34 * MiB, WS_SS2 = 35 * MiB;
constexpr size_t WS_TOPK = 36 * MiB  , WS_PU = 196 * MiB  , WS_PV = 228 * MiB  ;
constexpr size_t WS_WQK = 23 * MiB  , WS_VW = 212 * MiB  ;
constexpr size_t WS_PQS = 52 * MiB  , WS_KS = 132 * MiB  ;
constexpr size_t WS_A0 = 36 * MiB, WS_A1 = 68 * MiB, WS_A2 = 100 * MiB, WS_A3 = 132 * MiB, WS_A4 = 164 * MiB, WS_A5 = 196 * MiB, WS_A6 = 228 * MiB, WS_END = 260 * MiB;

__device__ __forceinline__ float wave_sum(float v) {
#pragma unroll
    for (int o = 1; o < 64; o <<= 1) v += __shfl_xor(v, o);
    return v;
}
__device__ __forceinline__ float wave_max(float v) {
#pragma unroll
    for (int o = 1; o < 64; o <<= 1) v = fmaxf(v, __shfl_xor(v, o));
    return v;
}
__device__ __forceinline__ int opaque_tid(int wv) { int t; asm volatile("v_mbcnt_lo_u32_b32 %0, -1, 0\n\tv_mbcnt_hi_u32_b32 %0, -1, %0" : "=v"(t)); return t + wv * 64; }
__device__ __forceinline__ unsigned f2bf(float f) { unsigned u = __builtin_bit_cast(unsigned, f); return (u + 0x7fffu + ((u >> 16) & 1u)) >> 16; }
__device__ __forceinline__ unsigned pk2(float lo, float hi) { return pg8::cvt_pk_bf16(lo, hi); }
__device__ __forceinline__ float bflo(unsigned w) { return __builtin_bit_cast(float, w << 16); }
__device__ __forceinline__ float bfhi(unsigned w) { return __builtin_bit_cast(float, w & 0xffff0000u); }
__device__ __forceinline__ float sigmoidf_(float x) { return 1.0f / (1.0f + __expf(-x)); }

struct Args { const float* in[25]; float* out; unsigned char* ws; int ph_lo, ph_hi; };
enum { I_X = 0, I_MEM, I_NORM_MIX_G, I_W_IN, I_CONV_W, I_W_CONV_OUT, I_LQ1, I_LK1, I_LQ2, I_LK2, I_SUBLN_G, I_W_ATTN_OUT, I_W_MIX_OUT, I_REL_BIAS, I_NORM_CROSS_G, I_NORM_MEM_G,
       I_W_CQ, I_W_CKV, I_W_CO, I_NORM_FFN_G, I_W_PQ, I_SUB_KEYS, I_PEER_U, I_PEER_V, I_FINAL_G };

namespace pg8 {
template <int CTRL> __device__ __forceinline__ float dppf(float x) { return __builtin_bit_cast(float, __builtin_amdgcn_mov_dpp(__builtin_bit_cast(int, x), CTRL, 0xf, 0xf, true)); }
__device__ __forceinline__ float row16_max(float v) { v = fmaxf(v, dppf<0xB1>(v)); v = fmaxf(v, dppf<0x4E>(v)); v = fmaxf(v, dppf<0x141>(v)); return fmaxf(v, dppf<0x140>(v)); }
__device__ __forceinline__ float xrow16_max(float x) {
    auto s = __builtin_amdgcn_permlane16_swap(__float_as_uint(x), __float_as_uint(x), false, false); x = fmaxf(__uint_as_float(s[0]), __uint_as_float(s[1]));
    auto t = __builtin_amdgcn_permlane32_swap(__float_as_uint(x), __float_as_uint(x), false, false); return fmaxf(__uint_as_float(t[0]), __uint_as_float(t[1])); }
__device__ __forceinline__ float xrow16_sum(float x) {
    auto s = __builtin_amdgcn_permlane16_swap(__float_as_uint(x), __float_as_uint(x), false, false); x = __uint_as_float(s[0]) + __uint_as_float(s[1]);
    auto t = __builtin_amdgcn_permlane32_swap(__float_as_uint(x), __float_as_uint(x), false, false); return __uint_as_float(t[0]) + __uint_as_float(t[1]); }
__device__ __forceinline__ u32x4 pack8(const f32x4& v0, const f32x4& v1) { u32x4 w; w.x = cvt_pk_bf16(v0[0], v0[1]); w.y = cvt_pk_bf16(v0[2], v0[3]); w.z = cvt_pk_bf16(v1[0], v1[1]); w.w = cvt_pk_bf16(v1[2], v1[3]); return w; }
struct EpiProj {
    static constexpr bool PERM = true, AFTER_DRAIN = false;
    const float* rstd; bf16_t *CB, *U, *Q, *K, *V, *SGC, *SGA; float qscale; unsigned* KMAX;
    __device__ __forceinline__ void operator()(const f32x4 (&acc)[2][2][4][2], const Unit& u, int wr, int wc, int fr0, int fq) const {
        int fr = fr0; asm volatile("" : "+v"(fr));
        const int row0 = u.pm * BM + wr * 64 + fr, pn = u.pn, colw = wc * 32 + 8 * fq;
        if (pn >= 4 && pn < 12) {
            const int col = 128 * (pn - 4) + colw;
#pragma unroll
            for (int ai = 0; ai < 2; ++ai)
#pragma unroll
                for (int m = 0; m < 4; ++m) { const int row = row0 + ai * HALF + m * 16; const float rs = rstd[row], r2 = rs * rs;
                    const f32x4 v0 = acc[ai][0][m][0] * acc[ai][1][m][0] * r2, v1 = acc[ai][0][m][1] * acc[ai][1][m][1] * r2;
                    *(u32x4*)(U + (size_t)row * 1024 + col) = pack8(v0, v1); }
            return;
        }
        bf16_t* base; int cbase; float sc = 1.f; bool gate = false;
        if (pn < 4) { base = CB; cbase = pn * 256; }
        else if (pn < 16) { base = Q; cbase = (pn - 12) * 256; sc = qscale; }
        else if (pn < 20) { base = K; cbase = (pn - 16) * 256; }
        else if (pn < 24) { base = V; cbase = (pn - 20) * 256; }
        else if (pn < 28) { base = SGC; cbase = (pn - 24) * 256; gate = true; }
        else { base = SGA; cbase = (pn - 28) * 256; gate = true; }
#pragma unroll
        for (int ai = 0; ai < 2; ++ai)
#pragma unroll
            for (int m = 0; m < 4; ++m) { const int row = row0 + ai * HALF + m * 16; const float rs = rstd[row] * sc;
#pragma unroll
                for (int bj = 0; bj < 2; ++bj) { f32x4 v0 = acc[ai][bj][m][0] * rs, v1 = acc[ai][bj][m][1] * rs;
                    if (gate) {
#pragma unroll
                        for (int e = 0; e < 4; ++e) { v0[e] = sigmoidf_(v0[e]); v1[e] = sigmoidf_(v1[e]); } }
                    *(u32x4*)(base + (size_t)row * 1024 + cbase + bj * HALF + colw) = pack8(v0, v1); } }
        if (pn >= 16 && pn < 20) {
            float mx[2] = {0.f, 0.f};
#pragma unroll
            for (int ai = 0; ai < 2; ++ai)
#pragma unroll
                for (int m = 0; m < 4; ++m) { const float rs = rstd[row0 + ai * HALF + m * 16];
#pragma unroll
                    for (int bj = 0; bj < 2; ++bj) { const f32x4 v0 = acc[ai][bj][m][0] * rs, v1 = acc[ai][bj][m][1] * rs;
                        const float s = xrow16_sum(((v0[0] * v0[0] + v0[1] * v0[1]) + (v0[2] * v0[2] + v0[3] * v0[3])) + ((v1[0] * v1[0] + v1[1] * v1[1]) + (v1[2] * v1[2] + v1[3] * v1[3])));
                        mx[bj] = fmaxf(mx[bj], s); } }
#pragma unroll
            for (int bj = 0; bj < 2; ++bj) { float v = mx[bj];
                v = row16_max(v);
                if (fr == 0 && fq == 0) atomicMax(KMAX + (((pn - 16) * 2 + bj) * 2 + (wc >> 1)) * 2 + (wc & 1), __float_as_uint(v)); }
        }
    }
};
struct EpiGateT {
    static constexpr bool PERM = true, AFTER_DRAIN = false;
    const bf16_t* SG; float* T;
    __device__ __forceinline__ void operator()(const f32x4 (&acc)[2][2][4][2], const Unit& u, int wr, int wc, int fr0, int fq) const {
        int fr = fr0; asm volatile("" : "+v"(fr));
        const int row0 = u.pm * BM + wr * 64 + fr, col0 = u.pn * BM + wc * 32 + 8 * fq;
#pragma unroll
        for (int ai = 0; ai < 2; ++ai)
#pragma unroll
            for (int m = 0; m < 4; ++m) { const size_t off = (size_t)(row0 + ai * HALF + m * 16) * 1024 + col0;
#pragma unroll
                for (int bj = 0; bj < 2; ++bj) { const u32x4 g = *(const u32x4*)(SG + off + bj * HALF);
                    f32x4 g0 = {bflo(g.x), bfhi(g.x), bflo(g.y), bfhi(g.y)}, g1 = {bflo(g.z), bfhi(g.z), bflo(g.w), bfhi(g.w)};
                    *(f32x4*)(T + off + bj * HALF) = g0 * acc[ai][bj][m][0]; *(f32x4*)(T + off + bj * HALF + 4) = g1 * acc[ai][bj][m][1]; } }
    }
};
struct EpiMerge {
    static constexpr bool PERM = true, AFTER_DRAIN = false;
    const float* T; const bf16_t* SG; bf16_t* O;
    __device__ __forceinline__ void operator()(const f32x4 (&acc)[2][2][4][2], const Unit& u, int wr, int wc, int fr0, int fq) const {
        int fr = fr0; asm volatile("" : "+v"(fr));
        const int row0 = u.pm * BM + wr * 64 + fr, col0 = u.pn * BM + wc * 32 + 8 * fq;
#pragma unroll
        for (int ai = 0; ai < 2; ++ai)
#pragma unroll
            for (int m = 0; m < 4; ++m) { const size_t off = (size_t)(row0 + ai * HALF + m * 16) * 1024 + col0;
#pragma unroll
                for (int bj = 0; bj < 2; ++bj) { const u32x4 g = *(const u32x4*)(SG + off + bj * HALF);
                    f32x4 g0 = {bflo(g.x), bfhi(g.x), bflo(g.y), bfhi(g.y)}, g1 = {bflo(g.z), bfhi(g.z), bflo(g.w), bfhi(g.w)};
                    const f32x4 t0 = *(const f32x4*)(T + off + bj * HALF), t1 = *(const f32x4*)(T + off + bj * HALF + 4);
                    *(u32x4*)(O + off + bj * HALF) = pack8(t0 + g0 * acc[ai][bj][m][0], t1 + g1 * acc[ai][bj][m][1]); } }
    }
};
struct EpiMergeK {
    static constexpr bool PERM = true, AFTER_DRAIN = false;
    const bf16_t* SGc; const bf16_t* SGa; bf16_t* O;
    __device__ __forceinline__ void mid(f32x4 (&acc)[2][2][4][2], const Unit& u, int wr, int wc, int fr0, int fq) const {
        int fr = fr0; asm volatile("" : "+v"(fr));
        const int row0 = u.pm * BM + wr * 64 + fr, col0 = u.pn * BM + wc * 32 + 8 * fq;
#pragma unroll
        for (int ai = 0; ai < 2; ++ai)
#pragma unroll
            for (int m = 0; m < 4; ++m) { const size_t off = (size_t)(row0 + ai * HALF + m * 16) * 1024 + col0;
#pragma unroll
                for (int bj = 0; bj < 2; ++bj) { const u32x4 c = *(const u32x4*)(SGc + off + bj * HALF), g = *(const u32x4*)(SGa + off + bj * HALF);
                    const f32x4 c0 = {bflo(c.x), bfhi(c.x), bflo(c.y), bfhi(c.y)}, c1 = {bflo(c.z), bfhi(c.z), bflo(c.w), bfhi(c.w)};
                    f32x4 g0 = {bflo(g.x), bfhi(g.x), bflo(g.y), bfhi(g.y)}, g1 = {bflo(g.z), bfhi(g.z), bflo(g.w), bfhi(g.w)};
#pragma unroll
                    for (int e = 0; e < 4; ++e) { g0[e] = c0[e] * __builtin_amdgcn_rcpf(fmaxf(g0[e], 1e-20f)); g1[e] = c1[e] * __builtin_amdgcn_rcpf(fmaxf(g1[e], 1e-20f)); }
                    acc[ai][bj][m][0] *= g0; acc[ai][bj][m][1] *= g1; } }
    }
    __device__ __forceinline__ void operator()(const f32x4 (&acc)[2][2][4][2], const Unit& u, int wr, int wc, int fr0, int fq) const {
        int fr = fr0; asm volatile("" : "+v"(fr));
        const int row0 = u.pm * BM + wr * 64 + fr, col0 = u.pn * BM + wc * 32 + 8 * fq;
#pragma unroll
        for (int ai = 0; ai < 2; ++ai)
#pragma unroll
            for (int m = 0; m < 4; ++m) { const size_t off = (size_t)(row0 + ai * HALF + m * 16) * 1024 + col0;
#pragma unroll
                for (int bj = 0; bj < 2; ++bj) { const u32x4 g = *(const u32x4*)(SGa + off + bj * HALF);
                    f32x4 g0 = {bflo(g.x), bfhi(g.x), bflo(g.y), bfhi(g.y)}, g1 = {bflo(g.z), bfhi(g.z), bflo(g.w), bfhi(g.w)};
#pragma unroll
                    for (int e = 0; e < 4; ++e) { g0[e] = fmaxf(g0[e], 1e-20f); g1[e] = fmaxf(g1[e], 1e-20f); }
                    st16wt(O + off + bj * HALF, pack8(g0 * acc[ai][bj][m][0], g1 * acc[ai][bj][m][1])); } }
    }
};
struct EpiResid {
    static constexpr bool PERM = true, AFTER_DRAIN = false;
    const float* R; bf16_t* XB; float* SS;
    __device__ __forceinline__ void operator()(const f32x4 (&acc)[2][2][4][2], const Unit& u, int wr, int wc, int fr0, int fq) const {
        int fr = fr0; asm volatile("" : "+v"(fr));
        const int row0 = u.pm * BM + wr * 64 + fr, col0 = u.pn * BM + wc * 32 + 8 * fq;
#pragma unroll
        for (int ai = 0; ai < 2; ++ai)
#pragma unroll
            for (int m = 0; m < 4; ++m) { const int row = row0 + ai * HALF + m * 16; const size_t off = (size_t)row * 1024 + col0; float ss = 0.f;
#pragma unroll
                for (int bj = 0; bj < 2; ++bj) {
                    const f32x4 x0 = *(const f32x4*)(R + off + bj * HALF) + acc[ai][bj][m][0], x1 = *(const f32x4*)(R + off + bj * HALF + 4) + acc[ai][bj][m][1];
                    st16wt(XB + off + bj * HALF, pack8(x0, x1));
                    ss += (x0[0] * x0[0] + x0[1] * x0[1]) + (x0[2] * x0[2] + x0[3] * x0[3]) + (x1[0] * x1[0] + x1[1] * x1[1]) + (x1[2] * x1[2] + x1[3] * x1[3]); }
                ss = xrow16_sum(ss);
                if (fq == 0) SS[(size_t)row * 16 + u.pn * 4 + wc] = ss; }
    }
};
struct EpiResidB {
    static constexpr bool PERM = true, AFTER_DRAIN = false;
    bf16_t* XB; float* SS;
    __device__ __forceinline__ void operator()(const f32x4 (&acc)[2][2][4][2], const Unit& u, int wr, int wc, int fr0, int fq) const {
        int fr = fr0; asm volatile("" : "+v"(fr));
        const int row0 = u.pm * BM + wr * 64 + fr, col0 = u.pn * BM + wc * 32 + 8 * fq;
#pragma unroll
        for (int ai = 0; ai < 2; ++ai)
#pragma unroll
            for (int m = 0; m < 4; ++m) { const int row = row0 + ai * HALF + m * 16; const size_t off = (size_t)row * 1024 + col0; float ss = 0.f;
#pragma unroll
                for (int bj = 0; bj < 2; ++bj) { const u32x4 g = *(const u32x4*)(XB + off + bj * HALF);
                    const f32x4 r0 = {bflo(g.x), bfhi(g.x), bflo(g.y), bfhi(g.y)}, r1 = {bflo(g.z), bfhi(g.z), bflo(g.w), bfhi(g.w)};
                    const f32x4 x0 = r0 + acc[ai][bj][m][0], x1 = r1 + acc[ai][bj][m][1];
                    st16wt(XB + off + bj * HALF, pack8(x0, x1));
                    ss += (x0[0] * x0[0] + x0[1] * x0[1]) + (x0[2] * x0[2] + x0[3] * x0[3]) + (x1[0] * x1[0] + x1[1] * x1[1]) + (x1[2] * x1[2] + x1[3] * x1[3]); }
                ss = xrow16_sum(ss);
                if (fq == 0) SS[(size_t)row * 16 + u.pn * 4 + wc] = ss; }
    }
};
struct EpiRowScale {
    static constexpr bool PERM = true, AFTER_DRAIN = false;
    const float* SS; bf16_t* O; int ldc; float sc;
    __device__ __forceinline__ void operator()(const f32x4 (&acc)[2][2][4][2], const Unit& u, int wr, int wc, int fr0, int fq) const {
        int fr = fr0; asm volatile("" : "+v"(fr));
        const int row0 = u.pm * BM + wr * 64 + fr, col0 = u.pn * BM + wc * 32 + 8 * fq;
#pragma unroll
        for (int ai = 0; ai < 2; ++ai)
#pragma unroll
            for (int m = 0; m < 4; ++m) { const int row = row0 + ai * HALF + m * 16;
                const f32x4* sp = (const f32x4*)(SS + (size_t)row * 16); const f32x4 s4 = (sp[0] + sp[1]) + (sp[2] + sp[3]);
                const float rs = sc / sqrtf(((s4[0] + s4[1]) + (s4[2] + s4[3])) * (1.0f / 1024.0f) + 1e-6f);
#pragma unroll
                for (int bj = 0; bj < 2; ++bj) *(u32x4*)(O + (size_t)row * ldc + col0 + bj * HALF) = pack8(acc[ai][bj][m][0] * rs, acc[ai][bj][m][1] * rs); }
    }
};

__device__ __forceinline__ unsigned f2ord(float f) { const unsigned u = __builtin_bit_cast(unsigned, f); return u ^ ((unsigned)((int)u >> 31) | 0x80000000u); }
__device__ __forceinline__ float ord2f(unsigned k) { const unsigned u = (k & 0x80000000u) ? (k ^ 0x80000000u) : ~k; return __builtin_bit_cast(float, u); }
#define PG8_CSWAP(a, b) do { const unsigned hi_ = (a) > (b) ? (a) : (b), lo_ = (a) > (b) ? (b) : (a); (a) = hi_; (b) = lo_; } while (0)
__device__ __forceinline__ void sort16_desc(unsigned (&k)[16]) {
#pragma unroll
    for (int sz = 2; sz <= 16; sz <<= 1)
#pragma unroll
        for (int st = sz >> 1; st > 0; st >>= 1)
#pragma unroll
            for (int i = 0; i < 16; ++i) { const int l = i ^ st; if (l > i) { if ((i & sz) == 0) PG8_CSWAP(k[i], k[l]); else PG8_CSWAP(k[l], k[i]); } }
}
__device__ __forceinline__ void merge16_desc(unsigned (&a)[16], const unsigned (&b)[16]) {
#pragma unroll
    for (int i = 0; i < 16; ++i) a[i] = a[i] > b[15 - i] ? a[i] : b[15 - i];
#pragma unroll
    for (int st = 8; st > 0; st >>= 1)
#pragma unroll
        for (int i = 0; i < 16; ++i) { const int l = i ^ st; if (l > i) PG8_CSWAP(a[i], a[l]); }
}
struct EpiKeys {
    static constexpr bool PERM = true, AFTER_DRAIN = false;
    const float* SS; unsigned* KS;
    __device__ __forceinline__ void operator()(const f32x4 (&acc)[2][2][4][2], const Unit& u, int wr, int wc, int fr0, int fq) const {
        int fr = fr0; asm volatile("" : "+v"(fr));
#pragma unroll
        for (int ai = 0; ai < 2; ++ai)
#pragma unroll
            for (int m = 0; m < 4; ++m) { const int row = ai * HALF + wr * 64 + m * 16 + fr;
                const f32x4* sp = (const f32x4*)(SS + (size_t)(u.pm * BM + row) * 16); const f32x4 s4 = (sp[0] + sp[1]) + (sp[2] + sp[3]);
                const float rs = 1.0f / sqrtf(((s4[0] + s4[1]) + (s4[2] + s4[3])) * (1.0f / 1024.0f) + 1e-6f);
#pragma unroll
                for (int bj = 0; bj < 2; ++bj)
#pragma unroll
                    for (int n = 0; n < 2; ++n) { const int cw = wc * 32 + 8 * fq + 4 * n; u32x4 k;
#pragma unroll
                        for (int e = 0; e < 4; ++e) k[e] = (f2ord(acc[ai][bj][m][n][e] * rs) & ~0x7Fu) | (unsigned)(127 - (cw + e));
                        *(u32x4*)(KS + row * 256 + bj * HALF + cw) = k; } }
    }
};
__device__ __forceinline__ void topk_from_keys(int tid, const unsigned* KS, unsigned* TOPK, int tok0, int h) {
#pragma unroll 1
    for (int ai = 0; ai < 2; ++ai) {
        const int j = tid & 1, rl = (tid >> 1) & 127, c = tid >> 8;
        const unsigned* src = KS + (ai * 128 + rl) * 256 + c * 128 + j * 64;
        unsigned best[16], cur[16];
        { const u32x4 a0 = *(const u32x4*)src, a1 = *(const u32x4*)(src + 4), a2 = *(const u32x4*)(src + 8), a3 = *(const u32x4*)(src + 12);
#pragma unroll
          for (int e = 0; e < 4; ++e) { best[e] = a0[e]; best[4 + e] = a1[e]; best[8 + e] = a2[e]; best[12 + e] = a3[e]; } }
        sort16_desc(best);
#pragma unroll 1
        for (int gq = 1; gq < 4; ++gq) {
            const u32x4 a0 = *(const u32x4*)(src + gq * 16), a1 = *(const u32x4*)(src + gq * 16 + 4), a2 = *(const u32x4*)(src + gq * 16 + 8), a3 = *(const u32x4*)(src + gq * 16 + 12);
#pragma unroll
            for (int e = 0; e < 4; ++e) { cur[e] = a0[e]; cur[4 + e] = a1[e]; cur[8 + e] = a2[e]; cur[12 + e] = a3[e]; }
            sort16_desc(cur); merge16_desc(best, cur); }
#pragma unroll
        for (int i = 0; i < 16; ++i) cur[i] = (unsigned)__shfl_xor((int)best[i], 1);
        merge16_desc(best, cur);
        unsigned* dst = TOPK + ((size_t)(tok0 + ai * 128 + rl) * 8 + h) * 32 + c * 16 + j * 8;
        u32x4 w0, w1;
        if (j == 0) { w0 = (u32x4){best[0], best[1], best[2], best[3]}; w1 = (u32x4){best[4], best[5], best[6], best[7]}; }
        else { w0 = (u32x4){best[8], best[9], best[10], best[11]}; w1 = (u32x4){best[12], best[13], best[14], best[15]}; }
        st16wt(dst, w0); st16wt(dst + 4, w1);
    }
}
struct EpiSoftmaxP {
    static constexpr bool PERM = true, AFTER_DRAIN = true;
    bf16_t* P; PG8_LAS float* lrow;
    __device__ __forceinline__ void fused(f32x4 (&acc)[2][2][4][2], const Unit& u, int wr, int wc, int fr0, int fq, PG8_LAS unsigned char* lds, int wid, int lane) const {
        int fr = fr0; asm volatile("" : "+v"(fr));
        PG8_LAS float* MX = (PG8_LAS float*)lds; PG8_LAS float* SM = MX + 1024;
#pragma unroll
        for (int ai = 0; ai < 2; ++ai)
#pragma unroll
            for (int m = 0; m < 4; ++m) { float mx = -INFINITY;
#pragma unroll
                for (int bj = 0; bj < 2; ++bj)
#pragma unroll
                    for (int n = 0; n < 2; ++n)
#pragma unroll
                        for (int e = 0; e < 4; ++e) mx = fmaxf(mx, acc[ai][bj][m][n][e]);
                mx = xrow16_max(mx);
                if (fq == 0) MX[(ai * HALF + wr * 64 + m * 16 + fr) * 4 + wc] = mx; }
        asm volatile("s_waitcnt lgkmcnt(0)\n\ts_barrier" ::: "memory");
#pragma unroll
        for (int ai = 0; ai < 2; ++ai)
#pragma unroll
            for (int m = 0; m < 4; ++m) { const int row = ai * HALF + wr * 64 + m * 16 + fr;
                const f32x4 m4 = *(const PG8_LAS f32x4*)(MX + row * 4); const float rm = fmaxf(fmaxf(m4[0], m4[1]), fmaxf(m4[2], m4[3])); float s = 0.f;
#pragma unroll
                for (int bj = 0; bj < 2; ++bj) { f32x4 p0, p1;
#pragma unroll
                    for (int e = 0; e < 4; ++e) { p0[e] = __builtin_amdgcn_exp2f(acc[ai][bj][m][0][e] - rm); p1[e] = __builtin_amdgcn_exp2f(acc[ai][bj][m][1][e] - rm); }
                    s += ((p0[0] + p0[1]) + (p0[2] + p0[3])) + ((p1[0] + p1[1]) + (p1[2] + p1[3]));
                    *(u32x4*)(P + (size_t)row * 256 + bj * HALF + wc * 32 + 8 * fq) = pack8(p0, p1); }
                s = xrow16_sum(s);
                if (fq == 0) SM[row * 4 + wc] = s; }
        asm volatile("s_waitcnt lgkmcnt(0)\n\ts_barrier" ::: "memory");
        const int tid = wid * 64 + lane;
        if (tid < 256) { const f32x4 s4 = *(const PG8_LAS f32x4*)(SM + tid * 4); lrow[tid] = (s4[0] + s4[1]) + (s4[2] + s4[3]); }
    }
};
struct EpiSoftmaxFull {
    static constexpr bool PERM = true, AFTER_DRAIN = true;
    const float* SS; bf16_t* P; float sc;
    __device__ __forceinline__ void fused(f32x4 (&acc)[2][2][4][2], const Unit& u, int wr, int wc, int fr0, int fq, PG8_LAS unsigned char* lds, int wid, int lane) const {
        int fr = fr0; asm volatile("" : "+v"(fr));
        PG8_LAS float* MX = (PG8_LAS float*)lds; PG8_LAS float* SM = MX + 1024;
#pragma unroll
        for (int ai = 0; ai < 2; ++ai)
#pragma unroll
            for (int m = 0; m < 4; ++m) { const int lr = ai * HALF + wr * 64 + m * 16 + fr, row = u.pm * BM + lr; float mx = -INFINITY;
                const f32x4* sp = (const f32x4*)(SS + (size_t)row * 16); const f32x4 s4 = (sp[0] + sp[1]) + (sp[2] + sp[3]);
                const float rs = sc / sqrtf(((s4[0] + s4[1]) + (s4[2] + s4[3])) * (1.0f / 1024.0f) + 1e-6f);
#pragma unroll
                for (int bj = 0; bj < 2; ++bj)
#pragma unroll
                    for (int n = 0; n < 2; ++n) { acc[ai][bj][m][n] *= rs;
#pragma unroll
                        for (int e = 0; e < 4; ++e) mx = fmaxf(mx, acc[ai][bj][m][n][e]); }
                mx = xrow16_max(mx);
                if (fq == 0) MX[lr * 4 + wc] = mx; }
        asm volatile("s_waitcnt lgkmcnt(0)\n\ts_barrier" ::: "memory");
#pragma unroll
        for (int ai = 0; ai < 2; ++ai)
#pragma unroll
            for (int m = 0; m < 4; ++m) { const int lr = ai * HALF + wr * 64 + m * 16 + fr;
                const f32x4 m4 = *(const PG8_LAS f32x4*)(MX + lr * 4); const float rm = fmaxf(fmaxf(m4[0], m4[1]), fmaxf(m4[2], m4[3])); float s = 0.f;
#pragma unroll
                for (int bj = 0; bj < 2; ++bj)
#pragma unroll
                    for (int n = 0; n < 2; ++n) {
#pragma unroll
                        for (int e = 0; e < 4; ++e) acc[ai][bj][m][n][e] = __builtin_amdgcn_exp2f(acc[ai][bj][m][n][e] - rm);
                        s += (acc[ai][bj][m][n][0] + acc[ai][bj][m][n][1]) + (acc[ai][bj][m][n][2] + acc[ai][bj][m][n][3]); }
                s = xrow16_sum(s);
                if (fq == 0) SM[lr * 4 + wc] = s; }
        asm volatile("s_waitcnt lgkmcnt(0)\n\ts_barrier" ::: "memory");
#pragma unroll
        for (int ai = 0; ai < 2; ++ai)
#pragma unroll
            for (int m = 0; m < 4; ++m) { const int lr = ai * HALF + wr * 64 + m * 16 + fr;
                const f32x4 s4 = *(const PG8_LAS f32x4*)(SM + lr * 4); const float inv = 1.0f / ((s4[0] + s4[1]) + (s4[2] + s4[3]));
#pragma unroll
                for (int bj = 0; bj < 2; ++bj)
                    st16wt(P + (size_t)(u.pm * BM + lr) * 1024 + u.pn * BM + bj * HALF + wc * 32 + 8 * fq, pack8(acc[ai][bj][m][0] * inv, acc[ai][bj][m][1] * inv)); }
    }
};
struct EpiCO {
    static constexpr bool PERM = true, AFTER_DRAIN = false;
    bf16_t* O; const PG8_LAS float* lrow;
    __device__ __forceinline__ void operator()(const f32x4 (&acc)[2][2][4][2], const Unit& u, int wr, int wc, int fr0, int fq) const {
        int fr = fr0; asm volatile("" : "+v"(fr));
#pragma unroll
        for (int ai = 0; ai < 2; ++ai)
#pragma unroll
            for (int m = 0; m < 4; ++m) { const int row = ai * HALF + wr * 64 + m * 16 + fr; const float inv = 1.0f / lrow[row];
#pragma unroll
                for (int bj = 0; bj < 2; ++bj) *(u32x4*)(O + (size_t)row * 1024 + bj * HALF + wc * 32 + 8 * fq) = pack8(acc[ai][bj][m][0] * inv, acc[ai][bj][m][1] * inv); }
    }
};
struct OneUnit {
    int pm, pn;
    __device__ __forceinline__ bool next(int i, Unit& u) const { if (i) return false; u.pm = pm; u.pn = pn; return true; }
    __device__ __forceinline__ void a_ready(const Unit&) const {}
    __device__ __forceinline__ void done(const Unit&) const {}
};
}

__device__ __forceinline__ int win_src_col(int n) {
    if (n < 1024 || n >= 3072) return n;
    const int t = (n - 1024) >> 8, j = (n - 1024) & 255;
    return j < 128 ? 1024 + 128 * t + j : 2048 + 128 * t + (j - 128);
}
__device__ __forceinline__ void p0_prologue(int wv, const Args& a, LAS unsigned char* lds, int blk, int G) {
    const int tid = opaque_tid(wv), lane = tid & 63, wave = tid >> 6;
    unsigned char* ws = a.ws;
    LAS float* tl = (LAS float*)lds;
    {
        f32x4 cur[8], nxt[8]; const float* gcur = nullptr; const float* gnxt = nullptr;
#define P0_DECODE(job, W, ldw, nb, kb, Wt, gain, perm) do { \
            if ((job) < 512) { W = a.in[I_W_IN]; ldw = NCOLS; kb = (job) >> 5; nb = (job) & 31; Wt = (bf16*)(ws + WS_WT_IN); gain = a.in[I_NORM_MIX_G]; perm = true; } \
            else { const int mat = ((job) - 512) >> 6, idx = ((job) - 512) & 63; kb = idx >> 2; nb = idx & 3; ldw = 1024; gain = nullptr; perm = false; \
                if (mat == 0) { W = a.in[I_W_CONV_OUT]; Wt = (bf16*)(ws + WS_WT_CONV); } \
                else if (mat == 1) { W = a.in[I_W_ATTN_OUT]; Wt = (bf16*)(ws + WS_WT_ATTN); } \
                else if (mat == 2) { W = a.in[I_W_MIX_OUT]; Wt = (bf16*)(ws + WS_WT_MIX); } \
                else { W = a.in[I_W_CO]; Wt = (bf16*)(ws + WS_WT_CO); } } } while (0)
#define P0_LOAD(dst, gv, job) do { const float* W; int ldw, nb, kb; bf16* Wt; const float* gain; bool perm; P0_DECODE(job, W, ldw, nb, kb, Wt, gain, perm); (void)Wt; \
            const int k0 = kb * 64, c = tid & 63, nd0 = nb * 256 + 64 * (c >> 4), ns0 = (perm ? win_src_col(nd0) : nd0) + 4 * (c & 15); gv = gain ? gain + k0 : nullptr; \
            _Pragma("unroll") for (int i = 0; i < 8; ++i) dst[i] = *(const f32x4*)(W + (size_t)(k0 + (tid >> 6) + 8 * i) * ldw + ns0); } while (0)
        if (blk < 768) P0_LOAD(cur, gcur, blk);
        for (int job = blk; job < 768; job += G) {
            if (job + G < 768) P0_LOAD(nxt, gnxt, job + G);
#pragma unroll
            for (int i = 0; i < 8; ++i) { const int kk = (tid >> 6) + 8 * i, c = tid & 63; const float gk = gcur ? gcur[kk] : 1.0f; LAS float* d = tl + kk * 257 + 4 * c;
                d[0] = cur[i][0] * gk; d[1] = cur[i][1] * gk; d[2] = cur[i][2] * gk; d[3] = cur[i][3] * gk; }
            __syncthreads();
            { const float* W; int ldw, nb, kb; bf16* Wt; const float* gain; bool perm; P0_DECODE(job, W, ldw, nb, kb, Wt, gain, perm); (void)W; (void)ldw; (void)gain; (void)perm;
#pragma unroll
              for (int r = 0; r < 4; ++r) { const int idx = tid + 512 * r, nn = idx >> 3, kq = idx & 7; const LAS float* s = tl + (kq * 8) * 257 + nn;
                  u32x4 o; o.x = pk2(s[0], s[257]); o.y = pk2(s[2 * 257], s[3 * 257]); o.z = pk2(s[4 * 257], s[5 * 257]); o.w = pk2(s[6 * 257], s[7 * 257]);
                  st16wt(Wt + (size_t)(nb * 256 + nn) * 1024 + kb * 64 + kq * 8, o); } }
            __syncthreads();
#pragma unroll
            for (int i = 0; i < 8; ++i) cur[i] = nxt[i];
            gcur = gnxt;
        }
#undef P0_DECODE
#undef P0_LOAD
    }
    { const float* x = a.in[I_X]; bf16* XB = (bf16*)(ws + WS_A0); float* rstd0 = (float*)(ws + WS_RSTD0);
      f32x4 v[4], w4[4]; int row = blk * 8 + wave;
#define P0_XLOAD(dst, r) do { const f32x4* xr = (const f32x4*)(x + (size_t)(r) * D) + 2 * lane; dst[0] = xr[0]; dst[1] = xr[1]; dst[2] = xr[128]; dst[3] = xr[129]; } while (0)
      if (row < S) P0_XLOAD(v, row);
      for (; row < S; row += G * 8) {
          if (row + G * 8 < S) P0_XLOAD(w4, row + G * 8);
          float s = 0.f;
#pragma unroll
          for (int j = 0; j < 4; ++j) s += (v[j][0] * v[j][0] + v[j][1] * v[j][1]) + (v[j][2] * v[j][2] + v[j][3] * v[j][3]);
          s = wave_sum(s);
          if (lane == 0) rstd0[row] = 1.0f / sqrtf(s * (1.0f / D) + 1e-6f);
          bf16* o = XB + (size_t)row * D + 8 * lane;
#pragma unroll
          for (int j = 0; j < 2; ++j) { u32x4 w; w.x = pk2(v[2 * j][0], v[2 * j][1]); w.y = pk2(v[2 * j][2], v[2 * j][3]); w.z = pk2(v[2 * j + 1][0], v[2 * j + 1][1]); w.w = pk2(v[2 * j + 1][2], v[2 * j + 1][3]);
              st16wt(o + 512 * j, w); }
#pragma unroll
          for (int j = 0; j < 4; ++j) v[j] = w4[j];
      }
#undef P0_XLOAD
    }
    { typedef short bf16x8_t __attribute__((ext_vector_type(8))); typedef float f32x16_t __attribute__((ext_vector_type(16)));
      LAS bf16* mnb = (LAS bf16*)lds;
      LAS float* red = (LAS float*)(lds + 32 * 1032 * 2);
      const float* mem = a.in[I_MEM]; const float* g = a.in[I_NORM_MEM_G]; const float* Wc = a.in[I_W_CKV]; bf16* KC = (bf16*)(ws + WS_KV); bf16* VC = KC + 4 * 256 * 256;
      const int r32 = lane & 31, kg = lane >> 5;
      for (int wb = blk; wb < 256; wb += G) {
          const int m0 = (wb >> 5) * 32, n0 = (wb & 31) * 64;
          __syncthreads();
#pragma unroll
          for (int r = 0; r < 4; ++r) { const int rr = wave * 4 + r; const f32x4* mr = (const f32x4*)(mem + (size_t)(m0 + rr) * D) + lane; f32x4 v[4]; float s = 0.f;
#pragma unroll
              for (int j = 0; j < 4; ++j) { v[j] = mr[64 * j]; s += (v[j][0] * v[j][0] + v[j][1] * v[j][1]) + (v[j][2] * v[j][2] + v[j][3] * v[j][3]); }
              s = wave_sum(s); const float rs = 1.0f / sqrtf(s * (1.0f / D) + 1e-6f);
#pragma unroll
              for (int j = 0; j < 4; ++j) { const f32x4 gg = ((const f32x4*)g)[lane + 64 * j]; const f32x4 y = v[j] * rs * gg; u32x2 w; w.x = pk2(y[0], y[1]); w.y = pk2(y[2], y[3]);
                  *(LAS u32x2*)(mnb + rr * 1032 + 4 * (lane + 64 * j)) = w; } }
          __syncthreads();
          const int it = wave & 1, kq = wave >> 1, ncol = n0 + 32 * it + r32;
          f32x16_t acc;
#pragma unroll
          for (int r = 0; r < 16; ++r) acc[r] = 0.f;
#pragma unroll 1
          for (int half = 0; half < 2; ++half) {
              float wv_[8][8];
#pragma unroll
              for (int s = 0; s < 8; ++s)
#pragma unroll
                  for (int j = 0; j < 8; ++j) wv_[s][j] = Wc[(size_t)(256 * kq + 128 * half + 16 * s + 8 * kg + j) * 2048 + ncol];
#pragma unroll
              for (int s = 0; s < 8; ++s) {
                  u32x4 bw; bw.x = pk2(wv_[s][0], wv_[s][1]); bw.y = pk2(wv_[s][2], wv_[s][3]); bw.z = pk2(wv_[s][4], wv_[s][5]); bw.w = pk2(wv_[s][6], wv_[s][7]);
                  const bf16x8_t af = *(const LAS bf16x8_t*)(mnb + r32 * 1032 + 256 * kq + 128 * half + 16 * s + 8 * kg);
                  acc = __builtin_amdgcn_mfma_f32_32x32x16_bf16(af, __builtin_bit_cast(bf16x8_t, bw), acc, 0, 0, 0); }
          }
#pragma unroll
          for (int r = 0; r < 16; ++r) red[((it * 4 + kq) * 16 + r) * 64 + lane] = acc[r];
          __syncthreads();
          if (kq == 0) {
#pragma unroll
              for (int r = 0; r < 16; ++r) acc[r] = (red[((it * 4 + 0) * 16 + r) * 64 + lane] + red[((it * 4 + 1) * 16 + r) * 64 + lane]) + (red[((it * 4 + 2) * 16 + r) * 64 + lane] + red[((it * 4 + 3) * 16 + r) * 64 + lane]);
              if (ncol < 1024) {
#pragma unroll
                  for (int r = 0; r < 16; ++r) KC[((size_t)(ncol >> 8) * 256 + (m0 + (r & 3) + 8 * (r >> 2) + 4 * kg)) * 256 + (ncol & 255)] = (bf16)f2bf(acc[r]);
              } else {
#pragma unroll
                  for (int r = 0; r < 16; ++r) VC[((size_t)((ncol - 1024) >> 8) * 256 + (m0 + (r & 3) + 8 * (r >> 2) + 4 * kg)) * 256 + (ncol & 255)] = (bf16)f2bf(acc[r]);
              }
          }
      }
      __syncthreads(); }
    { typedef short bf16x8_t __attribute__((ext_vector_type(8))); typedef float f32x16_t __attribute__((ext_vector_type(16)));
      const float* sk = a.in[I_SUB_KEYS]; const float* wpq = a.in[I_W_PQ]; const float* gf = a.in[I_NORM_FFN_G]; bf16* WT = (bf16*)(ws + WS_WT_PQ);
      const int r32 = lane & 31, kg = lane >> 5;
      for (int item = blk * 8 + wave; item < 2048; item += G * 8) {
          const int hc = item >> 7, h = hc >> 1, c = hc & 1, kt = (item >> 2) & 31, nt = item & 3;
          const float* ap = wpq + (size_t)(kt * 32 + r32) * 2048 + hc * 128 + 8 * kg;
          const float* bp = sk + ((size_t)((c * 8 + h) * 128 + nt * 32 + r32)) * 128 + 8 * kg;
          const float gk = gf[kt * 32 + r32];
          f32x4 av[8][2], bv[8][2];
#pragma unroll
          for (int s = 0; s < 8; ++s) { av[s][0] = *(const f32x4*)(ap + 16 * s); av[s][1] = *(const f32x4*)(ap + 16 * s + 4); bv[s][0] = *(const f32x4*)(bp + 16 * s); bv[s][1] = *(const f32x4*)(bp + 16 * s + 4); }
          f32x16_t acc;
#pragma unroll
          for (int r = 0; r < 16; ++r) acc[r] = 0.f;
#pragma unroll
          for (int s = 0; s < 8; ++s) {
              const f32x4 a0 = av[s][0] * gk, a1 = av[s][1] * gk;
              u32x4 aw, bw; aw.x = pk2(a0[0], a0[1]); aw.y = pk2(a0[2], a0[3]); aw.z = pk2(a1[0], a1[1]); aw.w = pk2(a1[2], a1[3]);
              bw.x = pk2(bv[s][0][0], bv[s][0][1]); bw.y = pk2(bv[s][0][2], bv[s][0][3]); bw.z = pk2(bv[s][1][0], bv[s][1][1]); bw.w = pk2(bv[s][1][2], bv[s][1][3]);
              acc = __builtin_amdgcn_mfma_f32_32x32x16_bf16(__builtin_bit_cast(bf16x8_t, aw), __builtin_bit_cast(bf16x8_t, bw), acc, 0, 0, 0); }
          bf16* dst = WT + (size_t)(hc * 128 + nt * 32 + r32) * 1024 + kt * 32 + 4 * kg;
#pragma unroll
          for (int q = 0; q < 4; ++q) { u32x2 w; w.x = pk2(acc[4 * q], acc[4 * q + 1]); w.y = pk2(acc[4 * q + 2], acc[4 * q + 3]); *(u32x2*)(dst + 8 * q) = w; }
      } }
}

__device__ __forceinline__ void cross_fold(int wv, const Args& a, int blk, int G) {
    typedef short bf16x8_t __attribute__((ext_vector_type(8))); typedef float f32x16_t __attribute__((ext_vector_type(16)));
    const int tid = opaque_tid(wv), lane = tid & 63, wave = tid >> 6, r32 = lane & 31, kg = lane >> 5;
    const bf16* KC = (const bf16*)(a.ws + WS_KV); const bf16* VC = KC + 4 * 256 * 256;
    for (int item = blk * 8 + wave; item < 2048; item += G * 8) {
        f32x16_t acc;
#pragma unroll
        for (int r = 0; r < 16; ++r) acc[r] = 0.f;
        bf16* dst;
        if (item < 1024) {
            const int h = item >> 8, kt = (item >> 3) & 31, mt = item & 7;
            const float* ap = a.in[I_W_CQ] + (size_t)(kt * 32 + r32) * 1024 + h * 256 + 8 * kg;
            const bf16* bp = KC + ((size_t)h * 256 + mt * 32 + r32) * 256 + 8 * kg;
            const float gk = a.in[I_NORM_CROSS_G][kt * 32 + r32];
#pragma unroll 1
            for (int half = 0; half < 2; ++half) {
                f32x4 av[8][2]; u32x4 bv[8];
#pragma unroll
                for (int s = 0; s < 8; ++s) { av[s][0] = *(const f32x4*)(ap + 128 * half + 16 * s); av[s][1] = *(const f32x4*)(ap + 128 * half + 16 * s + 4); bv[s] = *(const u32x4*)(bp + 128 * half + 16 * s); }
#pragma unroll
                for (int s = 0; s < 8; ++s) { const f32x4 a0 = av[s][0] * gk, a1 = av[s][1] * gk;
                    u32x4 aw; aw.x = pk2(a0[0], a0[1]); aw.y = pk2(a0[2], a0[3]); aw.z = pk2(a1[0], a1[1]); aw.w = pk2(a1[2], a1[3]);
                    acc = __builtin_amdgcn_mfma_f32_32x32x16_bf16(__builtin_bit_cast(bf16x8_t, aw), __builtin_bit_cast(bf16x8_t, bv[s]), acc, 0, 0, 0); }
            }
            dst = (bf16*)(a.ws + WS_WQK) + (size_t)(h * 256 + mt * 32 + r32) * 1024 + kt * 32 + 4 * kg;
        } else {
            const int it = item - 1024, h = it >> 8, mt = (it >> 5) & 7, nt = it & 31;
            const bf16* ap = VC + ((size_t)h * 256 + mt * 32 + r32) * 256 + 8 * kg;
            const bf16* bp = (const bf16*)(a.ws + WS_WT_CO) + (size_t)(nt * 32 + r32) * 1024 + h * 256 + 8 * kg;
            u32x4 av[16], bv[16];
#pragma unroll
            for (int s = 0; s < 16; ++s) { av[s] = *(const u32x4*)(ap + 16 * s); bv[s] = *(const u32x4*)(bp + 16 * s); }
#pragma unroll
            for (int s = 0; s < 16; ++s) acc = __builtin_amdgcn_mfma_f32_32x32x16_bf16(__builtin_bit_cast(bf16x8_t, av[s]), __builtin_bit_cast(bf16x8_t, bv[s]), acc, 0, 0, 0);
            dst = (bf16*)(a.ws + WS_VW) + (size_t)(nt * 32 + r32) * 1024 + h * 256 + mt * 32 + 4 * kg;
        }
#pragma unroll
        for (int q = 0; q < 4; ++q) { u32x2 w; w.x = pk2(acc[4 * q], acc[4 * q + 1]); w.y = pk2(acc[4 * q + 2], acc[4 * q + 3]); *(u32x2*)(dst + 8 * q) = w; }
    }
}

__device__ __forceinline__ void conv_phase(int wv, const Args& a, int blk, int G) {
    bf16* CB = (bf16*)(a.ws + WS_A1); const bf16* U = (const bf16*)(a.ws + WS_A2); const float* cw = a.in[I_CONV_W];
    const int tid = opaque_tid(wv);
    for (size_t i = (size_t)blk * 512 + tid; i < (size_t)S * D / 8; i += (size_t)G * 512) {
        const int r = (int)(i >> 7), c = (int)(i & 127) * 8;
        const u32x4 cb = *(const u32x4*)(CB + i * 8), u2 = *(const u32x4*)(U + i * 8);
        u32x4 u1 = {0, 0, 0, 0}, u0 = {0, 0, 0, 0};
        if (r >= 1) u1 = *(const u32x4*)(U + i * 8 - D);
        if (r >= 2) u0 = *(const u32x4*)(U + i * 8 - 2 * D);
        u32x4 o;
#pragma unroll
        for (int e = 0; e < 4; ++e) {
            const int c0 = c + 2 * e;
            const float lo = bflo(cb[e]) * (cw[c0] * bflo(u0[e]) + cw[D + c0] * bflo(u1[e]) + cw[2 * D + c0] * bflo(u2[e]));
            const float hi = bfhi(cb[e]) * (cw[c0 + 1] * bfhi(u0[e]) + cw[D + c0 + 1] * bfhi(u1[e]) + cw[2 * D + c0 + 1] * bfhi(u2[e]));
            o[e] = pk2(lo, hi);
        }
        st16wt(CB + i * 8, o);
    }
}


namespace att {
typedef short bf16x8 __attribute__((ext_vector_type(8)));
typedef short s16x4 __attribute__((ext_vector_type(4)));
typedef float f32x16 __attribute__((ext_vector_type(16)));
typedef short v4i16_t __attribute__((ext_vector_type(4)));
typedef LAS const char* lds_cptr;
constexpr int SLOT = 16384, LDS_K = 0, LDS_V = 4 * SLOT, LDS_WSF = 8 * SLOT, LDS_BT = LDS_WSF + 2048, LDS_TOTAL = LDS_BT + 1024;
constexpr int LDS_XCH = 0, LDS_OST = 65536;
constexpr float LOG2E = 1.4426950408889634f, THR = 8.0f;
__device__ __forceinline__ int crow(int r, int hi) { return (r & 3) + 8 * (r >> 2) + 4 * hi; }
typedef float f32x2_t __attribute__((ext_vector_type(2))); typedef __bf16 bf16x2_t __attribute__((ext_vector_type(2)));
__device__ __forceinline__ unsigned cvtpk(float lo, float hi) { const f32x2_t v = {lo, hi}; const bf16x2_t b = __builtin_convertvector(v, bf16x2_t); return __builtin_bit_cast(unsigned, b); }
__device__ __forceinline__ void glds16(const void* g, unsigned lds_base) {
    unsigned sv; asm volatile("s_mov_b32 %0, m0\n\ts_mov_b32 m0, %2\n\ts_nop 0\n\tglobal_load_lds_dwordx4 %1, off\n\ts_mov_b32 m0, %0" : "=&s"(sv) : "v"(g), "s"(lds_base) : "memory"); }
template <int IMM> __device__ __forceinline__ void glds16s(unsigned voff, const void* sbase, unsigned lds_base) {
    unsigned sv; asm volatile("s_mov_b32 %0, m0\n\ts_mov_b32 m0, %3\n\ts_nop 0\n\tglobal_load_lds_dwordx4 %1, %2 offset:%c4\n\ts_mov_b32 m0, %0" : "=&s"(sv) : "v"(voff), "s"(sbase), "s"(lds_base), "i"(IMM) : "memory"); }
__device__ __forceinline__ s16x4 vtr(lds_cptr p) { return __builtin_bit_cast(s16x4, __builtin_amdgcn_ds_read_tr16_b64_v4i16((LAS v4i16_t*)p)); }
#define ATT_MX3(a, b, c) __builtin_fmaxf(__builtin_fmaxf((a), (b)), (c))
__device__ __forceinline__ float rowmax(const f32x16& p0, const f32x16& p1) {
    float a = ATT_MX3(p0[0], p0[1], p1[0]), b = ATT_MX3(p0[2], p0[3], p1[1]); a = ATT_MX3(a, p1[2], p1[3]);
#pragma unroll
    for (int r = 4; r < 16; r += 4) { a = ATT_MX3(a, p0[r], p0[r + 1]); b = ATT_MX3(b, p0[r + 2], p0[r + 3]); a = ATT_MX3(a, p1[r], p1[r + 1]); b = ATT_MX3(b, p1[r + 2], p1[r + 3]); }
    float m = __builtin_fmaxf(a, b); auto rr = __builtin_amdgcn_permlane32_swap(__float_as_uint(m), __float_as_uint(m), false, false);
    return __builtin_fmaxf(__uint_as_float(rr[0]), __uint_as_float(rr[1])); }
#define ATT_WAIT_BAR(N) asm volatile("s_waitcnt vmcnt(" #N ") lgkmcnt(0)\n\ts_barrier" ::: "memory")
#define ATT_LBAR() asm volatile("s_waitcnt lgkmcnt(0)\n\ts_barrier" ::: "memory")
#define ATT_MFMA(a, b, c) __builtin_amdgcn_mfma_f32_32x32x16_bf16(a, b, c, 0, 0, 0)

__device__ __forceinline__ void attn_unit_pipe(int wv, int h, int qb, const bf16* Q, const bf16* __restrict__ K, const bf16* __restrict__ V, bf16* O, LAS unsigned char* lds,
                                               float lam, const float* rel_bias, const float* subln_g, const unsigned* KMAX) {
    const int tid = opaque_tid(wv), lane = tid & 63, r32 = lane & 31, hi = lane >> 5;
    const int wid = __builtin_amdgcn_readfirstlane(tid >> 6), comp = wid >> 2, rg = wid & 3;
    const int q0 = qb * 128, qw0 = q0 + 32 * rg, NT = 2 * qb + 2;
    const unsigned lds0 = (unsigned)(unsigned long long)lds;
    LAS float* wsf = (LAS float*)(lds + LDS_WSF) + wid * 64;
    LAS float* bt = (LAS float*)(lds + LDS_BT);
    const float bfar = rel_bias[31 * 8 + h] * LOG2E;
    float bmax = -INFINITY;
    if (tid < 129) { const int b = tid < 128 ? (int)T5_BUCKET[tid] : 31; bt[tid] = (rel_bias[b * 8 + h] - rel_bias[31 * 8 + h]) * LOG2E; }
#pragma unroll
    for (int b = 0; b < 32; ++b) bmax = fmaxf(bmax, rel_bias[b * 8 + h] * LOG2E);
    const float kmx = sqrtf(__uint_as_float(KMAX[(h * 2 + comp) * 2]) + __uint_as_float(KMAX[(h * 2 + comp) * 2 + 1])) * 1.02f;
    const unsigned kvoff = (unsigned)lane * 2048u + (unsigned)wid * 16u;
    const unsigned vvoff = (unsigned)(16 * (wid & 3) + (lane >> 2)) * 2048u + (unsigned)((wid >> 2) * 32 + (lane & 3) * 8) * 2u;
    const char* kbase = (const char*)(K + h * 128); const char* vbase = (const char*)(V + h * 128);
    const unsigned kdst = lds0 + LDS_K + wid * 1024, vdst = lds0 + LDS_V + wid * 1024;
#define ATT_RFL(x) ((unsigned)__builtin_amdgcn_readfirstlane((int)(x)))
#define DMA_K(t, so) do { const char* b_ = kbase + (size_t)(t) * 131072; glds16s<0>(kvoff, b_, ATT_RFL(kdst + (so))); glds16s<128>(kvoff, b_, ATT_RFL(kdst + (so) + 8192 - 128)); } while (0)
#define DMA_V(t, so) do { const char* b_ = vbase + (size_t)(t) * 131072; glds16s<0>(vvoff, b_, ATT_RFL(vdst + (so))); glds16s<128>(vvoff, b_, ATT_RFL(vdst + (so) + 8192 - 128)); } while (0)
    bf16x8 qr[4];
    float cfar;
    { const bf16* Qw = Q + (size_t)(qw0 + r32) * 1024 + h * 128 + comp * 64 + hi * 8;
#pragma unroll
      for (int d0 = 0; d0 < 4; ++d0) qr[d0] = *(const bf16x8*)(Qw + d0 * 16);
      float s = 0.f;
#pragma unroll
      for (int d0 = 0; d0 < 4; ++d0)
#pragma unroll
          for (int e2 = 0; e2 < 8; ++e2) { const float f = __builtin_bit_cast(float, (unsigned)(unsigned short)qr[d0][e2] << 16); s += f * f; }
      auto rr = __builtin_amdgcn_permlane32_swap(__float_as_uint(s), __float_as_uint(s), false, false); s = __uint_as_float(rr[0]) + __uint_as_float(rr[1]);
      cfar = bfar - (sqrtf(s) * 1.01f * kmx + bmax); }
    DMA_K(0, 0); DMA_K(1, SLOT); DMA_V(0, 0); if (NT > 2) DMA_K(2, 2 * SLOT);
    const lds_cptr kp0 = (lds_cptr)(lds + LDS_K) + comp * 8192 + hi * 1024 + r32 * 16;
    const lds_cptr vp0 = (lds_cptr)(lds + LDS_V) + ((lane >> 4) & 1) * 32 + (lane & 3) * 8 + (4 * hi + ((lane & 15) >> 2)) * 64;
    float l_reg = 0.f;
    f32x16 o[4];
#pragma unroll
    for (int d0 = 0; d0 < 4; ++d0)
#pragma unroll
        for (int r = 0; r < 16; ++r) o[d0][r] = 0.f;
    bf16x8 kf[8];
    f32x16 pA0, pA1, pB0, pB1;
    u32x4 pw0, pw1, pw2, pw3;
    s16x4 vl0, vh0, vl1, vh1;
#define SBAR() __builtin_amdgcn_sched_barrier(0)
#define PIN(x) asm volatile("" : "+v"(x))
#define PKW(P, B) cvtpk(P[B], P[B + 1])
#define PAF(k) __builtin_bit_cast(bf16x8, pw##k)
#define EX(v) __builtin_amdgcn_exp2f(v)
#define ROT3() do { const int t_ = s0; s0 = s1; s1 = s2; s2 = t_; } while (0)
#define ENDW(t) do { if ((t) + 3 < NT) { ATT_WAIT_BAR(4); } else if ((t) + 1 < NT) { ATT_WAIT_BAR(2); } else { ATT_WAIT_BAR(0); } } while (0)
#define KLD(f, kp_) kf[f] = *(LAS const bf16x8*)((kp_) + ((f) >> 1) * 2048 + ((f) & 1) * 512)
#define BANDFIX(C0, C1, t) do { if (__builtin_expect(64 * (t) + 63 + 128 > qw0, 0)) { const int ln_ = opaque_tid(0);   \
        const int dq = qw0 + (ln_ & 31) - 64 * (t) - 4 * (ln_ >> 5); \
        _Pragma("unroll") for (int r = 0; r < 16; ++r) { const int d0_ = dq - ((r & 3) + 8 * (r >> 2)), d1_ = d0_ - 32; \
            const float b0 = bt[min(max(d0_, 0), 128)], b1 = bt[min(max(d1_, 0), 128)]; \
            C0[r] = d0_ < 0 ? -INFINITY : C0[r] + b0; C1[r] = d1_ < 0 ? -INFINITY : C1[r] + b1; } } } while (0)
#define VRD(j, i, vp_) do { vl##j = vtr((vp_) + ((i) & 3) * 4096 + ((i) >> 2) * 1024); vh##j = vtr((vp_) + ((i) & 3) * 4096 + ((i) >> 2) * 1024 + 512); } while (0)
#define VFR(j) (bf16x8){vl##j[0], vl##j[1], vl##j[2], vl##j[3], vh##j[0], vh##j[1], vh##j[2], vh##j[3]}
#define GAPA(MF, A0, A1, A2, A3, W0, W1, PWX) do { MF; sacc += A0; sacc += A1; sacc += A2; sacc += A3; PIN(sacc); W0; W1; PIN(PWX); SBAR(); } while (0)
#define PHASE_A(C0, C1, P0, P1, vp_) do { float sacc = P0[0] + P0[1]; \
        GAPA(C0 = ATT_MFMA(kf[0], qr[0], C0), P0[2], P0[3], P0[4], P0[5],     pw0[0] = PKW(P0, 0), pw0[1] = PKW(P0, 2), pw0); \
        GAPA(C1 = ATT_MFMA(kf[1], qr[0], C1), P0[6], P0[7], P0[8], P0[9],     pw0[2] = PKW(P0, 4), pw0[3] = PKW(P0, 6), pw0); \
        GAPA(C0 = ATT_MFMA(kf[2], qr[1], C0), P0[10], P0[11], P0[12], P0[13], pw1[0] = PKW(P0, 8), pw1[1] = PKW(P0, 10), pw1); \
        GAPA(C1 = ATT_MFMA(kf[3], qr[1], C1), P0[14], P0[15], P1[0], P1[1],   pw1[2] = PKW(P0, 12), pw1[3] = PKW(P0, 14), pw1); \
        GAPA(C0 = ATT_MFMA(kf[4], qr[2], C0), P1[2], P1[3], P1[4], P1[5],     pw2[0] = PKW(P1, 0), pw2[1] = PKW(P1, 2), pw2); \
        GAPA(C1 = ATT_MFMA(kf[5], qr[2], C1), P1[6], P1[7], P1[8], P1[9],     pw2[2] = PKW(P1, 4), pw2[3] = PKW(P1, 6), pw2); \
        GAPA(C0 = ATT_MFMA(kf[6], qr[3], C0), P1[10], P1[11], P1[12], P1[13], pw3[0] = PKW(P1, 8), pw3[1] = PKW(P1, 10), pw3); \
        VRD(0, 0, vp_); SBAR(); \
        GAPA(C1 = ATT_MFMA(kf[7], qr[3], C1), P1[14], P1[15], 0.f, 0.f,       pw3[2] = PKW(P1, 12), pw3[3] = PKW(P1, 14), pw3); \
        l_reg += sacc; } while (0)
#define GAPB(i, j, jn, X, XB, DOEX, GL, vp_, kp_, N0, N1, DOSP) do { if ((i) + 1 < 16) { VRD(jn, (i) + 1, vp_); } \
        if ((GL) && ((i) & 1)) { KLD((i) >> 1, kp_); } SBAR(); \
        o[(i) & 3] = ATT_MFMA(PAF_SEL((i) >> 2), VFR(j), o[(i) & 3]); \
        if (DOEX) { X[XB] = EX(X[XB]); X[XB + 1] = EX(X[XB + 1]); PIN(X); } \
        if (DOSP) { N0[(i)] = cfar; N1[(i)] = cfar; } SBAR(); } while (0)
#define PAF_SEL(k) ((k) == 0 ? PAF(0) : (k) == 1 ? PAF(1) : (k) == 2 ? PAF(2) : PAF(3))
#define PHASE_B(C0, C1, DOEX, GL, vp_, kp_, N0, N1, DOSP) do { \
        GAPB(0, 0, 1, C0, 0, DOEX, GL, vp_, kp_, N0, N1, DOSP); GAPB(1, 1, 0, C0, 2, DOEX, GL, vp_, kp_, N0, N1, DOSP); GAPB(2, 0, 1, C0, 4, DOEX, GL, vp_, kp_, N0, N1, DOSP); GAPB(3, 1, 0, C0, 6, DOEX, GL, vp_, kp_, N0, N1, DOSP); \
        GAPB(4, 0, 1, C0, 8, DOEX, GL, vp_, kp_, N0, N1, DOSP); GAPB(5, 1, 0, C0, 10, DOEX, GL, vp_, kp_, N0, N1, DOSP); GAPB(6, 0, 1, C0, 12, DOEX, GL, vp_, kp_, N0, N1, DOSP); GAPB(7, 1, 0, C0, 14, DOEX, GL, vp_, kp_, N0, N1, DOSP); \
        GAPB(8, 0, 1, C1, 0, DOEX, GL, vp_, kp_, N0, N1, DOSP); GAPB(9, 1, 0, C1, 2, DOEX, GL, vp_, kp_, N0, N1, DOSP); GAPB(10, 0, 1, C1, 4, DOEX, GL, vp_, kp_, N0, N1, DOSP); GAPB(11, 1, 0, C1, 6, DOEX, GL, vp_, kp_, N0, N1, DOSP); \
        GAPB(12, 0, 1, C1, 8, DOEX, GL, vp_, kp_, N0, N1, DOSP); GAPB(13, 1, 0, C1, 10, DOEX, GL, vp_, kp_, N0, N1, DOSP); GAPB(14, 0, 1, C1, 12, DOEX, GL, vp_, kp_, N0, N1, DOSP); GAPB(15, 1, 0, C1, 14, DOEX, GL, vp_, kp_, N0, N1, DOSP); \
        } while (0)
#define KSL(t) ((((t) & 3)) * SLOT)
#define DMA_GROUP(t) do { if ((t) + 3 < NT) DMA_K((t) + 3, KSL((t) + 3)); if ((t) + 1 < NT) DMA_V((t) + 1, KSL((t) + 1)); } while (0)
#define STEP(C0, C1, P0, P1, t) do { const lds_cptr vpp = vp0 + KSL((t) - 1); const lds_cptr kpn = kp0 + KSL((t) + 1); \
        PHASE_A(C0, C1, P0, P1, vpp); \
        BANDFIX(C0, C1, t); \
        if (comp == 0) { DMA_GROUP(t); } else { ENDW(t); } \
        SBAR(); \
        PHASE_B(C0, C1, true, true, vpp, kpn, P0, P1, true); PIN(P0); PIN(P1); \
        if (comp == 0) { ENDW(t); } else { DMA_GROUP((t) + 1); } } while (0)
#define PACKSUM(P0, P1) do { float sacc = 0.f; _Pragma("unroll") for (int r = 0; r < 16; ++r) sacc += P0[r] + P1[r]; l_reg += sacc; \
        pw0 = (u32x4){PKW(P0, 0), PKW(P0, 2), PKW(P0, 4), PKW(P0, 6)}; pw1 = (u32x4){PKW(P0, 8), PKW(P0, 10), PKW(P0, 12), PKW(P0, 14)}; \
        pw2 = (u32x4){PKW(P1, 0), PKW(P1, 2), PKW(P1, 4), PKW(P1, 6)}; pw3 = (u32x4){PKW(P1, 8), PKW(P1, 10), PKW(P1, 12), PKW(P1, 14)}; } while (0)

    if (NT > 2) { ATT_WAIT_BAR(4); } else { ATT_WAIT_BAR(2); }
    if (comp != 0) { DMA_GROUP(0); }
    {
#pragma unroll
      for (int f = 0; f < 8; ++f) KLD(f, kp0);
#pragma unroll
      for (int r = 0; r < 16; ++r) { pA0[r] = cfar; pA1[r] = cfar; pB0[r] = cfar; pB1[r] = cfar; }
#pragma unroll
      for (int d0 = 0; d0 < 4; ++d0) { pA0 = ATT_MFMA(kf[2 * d0], qr[d0], pA0); pA1 = ATT_MFMA(kf[2 * d0 + 1], qr[d0], pA1); } }
    SBAR();
    BANDFIX(pA0, pA1, 0);
    if (comp == 0) { DMA_GROUP(0); } else { ENDW(0); }
    {
#pragma unroll
        for (int r = 0; r < 16; ++r) { pA0[r] = EX(pA0[r]); pA1[r] = EX(pA1[r]); }
#pragma unroll
        for (int f = 0; f < 8; ++f) KLD(f, kp0 + KSL(1));
    }
    if (comp == 0) { ENDW(0); } else { DMA_GROUP(1); }
    {
        int t = 1;
        for (; t + 2 < NT; t += 2) { STEP(pB0, pB1, pA0, pA1, t); STEP(pA0, pA1, pB0, pB1, t + 1); }
        STEP(pB0, pB1, pA0, pA1, t);
        PACKSUM(pB0, pB1);
        VRD(0, 0, vp0 + KSL(NT - 1)); SBAR();
        PHASE_B(pA0, pA1, false, false, vp0 + KSL(NT - 1), kp0, pA0, pA1, false);
    }
    float l = l_reg;
    { auto rr = __builtin_amdgcn_permlane32_swap(__float_as_uint(l), __float_as_uint(l), false, false); l = __uint_as_float(rr[0]) + __uint_as_float(rr[1]); }
    if (hi == 0) wsf[32 + r32] = l;
    float rli[16];
#pragma unroll
    for (int r = 0; r < 16; ++r) rli[r] = 1.0f / wsf[32 + crow(r, hi)];
    ATT_LBAR();
    LAS float* xch = (LAS float*)(lds + LDS_XCH) + rg * 4096;
    if (comp == 1) {
#pragma unroll
        for (int d0 = 0; d0 < 4; ++d0)
#pragma unroll
            for (int r = 0; r < 16; ++r) xch[(d0 * 16 + r) * 64 + lane] = o[d0][r] * rli[r] * lam;
    }
    ATT_LBAR();
    if (comp == 0) {
        float ss[16];
#pragma unroll
        for (int r = 0; r < 16; ++r) { float s_ = 0.f;
#pragma unroll
            for (int d0 = 0; d0 < 4; ++d0) { const float v = o[d0][r] * rli[r] - xch[(d0 * 16 + r) * 64 + lane]; o[d0][r] = v; s_ += v * v; }
            ss[r] = s_; }
#pragma unroll
        for (int r = 0; r < 16; ++r) {
            float v = ss[r]; v += pg8::dppf<0xB1>(v); v += pg8::dppf<0x4E>(v); v += pg8::dppf<0x141>(v); v += pg8::dppf<0x140>(v);
            auto sw = __builtin_amdgcn_permlane16_swap(__float_as_uint(v), __float_as_uint(v), false, false); ss[r] = __uint_as_float(sw[0]) + __uint_as_float(sw[1]); }
        LAS bf16* stg = (LAS bf16*)(lds + LDS_OST) + rg * 4096;
        float g4[4];
#pragma unroll
        for (int d0 = 0; d0 < 4; ++d0) g4[d0] = subln_g[d0 * 32 + r32];
#pragma unroll
        for (int r = 0; r < 16; ++r) { const float rs = 0.8f / sqrtf(ss[r] * (1.0f / 128.0f) + 1e-5f); const int orow = crow(r, hi);
#pragma unroll
            for (int d0 = 0; d0 < 4; ++d0) stg[orow * 128 + d0 * 32 + r32] = (bf16)f2bf(o[d0][r] * rs * g4[d0]); }
#pragma unroll
        for (int i = 0; i < 8; ++i) { const int row = i * 4 + (lane >> 4), ch = lane & 15;
            const u32x4 v = *(LAS const u32x4*)(stg + row * 128 + ch * 8);
            st16wt(O + (size_t)(qw0 + row) * 1024 + h * 128 + ch * 8, v); }
    }
    ATT_LBAR();
#undef ATT_RFL
#undef DMA_K
#undef DMA_V
#undef SBAR
#undef PIN
#undef PKW
#undef PAF
#undef EX
#undef ROT3
#undef ENDW
#undef KLD
#undef BANDFIX
#undef VRD
#undef VFR
#undef GAPA
#undef PHASE_A
#undef GAPB
#undef PAF_SEL
#undef PHASE_B
#undef STEP
#undef PACKSUM
#undef KSL
#undef DMA_GROUP
}

__device__ __forceinline__ void attn_phase(int wv, const Args& a, LAS unsigned char* lds, int blk, int G, bf16* Odst) {
    float s1 = 0.f, s2 = 0.f;
    for (int i = 0; i < 64; ++i) { s1 += a.in[I_LQ1][i] * a.in[I_LK1][i]; s2 += a.in[I_LQ2][i] * a.in[I_LK2][i]; }
    const float lam = __builtin_bit_cast(float, __builtin_amdgcn_readfirstlane(__builtin_bit_cast(int, expf(s1) - expf(s2) + 0.2f)));
    const bf16* Q = (const bf16*)(a.ws + WS_A3); const bf16* K = (const bf16*)(a.ws + WS_A4); const bf16* V = (const bf16*)(a.ws + WS_A5);
    const bool snake = (1024 % G) == 0;
    for (int j = 0;; ++j) {
        const int idx = j * G + blk; if (idx >= 1024) break;
        const int rank = (snake && (j & 1)) ? (j * G + (G - 1 - blk)) : idx;
        attn_unit_pipe(wv, rank & 7, 127 - (rank >> 3), Q, K, V, Odst, lds, lam, a.in[I_REL_BIAS], a.in[I_SUBLN_G], (const unsigned*)(a.ws + WS_KMAX));
    }
}
}


__device__ __forceinline__ void peer_convert(int wv, const Args& a, int blk, int G) {
    const int tid = opaque_tid(wv), lane = tid & 63, gw = blk * 8 + (tid >> 6);
    for (int which = 0; which < 2; ++which) {
        const float* src = a.in[which ? I_PEER_V : I_PEER_U]; unsigned* dst = (unsigned*)(a.ws + (which ? WS_PV : WS_PU));
        for (size_t c = gw; c < (size_t)16384 * 1024 / 1024; c += (size_t)G * 8) {
            f32x4 v[4];
#pragma unroll
            for (int j = 0; j < 4; ++j) v[j] = __builtin_nontemporal_load((const f32x4*)(src + c * 1024 + 256 * j + 4 * lane)) * 128.0f;
#pragma unroll
            for (int j = 0; j < 4; ++j) { int w = __builtin_amdgcn_cvt_pk_fp8_f32(v[j][0], v[j][1], 0, false); w = __builtin_amdgcn_cvt_pk_fp8_f32(v[j][2], v[j][3], w, true);
                dst[c * 256 + 64 * j + lane] = (unsigned)w; } } }
}
namespace peer {
typedef float f32x2v __attribute__((ext_vector_type(2)));
template <int CTRL> __device__ __forceinline__ float dpp(float x) { return __builtin_bit_cast(float, __builtin_amdgcn_mov_dpp(__builtin_bit_cast(int, x), CTRL, 0xf, 0xf, true)); }
template <int CTRL> __device__ __forceinline__ unsigned dppu(unsigned x) { return (unsigned)__builtin_amdgcn_mov_dpp((int)x, CTRL, 0xf, 0xf, true); }
__device__ __forceinline__ unsigned half32_umax(unsigned m) {
    unsigned t = dppu<0xB1>(m); m = t > m ? t : m; t = dppu<0x4E>(m); m = t > m ? t : m; t = dppu<0x141>(m); m = t > m ? t : m; t = dppu<0x140>(m); m = t > m ? t : m;
    auto s = __builtin_amdgcn_permlane16_swap(m, m, false, false); return s[0] > s[1] ? s[0] : s[1]; }
__device__ __forceinline__ float row16_sum(float x) { x += dpp<0xB1>(x); x += dpp<0x4E>(x); x += dpp<0x141>(x); x += dpp<0x140>(x); return x; }
__device__ __forceinline__ float wsum(float x) {
    x += dpp<0xB1>(x); x += dpp<0x4E>(x); x += dpp<0x141>(x); x += dpp<0x140>(x);
    auto s = __builtin_amdgcn_permlane16_swap(__float_as_uint(x), __float_as_uint(x), false, false); x = __uint_as_float(s[0]) + __uint_as_float(s[1]);
    auto t = __builtin_amdgcn_permlane32_swap(__float_as_uint(x), __float_as_uint(x), false, false); return __uint_as_float(t[0]) + __uint_as_float(t[1]);
}
__device__ __forceinline__ void peer_phase(int wv, const Args& a, int blk, int G, float* OUTP) {
    const int tid = opaque_tid(wv), lane = tid & 63, wave = tid >> 6, hh = lane >> 5, l32 = lane & 31;
    const unsigned* TK = (const unsigned*)(a.ws + WS_TOPK); const unsigned char* PU = (const unsigned char*)(a.ws + WS_PU); const unsigned char* PVt = (const unsigned char*)(a.ws + WS_PV);
    const float* gF = a.in[I_NORM_FFN_G]; const float* gO = a.in[I_FINAL_G];
    int ci0 = 0, cj0 = 0, ci1 = 0, cj1 = 0; bool valid1 = false;
    { int p = 0;
      for (int i = 0; i < 16; ++i) for (int j = 0; j < 16; ++j) if ((i + 1) * (j + 1) <= 16) { if (p == l32) { ci0 = i; cj0 = j; } if (p == l32 + 32) { ci1 = i; cj1 = j; valid1 = true; } ++p; } }
    for (int tok = blk * 8 + wave; tok < S; tok += G * 8) {
        const unsigned short* xrow = (const unsigned short*)(a.ws + WS_A2) + (size_t)tok * D + 16 * lane;
        f32x4 xa[4];
        { const u32x4 r0 = *(const u32x4*)xrow, r1 = *(const u32x4*)(xrow + 8);
          xa[0] = (f32x4){bflo(r0.x), bfhi(r0.x), bflo(r0.y), bfhi(r0.y)}; xa[1] = (f32x4){bflo(r0.z), bfhi(r0.z), bflo(r0.w), bfhi(r0.w)};
          xa[2] = (f32x4){bflo(r1.x), bfhi(r1.x), bflo(r1.y), bfhi(r1.y)}; xa[3] = (f32x4){bflo(r1.z), bfhi(r1.z), bflo(r1.w), bfhi(r1.w)}; }
        unsigned key[4];
#pragma unroll
        for (int i = 0; i < 4; ++i) key[i] = TK[(size_t)tok * 256 + lane + 64 * i];
        float ss = 0.f;
#pragma unroll
        for (int j = 0; j < 4; ++j) ss += (xa[j][0] * xa[j][0] + xa[j][1] * xa[j][1]) + (xa[j][2] * xa[j][2] + xa[j][3] * xa[j][3]);
        ss = wsum(ss);
        const float rstd = 1.0f / sqrtf(ss * (1.0f / D) + 1e-6f);
        float hf[16];
#pragma unroll
        for (int j = 0; j < 4; ++j) { const f32x4 gg = *(const f32x4*)(gF + 16 * lane + 4 * j);
#pragma unroll
            for (int e = 0; e < 4; ++e) hf[4 * j + e] = xa[j][e] * rstd * gg[e]; }
        int ex[4]; float gw[4];
#pragma unroll
        for (int i = 0; i < 4; ++i) {
            const unsigned k = key[i];
            const float v = pg8::ord2f(k & ~0x7Fu); const int ix = 127 - (int)(k & 0x7Fu);
            const float s0 = __shfl(v, hh * 32 + ci0) + __shfl(v, hh * 32 + 16 + cj0);
            const float s1 = __shfl(v, hh * 32 + ci1) + __shfl(v, hh * 32 + 16 + cj1);
            unsigned ck0 = (pg8::f2ord(s0) & ~0xFFu) | (unsigned)(255 - (ci0 * 16 + cj0));
            unsigned ck1 = valid1 ? ((pg8::f2ord(s1) & ~0xFFu) | (unsigned)(255 - (ci1 * 16 + cj1))) : 0u;
            unsigned win = 0u;
#pragma unroll
            for (int r = 0; r < 16; ++r) {
                const unsigned m = half32_umax(ck0 > ck1 ? ck0 : ck1);
                if (l32 == r) win = m;
                if (ck0 == m) ck0 = 0u;
                if (ck1 == m) ck1 = 0u;
            }
            const float ts = pg8::ord2f(win & ~0xFFu); const int flat = 255 - (int)(win & 0xFFu);
            const float mx = __shfl(ts, hh * 32);
            const float e = (l32 < 16) ? __expf(ts - mx) : 0.f;
            const float sum = row16_sum(e);
            gw[i] = e / sum;
            const int e0 = __shfl(ix, hh * 32 + ((flat >> 4) & 15)), e1 = __shfl(ix, hh * 32 + 16 + (flat & 15));
            ex[i] = e0 * 128 + e1;
        }
        float acc[16];
#pragma unroll
        for (int j = 0; j < 16; ++j) acc[j] = 0.f;
#pragma unroll 1
        for (int b = 0; b < 16; ++b) {
            const int i = b >> 2, sl = ((b >> 1) & 1) * 32 + (b & 1) * 8;
            const int exv = i == 0 ? ex[0] : i == 1 ? ex[1] : i == 2 ? ex[2] : ex[3];
            const float gwv = i == 0 ? gw[0] : i == 1 ? gw[1] : i == 2 ? gw[2] : gw[3];
            u32x4 uu[8], vv[8];
#pragma unroll
            for (int q = 0; q < 8; ++q) { const int eid = __builtin_amdgcn_readlane(exv, sl + q); uu[q] = *(const u32x4*)(PU + (size_t)eid * 1024 + 16 * lane); vv[q] = *(const u32x4*)(PVt + (size_t)eid * 1024 + 16 * lane); }
            float d[8];
#pragma unroll
            for (int q = 0; q < 8; ++q) { float s_ = 0.f;
#pragma unroll
                for (int e = 0; e < 4; ++e) { const f32x2v lo = __builtin_amdgcn_cvt_pk_f32_fp8((int)uu[q][e], false), hi2 = __builtin_amdgcn_cvt_pk_f32_fp8((int)uu[q][e], true);
                    s_ += (lo[0] * hf[4 * e] + lo[1] * hf[4 * e + 1]) + (hi2[0] * hf[4 * e + 2] + hi2[1] * hf[4 * e + 3]); }
                d[q] = s_; }
            float z;
            { const bool b0 = lane & 1, b1 = lane & 2, b2 = lane & 4;
              float r4[4], r2[2];
#pragma unroll
              for (int q = 0; q < 4; ++q) { const float keep = b0 ? d[q + 4] : d[q], give = b0 ? d[q] : d[q + 4]; r4[q] = keep + dpp<0xB1>(give); }
#pragma unroll
              for (int q = 0; q < 2; ++q) { const float keep = b1 ? r4[q + 2] : r4[q], give = b1 ? r4[q] : r4[q + 2]; r2[q] = keep + dpp<0x4E>(give); }
              { const float keep = b2 ? r2[1] : r2[0], give = b2 ? r2[0] : r2[1];
                const float up = dpp<0x104>(give), dn = dpp<0x114>(give);
                z = keep + (b2 ? dn : up); }
              z += dpp<0x128>(z);
              auto s16 = __builtin_amdgcn_permlane16_swap(__float_as_uint(z), __float_as_uint(z), false, false); z = __uint_as_float(s16[0]) + __uint_as_float(s16[1]);
              auto s32 = __builtin_amdgcn_permlane32_swap(__float_as_uint(z), __float_as_uint(z), false, false); z = __uint_as_float(s32[0]) + __uint_as_float(s32[1]); }
            const int myq = 4 * (lane & 1) + 2 * ((lane >> 1) & 1) + ((lane >> 2) & 1);
            const float gmine = __shfl(gwv, sl + myq);
            z *= (1.0f / 128.0f);
            const float wl = gmine * 0.5f * z * (1.0f + erff(z * 0.70710678118654752f)) * (1.0f / 128.0f);
#pragma unroll
            for (int q = 0; q < 8; ++q) { const float w = __builtin_bit_cast(float, __builtin_amdgcn_readlane(__builtin_bit_cast(int, wl), ((q >> 2) & 1) | (((q >> 1) & 1) << 1) | ((q & 1) << 2)));
#pragma unroll
                for (int e = 0; e < 4; ++e) { const f32x2v lo = __builtin_amdgcn_cvt_pk_f32_fp8((int)vv[q][e], false), hi2 = __builtin_amdgcn_cvt_pk_f32_fp8((int)vv[q][e], true);
                    acc[4 * e] += w * lo[0]; acc[4 * e + 1] += w * lo[1]; acc[4 * e + 2] += w * hi2[0]; acc[4 * e + 3] += w * hi2[1]; } }
        }
        float s3 = 0.f;
#pragma unroll
        for (int j = 0; j < 4; ++j)
#pragma unroll
            for (int e = 0; e < 4; ++e) { xa[j][e] += acc[4 * j + e]; s3 += xa[j][e] * xa[j][e]; }
        s3 = wsum(s3);
        const float r3 = 1.0f / sqrtf(s3 * (1.0f / D) + 1e-6f);
        float* orow = OUTP + (size_t)tok * D + 16 * lane;
#pragma unroll
        for (int j = 0; j < 4; ++j) { const f32x4 gg = *(const f32x4*)(gO + 16 * lane + 4 * j); *(f32x4*)(orow + 4 * j) = xa[j] * r3 * gg; }
    }
}
}

#define XB_TMO      128
#define XB_XCNT(j)  (256  + 64 * (j))
#define XB_XSUB(j)  (1280 + 64 * (j))
#define XB_XGEN(j)  (2304 + 64 * (j))
#define XB_TOP      3328
#define XB_TOPGEN   3392
#define XCD_BAR_WORDS 3456
#define XB_SPIN_CAP (1u << 18)

__device__ __forceinline__ unsigned xb_ld(unsigned* p)              { return __hip_atomic_load(p, __ATOMIC_RELAXED, __HIP_MEMORY_SCOPE_AGENT); }
__device__ __forceinline__ unsigned xb_add(unsigned* p, unsigned v) { return __hip_atomic_fetch_add(p, v, __ATOMIC_RELAXED, __HIP_MEMORY_SCOPE_AGENT); }
__device__ __forceinline__ unsigned xb_xcc_id() { return (unsigned)__builtin_amdgcn_s_getreg((3 << 11) | 20) & 0xFu; }
#define XB_SPIN(cond, bar) do { unsigned _sp = 0; while (cond) { __builtin_amdgcn_s_sleep(1); \
    if ((++_sp & 255u) == 0u) { if (xb_ld(&(bar)[XB_TMO])) break; if (_sp > XB_SPIN_CAP) { atomicAdd(&(bar)[XB_TMO], 1u); break; } } } } while (0)

struct XcdBarrier {
    unsigned* bar; unsigned x;
    volatile LAS unsigned* st;
};

__device__ __forceinline__ XcdBarrier xcd_barrier_post(unsigned* bar, volatile LAS unsigned* st, int tid) {
    XcdBarrier b; b.bar = bar; b.x = xb_xcc_id(); b.st = st;
    if (tid == 0) (void)xb_add(&bar[XB_XCNT(b.x)], 1u);
    return b;
}
__device__ __forceinline__ void xcd_barrier_complete(unsigned* bar, unsigned x, unsigned& nloc, unsigned& nx) {
    const unsigned G = gridDim.x * gridDim.y * gridDim.z;
    unsigned sum, cnt, mine, sp = 0u;
    for (;;) {
        sum = 0u; cnt = 0u; mine = 0u;
#pragma unroll
        for (unsigned j = 0; j < 16; ++j) { const unsigned c = xb_ld(&bar[XB_XCNT(j)]); sum += c; cnt += (c > 0u) ? 1u : 0u; mine = (j == x) ? c : mine; }
        if (sum == G) break;
        __builtin_amdgcn_s_sleep(1);
        if ((++sp & 255u) == 0u) { if (xb_ld(&bar[XB_TMO])) break; if (sp > XB_SPIN_CAP) { atomicAdd(&bar[XB_TMO], 1u); break; } }
    }
    nloc = mine > 0u ? mine : 1u; nx = cnt > 0u ? cnt : 1u;
}

__device__ __forceinline__ void xcd_barrier(const XcdBarrier& b, int tid) {
    asm volatile("s_waitcnt vmcnt(0)" ::: "memory");
    __syncthreads();
    if (tid == 0) {
        unsigned* bar = b.bar;
        __builtin_amdgcn_s_waitcnt(0);
        unsigned nloc = b.st[0], nx = b.st[1];
        if (nloc == 0u) { xcd_barrier_complete(bar, b.x, nloc, nx); b.st[0] = nloc; b.st[1] = nx; }
        const unsigned old = xb_add(&bar[XB_XSUB(b.x)], 1u);
        const unsigned gen = old / nloc;
        if (old + 1u == (gen + 1u) * nloc) {
            __builtin_amdgcn_fence(__ATOMIC_RELEASE, "agent");
            asm volatile("s_waitcnt vmcnt(0)" ::: "memory");
            const unsigned og = xb_add(&bar[XB_TOP], 1u);
            const unsigned tg = og / nx;
            if (og + 1u == (tg + 1u) * nx) xb_add(&bar[XB_TOPGEN], 1u);
            else XB_SPIN(xb_ld(&bar[XB_TOPGEN]) == tg, bar);
            __builtin_amdgcn_fence(__ATOMIC_ACQUIRE, "agent");
            xb_add(&bar[XB_XGEN(b.x)], 1u);
            asm volatile("s_waitcnt vmcnt(0)" ::: "memory");
        } else {
            XB_SPIN(xb_ld(&bar[XB_XGEN(b.x)]) == gen, bar);
            __builtin_amdgcn_fence(__ATOMIC_ACQUIRE, "agent");
            asm volatile("s_waitcnt vmcnt(0)" ::: "memory");
        }
    }
    __syncthreads();
}

constexpr int LDS_BYTES = 147456, LDS_MISC = 139264;
__global__ void __launch_bounds__(512, 2) mk_fwd(Args a) {
    extern __shared__ __attribute__((aligned(16))) unsigned char lds_raw[];
    LAS unsigned char* lds = (LAS unsigned char*)lds_raw;
    unsigned char* ws = a.ws;
    const int G = gridDim.x, blk = blockIdx.x, wv = __builtin_amdgcn_readfirstlane(threadIdx.x >> 6);
    { const int t0 = opaque_tid(wv); if (t0 < 16) ((volatile LAS unsigned*)(lds + LDS_MISC))[t0] = 0u; }
    __syncthreads();
    XcdBarrier bar = xcd_barrier_post((unsigned*)(ws + WS_CTL), (volatile LAS unsigned*)(lds + LDS_MISC), opaque_tid(wv));
#define IN(k) (a.ph_lo <= (k) && (k) < a.ph_hi)
#define SEAM(k) do { if (IN(k) && IN((k) + 1)) xcd_barrier(bar, opaque_tid(wv)); } while (0)
    if (IN(0)) p0_prologue(wv, a, lds, blk, G);
    SEAM(0);
    if (IN(1)) {
        pg8::Gemm g{(const bf16*)(ws + WS_A0), (const bf16*)(ws + WS_WT_IN), S, NCOLS, D, D, D}; pg8::StaticOrder So; So.init(S, NCOLS, G, blk);
        pg8::EpiProj E{(const float*)(ws + WS_RSTD0), (bf16*)(ws + WS_A1), (bf16*)(ws + WS_A2), (bf16*)(ws + WS_A3), (bf16*)(ws + WS_A4), (bf16*)(ws + WS_A5), (bf16*)(ws + WS_A6), (bf16*)a.out, 0.125f * 1.4426950408889634f, (unsigned*)(ws + WS_KMAX)};
        pg8::gemm_phase<pg8::EpiProj, pg8::StaticOrder, true, true>(wv, lds, g, So, E);
    }
    SEAM(1);
    if (IN(2)) { conv_phase(wv, a, blk, G);  att::attn_phase(wv, a, lds, blk, G, (bf16*)(ws + WS_A3)); }
    SEAM(2);
    if (IN(3)) {
        pg8::StaticOrder So; So.init(S, D, G, blk);
        { pg8::Gemm g{(const bf16*)(ws + WS_A1), (const bf16*)(ws + WS_WT_CONV), S, D, 2 * D, D, D};
          const pg8::Split sp{16, (long long)WS_A3 - (long long)WS_A1 - 16 * 128, (long long)WS_WT_ATTN - (long long)WS_WT_CONV - 16 * 128};
          pg8::EpiMergeK E{(const bf16*)(ws + WS_A6), (const bf16*)a.out, (bf16*)(ws + WS_A0)};
          pg8::gemm_phase<pg8::EpiMergeK, pg8::StaticOrder, true, true, true>(wv, lds, g, So, E, sp); }
    }
    SEAM(3);
    if (IN(4)) {
        cross_fold(wv, a, blk, G);
        peer_convert(wv, a, blk, G);
        pg8::Gemm g{(const bf16*)(ws + WS_A0), (const bf16*)(ws + WS_WT_MIX), S, D, D, D, D}; pg8::StaticOrder So; So.init(S, D, G, blk);
        pg8::EpiResid E{a.in[I_X], (bf16*)(ws + WS_A2), (float*)(ws + WS_SS1)};
        pg8::gemm_phase<pg8::EpiResid, pg8::StaticOrder, true, true>(wv, lds, g, So, E);
    }
    SEAM(4);
    if (IN(5)) {
        pg8::Gemm g{(const bf16*)(ws + WS_A2), (const bf16*)(ws + WS_WQK), S, D, D, D, D}; pg8::StaticOrder So; So.init(S, D, G, blk);
        pg8::EpiSoftmaxFull E{(const float*)(ws + WS_SS1), (bf16*)(ws + WS_A1), 0.0625f * 1.4426950408889634f};
        pg8::gemm_phase<pg8::EpiSoftmaxFull, pg8::StaticOrder, false, true>(wv, lds, g, So, E);
    }
    SEAM(5);
    if (IN(6)) {
        pg8::Gemm g{(const bf16*)(ws + WS_A1), (const bf16*)(ws + WS_VW), S, D, D, D, D}; pg8::StaticOrder So; So.init(S, D, G, blk);
        pg8::EpiResidB E{(bf16*)(ws + WS_A2), (float*)(ws + WS_SS2)};
        pg8::gemm_phase<pg8::EpiResidB, pg8::StaticOrder, true, true>(wv, lds, g, So, E);
    }
    SEAM(6);
    if (IN(7)) {
        pg8::StaticOrder So; So.init(S, 2048, G, blk);
        unsigned* KS = (unsigned*)(ws + WS_KS) + (size_t)blk * 65536;
        for (int i = 0;; ++i) { pg8::Unit u; if (!So.next(i, u)) break;
            { pg8::Gemm g{(const bf16*)(ws + WS_A2), (const bf16*)(ws + WS_WT_PQ), S, 2048, D, D, D}; pg8::OneUnit S1{u.pm, u.pn};
              pg8::EpiKeys E{(const float*)(ws + WS_SS2), KS};
              pg8::gemm_phase<pg8::EpiKeys, pg8::OneUnit, false, true>(wv, lds, g, S1, E); }
            pg8::topk_from_keys(opaque_tid(wv), KS, (unsigned*)(ws + WS_TOPK), u.pm * 256, u.pn);
            asm volatile("s_waitcnt vmcnt(0)" ::: "memory"); __syncthreads(); }
    }
    SEAM(7);
    if (IN(8)) peer::peer_phase(wv, a, blk, G, a.out);
#undef IN
#undef SEAM
}

extern "C" void kernel_launch(void* const* d_in, const int* in_sizes, int n_in, void* d_out, int out_size, void* d_ws, size_t ws_size, hipStream_t stream) {
    static int grid = 0;
    if (grid == 0) {
        if (ws_size < WS_END || n_in != 25 || out_size != S * D) { fprintf(stderr, "kernel_launch: unexpected ws_size %zu / n_in %d / out_size %d\n", ws_size, n_in, out_size); grid = -1; return; }
        if (hipFuncSetAttribute((const void*)mk_fwd, hipFuncAttributeMaxDynamicSharedMemorySize, LDS_BYTES) != hipSuccess) { fprintf(stderr, "kernel_launch: hipFuncSetAttribute failed\n"); grid = -1; return; }
        int dev = 0, cus = 0, per_cu = 0;
        if (hipGetDevice(&dev) != hipSuccess || hipDeviceGetAttribute(&cus, hipDeviceAttributeMultiprocessorCount, dev) != hipSuccess) { grid = -1; return; }
        if (hipOccupancyMaxActiveBlocksPerMultiprocessor(&per_cu, (const void*)mk_fwd, 512, LDS_BYTES) != hipSuccess || per_cu < 1) { fprintf(stderr, "kernel_launch: occupancy query says %d blocks per CU\n", per_cu); grid = -1; return; }
        grid = cus;
    }
    if (grid < 0) return;
    Args a{};
    for (int i = 0; i < 25; ++i) a.in[i] = (const float*)d_in[i];
    a.out = (float*)d_out; a.ws = (unsigned char*)d_ws; a.ph_lo = 0; a.ph_hi = 9;
    if (hipMemsetAsync(d_ws, 0, 65536, stream) != hipSuccess) { fprintf(stderr, "kernel_launch: hipMemsetAsync failed\n"); return; }
    void* kargs[] = {&a};
    hipError_t e = hipLaunchCooperativeKernel((const void*)mk_fwd, dim3(grid), dim3(512), kargs, LDS_BYTES, stream);
    if (e != hipSuccess) fprintf(stderr, "kernel_launch: cooperative launch failed: %s (grid %d)\n", hipGetErrorString(e), grid);
}
```

```cpp
#include <hip/hip_runtime.h>
#include <math.h>
#include <cstdio>
#include <cstdint>
namespace pg8 {
#define PG8_LAS __attribute__((address_space(3)))
typedef unsigned short bf16_t;
typedef short bf16x8 __attribute__((ext_vector_type(8)));
typedef float f32x4 __attribute__((ext_vector_type(4)));
typedef unsigned u32x4 __attribute__((ext_vector_type(4)));
constexpr int BM = 256, BK = 64, HALF = 128, HTB = HALF * BK * 2  , STAGE_BYTES = 8 * HTB, NXCD = 8, WGM = 8;

__host__ __device__ __forceinline__ int lds_byte(int r, int c) { const int st = (r >> 4) * 2 + (c >> 5), rr = r & 15, cc = c & 31, ob = rr * 64 + cc * 2; return st * 1024 + (ob ^ (((ob >> 9) & 1) << 5)); }
__host__ __device__ __forceinline__ void stage_rc(int b, int& R, int& C) { const int st = b / 1024, sb = b % 1024, swz = sb ^ (((sb >> 9) & 1) << 5); R = (st >> 1) * 16 + swz / 64; C = (st & 1) * 32 + (swz % 64) / 2; }
__host__ __device__ __forceinline__ int perm32(int rho) { const int n = rho >> 4, i = rho & 15; return 8 * (i >> 2) + 4 * n + (i & 3); }

struct Unit { int pm, pn; };
struct Gemm { const bf16_t* A; const bf16_t* Bt; int M, N, K, lda, ldb; };
struct Split { int ksplit; long long dA2, dB2; };

struct StaticOrder {
    int nM, nN, nwg, G, c;
    __host__ __device__ void init(int M, int N, int G_, int c_) { nM = M / BM; nN = N / BM; nwg = nM * nN; G = G_; c = c_; }
    __host__ __device__ bool next(int i, Unit& u) const {
        const long L = (long)i * G + c; if (L >= nwg) return false;
        int wgid = (int)L; { const int q = nwg / NXCD, r = nwg % NXCD, xcd = wgid % NXCD, off = wgid / NXCD; wgid = (xcd < r ? xcd * (q + 1) : r * (q + 1) + (xcd - r) * q) + off; }
        const int nig = WGM * nN, gid = wgid / nig, fm = gid * WGM, gsz = (nM - fm) < WGM ? (nM - fm) : WGM;
        u.pm = fm + ((wgid % nig) % gsz); u.pn = (wgid % nig) / gsz; return true;
    }
    __device__ __forceinline__ void a_ready(const Unit&) const {}
    __device__ __forceinline__ void done(const Unit&) const {}
};

typedef float f32x2 __attribute__((ext_vector_type(2)));
typedef __bf16 bf16x2v __attribute__((ext_vector_type(2)));
__device__ __forceinline__ unsigned cvt_pk_bf16(float lo, float hi) { const f32x2 v = {lo, hi}; const bf16x2v b = __builtin_convertvector(v, bf16x2v); return __builtin_bit_cast(unsigned, b); }
template <class E, class = void> struct HasPrefetch { static constexpr bool value = false; };
template <class E> struct HasPrefetch<E, decltype((void)&E::prefetch)> { static constexpr bool value = true; };
template <class Epi, class Sched, bool ALIGN_EPI = false, bool SP2 = false, bool SPLIT = false>
__device__ __forceinline__ void gemm_phase(int wv, PG8_LAS unsigned char* lds, const Gemm g, const Sched& S, const Epi& E, const Split sp = Split{0, 0, 0}) {
    int tid_; asm volatile("v_mbcnt_lo_u32_b32 %0, -1, 0\n\tv_mbcnt_hi_u32_b32 %0, -1, %0" : "=v"(tid_)); tid_ += wv * 64;
    const int tid = tid_, wid = __builtin_amdgcn_readfirstlane(tid >> 6), lane = tid & 63, wr = wid >> 2, wc = wid & 3, fr = lane & 15, fq = lane >> 4;
    const int K = g.K, nt = K / BK;
    unsigned voffA[2], voffB[2];
#pragma unroll
    for (int i = 0; i < 2; ++i) { int R, C; stage_rc(tid * 16 + i * 8192, R, C); const int Rb = Epi::PERM ? ((R & ~31) + perm32(R & 31)) : R;
        voffA[i] = (unsigned)(R * g.lda + C) * 2u; voffB[i] = (unsigned)(Rb * g.ldb + C) * 2u; }
    const size_t kstep = (size_t)(BK * 2);
    const size_t hstepA = (size_t)HALF * g.lda * 2, hstepB = (size_t)HALF * g.ldb * 2;
    const size_t tstepA = 2 * hstepA, tstepB = 2 * hstepB;
    const unsigned ldsw = (unsigned)wid * 1024u;
    const int aoff = lds_byte(wr * 64 + fr, fq * 8), boff = lds_byte(wc * 32 + fr, fq * 8);
#define PG8_SA(b, h) (((b) * 2 + (h)) * HTB)
#define PG8_SB(b, h) ((4 + (b) * 2 + (h)) * HTB)
#define PG8_STAGE(bufoff, gbase, voff) do { _Pragma("unroll") for (int _i = 0; _i < 2; ++_i) \
        __builtin_amdgcn_global_load_lds((const unsigned*)((const char*)(gbase) + (voff)[_i]), (PG8_LAS unsigned*)(lds + (bufoff) + ldsw + _i * 8192), 16, 0, 0); } while (0)
#define PG8_LDA(dst, b, h) do { _Pragma("unroll") for (int m = 0; m < 4; ++m) _Pragma("unroll") for (int k = 0; k < 2; ++k) dst[m][k] = *(const PG8_LAS bf16x8*)(lds + PG8_SA(b, h) + aoff + m * 2048 + k * 1024); } while (0)
#define PG8_LDB(dst, b, h) do { _Pragma("unroll") for (int n = 0; n < 2; ++n) _Pragma("unroll") for (int k = 0; k < 2; ++k) dst[n][k] = *(const PG8_LAS bf16x8*)(lds + PG8_SB(b, h) + boff + n * 2048 + k * 1024); } while (0)
#define PG8_MMA(ai, bj, At, Bt) do { __builtin_amdgcn_s_setprio(1); _Pragma("unroll") for (int m = 0; m < 4; ++m) _Pragma("unroll") for (int n = 0; n < 2; ++n) _Pragma("unroll") for (int k = 0; k < 2; ++k) \
        acc[ai][bj][m][n] = __builtin_amdgcn_mfma_f32_16x16x32_bf16(Bt[n][k], At[m][k], acc[ai][bj][m][n], 0, 0, 0); __builtin_amdgcn_s_setprio(0); } while (0)
#define PG8_WAIT_V(n) asm volatile("s_waitcnt vmcnt(" #n ")" ::: "memory")
#define PG8_WAIT_L(n) asm volatile("s_waitcnt lgkmcnt(" #n ")" ::: "memory")
#define PG8_BAR __builtin_amdgcn_s_barrier()
#define PG8_SCHED __builtin_amdgcn_sched_barrier(0)
    Unit cur, nxt; int ui = 0;
    if (!S.next(0, cur)) return;
    f32x4 acc[2][2][4][2];
#pragma unroll
    for (int a = 0; a < 2; ++a)
#pragma unroll
        for (int b = 0; b < 2; ++b)
#pragma unroll
            for (int m = 0; m < 4; ++m)
#pragma unroll
                for (int n = 0; n < 2; ++n) acc[a][b][m][n] = (f32x4){0.f, 0.f, 0.f, 0.f};
    bf16x8 At[4][2], B0[2][2], B1[2][2];
    const char* cA = (const char*)g.A + (size_t)cur.pm * tstepA; const char* cB = (const char*)g.Bt + (size_t)cur.pn * tstepB;
    S.a_ready(cur);
    if constexpr (HasPrefetch<Epi>::value) E.prefetch(cur, lds, wid);
    if constexpr (SP2) {
        PG8_STAGE(PG8_SB(0, 0), cB, voffB); PG8_STAGE(PG8_SB(0, 1), cB + hstepB, voffB); PG8_STAGE(PG8_SA(0, 0), cA, voffA); PG8_STAGE(PG8_SA(0, 1), cA + hstepA, voffA);
        if (wr == 1) PG8_BAR;
        PG8_WAIT_V(2); PG8_BAR;
        PG8_STAGE(PG8_SB(1, 0), cB + kstep, voffB); PG8_STAGE(PG8_SA(1, 0), cA + kstep, voffA); PG8_STAGE(PG8_SB(1, 1), cB + hstepB + kstep, voffB);
        PG8_WAIT_V(6); PG8_BAR;
    } else {
        PG8_STAGE(PG8_SB(0, 0), cB, voffB); PG8_STAGE(PG8_SA(0, 0), cA, voffA); PG8_STAGE(PG8_SB(0, 1), cB + hstepB, voffB); PG8_STAGE(PG8_SA(0, 1), cA + hstepA, voffA);
        if (wr == 1) PG8_BAR;
        PG8_WAIT_V(4); PG8_BAR;
        PG8_STAGE(PG8_SB(1, 0), cB + kstep, voffB); PG8_STAGE(PG8_SA(1, 0), cA + kstep, voffA); PG8_STAGE(PG8_SB(1, 1), cB + hstepB + kstep, voffB);
        PG8_WAIT_V(6); PG8_BAR;
    }
    for (;;) {
        const bool has_next = S.next(ui + 1, nxt);
        const char* nA = has_next ? (const char*)g.A + (size_t)nxt.pm * tstepA : cA; const char* nB = has_next ? (const char*)g.Bt + (size_t)nxt.pn * tstepB : cB;
        for (int t = 0; t < nt; t += 2) {
            const bool last = (t == nt - 2);
            long long oa1 = 0, oa2 = 0, ob2 = 0;
            if constexpr (SPLIT) { if (t == sp.ksplit) E.mid(acc, cur, wr, wc, fr, fq);
                if (t >= sp.ksplit) oa1 = sp.dA2; if (t + 2 >= sp.ksplit) { oa2 = sp.dA2; ob2 = sp.dB2; } }
            const char* a1 = cA + (size_t)(t + 1) * kstep + oa1;
            const char* a2 = last ? nA : cA + (size_t)(t + 2) * kstep + oa2; const char* b2 = last ? nB : cB + (size_t)(t + 2) * kstep + ob2;
            const char* a3 = a2 + kstep; const char* b3 = b2 + kstep;
            if (last && has_next) S.a_ready(nxt);
            if constexpr (SP2) {
            PG8_LDB(B0, 0, 0); PG8_LDB(B1, 0, 1); PG8_SCHED; PG8_LDA(At, 0, 0); PG8_STAGE(PG8_SA(1, 1), a1 + hstepA, voffA);
            PG8_WAIT_V(8); PG8_WAIT_L(0); PG8_BAR; PG8_MMA(0, 0, At, B0); PG8_MMA(0, 1, At, B1); PG8_BAR; PG8_SCHED;
            PG8_LDA(At, 0, 1); PG8_STAGE(PG8_SB(0, 0), b2, voffB); PG8_STAGE(PG8_SB(0, 1), b2 + hstepB, voffB); PG8_STAGE(PG8_SA(0, 0), a2, voffA);
            PG8_WAIT_V(8); PG8_WAIT_L(0); PG8_BAR; PG8_MMA(1, 0, At, B0); PG8_MMA(1, 1, At, B1); PG8_BAR; PG8_SCHED;
            PG8_LDB(B0, 1, 0); PG8_LDB(B1, 1, 1); PG8_SCHED; PG8_LDA(At, 1, 0); PG8_STAGE(PG8_SA(0, 1), a2 + hstepA, voffA);
            PG8_WAIT_V(8); PG8_WAIT_L(0); PG8_BAR; PG8_MMA(0, 0, At, B0); PG8_MMA(0, 1, At, B1); PG8_BAR; PG8_SCHED;
            PG8_LDA(At, 1, 1); PG8_STAGE(PG8_SB(1, 0), b3, voffB); PG8_STAGE(PG8_SB(1, 1), b3 + hstepB, voffB); PG8_STAGE(PG8_SA(1, 0), a3, voffA);
            PG8_WAIT_V(8); PG8_WAIT_L(0); PG8_BAR; PG8_MMA(1, 0, At, B0); PG8_MMA(1, 1, At, B1); PG8_BAR; PG8_SCHED;
            } else {
            PG8_LDB(B0, 0, 0); PG8_SCHED; PG8_LDA(At, 0, 0); PG8_STAGE(PG8_SA(1, 1), a1 + hstepA, voffA);
            PG8_WAIT_L(8); PG8_BAR; PG8_WAIT_L(0); PG8_MMA(0, 0, At, B0); PG8_BAR; PG8_SCHED;
            PG8_LDB(B1, 0, 1); PG8_STAGE(PG8_SB(0, 0), b2, voffB);
            PG8_BAR; PG8_WAIT_L(0); PG8_MMA(0, 1, At, B1); PG8_BAR;
            PG8_LDA(At, 0, 1); PG8_STAGE(PG8_SA(0, 0), a2, voffA);
            PG8_BAR; PG8_WAIT_L(0); PG8_MMA(1, 0, At, B0); PG8_BAR; PG8_SCHED;
            PG8_STAGE(PG8_SB(0, 1), b2 + hstepB, voffB);
            PG8_WAIT_V(6); PG8_BAR; PG8_MMA(1, 1, At, B1); PG8_BAR;
            PG8_LDB(B0, 1, 0); PG8_SCHED; PG8_LDA(At, 1, 0); PG8_STAGE(PG8_SA(0, 1), a2 + hstepA, voffA);
            PG8_WAIT_L(8); PG8_BAR; PG8_WAIT_L(0); PG8_MMA(0, 0, At, B0); PG8_BAR; PG8_SCHED;
            PG8_LDB(B1, 1, 1); PG8_STAGE(PG8_SB(1, 0), b3, voffB);
            PG8_BAR; PG8_WAIT_L(0); PG8_MMA(0, 1, At, B1); PG8_BAR;
            PG8_LDA(At, 1, 1); PG8_STAGE(PG8_SA(1, 0), a3, voffA);
            PG8_BAR; PG8_WAIT_L(0); PG8_MMA(1, 0, At, B0); PG8_BAR; PG8_SCHED;
            PG8_STAGE(PG8_SB(1, 1), b3 + hstepB, voffB);
            PG8_WAIT_V(6); PG8_BAR; PG8_MMA(1, 1, At, B1); PG8_BAR;
            }
        }
        if constexpr (ALIGN_EPI) { if (wr == 0) PG8_BAR; }
        if constexpr (!Epi::AFTER_DRAIN) { E(acc, cur, wr, wc, fr, fq); S.done(cur); }
        if (!has_next) break;
#pragma unroll
        for (int a = 0; a < 2; ++a)
#pragma unroll
            for (int b = 0; b < 2; ++b)
#pragma unroll
                for (int m = 0; m < 4; ++m)
#pragma unroll
                    for (int n = 0; n < 2; ++n) acc[a][b][m][n] = (f32x4){0.f, 0.f, 0.f, 0.f};
        cur = nxt; cA = nA; cB = nB; ++ui;
        if constexpr (HasPrefetch<Epi>::value) E.prefetch(cur, lds, wid);
        if constexpr (ALIGN_EPI) { if (wr == 1) PG8_BAR; }
    }
    PG8_WAIT_V(0);
    if constexpr (!ALIGN_EPI) { if (wr == 0) PG8_BAR; }
    PG8_BAR;
    if constexpr (Epi::AFTER_DRAIN) { E.fused(acc, cur, wr, wc, fr, fq, lds, wid, lane); S.done(cur); }
#undef PG8_SA
#undef PG8_SB
#undef PG8_STAGE
#undef PG8_LDA
#undef PG8_LDB
#undef PG8_MMA
#undef PG8_WAIT_V
#undef PG8_WAIT_L
#undef PG8_BAR
#undef PG8_SCHED
}
}


constexpr int S = 16384, D = 1024, NCOLS = 8192, MEMN = 256;
typedef unsigned short bf16;
typedef float f32x4 __attribute__((ext_vector_type(4)));
typedef unsigned u32x4 __attribute__((ext_vector_type(4)));
typedef unsigned u32x2 __attribute__((ext_vector_type(2)));
__device__ __forceinline__ void st16wt(void* p, u32x4 v) { asm volatile("global_store_dwordx4 %0, %1, off sc1\n\ts_nop 1" :: "v"(p), "v"(v) : "memory"); }
#define LAS __attribute__((address_space(3)))

__device__ const unsigned char T5_BUCKET[128] = {0, 1, 2, 3, 4, 5, 6, 7, 8, 9, 10, 11, 12, 13, 14, 15, 16, 16, 16, 17, 17, 18, 18, 18, 19, 19, 19, 20, 20, 20, 20, 21, 21, 21, 21, 22, 22, 22, 22, 22, 23, 23, 23, 23, 23, 23, 24, 24, 24, 24, 24, 24, 25, 25, 25, 25, 25, 25, 25, 26, 26, 26, 26, 26, 26, 26, 26, 27, 27, 27, 27, 27, 27, 27, 27, 27, 27, 28, 28, 28, 28, 28, 28, 28, 28, 28, 28, 29, 29, 29, 29, 29, 29, 29, 29, 29, 29, 29, 29, 30, 30, 30, 30, 30, 30, 30, 30, 30, 30, 30, 30, 30, 30, 31, 31, 31, 31, 31, 31, 31, 31, 31, 31, 31, 31, 31, 31, 31};

constexpr size_t MiB = 1u << 20;
constexpr size_t WS_CTL = 0, WS_KMAX = 32768  , WS_RSTD0 = 512 * 1024;
constexpr size_t WS_WT_IN = 1 * MiB, WS_WT_CONV = 17 * MiB, WS_WT_ATTN = 19 * MiB, WS_WT_MIX = 21 * MiB, WS_WT_CQ = 23 * MiB, WS_WT_CO = 25 * MiB, WS_WT_PQ = 27 * MiB;
constexpr size_t WS_SUBK = 31 * MiB, WS_KV = 32 * MiB, WS_SS1 = 34 * MiB, WS_SS2 = 35 * MiB;
constexpr size_t WS_TOPK = 36 * MiB  , WS_PU = 196 * MiB  , WS_PV = 228 * MiB  ;
constexpr size_t WS_WQK = 23 * MiB  , WS_VW = 212 * MiB  ;
constexpr size_t WS_PQS = 52 * MiB  , WS_KS = 132 * MiB  ;
constexpr size_t WS_A0 = 36 * MiB, WS_A1 = 68 * MiB, WS_A2 = 100 * MiB, WS_A3 = 132 * MiB, WS_A4 = 164 * MiB, WS_A5 = 196 * MiB, WS_A6 = 228 * MiB, WS_END = 260 * MiB;

__device__ __forceinline__ float wave_sum(float v) {
#pragma unroll
    for (int o = 1; o < 64; o <<= 1) v += __shfl_xor(v, o);
    return v;
}
__device__ __forceinline__ float wave_max(float v) {
#pragma unroll
    for (int o = 1; o < 64; o <<= 1) v = fmaxf(v, __shfl_xor(v, o));
    return v;
}
__device__ __forceinline__ int opaque_tid(int wv) { int t; asm volatile("v_mbcnt_lo_u32_b32 %0, -1, 0\n\tv_mbcnt_hi_u32_b32 %0, -1, %0" : "=v"(t)); return t + wv * 64; }
__device__ __forceinline__ unsigned f2bf(float f) { unsigned u = __builtin_bit_cast(unsigned, f); return (u + 0x7fffu + ((u >> 16) & 1u)) >> 16; }
__device__ __forceinline__ unsigned pk2(float lo, float hi) { return pg8::cvt_pk_bf16(lo, hi); }
__device__ __forceinline__ float bflo(unsigned w) { return __builtin_bit_cast(float, w << 16); }
__device__ __forceinline__ float bfhi(unsigned w) { return __builtin_bit_cast(float, w & 0xffff0000u); }
__device__ __forceinline__ float sigmoidf_(float x) { return __builtin_amdgcn_rcpf(1.0f + __builtin_amdgcn_exp2f(x * -1.4426950408889634f)); }

struct Args { const float* in[25]; float* out; unsigned char* ws; int ph_lo, ph_hi; };
enum { I_X = 0, I_MEM, I_NORM_MIX_G, I_W_IN, I_CONV_W, I_W_CONV_OUT, I_LQ1, I_LK1, I_LQ2, I_LK2, I_SUBLN_G, I_W_ATTN_OUT, I_W_MIX_OUT, I_REL_BIAS, I_NORM_CROSS_G, I_NORM_MEM_G,
       I_W_CQ, I_W_CKV, I_W_CO, I_NORM_FFN_G, I_W_PQ, I_SUB_KEYS, I_PEER_U, I_PEER_V, I_FINAL_G };

namespace pg8 {
template <int CTRL> __device__ __forceinline__ float dppf(float x) { return __builtin_bit_cast(float, __builtin_amdgcn_mov_dpp(__builtin_bit_cast(int, x), CTRL, 0xf, 0xf, true)); }
__device__ __forceinline__ float row16_max(float v) { v = fmaxf(v, dppf<0xB1>(v)); v = fmaxf(v, dppf<0x4E>(v)); v = fmaxf(v, dppf<0x141>(v)); return fmaxf(v, dppf<0x140>(v)); }
__device__ __forceinline__ float xrow16_max(float x) {
    auto s = __builtin_amdgcn_permlane16_swap(__float_as_uint(x), __float_as_uint(x), false, false); x = fmaxf(__uint_as_float(s[0]), __uint_as_float(s[1]));
    auto t = __builtin_amdgcn_permlane32_swap(__float_as_uint(x), __float_as_uint(x), false, false); return fmaxf(__uint_as_float(t[0]), __uint_as_float(t[1])); }
__device__ __forceinline__ float xrow16_sum(float x) {
    auto s = __builtin_amdgcn_permlane16_swap(__float_as_uint(x), __float_as_uint(x), false, false); x = __uint_as_float(s[0]) + __uint_as_float(s[1]);
    auto t = __builtin_amdgcn_permlane32_swap(__float_as_uint(x), __float_as_uint(x), false, false); return __uint_as_float(t[0]) + __uint_as_float(t[1]); }
__device__ __forceinline__ u32x4 pack8(const f32x4& v0, const f32x4& v1) { u32x4 w; w.x = cvt_pk_bf16(v0[0], v0[1]); w.y = cvt_pk_bf16(v0[2], v0[3]); w.z = cvt_pk_bf16(v1[0], v1[1]); w.w = cvt_pk_bf16(v1[2], v1[3]); return w; }
struct EpiProj {
    static constexpr bool PERM = true, AFTER_DRAIN = false;
    const float* rstd_g; bf16_t *CB, *U, *Q, *K, *V, *SGC, *SGA; float qscale; unsigned* KMAX; PG8_LAS float* rl;
    __device__ __forceinline__ void prefetch(const Unit& u, PG8_LAS unsigned char* lds, int wid) const {
        if (wid == 0) { int ln; asm volatile("v_mbcnt_lo_u32_b32 %0, -1, 0\n\tv_mbcnt_hi_u32_b32 %0, -1, %0" : "=v"(ln));
            __builtin_amdgcn_global_load_lds((const unsigned*)(rstd_g + u.pm * BM + ln * 4), (PG8_LAS unsigned*)rl, 16, 0, 0); }
    }
    __device__ __forceinline__ void operator()(const f32x4 (&acc)[2][2][4][2], const Unit& u, int wr, int wc, int fr0, int fq) const {
        int fr = fr0; asm volatile("" : "+v"(fr));
        const int row0 = u.pm * BM + wr * 64 + fr, pn = u.pn, colw = wc * 32 + 8 * fq;
        const PG8_LAS float* rstd = rl - u.pm * BM;
        if (pn >= 4 && pn < 12) {
            const int col = 128 * (pn - 4) + colw;
#pragma unroll
            for (int ai = 0; ai < 2; ++ai)
#pragma unroll
                for (int m = 0; m < 4; ++m) { const int row = row0 + ai * HALF + m * 16; const float rs = rstd[row], r2 = rs * rs;
                    const f32x4 v0 = acc[ai][0][m][0] * acc[ai][1][m][0] * r2, v1 = acc[ai][0][m][1] * acc[ai][1][m][1] * r2;
                    *(u32x4*)(U + (size_t)row * 1024 + col) = pack8(v0, v1); }
            return;
        }
        bf16_t* base; int cbase; float sc = 1.f; bool gate = false;
        if (pn < 4) { base = CB; cbase = pn * 256; }
        else if (pn < 16) { base = Q; cbase = (pn - 12) * 256; sc = qscale; }
        else if (pn < 20) { base = K; cbase = (pn - 16) * 256; }
        else if (pn < 24) { base = V; cbase = (pn - 20) * 256; }
        else if (pn < 28) { base = SGC; cbase = (pn - 24) * 256; gate = true; }
        else { base = SGA; cbase = (pn - 28) * 256; gate = true; }
#pragma unroll
        for (int ai = 0; ai < 2; ++ai)
#pragma unroll
            for (int m = 0; m < 4; ++m) { const int row = row0 + ai * HALF + m * 16; const float rs = rstd[row] * sc;
#pragma unroll
                for (int bj = 0; bj < 2; ++bj) { f32x4 v0 = acc[ai][bj][m][0] * rs, v1 = acc[ai][bj][m][1] * rs;
                    if (gate) {
#pragma unroll
                        for (int e = 0; e < 4; ++e) { v0[e] = sigmoidf_(v0[e]); v1[e] = sigmoidf_(v1[e]); } }
                    *(u32x4*)(base + (size_t)row * 1024 + cbase + bj * HALF + colw) = pack8(v0, v1); } }
        if (pn >= 16 && pn < 20) {
            float mx[2] = {0.f, 0.f};
#pragma unroll
            for (int ai = 0; ai < 2; ++ai)
#pragma unroll
                for (int m = 0; m < 4; ++m) { const float rs = rstd[row0 + ai * HALF + m * 16];
#pragma unroll
                    for (int bj = 0; bj < 2; ++bj) { const f32x4 v0 = acc[ai][bj][m][0] * rs, v1 = acc[ai][bj][m][1] * rs;
                        const float s = xrow16_sum(((v0[0] * v0[0] + v0[1] * v0[1]) + (v0[2] * v0[2] + v0[3] * v0[3])) + ((v1[0] * v1[0] + v1[1] * v1[1]) + (v1[2] * v1[2] + v1[3] * v1[3])));
                        mx[bj] = fmaxf(mx[bj], s); } }
#pragma unroll
            for (int bj = 0; bj < 2; ++bj) { float v = mx[bj];
                v = row16_max(v);
                if (fr == 0 && fq == 0) atomicMax(KMAX + (((pn - 16) * 2 + bj) * 2 + (wc >> 1)) * 2 + (wc & 1), __float_as_uint(v)); }
        }
    }
};
struct EpiGateT {
    static constexpr bool PERM = true, AFTER_DRAIN = false;
    const bf16_t* SG; float* T;
    __device__ __forceinline__ void operator()(const f32x4 (&acc)[2][2][4][2], const Unit& u, int wr, int wc, int fr0, int fq) const {
        int fr = fr0; asm volatile("" : "+v"(fr));
        const int row0 = u.pm * BM + wr * 64 + fr, col0 = u.pn * BM + wc * 32 + 8 * fq;
#pragma unroll
        for (int ai = 0; ai < 2; ++ai)
#pragma unroll
            for (int m = 0; m < 4; ++m) { const size_t off = (size_t)(row0 + ai * HALF + m * 16) * 1024 + col0;
#pragma unroll
                for (int bj = 0; bj < 2; ++bj) { const u32x4 g = *(const u32x4*)(SG + off + bj * HALF);
                    f32x4 g0 = {bflo(g.x), bfhi(g.x), bflo(g.y), bfhi(g.y)}, g1 = {bflo(g.z), bfhi(g.z), bflo(g.w), bfhi(g.w)};
                    *(f32x4*)(T + off + bj * HALF) = g0 * acc[ai][bj][m][0]; *(f32x4*)(T + off + bj * HALF + 4) = g1 * acc[ai][bj][m][1]; } }
    }
};
struct EpiMerge {
    static constexpr bool PERM = true, AFTER_DRAIN = false;
    const float* T; const bf16_t* SG; bf16_t* O;
    __device__ __forceinline__ void operator()(const f32x4 (&acc)[2][2][4][2], const Unit& u, int wr, int wc, int fr0, int fq) const {
        int fr = fr0; asm volatile("" : "+v"(fr));
        const int row0 = u.pm * BM + wr * 64 + fr, col0 = u.pn * BM + wc * 32 + 8 * fq;
#pragma unroll
        for (int ai = 0; ai < 2; ++ai)
#pragma unroll
            for (int m = 0; m < 4; ++m) { const size_t off = (size_t)(row0 + ai * HALF + m * 16) * 1024 + col0;
#pragma unroll
                for (int bj = 0; bj < 2; ++bj) { const u32x4 g = *(const u32x4*)(SG + off + bj * HALF);
                    f32x4 g0 = {bflo(g.x), bfhi(g.x), bflo(g.y), bfhi(g.y)}, g1 = {bflo(g.z), bfhi(g.z), bflo(g.w), bfhi(g.w)};
                    const f32x4 t0 = *(const f32x4*)(T + off + bj * HALF), t1 = *(const f32x4*)(T + off + bj * HALF + 4);
                    *(u32x4*)(O + off + bj * HALF) = pack8(t0 + g0 * acc[ai][bj][m][0], t1 + g1 * acc[ai][bj][m][1]); } }
    }
};
struct EpiMergeK {
    static constexpr bool PERM = true, AFTER_DRAIN = false;
    const bf16_t* SGc; const bf16_t* SGa; bf16_t* O;
    __device__ __forceinline__ void mid(f32x4 (&acc)[2][2][4][2], const Unit& u, int wr, int wc, int fr0, int fq) const {
        int fr = fr0; asm volatile("" : "+v"(fr));
        const int row0 = u.pm * BM + wr * 64 + fr, col0 = u.pn * BM + wc * 32 + 8 * fq;
#pragma unroll
        for (int ai = 0; ai < 2; ++ai)
#pragma unroll
            for (int m = 0; m < 4; ++m) { const size_t off = (size_t)(row0 + ai * HALF + m * 16) * 1024 + col0;
#pragma unroll
                for (int bj = 0; bj < 2; ++bj) { const u32x4 c = *(const u32x4*)(SGc + off + bj * HALF), g = *(const u32x4*)(SGa + off + bj * HALF);
                    const f32x4 c0 = {bflo(c.x), bfhi(c.x), bflo(c.y), bfhi(c.y)}, c1 = {bflo(c.z), bfhi(c.z), bflo(c.w), bfhi(c.w)};
                    f32x4 g0 = {bflo(g.x), bfhi(g.x), bflo(g.y), bfhi(g.y)}, g1 = {bflo(g.z), bfhi(g.z), bflo(g.w), bfhi(g.w)};
#pragma unroll
                    for (int e = 0; e < 4; ++e) { g0[e] = c0[e] * __builtin_amdgcn_rcpf(fmaxf(g0[e], 1e-20f)); g1[e] = c1[e] * __builtin_amdgcn_rcpf(fmaxf(g1[e], 1e-20f)); }
                    acc[ai][bj][m][0] *= g0; acc[ai][bj][m][1] *= g1; } }
    }
    __device__ __forceinline__ void operator()(const f32x4 (&acc)[2][2][4][2], const Unit& u, int wr, int wc, int fr0, int fq) const {
        int fr = fr0; asm volatile("" : "+v"(fr));
        const int row0 = u.pm * BM + wr * 64 + fr, col0 = u.pn * BM + wc * 32 + 8 * fq;
#pragma unroll
        for (int ai = 0; ai < 2; ++ai)
#pragma unroll
            for (int m = 0; m < 4; ++m) { const size_t off = (size_t)(row0 + ai * HALF + m * 16) * 1024 + col0;
#pragma unroll
                for (int bj = 0; bj < 2; ++bj) { const u32x4 g = *(const u32x4*)(SGa + off + bj * HALF);
                    f32x4 g0 = {bflo(g.x), bfhi(g.x), bflo(g.y), bfhi(g.y)}, g1 = {bflo(g.z), bfhi(g.z), bflo(g.w), bfhi(g.w)};
#pragma unroll
                    for (int e = 0; e < 4; ++e) { g0[e] = fmaxf(g0[e], 1e-20f); g1[e] = fmaxf(g1[e], 1e-20f); }
                    st16wt(O + off + bj * HALF, pack8(g0 * acc[ai][bj][m][0], g1 * acc[ai][bj][m][1])); } }
    }
};
struct EpiResid {
    static constexpr bool PERM = true, AFTER_DRAIN = false;
    const float* R; bf16_t* XB; float* SS;
    __device__ __forceinline__ void operator()(const f32x4 (&acc)[2][2][4][2], const Unit& u, int wr, int wc, int fr0, int fq) const {
        int fr = fr0; asm volatile("" : "+v"(fr));
        const int row0 = u.pm * BM + wr * 64 + fr, col0 = u.pn * BM + wc * 32 + 8 * fq;
#pragma unroll
        for (int ai = 0; ai < 2; ++ai)
#pragma unroll
            for (int m = 0; m < 4; ++m) { const int row = row0 + ai * HALF + m * 16; const size_t off = (size_t)row * 1024 + col0; float ss = 0.f;
#pragma unroll
                for (int bj = 0; bj < 2; ++bj) {
                    const f32x4 x0 = *(const f32x4*)(R + off + bj * HALF) + acc[ai][bj][m][0], x1 = *(const f32x4*)(R + off + bj * HALF + 4) + acc[ai][bj][m][1];
                    st16wt(XB + off + bj * HALF, pack8(x0, x1));
                    ss += (x0[0] * x0[0] + x0[1] * x0[1]) + (x0[2] * x0[2] + x0[3] * x0[3]) + (x1[0] * x1[0] + x1[1] * x1[1]) + (x1[2] * x1[2] + x1[3] * x1[3]); }
                ss = xrow16_sum(ss);
                if (fq == 0) SS[(size_t)row * 16 + u.pn * 4 + wc] = ss; }
    }
};
struct EpiResidB {
    static constexpr bool PERM = true, AFTER_DRAIN = false;
    bf16_t* XB; float* SS;
    __device__ __forceinline__ void operator()(const f32x4 (&acc)[2][2][4][2], const Unit& u, int wr, int wc, int fr0, int fq) const {
        int fr = fr0; asm volatile("" : "+v"(fr));
        const int row0 = u.pm * BM + wr * 64 + fr, col0 = u.pn * BM + wc * 32 + 8 * fq;
#pragma unroll
        for (int ai = 0; ai < 2; ++ai)
#pragma unroll
            for (int m = 0; m < 4; ++m) { const int row = row0 + ai * HALF + m * 16; const size_t off = (size_t)row * 1024 + col0; float ss = 0.f;
#pragma unroll
                for (int bj = 0; bj < 2; ++bj) { const u32x4 g = *(const u32x4*)(XB + off + bj * HALF);
                    const f32x4 r0 = {bflo(g.x), bfhi(g.x), bflo(g.y), bfhi(g.y)}, r1 = {bflo(g.z), bfhi(g.z), bflo(g.w), bfhi(g.w)};
                    const f32x4 x0 = r0 + acc[ai][bj][m][0], x1 = r1 + acc[ai][bj][m][1];
                    st16wt(XB + off + bj * HALF, pack8(x0, x1));
                    ss += (x0[0] * x0[0] + x0[1] * x0[1]) + (x0[2] * x0[2] + x0[3] * x0[3]) + (x1[0] * x1[0] + x1[1] * x1[1]) + (x1[2] * x1[2] + x1[3] * x1[3]); }
                ss = xrow16_sum(ss);
                if (fq == 0) SS[(size_t)row * 16 + u.pn * 4 + wc] = ss; }
    }
};
struct EpiRowScale {
    static constexpr bool PERM = true, AFTER_DRAIN = false;
    const float* SS; bf16_t* O; int ldc; float sc;
    __device__ __forceinline__ void operator()(const f32x4 (&acc)[2][2][4][2], const Unit& u, int wr, int wc, int fr0, int fq) const {
        int fr = fr0; asm volatile("" : "+v"(fr));
        const int row0 = u.pm * BM + wr * 64 + fr, col0 = u.pn * BM + wc * 32 + 8 * fq;
#pragma unroll
        for (int ai = 0; ai < 2; ++ai)
#pragma unroll
            for (int m = 0; m < 4; ++m) { const int row = row0 + ai * HALF + m * 16;
                const f32x4* sp = (const f32x4*)(SS + (size_t)row * 16); const f32x4 s4 = (sp[0] + sp[1]) + (sp[2] + sp[3]);
                const float rs = sc / sqrtf(((s4[0] + s4[1]) + (s4[2] + s4[3])) * (1.0f / 1024.0f) + 1e-6f);
#pragma unroll
                for (int bj = 0; bj < 2; ++bj) *(u32x4*)(O + (size_t)row * ldc + col0 + bj * HALF) = pack8(acc[ai][bj][m][0] * rs, acc[ai][bj][m][1] * rs); }
    }
};

__device__ __forceinline__ unsigned f2ord(float f) { const unsigned u = __builtin_bit_cast(unsigned, f); return u ^ ((unsigned)((int)u >> 31) | 0x80000000u); }
__device__ __forceinline__ float ord2f(unsigned k) { const unsigned u = (k & 0x80000000u) ? (k ^ 0x80000000u) : ~k; return __builtin_bit_cast(float, u); }
#define PG8_CSWAP(a, b) do { const unsigned hi_ = (a) > (b) ? (a) : (b), lo_ = (a) > (b) ? (b) : (a); (a) = hi_; (b) = lo_; } while (0)
__device__ __forceinline__ void sort16_desc(unsigned (&k)[16]) {
#pragma unroll
    for (int sz = 2; sz <= 16; sz <<= 1)
#pragma unroll
        for (int st = sz >> 1; st > 0; st >>= 1)
#pragma unroll
            for (int i = 0; i < 16; ++i) { const int l = i ^ st; if (l > i) { if ((i & sz) == 0) PG8_CSWAP(k[i], k[l]); else PG8_CSWAP(k[l], k[i]); } }
}
__device__ __forceinline__ void merge16_desc(unsigned (&a)[16], const unsigned (&b)[16]) {
#pragma unroll
    for (int i = 0; i < 16; ++i) a[i] = a[i] > b[15 - i] ? a[i] : b[15 - i];
#pragma unroll
    for (int st = 8; st > 0; st >>= 1)
#pragma unroll
        for (int i = 0; i < 16; ++i) { const int l = i ^ st; if (l > i) PG8_CSWAP(a[i], a[l]); }
}
struct EpiKeys {
    static constexpr bool PERM = true, AFTER_DRAIN = false;
    const float* SS; unsigned* KS;
    __device__ __forceinline__ void operator()(const f32x4 (&acc)[2][2][4][2], const Unit& u, int wr, int wc, int fr0, int fq) const {
        int fr = fr0; asm volatile("" : "+v"(fr));
#pragma unroll
        for (int ai = 0; ai < 2; ++ai)
#pragma unroll
            for (int m = 0; m < 4; ++m) { const int row = ai * HALF + wr * 64 + m * 16 + fr;
                const f32x4* sp = (const f32x4*)(SS + (size_t)(u.pm * BM + row) * 16); const f32x4 s4 = (sp[0] + sp[1]) + (sp[2] + sp[3]);
                const float rs = 1.0f / sqrtf(((s4[0] + s4[1]) + (s4[2] + s4[3])) * (1.0f / 1024.0f) + 1e-6f);
#pragma unroll
                for (int bj = 0; bj < 2; ++bj)
#pragma unroll
                    for (int n = 0; n < 2; ++n) { const int cw = wc * 32 + 8 * fq + 4 * n; u32x4 k;
#pragma unroll
                        for (int e = 0; e < 4; ++e) k[e] = (f2ord(acc[ai][bj][m][n][e] * rs) & ~0x7Fu) | (unsigned)(127 - (cw + e));
                        *(u32x4*)(KS + row * 256 + bj * HALF + cw) = k; } }
    }
};
__device__ __forceinline__ void topk_from_keys(int tid, const unsigned* KS, unsigned* TOPK, int tok0, int h) {
#pragma unroll 1
    for (int ai = 0; ai < 2; ++ai) {
        const int j = tid & 1, rl = (tid >> 1) & 127, c = tid >> 8;
        const unsigned* src = KS + (ai * 128 + rl) * 256 + c * 128 + j * 64;
        unsigned best[16], cur[16];
        { const u32x4 a0 = *(const u32x4*)src, a1 = *(const u32x4*)(src + 4), a2 = *(const u32x4*)(src + 8), a3 = *(const u32x4*)(src + 12);
#pragma unroll
          for (int e = 0; e < 4; ++e) { best[e] = a0[e]; best[4 + e] = a1[e]; best[8 + e] = a2[e]; best[12 + e] = a3[e]; } }
        sort16_desc(best);
#pragma unroll 1
        for (int gq = 1; gq < 4; ++gq) {
            const u32x4 a0 = *(const u32x4*)(src + gq * 16), a1 = *(const u32x4*)(src + gq * 16 + 4), a2 = *(const u32x4*)(src + gq * 16 + 8), a3 = *(const u32x4*)(src + gq * 16 + 12);
#pragma unroll
            for (int e = 0; e < 4; ++e) { cur[e] = a0[e]; cur[4 + e] = a1[e]; cur[8 + e] = a2[e]; cur[12 + e] = a3[e]; }
            sort16_desc(cur); merge16_desc(best, cur); }
#pragma unroll
        for (int i = 0; i < 16; ++i) cur[i] = (unsigned)__shfl_xor((int)best[i], 1);
        merge16_desc(best, cur);
        unsigned* dst = TOPK + ((size_t)(tok0 + ai * 128 + rl) * 8 + h) * 32 + c * 16 + j * 8;
        u32x4 w0, w1;
        if (j == 0) { w0 = (u32x4){best[0], best[1], best[2], best[3]}; w1 = (u32x4){best[4], best[5], best[6], best[7]}; }
        else { w0 = (u32x4){best[8], best[9], best[10], best[11]}; w1 = (u32x4){best[12], best[13], best[14], best[15]}; }
        st16wt(dst, w0); st16wt(dst + 4, w1);
    }
}
struct EpiSoftmaxP {
    static constexpr bool PERM = true, AFTER_DRAIN = true;
    bf16_t* P; PG8_LAS float* lrow;
    __device__ __forceinline__ void fused(f32x4 (&acc)[2][2][4][2], const Unit& u, int wr, int wc, int fr0, int fq, PG8_LAS unsigned char* lds, int wid, int lane) const {
        int fr = fr0; asm volatile("" : "+v"(fr));
        PG8_LAS float* MX = (PG8_LAS float*)lds; PG8_LAS float* SM = MX + 1024;
#pragma unroll
        for (int ai = 0; ai < 2; ++ai)
#pragma unroll
            for (int m = 0; m < 4; ++m) { float mx = -INFINITY;
#pragma unroll
                for (int bj = 0; bj < 2; ++bj)
#pragma unroll
                    for (int n = 0; n < 2; ++n)
#pragma unroll
                        for (int e = 0; e < 4; ++e) mx = fmaxf(mx, acc[ai][bj][m][n][e]);
                mx = xrow16_max(mx);
                if (fq == 0) MX[(ai * HALF + wr * 64 + m * 16 + fr) * 4 + wc] = mx; }
        asm volatile("s_waitcnt lgkmcnt(0)\n\ts_barrier" ::: "memory");
#pragma unroll
        for (int ai = 0; ai < 2; ++ai)
#pragma unroll
            for (int m = 0; m < 4; ++m) { const int row = ai * HALF + wr * 64 + m * 16 + fr;
                const f32x4 m4 = *(const PG8_LAS f32x4*)(MX + row * 4); const float rm = fmaxf(fmaxf(m4[0], m4[1]), fmaxf(m4[2], m4[3])); float s = 0.f;
#pragma unroll
                for (int bj = 0; bj < 2; ++bj) { f32x4 p0, p1;
#pragma unroll
                    for (int e = 0; e < 4; ++e) { p0[e] = __builtin_amdgcn_exp2f(acc[ai][bj][m][0][e] - rm); p1[e] = __builtin_amdgcn_exp2f(acc[ai][bj][m][1][e] - rm); }
                    s += ((p0[0] + p0[1]) + (p0[2] + p0[3])) + ((p1[0] + p1[1]) + (p1[2] + p1[3]));
                    *(u32x4*)(P + (size_t)row * 256 + bj * HALF + wc * 32 + 8 * fq) = pack8(p0, p1); }
                s = xrow16_sum(s);
                if (fq == 0) SM[row * 4 + wc] = s; }
        asm volatile("s_waitcnt lgkmcnt(0)\n\ts_barrier" ::: "memory");
        const int tid = wid * 64 + lane;
        if (tid < 256) { const f32x4 s4 = *(const PG8_LAS f32x4*)(SM + tid * 4); lrow[tid] = (s4[0] + s4[1]) + (s4[2] + s4[3]); }
    }
};
struct EpiSoftmaxFull {
    static constexpr bool PERM = true, AFTER_DRAIN = true;
    const float* SS; bf16_t* P; float sc;
    __device__ __forceinline__ void fused(f32x4 (&acc)[2][2][4][2], const Unit& u, int wr, int wc, int fr0, int fq, PG8_LAS unsigned char* lds, int wid, int lane) const {
        int fr = fr0; asm volatile("" : "+v"(fr));
        PG8_LAS float* MX = (PG8_LAS float*)lds; PG8_LAS float* SM = MX + 1024;
#pragma unroll
        for (int ai = 0; ai < 2; ++ai)
#pragma unroll
            for (int m = 0; m < 4; ++m) { const int lr = ai * HALF + wr * 64 + m * 16 + fr, row = u.pm * BM + lr; float mx = -INFINITY;
                const f32x4* sp = (const f32x4*)(SS + (size_t)row * 16); const f32x4 s4 = (sp[0] + sp[1]) + (sp[2] + sp[3]);
                const float rs = sc / sqrtf(((s4[0] + s4[1]) + (s4[2] + s4[3])) * (1.0f / 1024.0f) + 1e-6f);
#pragma unroll
                for (int bj = 0; bj < 2; ++bj)
#pragma unroll
                    for (int n = 0; n < 2; ++n) { acc[ai][bj][m][n] *= rs;
#pragma unroll
                        for (int e = 0; e < 4; ++e) mx = fmaxf(mx, acc[ai][bj][m][n][e]); }
                mx = xrow16_max(mx);
                if (fq == 0) MX[lr * 4 + wc] = mx; }
        asm volatile("s_waitcnt lgkmcnt(0)\n\ts_barrier" ::: "memory");
#pragma unroll
        for (int ai = 0; ai < 2; ++ai)
#pragma unroll
            for (int m = 0; m < 4; ++m) { const int lr = ai * HALF + wr * 64 + m * 16 + fr;
                const f32x4 m4 = *(const PG8_LAS f32x4*)(MX + lr * 4); const float rm = fmaxf(fmaxf(m4[0], m4[1]), fmaxf(m4[2], m4[3])); float s = 0.f;
#pragma unroll
                for (int bj = 0; bj < 2; ++bj)
#pragma unroll
                    for (int n = 0; n < 2; ++n) {
#pragma unroll
                        for (int e = 0; e < 4; ++e) acc[ai][bj][m][n][e] = __builtin_amdgcn_exp2f(acc[ai][bj][m][n][e] - rm);
                        s += (acc[ai][bj][m][n][0] + acc[ai][bj][m][n][1]) + (acc[ai][bj][m][n][2] + acc[ai][bj][m][n][3]); }
                s = xrow16_sum(s);
                if (fq == 0) SM[lr * 4 + wc] = s; }
        asm volatile("s_waitcnt lgkmcnt(0)\n\ts_barrier" ::: "memory");
#pragma unroll
        for (int ai = 0; ai < 2; ++ai)
#pragma unroll
            for (int m = 0; m < 4; ++m) { const int lr = ai * HALF + wr * 64 + m * 16 + fr;
                const f32x4 s4 = *(const PG8_LAS f32x4*)(SM + lr * 4); const float inv = 1.0f / ((s4[0] + s4[1]) + (s4[2] + s4[3]));
#pragma unroll
                for (int bj = 0; bj < 2; ++bj)
                    st16wt(P + (size_t)(u.pm * BM + lr) * 1024 + u.pn * BM + bj * HALF + wc * 32 + 8 * fq, pack8(acc[ai][bj][m][0] * inv, acc[ai][bj][m][1] * inv)); }
    }
};
struct EpiCO {
    static constexpr bool PERM = true, AFTER_DRAIN = false;
    bf16_t* O; const PG8_LAS float* lrow;
    __device__ __forceinline__ void operator()(const f32x4 (&acc)[2][2][4][2], const Unit& u, int wr, int wc, int fr0, int fq) const {
        int fr = fr0; asm volatile("" : "+v"(fr));
#pragma unroll
        for (int ai = 0; ai < 2; ++ai)
#pragma unroll
            for (int m = 0; m < 4; ++m) { const int row = ai * HALF + wr * 64 + m * 16 + fr; const float inv = 1.0f / lrow[row];
#pragma unroll
                for (int bj = 0; bj < 2; ++bj) *(u32x4*)(O + (size_t)row * 1024 + bj * HALF + wc * 32 + 8 * fq) = pack8(acc[ai][bj][m][0] * inv, acc[ai][bj][m][1] * inv); }
    }
};
struct OneUnit {
    int pm, pn;
    __device__ __forceinline__ bool next(int i, Unit& u) const { if (i) return false; u.pm = pm; u.pn = pn; return true; }
    __device__ __forceinline__ void a_ready(const Unit&) const {}
    __device__ __forceinline__ void done(const Unit&) const {}
};
}

__device__ __forceinline__ int win_src_col(int n) {
    if (n < 1024 || n >= 3072) return n;
    const int t = (n - 1024) >> 8, j = (n - 1024) & 255;
    return j < 128 ? 1024 + 128 * t + j : 2048 + 128 * t + (j - 128);
}
__device__ __forceinline__ void p0_prologue(int wv, const Args& a, LAS unsigned char* lds, int blk, int G) {
    const int tid = opaque_tid(wv), lane = tid & 63, wave = tid >> 6;
    unsigned char* ws = a.ws;
    LAS float* tl = (LAS float*)lds;
    {
        f32x4 cur[8], nxt[8]; const float* gcur = nullptr; const float* gnxt = nullptr;
#define P0_DECODE(job, W, ldw, nb, kb, Wt, gain, perm) do { \
            if ((job) < 512) { W = a.in[I_W_IN]; ldw = NCOLS; kb = (job) >> 5; nb = (job) & 31; Wt = (bf16*)(ws + WS_WT_IN); gain = a.in[I_NORM_MIX_G]; perm = true; } \
            else { const int mat = ((job) - 512) >> 6, idx = ((job) - 512) & 63; kb = idx >> 2; nb = idx & 3; ldw = 1024; gain = nullptr; perm = false; \
                if (mat == 0) { W = a.in[I_W_CONV_OUT]; Wt = (bf16*)(ws + WS_WT_CONV); } \
                else if (mat == 1) { W = a.in[I_W_ATTN_OUT]; Wt = (bf16*)(ws + WS_WT_ATTN); } \
                else if (mat == 2) { W = a.in[I_W_MIX_OUT]; Wt = (bf16*)(ws + WS_WT_MIX); } \
                else { W = a.in[I_W_CO]; Wt = (bf16*)(ws + WS_WT_CO); } } } while (0)
#define P0_LOAD(dst, gv, job) do { const float* W; int ldw, nb, kb; bf16* Wt; const float* gain; bool perm; P0_DECODE(job, W, ldw, nb, kb, Wt, gain, perm); (void)Wt; \
            const int k0 = kb * 64, c = tid & 63, nd0 = nb * 256 + 64 * (c >> 4), ns0 = (perm ? win_src_col(nd0) : nd0) + 4 * (c & 15); gv = gain ? gain + k0 : nullptr; \
            _Pragma("unroll") for (int i = 0; i < 8; ++i) dst[i] = *(const f32x4*)(W + (size_t)(k0 + (tid >> 6) + 8 * i) * ldw + ns0); } while (0)
        if (blk < 768) P0_LOAD(cur, gcur, blk);
        for (int job = blk; job < 768; job += G) {
            if (job + G < 768) P0_LOAD(nxt, gnxt, job + G);
#pragma unroll
            for (int i = 0; i < 8; ++i) { const int kk = (tid >> 6) + 8 * i, c = tid & 63; const float gk = gcur ? gcur[kk] : 1.0f; LAS float* d = tl + kk * 257 + 4 * c;
                d[0] = cur[i][0] * gk; d[1] = cur[i][1] * gk; d[2] = cur[i][2] * gk; d[3] = cur[i][3] * gk; }
            __syncthreads();
            { const float* W; int ldw, nb, kb; bf16* Wt; const float* gain; bool perm; P0_DECODE(job, W, ldw, nb, kb, Wt, gain, perm); (void)W; (void)ldw; (void)gain; (void)perm;
#pragma unroll
              for (int r = 0; r < 4; ++r) { const int idx = tid + 512 * r, nn = idx >> 3, kq = idx & 7; const LAS float* s = tl + (kq * 8) * 257 + nn;
                  u32x4 o; o.x = pk2(s[0], s[257]); o.y = pk2(s[2 * 257], s[3 * 257]); o.z = pk2(s[4 * 257], s[5 * 257]); o.w = pk2(s[6 * 257], s[7 * 257]);
                  st16wt(Wt + (size_t)(nb * 256 + nn) * 1024 + kb * 64 + kq * 8, o); } }
            __syncthreads();
#pragma unroll
            for (int i = 0; i < 8; ++i) cur[i] = nxt[i];
            gcur = gnxt;
        }
#undef P0_DECODE
#undef P0_LOAD
    }
    { const float* x = a.in[I_X]; bf16* XB = (bf16*)(ws + WS_A0); float* rstd0 = (float*)(ws + WS_RSTD0);
      f32x4 v[4], w4[4]; int row = blk * 8 + wave;
#define P0_XLOAD(dst, r) do { const f32x4* xr = (const f32x4*)(x + (size_t)(r) * D) + 2 * lane; dst[0] = xr[0]; dst[1] = xr[1]; dst[2] = xr[128]; dst[3] = xr[129]; } while (0)
      if (row < S) P0_XLOAD(v, row);
      for (; row < S; row += G * 8) {
          if (row + G * 8 < S) P0_XLOAD(w4, row + G * 8);
          float s = 0.f;
#pragma unroll
          for (int j = 0; j < 4; ++j) s += (v[j][0] * v[j][0] + v[j][1] * v[j][1]) + (v[j][2] * v[j][2] + v[j][3] * v[j][3]);
          s = wave_sum(s);
          if (lane == 0) rstd0[row] = 1.0f / sqrtf(s * (1.0f / D) + 1e-6f);
          bf16* o = XB + (size_t)row * D + 8 * lane;
#pragma unroll
          for (int j = 0; j < 2; ++j) { u32x4 w; w.x = pk2(v[2 * j][0], v[2 * j][1]); w.y = pk2(v[2 * j][2], v[2 * j][3]); w.z = pk2(v[2 * j + 1][0], v[2 * j + 1][1]); w.w = pk2(v[2 * j + 1][2], v[2 * j + 1][3]);
              st16wt(o + 512 * j, w); }
#pragma unroll
          for (int j = 0; j < 4; ++j) v[j] = w4[j];
      }
#undef P0_XLOAD
    }
    { typedef short bf16x8_t __attribute__((ext_vector_type(8))); typedef float f32x16_t __attribute__((ext_vector_type(16)));
      LAS bf16* mnb = (LAS bf16*)lds;
      LAS float* red = (LAS float*)(lds + 32 * 1032 * 2);
      const float* mem = a.in[I_MEM]; const float* g = a.in[I_NORM_MEM_G]; const float* Wc = a.in[I_W_CKV]; bf16* KC = (bf16*)(ws + WS_KV); bf16* VC = KC + 4 * 256 * 256;
      const int r32 = lane & 31, kg = lane >> 5;
      for (int wb = blk; wb < 256; wb += G) {
          const int m0 = (wb >> 5) * 32, n0 = (wb & 31) * 64;
          __syncthreads();
#pragma unroll
          for (int r = 0; r < 4; ++r) { const int rr = wave * 4 + r; const f32x4* mr = (const f32x4*)(mem + (size_t)(m0 + rr) * D) + lane; f32x4 v[4]; float s = 0.f;
#pragma unroll
              for (int j = 0; j < 4; ++j) { v[j] = mr[64 * j]; s += (v[j][0] * v[j][0] + v[j][1] * v[j][1]) + (v[j][2] * v[j][2] + v[j][3] * v[j][3]); }
              s = wave_sum(s); const float rs = 1.0f / sqrtf(s * (1.0f / D) + 1e-6f);
#pragma unroll
              for (int j = 0; j < 4; ++j) { const f32x4 gg = ((const f32x4*)g)[lane + 64 * j]; const f32x4 y = v[j] * rs * gg; u32x2 w; w.x = pk2(y[0], y[1]); w.y = pk2(y[2], y[3]);
                  *(LAS u32x2*)(mnb + rr * 1032 + 4 * (lane + 64 * j)) = w; } }
          __syncthreads();
          const int it = wave & 1, kq = wave >> 1, ncol = n0 + 32 * it + r32;
          f32x16_t acc;
#pragma unroll
          for (int r = 0; r < 16; ++r) acc[r] = 0.f;
#pragma unroll 1
          for (int half = 0; half < 2; ++half) {
              float wv_[8][8];
#pragma unroll
              for (int s = 0; s < 8; ++s)
#pragma unroll
                  for (int j = 0; j < 8; ++j) wv_[s][j] = Wc[(size_t)(256 * kq + 128 * half + 16 * s + 8 * kg + j) * 2048 + ncol];
#pragma unroll
              for (int s = 0; s < 8; ++s) {
                  u32x4 bw; bw.x = pk2(wv_[s][0], wv_[s][1]); bw.y = pk2(wv_[s][2], wv_[s][3]); bw.z = pk2(wv_[s][4], wv_[s][5]); bw.w = pk2(wv_[s][6], wv_[s][7]);
                  const bf16x8_t af = *(const LAS bf16x8_t*)(mnb + r32 * 1032 + 256 * kq + 128 * half + 16 * s + 8 * kg);
                  acc = __builtin_amdgcn_mfma_f32_32x32x16_bf16(af, __builtin_bit_cast(bf16x8_t, bw), acc, 0, 0, 0); }
          }
#pragma unroll
          for (int r = 0; r < 16; ++r) red[((it * 4 + kq) * 16 + r) * 64 + lane] = acc[r];
          __syncthreads();
          if (kq == 0) {
#pragma unroll
              for (int r = 0; r < 16; ++r) acc[r] = (red[((it * 4 + 0) * 16 + r) * 64 + lane] + red[((it * 4 + 1) * 16 + r) * 64 + lane]) + (red[((it * 4 + 2) * 16 + r) * 64 + lane] + red[((it * 4 + 3) * 16 + r) * 64 + lane]);
              if (ncol < 1024) {
#pragma unroll
                  for (int r = 0; r < 16; ++r) KC[((size_t)(ncol >> 8) * 256 + (m0 + (r & 3) + 8 * (r >> 2) + 4 * kg)) * 256 + (ncol & 255)] = (bf16)f2bf(acc[r]);
              } else {
#pragma unroll
                  for (int r = 0; r < 16; ++r) VC[((size_t)((ncol - 1024) >> 8) * 256 + (m0 + (r & 3) + 8 * (r >> 2) + 4 * kg)) * 256 + (ncol & 255)] = (bf16)f2bf(acc[r]);
              }
          }
      }
      __syncthreads(); }
    { typedef short bf16x8_t __attribute__((ext_vector_type(8))); typedef float f32x16_t __attribute__((ext_vector_type(16)));
      const float* sk = a.in[I_SUB_KEYS]; const float* wpq = a.in[I_W_PQ]; const float* gf = a.in[I_NORM_FFN_G]; bf16* WT = (bf16*)(ws + WS_WT_PQ);
      const int r32 = lane & 31, kg = lane >> 5;
      for (int item = blk * 8 + wave; item < 2048; item += G * 8) {
          const int hc = item >> 7, h = hc >> 1, c = hc & 1, kt = (item >> 2) & 31, nt = item & 3;
          const float* ap = wpq + (size_t)(kt * 32 + r32) * 2048 + hc * 128 + 8 * kg;
          const float* bp = sk + ((size_t)((c * 8 + h) * 128 + nt * 32 + r32)) * 128 + 8 * kg;
          const float gk = gf[kt * 32 + r32];
          f32x4 av[8][2], bv[8][2];
#pragma unroll
          for (int s = 0; s < 8; ++s) { av[s][0] = *(const f32x4*)(ap + 16 * s); av[s][1] = *(const f32x4*)(ap + 16 * s + 4); bv[s][0] = *(const f32x4*)(bp + 16 * s); bv[s][1] = *(const f32x4*)(bp + 16 * s + 4); }
          f32x16_t acc;
#pragma unroll
          for (int r = 0; r < 16; ++r) acc[r] = 0.f;
#pragma unroll
          for (int s = 0; s < 8; ++s) {
              const f32x4 a0 = av[s][0] * gk, a1 = av[s][1] * gk;
              u32x4 aw, bw; aw.x = pk2(a0[0], a0[1]); aw.y = pk2(a0[2], a0[3]); aw.z = pk2(a1[0], a1[1]); aw.w = pk2(a1[2], a1[3]);
              bw.x = pk2(bv[s][0][0], bv[s][0][1]); bw.y = pk2(bv[s][0][2], bv[s][0][3]); bw.z = pk2(bv[s][1][0], bv[s][1][1]); bw.w = pk2(bv[s][1][2], bv[s][1][3]);
              acc = __builtin_amdgcn_mfma_f32_32x32x16_bf16(__builtin_bit_cast(bf16x8_t, aw), __builtin_bit_cast(bf16x8_t, bw), acc, 0, 0, 0); }
          bf16* dst = WT + (size_t)(hc * 128 + nt * 32 + r32) * 1024 + kt * 32 + 4 * kg;
#pragma unroll
          for (int q = 0; q < 4; ++q) { u32x2 w; w.x = pk2(acc[4 * q], acc[4 * q + 1]); w.y = pk2(acc[4 * q + 2], acc[4 * q + 3]); *(u32x2*)(dst + 8 * q) = w; }
      } }
}

__device__ __forceinline__ void cross_fold(int wv, const Args& a, int blk, int G) {
    typedef short bf16x8_t __attribute__((ext_vector_type(8))); typedef float f32x16_t __attribute__((ext_vector_type(16)));
    const int tid = opaque_tid(wv), lane = tid & 63, wave = tid >> 6, r32 = lane & 31, kg = lane >> 5;
    const bf16* KC = (const bf16*)(a.ws + WS_KV); const bf16* VC = KC + 4 * 256 * 256;
    for (int item = blk * 8 + wave; item < 2048; item += G * 8) {
        f32x16_t acc;
#pragma unroll
        for (int r = 0; r < 16; ++r) acc[r] = 0.f;
        bf16* dst;
        if (item < 1024) {
            const int h = item >> 8, kt = (item >> 3) & 31, mt = item & 7;
            const float* ap = a.in[I_W_CQ] + (size_t)(kt * 32 + r32) * 1024 + h * 256 + 8 * kg;
            const bf16* bp = KC + ((size_t)h * 256 + mt * 32 + r32) * 256 + 8 * kg;
            const float gk = a.in[I_NORM_CROSS_G][kt * 32 + r32];
#pragma unroll 1
            for (int half = 0; half < 2; ++half) {
                f32x4 av[8][2]; u32x4 bv[8];
#pragma unroll
                for (int s = 0; s < 8; ++s) { av[s][0] = *(const f32x4*)(ap + 128 * half + 16 * s); av[s][1] = *(const f32x4*)(ap + 128 * half + 16 * s + 4); bv[s] = *(const u32x4*)(bp + 128 * half + 16 * s); }
#pragma unroll
                for (int s = 0; s < 8; ++s) { const f32x4 a0 = av[s][0] * gk, a1 = av[s][1] * gk;
                    u32x4 aw; aw.x = pk2(a0[0], a0[1]); aw.y = pk2(a0[2], a0[3]); aw.z = pk2(a1[0], a1[1]); aw.w = pk2(a1[2], a1[3]);
                    acc = __builtin_amdgcn_mfma_f32_32x32x16_bf16(__builtin_bit_cast(bf16x8_t, aw), __builtin_bit_cast(bf16x8_t, bv[s]), acc, 0, 0, 0); }
            }
            dst = (bf16*)(a.ws + WS_WQK) + (size_t)(h * 256 + mt * 32 + r32) * 1024 + kt * 32 + 4 * kg;
        } else {
            const int it = item - 1024, h = it >> 8, mt = (it >> 5) & 7, nt = it & 31;
            const bf16* ap = VC + ((size_t)h * 256 + mt * 32 + r32) * 256 + 8 * kg;
            const bf16* bp = (const bf16*)(a.ws + WS_WT_CO) + (size_t)(nt * 32 + r32) * 1024 + h * 256 + 8 * kg;
            u32x4 av[16], bv[16];
#pragma unroll
            for (int s = 0; s < 16; ++s) { av[s] = *(const u32x4*)(ap + 16 * s); bv[s] = *(const u32x4*)(bp + 16 * s); }
#pragma unroll
            for (int s = 0; s < 16; ++s) acc = __builtin_amdgcn_mfma_f32_32x32x16_bf16(__builtin_bit_cast(bf16x8_t, av[s]), __builtin_bit_cast(bf16x8_t, bv[s]), acc, 0, 0, 0);
            dst = (bf16*)(a.ws + WS_VW) + (size_t)(nt * 32 + r32) * 1024 + h * 256 + mt * 32 + 4 * kg;
        }
#pragma unroll
        for (int q = 0; q < 4; ++q) { u32x2 w; w.x = pk2(acc[4 * q], acc[4 * q + 1]); w.y = pk2(acc[4 * q + 2], acc[4 * q + 3]); *(u32x2*)(dst + 8 * q) = w; }
    }
}

__device__ __forceinline__ void conv_phase(int wv, const Args& a, int blk, int G) {
    bf16* CB = (bf16*)(a.ws + WS_A1); const bf16* U = (const bf16*)(a.ws + WS_A2); const float* cw = a.in[I_CONV_W];
    const int tid = opaque_tid(wv);
    for (size_t i = (size_t)blk * 512 + tid; i < (size_t)S * D / 8; i += (size_t)G * 512) {
        const int r = (int)(i >> 7), c = (int)(i & 127) * 8;
        const u32x4 cb = *(const u32x4*)(CB + i * 8), u2 = *(const u32x4*)(U + i * 8);
        u32x4 u1 = {0, 0, 0, 0}, u0 = {0, 0, 0, 0};
        if (r >= 1) u1 = *(const u32x4*)(U + i * 8 - D);
        if (r >= 2) u0 = *(const u32x4*)(U + i * 8 - 2 * D);
        u32x4 o;
#pragma unroll
        for (int e = 0; e < 4; ++e) {
            const int c0 = c + 2 * e;
            const float lo = bflo(cb[e]) * (cw[c0] * bflo(u0[e]) + cw[D + c0] * bflo(u1[e]) + cw[2 * D + c0] * bflo(u2[e]));
            const float hi = bfhi(cb[e]) * (cw[c0 + 1] * bfhi(u0[e]) + cw[D + c0 + 1] * bfhi(u1[e]) + cw[2 * D + c0 + 1] * bfhi(u2[e]));
            o[e] = pk2(lo, hi);
        }
        st16wt(CB + i * 8, o);
    }
}


namespace att {
typedef short bf16x8 __attribute__((ext_vector_type(8)));
typedef short s16x4 __attribute__((ext_vector_type(4)));
typedef float f32x16 __attribute__((ext_vector_type(16)));
typedef short v4i16_t __attribute__((ext_vector_type(4)));
typedef LAS const char* lds_cptr;
constexpr int SLOT = 16384, LDS_K = 0, LDS_V = 4 * SLOT, LDS_WSF = 8 * SLOT, LDS_BT = LDS_WSF + 2048, LDS_TOTAL = LDS_BT + 1024;
constexpr int LDS_XCH = 0, LDS_OST = 65536;
constexpr float LOG2E = 1.4426950408889634f, THR = 8.0f;
__device__ __forceinline__ int crow(int r, int hi) { return (r & 3) + 8 * (r >> 2) + 4 * hi; }
typedef float f32x2_t __attribute__((ext_vector_type(2))); typedef __bf16 bf16x2_t __attribute__((ext_vector_type(2)));
__device__ __forceinline__ unsigned cvtpk(float lo, float hi) { const f32x2_t v = {lo, hi}; const bf16x2_t b = __builtin_convertvector(v, bf16x2_t); return __builtin_bit_cast(unsigned, b); }
__device__ __forceinline__ void glds16(const void* g, unsigned lds_base) {
    unsigned sv; asm volatile("s_mov_b32 %0, m0\n\ts_mov_b32 m0, %2\n\ts_nop 0\n\tglobal_load_lds_dwordx4 %1, off\n\ts_mov_b32 m0, %0" : "=&s"(sv) : "v"(g), "s"(lds_base) : "memory"); }
template <int IMM> __device__ __forceinline__ void glds16s(unsigned voff, const void* sbase, unsigned lds_base) {
    unsigned sv; asm volatile("s_mov_b32 %0, m0\n\ts_mov_b32 m0, %3\n\ts_nop 0\n\tglobal_load_lds_dwordx4 %1, %2 offset:%c4\n\ts_mov_b32 m0, %0" : "=&s"(sv) : "v"(voff), "s"(sbase), "s"(lds_base), "i"(IMM) : "memory"); }
__device__ __forceinline__ s16x4 vtr(lds_cptr p) { return __builtin_bit_cast(s16x4, __builtin_amdgcn_ds_read_tr16_b64_v4i16((LAS v4i16_t*)p)); }
#define ATT_MX3(a, b, c) __builtin_fmaxf(__builtin_fmaxf((a), (b)), (c))
__device__ __forceinline__ float rowmax(const f32x16& p0, const f32x16& p1) {
    float a = ATT_MX3(p0[0], p0[1], p1[0]), b = ATT_MX3(p0[2], p0[3], p1[1]); a = ATT_MX3(a, p1[2], p1[3]);
#pragma unroll
    for (int r = 4; r < 16; r += 4) { a = ATT_MX3(a, p0[r], p0[r + 1]); b = ATT_MX3(b, p0[r + 2], p0[r + 3]); a = ATT_MX3(a, p1[r], p1[r + 1]); b = ATT_MX3(b, p1[r + 2], p1[r + 3]); }
    float m = __builtin_fmaxf(a, b); auto rr = __builtin_amdgcn_permlane32_swap(__float_as_uint(m), __float_as_uint(m), false, false);
    return __builtin_fmaxf(__uint_as_float(rr[0]), __uint_as_float(rr[1])); }
#define ATT_WAIT_BAR(N) asm volatile("s_waitcnt vmcnt(" #N ") lgkmcnt(0)\n\ts_barrier" ::: "memory")
#define ATT_LBAR() asm volatile("s_waitcnt lgkmcnt(0)\n\ts_barrier" ::: "memory")
#define ATT_MFMA(a, b, c) __builtin_amdgcn_mfma_f32_32x32x16_bf16(a, b, c, 0, 0, 0)

__device__ __forceinline__ void attn_unit_pipe(int wv, int h, int qb, const bf16* Q, const bf16* __restrict__ K, const bf16* __restrict__ V, bf16* O, LAS unsigned char* lds,
                                               float lam, const float* rel_bias, const float* subln_g, const unsigned* KMAX) {
    const int tid = opaque_tid(wv), lane = tid & 63, r32 = lane & 31, hi = lane >> 5;
    const int wid = __builtin_amdgcn_readfirstlane(tid >> 6), comp = wid >> 2, rg = wid & 3;
    const int q0 = qb * 128, qw0 = q0 + 32 * rg, NT = 2 * qb + 2;
    const unsigned lds0 = (unsigned)(unsigned long long)lds;
    LAS float* wsf = (LAS float*)(lds + LDS_WSF) + wid * 64;
    LAS float* bt = (LAS float*)(lds + LDS_BT);
    const float bfar = rel_bias[31 * 8 + h] * LOG2E;
    float bmax = -INFINITY;
    if (tid < 129) { const int b = tid < 128 ? (int)T5_BUCKET[tid] : 31; bt[tid] = (rel_bias[b * 8 + h] - rel_bias[31 * 8 + h]) * LOG2E; }
#pragma unroll
    for (int b = 0; b < 32; ++b) bmax = fmaxf(bmax, rel_bias[b * 8 + h] * LOG2E);
    const float kmx = sqrtf(__uint_as_float(KMAX[(h * 2 + comp) * 2]) + __uint_as_float(KMAX[(h * 2 + comp) * 2 + 1])) * 1.02f;
    const unsigned kvoff = (unsigned)lane * 2048u + (unsigned)wid * 16u;
    const unsigned vvoff = (unsigned)(16 * (wid & 3) + (lane >> 2)) * 2048u + (unsigned)((wid >> 2) * 32 + (lane & 3) * 8) * 2u;
    const char* kbase = (const char*)(K + h * 128); const char* vbase = (const char*)(V + h * 128);
    const unsigned kdst = lds0 + LDS_K + wid * 1024, vdst = lds0 + LDS_V + wid * 1024;
#define ATT_RFL(x) ((unsigned)__builtin_amdgcn_readfirstlane((int)(x)))
#define DMA_K(t, so) do { const char* b_ = kbase + (size_t)(t) * 131072; glds16s<0>(kvoff, b_, ATT_RFL(kdst + (so))); glds16s<128>(kvoff, b_, ATT_RFL(kdst + (so) + 8192 - 128)); } while (0)
#define DMA_V(t, so) do { const char* b_ = vbase + (size_t)(t) * 131072; glds16s<0>(vvoff, b_, ATT_RFL(vdst + (so))); glds16s<128>(vvoff, b_, ATT_RFL(vdst + (so) + 8192 - 128)); } while (0)
    bf16x8 qr[4];
    float cfar;
    { const bf16* Qw = Q + (size_t)(qw0 + r32) * 1024 + h * 128 + comp * 64 + hi * 8;
#pragma unroll
      for (int d0 = 0; d0 < 4; ++d0) qr[d0] = *(const bf16x8*)(Qw + d0 * 16);
      float s = 0.f;
#pragma unroll
      for (int d0 = 0; d0 < 4; ++d0)
#pragma unroll
          for (int e2 = 0; e2 < 8; ++e2) { const float f = __builtin_bit_cast(float, (unsigned)(unsigned short)qr[d0][e2] << 16); s += f * f; }
      auto rr = __builtin_amdgcn_permlane32_swap(__float_as_uint(s), __float_as_uint(s), false, false); s = __uint_as_float(rr[0]) + __uint_as_float(rr[1]);
      cfar = bfar - (sqrtf(s) * 1.01f * kmx + bmax); }
    DMA_K(0, 0); DMA_K(1, SLOT); DMA_V(0, 0); if (NT > 2) DMA_K(2, 2 * SLOT);
    const lds_cptr kp0 = (lds_cptr)(lds + LDS_K) + comp * 8192 + hi * 1024 + r32 * 16;
    const lds_cptr vp0 = (lds_cptr)(lds + LDS_V) + ((lane >> 4) & 1) * 32 + (lane & 3) * 8 + (4 * hi + ((lane & 15) >> 2)) * 64;
    float l_reg = 0.f;
    f32x16 o[4];
#pragma unroll
    for (int d0 = 0; d0 < 4; ++d0)
#pragma unroll
        for (int r = 0; r < 16; ++r) o[d0][r] = 0.f;
    bf16x8 kf[8];
    f32x16 pA0, pA1, pB0, pB1;
    u32x4 pw0, pw1, pw2, pw3;
    s16x4 vl0, vh0, vl1, vh1;
#define SBAR() __builtin_amdgcn_sched_barrier(0)
#define PIN(x) asm volatile("" : "+v"(x))
#define PKW(P, B) cvtpk(P[B], P[B + 1])
#define PAF(k) __builtin_bit_cast(bf16x8, pw##k)
#define EX(v) __builtin_amdgcn_exp2f(v)
#define ROT3() do { const int t_ = s0; s0 = s1; s1 = s2; s2 = t_; } while (0)
#define ENDW(t) do { if ((t) + 3 < NT) { ATT_WAIT_BAR(4); } else if ((t) + 1 < NT) { ATT_WAIT_BAR(2); } else { ATT_WAIT_BAR(0); } } while (0)
#define KLD(f, kp_) kf[f] = *(LAS const bf16x8*)((kp_) + ((f) >> 1) * 2048 + ((f) & 1) * 512)
#define BANDFIX(C0, C1, t) do { if (__builtin_expect(64 * (t) + 63 + 128 > qw0, 0)) { const int ln_ = opaque_tid(0);   \
        const int dq = qw0 + (ln_ & 31) - 64 * (t) - 4 * (ln_ >> 5); \
        _Pragma("unroll") for (int r = 0; r < 16; ++r) { const int d0_ = dq - ((r & 3) + 8 * (r >> 2)), d1_ = d0_ - 32; \
            const float b0 = bt[min(max(d0_, 0), 128)], b1 = bt[min(max(d1_, 0), 128)]; \
            C0[r] = d0_ < 0 ? -INFINITY : C0[r] + b0; C1[r] = d1_ < 0 ? -INFINITY : C1[r] + b1; } } } while (0)
#define VRD(j, i, vp_) do { vl##j = vtr((vp_) + ((i) & 3) * 4096 + ((i) >> 2) * 1024); vh##j = vtr((vp_) + ((i) & 3) * 4096 + ((i) >> 2) * 1024 + 512); } while (0)
#define VFR(j) (bf16x8){vl##j[0], vl##j[1], vl##j[2], vl##j[3], vh##j[0], vh##j[1], vh##j[2], vh##j[3]}
#define GAPA(MF, A0, A1, A2, A3, W0, W1, PWX) do { MF; sacc += A0; sacc += A1; sacc += A2; sacc += A3; PIN(sacc); W0; W1; PIN(PWX); SBAR(); } while (0)
#define PHASE_A(C0, C1, P0, P1, vp_) do { float sacc = P0[0] + P0[1]; \
        GAPA(C0 = ATT_MFMA(kf[0], qr[0], C0), P0[2], P0[3], P0[4], P0[5],     pw0[0] = PKW(P0, 0), pw0[1] = PKW(P0, 2), pw0); \
        GAPA(C1 = ATT_MFMA(kf[1], qr[0], C1), P0[6], P0[7], P0[8], P0[9],     pw0[2] = PKW(P0, 4), pw0[3] = PKW(P0, 6), pw0); \
        GAPA(C0 = ATT_MFMA(kf[2], qr[1], C0), P0[10], P0[11], P0[12], P0[13], pw1[0] = PKW(P0, 8), pw1[1] = PKW(P0, 10), pw1); \
        GAPA(C1 = ATT_MFMA(kf[3], qr[1], C1), P0[14], P0[15], P1[0], P1[1],   pw1[2] = PKW(P0, 12), pw1[3] = PKW(P0, 14), pw1); \
        GAPA(C0 = ATT_MFMA(kf[4], qr[2], C0), P1[2], P1[3], P1[4], P1[5],     pw2[0] = PKW(P1, 0), pw2[1] = PKW(P1, 2), pw2); \
        GAPA(C1 = ATT_MFMA(kf[5], qr[2], C1), P1[6], P1[7], P1[8], P1[9],     pw2[2] = PKW(P1, 4), pw2[3] = PKW(P1, 6), pw2); \
        GAPA(C0 = ATT_MFMA(kf[6], qr[3], C0), P1[10], P1[11], P1[12], P1[13], pw3[0] = PKW(P1, 8), pw3[1] = PKW(P1, 10), pw3); \
        VRD(0, 0, vp_); SBAR(); \
        GAPA(C1 = ATT_MFMA(kf[7], qr[3], C1), P1[14], P1[15], 0.f, 0.f,       pw3[2] = PKW(P1, 12), pw3[3] = PKW(P1, 14), pw3); \
        l_reg += sacc; } while (0)
#define GAPB(i, j, jn, X, XB, DOEX, GL, vp_, kp_, N0, N1, DOSP) do { if ((i) + 1 < 16) { VRD(jn, (i) + 1, vp_); } \
        if ((GL) && ((i) & 1)) { KLD((i) >> 1, kp_); } SBAR(); \
        o[(i) & 3] = ATT_MFMA(PAF_SEL((i) >> 2), VFR(j), o[(i) & 3]); \
        if (DOEX) { X[XB] = EX(X[XB]); X[XB + 1] = EX(X[XB + 1]); PIN(X); } \
        if (DOSP) { N0[(i)] = cfar; N1[(i)] = cfar; } SBAR(); } while (0)
#define PAF_SEL(k) ((k) == 0 ? PAF(0) : (k) == 1 ? PAF(1) : (k) == 2 ? PAF(2) : PAF(3))
#define PHASE_B(C0, C1, DOEX, GL, vp_, kp_, N0, N1, DOSP) do { \
        GAPB(0, 0, 1, C0, 0, DOEX, GL, vp_, kp_, N0, N1, DOSP); GAPB(1, 1, 0, C0, 2, DOEX, GL, vp_, kp_, N0, N1, DOSP); GAPB(2, 0, 1, C0, 4, DOEX, GL, vp_, kp_, N0, N1, DOSP); GAPB(3, 1, 0, C0, 6, DOEX, GL, vp_, kp_, N0, N1, DOSP); \
        GAPB(4, 0, 1, C0, 8, DOEX, GL, vp_, kp_, N0, N1, DOSP); GAPB(5, 1, 0, C0, 10, DOEX, GL, vp_, kp_, N0, N1, DOSP); GAPB(6, 0, 1, C0, 12, DOEX, GL, vp_, kp_, N0, N1, DOSP); GAPB(7, 1, 0, C0, 14, DOEX, GL, vp_, kp_, N0, N1, DOSP); \
        GAPB(8, 0, 1, C1, 0, DOEX, GL, vp_, kp_, N0, N1, DOSP); GAPB(9, 1, 0, C1, 2, DOEX, GL, vp_, kp_, N0, N1, DOSP); GAPB(10, 0, 1, C1, 4, DOEX, GL, vp_, kp_, N0, N1, DOSP); GAPB(11, 1, 0, C1, 6, DOEX, GL, vp_, kp_, N0, N1, DOSP); \
        GAPB(12, 0, 1, C1, 8, DOEX, GL, vp_, kp_, N0, N1, DOSP); GAPB(13, 1, 0, C1, 10, DOEX, GL, vp_, kp_, N0, N1, DOSP); GAPB(14, 0, 1, C1, 12, DOEX, GL, vp_, kp_, N0, N1, DOSP); GAPB(15, 1, 0, C1, 14, DOEX, GL, vp_, kp_, N0, N1, DOSP); \
        } while (0)
#define KSL(t) ((((t) & 3)) * SLOT)
#define DMA_GROUP(t) do { if ((t) + 3 < NT) DMA_K((t) + 3, KSL((t) + 3)); if ((t) + 1 < NT) DMA_V((t) + 1, KSL((t) + 1)); } while (0)
#define STEP(C0, C1, P0, P1, t) do { const lds_cptr vpp = vp0 + KSL((t) - 1); const lds_cptr kpn = kp0 + KSL((t) + 1); \
        PHASE_A(C0, C1, P0, P1, vpp); \
        BANDFIX(C0, C1, t); \
        if (comp == 0) { DMA_GROUP(t); } else { ENDW(t); } \
        SBAR(); \
        PHASE_B(C0, C1, true, true, vpp, kpn, P0, P1, true); PIN(P0); PIN(P1); \
        if (comp == 0) { ENDW(t); } else { DMA_GROUP((t) + 1); } } while (0)
#define PACKSUM(P0, P1) do { float sacc = 0.f; _Pragma("unroll") for (int r = 0; r < 16; ++r) sacc += P0[r] + P1[r]; l_reg += sacc; \
        pw0 = (u32x4){PKW(P0, 0), PKW(P0, 2), PKW(P0, 4), PKW(P0, 6)}; pw1 = (u32x4){PKW(P0, 8), PKW(P0, 10), PKW(P0, 12), PKW(P0, 14)}; \
        pw2 = (u32x4){PKW(P1, 0), PKW(P1, 2), PKW(P1, 4), PKW(P1, 6)}; pw3 = (u32x4){PKW(P1, 8), PKW(P1, 10), PKW(P1, 12), PKW(P1, 14)}; } while (0)

    if (NT > 2) { ATT_WAIT_BAR(4); } else { ATT_WAIT_BAR(2); }
    if (comp != 0) { DMA_GROUP(0); }
    {
#pragma unroll
      for (int f = 0; f < 8; ++f) KLD(f, kp0);
#pragma unroll
      for (int r = 0; r < 16; ++r) { pA0[r] = cfar; pA1[r] = cfar; pB0[r] = cfar; pB1[r] = cfar; }
#pragma unroll
      for (int d0 = 0; d0 < 4; ++d0) { pA0 = ATT_MFMA(kf[2 * d0], qr[d0], pA0); pA1 = ATT_MFMA(kf[2 * d0 + 1], qr[d0], pA1); } }
    SBAR();
    BANDFIX(pA0, pA1, 0);
    if (comp == 0) { DMA_GROUP(0); } else { ENDW(0); }
    {
#pragma unroll
        for (int r = 0; r < 16; ++r) { pA0[r] = EX(pA0[r]); pA1[r] = EX(pA1[r]); }
#pragma unroll
        for (int f = 0; f < 8; ++f) KLD(f, kp0 + KSL(1));
    }
    if (comp == 0) { ENDW(0); } else { DMA_GROUP(1); }
    {
        int t = 1;
        for (; t + 2 < NT; t += 2) { STEP(pB0, pB1, pA0, pA1, t); STEP(pA0, pA1, pB0, pB1, t + 1); }
        STEP(pB0, pB1, pA0, pA1, t);
        PACKSUM(pB0, pB1);
        VRD(0, 0, vp0 + KSL(NT - 1)); SBAR();
        PHASE_B(pA0, pA1, false, false, vp0 + KSL(NT - 1), kp0, pA0, pA1, false);
    }
    float l = l_reg;
    { auto rr = __builtin_amdgcn_permlane32_swap(__float_as_uint(l), __float_as_uint(l), false, false); l = __uint_as_float(rr[0]) + __uint_as_float(rr[1]); }
    if (hi == 0) wsf[32 + r32] = l;
    float rli[16];
#pragma unroll
    for (int r = 0; r < 16; ++r) rli[r] = 1.0f / wsf[32 + crow(r, hi)];
    ATT_LBAR();
    LAS float* xch = (LAS float*)(lds + LDS_XCH) + rg * 4096;
    if (comp == 1) {
#pragma unroll
        for (int d0 = 0; d0 < 4; ++d0)
#pragma unroll
            for (int r = 0; r < 16; ++r) xch[(d0 * 16 + r) * 64 + lane] = o[d0][r] * rli[r] * lam;
    }
    ATT_LBAR();
    if (comp == 0) {
        float ss[16];
#pragma unroll
        for (int r = 0; r < 16; ++r) { float s_ = 0.f;
#pragma unroll
            for (int d0 = 0; d0 < 4; ++d0) { const float v = o[d0][r] * rli[r] - xch[(d0 * 16 + r) * 64 + lane]; o[d0][r] = v; s_ += v * v; }
            ss[r] = s_; }
#pragma unroll
        for (int r = 0; r < 16; ++r) {
            float v = ss[r]; v += pg8::dppf<0xB1>(v); v += pg8::dppf<0x4E>(v); v += pg8::dppf<0x141>(v); v += pg8::dppf<0x140>(v);
            auto sw = __builtin_amdgcn_permlane16_swap(__float_as_uint(v), __float_as_uint(v), false, false); ss[r] = __uint_as_float(sw[0]) + __uint_as_float(sw[1]); }
        LAS bf16* stg = (LAS bf16*)(lds + LDS_OST) + rg * 4096;
        float g4[4];
#pragma unroll
        for (int d0 = 0; d0 < 4; ++d0) g4[d0] = subln_g[d0 * 32 + r32];
#pragma unroll
        for (int r = 0; r < 16; ++r) { const float rs = 0.8f / sqrtf(ss[r] * (1.0f / 128.0f) + 1e-5f); const int orow = crow(r, hi);
#pragma unroll
            for (int d0 = 0; d0 < 4; ++d0) stg[orow * 128 + d0 * 32 + r32] = (bf16)f2bf(o[d0][r] * rs * g4[d0]); }
#pragma unroll
        for (int i = 0; i < 8; ++i) { const int row = i * 4 + (lane >> 4), ch = lane & 15;
            const u32x4 v = *(LAS const u32x4*)(stg + row * 128 + ch * 8);
            st16wt(O + (size_t)(qw0 + row) * 1024 + h * 128 + ch * 8, v); }
    }
    ATT_LBAR();
#undef ATT_RFL
#undef DMA_K
#undef DMA_V
#undef SBAR
#undef PIN
#undef PKW
#undef PAF
#undef EX
#undef ROT3
#undef ENDW
#undef KLD
#undef BANDFIX
#undef VRD
#undef VFR
#undef GAPA
#undef PHASE_A
#undef GAPB
#undef PAF_SEL
#undef PHASE_B
#undef STEP
#undef PACKSUM
#undef KSL
#undef DMA_GROUP
}

__device__ __forceinline__ void attn_phase(int wv, const Args& a, LAS unsigned char* lds, int blk, int G, bf16* Odst) {
    float s1 = 0.f, s2 = 0.f;
    for (int i = 0; i < 64; ++i) { s1 += a.in[I_LQ1][i] * a.in[I_LK1][i]; s2 += a.in[I_LQ2][i] * a.in[I_LK2][i]; }
    const float lam = __builtin_bit_cast(float, __builtin_amdgcn_readfirstlane(__builtin_bit_cast(int, expf(s1) - expf(s2) + 0.2f)));
    const bf16* Q = (const bf16*)(a.ws + WS_A3); const bf16* K = (const bf16*)(a.ws + WS_A4); const bf16* V = (const bf16*)(a.ws + WS_A5);
    const bool snake = (1024 % G) == 0;
    for (int j = 0;; ++j) {
        const int idx = j * G + blk; if (idx >= 1024) break;
        const int rank = (snake && (j & 1)) ? (j * G + (G - 1 - blk)) : idx;
        attn_unit_pipe(wv, rank & 7, 127 - (rank >> 3), Q, K, V, Odst, lds, lam, a.in[I_REL_BIAS], a.in[I_SUBLN_G], (const unsigned*)(a.ws + WS_KMAX));
    }
}
}


__device__ __forceinline__ void peer_convert(int wv, const Args& a, int blk, int G) {
    const int tid = opaque_tid(wv), lane = tid & 63, gw = blk * 8 + (tid >> 6);
    for (int which = 0; which < 2; ++which) {
        const float* src = a.in[which ? I_PEER_V : I_PEER_U]; unsigned* dst = (unsigned*)(a.ws + (which ? WS_PV : WS_PU));
        for (size_t c = gw; c < (size_t)16384 * 1024 / 1024; c += (size_t)G * 8) {
            f32x4 v[4];
#pragma unroll
            for (int j = 0; j < 4; ++j) v[j] = __builtin_nontemporal_load((const f32x4*)(src + c * 1024 + 256 * j + 4 * lane)) * 128.0f;
#pragma unroll
            for (int j = 0; j < 4; ++j) { int w = __builtin_amdgcn_cvt_pk_fp8_f32(v[j][0], v[j][1], 0, false); w = __builtin_amdgcn_cvt_pk_fp8_f32(v[j][2], v[j][3], w, true);
                dst[c * 256 + 64 * j + lane] = (unsigned)w; } } }
}
namespace peer {
typedef float f32x2v __attribute__((ext_vector_type(2)));
template <int CTRL> __device__ __forceinline__ float dpp(float x) { return __builtin_bit_cast(float, __builtin_amdgcn_mov_dpp(__builtin_bit_cast(int, x), CTRL, 0xf, 0xf, true)); }
template <int CTRL> __device__ __forceinline__ unsigned dppu(unsigned x) { return (unsigned)__builtin_amdgcn_mov_dpp((int)x, CTRL, 0xf, 0xf, true); }
__device__ __forceinline__ unsigned half32_umax(unsigned m) {
    unsigned t = dppu<0xB1>(m); m = t > m ? t : m; t = dppu<0x4E>(m); m = t > m ? t : m; t = dppu<0x141>(m); m = t > m ? t : m; t = dppu<0x140>(m); m = t > m ? t : m;
    auto s = __builtin_amdgcn_permlane16_swap(m, m, false, false); return s[0] > s[1] ? s[0] : s[1]; }
__device__ __forceinline__ float row16_sum(float x) { x += dpp<0xB1>(x); x += dpp<0x4E>(x); x += dpp<0x141>(x); x += dpp<0x140>(x); return x; }
__device__ __forceinline__ float wsum(float x) {
    x += dpp<0xB1>(x); x += dpp<0x4E>(x); x += dpp<0x141>(x); x += dpp<0x140>(x);
    auto s = __builtin_amdgcn_permlane16_swap(__float_as_uint(x), __float_as_uint(x), false, false); x = __uint_as_float(s[0]) + __uint_as_float(s[1]);
    auto t = __builtin_amdgcn_permlane32_swap(__float_as_uint(x), __float_as_uint(x), false, false); return __uint_as_float(t[0]) + __uint_as_float(t[1]);
}
__device__ __forceinline__ void peer_phase(int wv, const Args& a, int blk, int G, float* OUTP) {
    const int tid = opaque_tid(wv), lane = tid & 63, wave = tid >> 6, hh = lane >> 5, l32 = lane & 31;
    const unsigned* TK = (const unsigned*)(a.ws + WS_TOPK); const unsigned char* PU = (const unsigned char*)(a.ws + WS_PU); const unsigned char* PVt = (const unsigned char*)(a.ws + WS_PV);
    const float* gF = a.in[I_NORM_FFN_G]; const float* gO = a.in[I_FINAL_G];
    int ci0 = 0, cj0 = 0, ci1 = 0, cj1 = 0; bool valid1 = false;
    { int p = 0;
      for (int i = 0; i < 16; ++i) for (int j = 0; j < 16; ++j) if ((i + 1) * (j + 1) <= 16) { if (p == l32) { ci0 = i; cj0 = j; } if (p == l32 + 32) { ci1 = i; cj1 = j; valid1 = true; } ++p; } }
    for (int tok = blk * 8 + wave; tok < S; tok += G * 8) {
        const unsigned short* xrow = (const unsigned short*)(a.ws + WS_A2) + (size_t)tok * D + 16 * lane;
        f32x4 xa[4];
        { const u32x4 r0 = *(const u32x4*)xrow, r1 = *(const u32x4*)(xrow + 8);
          xa[0] = (f32x4){bflo(r0.x), bfhi(r0.x), bflo(r0.y), bfhi(r0.y)}; xa[1] = (f32x4){bflo(r0.z), bfhi(r0.z), bflo(r0.w), bfhi(r0.w)};
          xa[2] = (f32x4){bflo(r1.x), bfhi(r1.x), bflo(r1.y), bfhi(r1.y)}; xa[3] = (f32x4){bflo(r1.z), bfhi(r1.z), bflo(r1.w), bfhi(r1.w)}; }
        unsigned key[4];
#pragma unroll
        for (int i = 0; i < 4; ++i) key[i] = TK[(size_t)tok * 256 + lane + 64 * i];
        float ss = 0.f;
#pragma unroll
        for (int j = 0; j < 4; ++j) ss += (xa[j][0] * xa[j][0] + xa[j][1] * xa[j][1]) + (xa[j][2] * xa[j][2] + xa[j][3] * xa[j][3]);
        ss = wsum(ss);
        const float rstd = 1.0f / sqrtf(ss * (1.0f / D) + 1e-6f);
        float hf[16];
#pragma unroll
        for (int j = 0; j < 4; ++j) { const f32x4 gg = *(const f32x4*)(gF + 16 * lane + 4 * j);
#pragma unroll
            for (int e = 0; e < 4; ++e) hf[4 * j + e] = xa[j][e] * rstd * gg[e]; }
        int ex[4]; float gw[4];
#pragma unroll
        for (int i = 0; i < 4; ++i) {
            const unsigned k = key[i];
            const float v = pg8::ord2f(k & ~0x7Fu); const int ix = 127 - (int)(k & 0x7Fu);
            const float s0 = __shfl(v, hh * 32 + ci0) + __shfl(v, hh * 32 + 16 + cj0);
            const float s1 = __shfl(v, hh * 32 + ci1) + __shfl(v, hh * 32 + 16 + cj1);
            unsigned ck0 = (pg8::f2ord(s0) & ~0xFFu) | (unsigned)(255 - (ci0 * 16 + cj0));
            unsigned ck1 = valid1 ? ((pg8::f2ord(s1) & ~0xFFu) | (unsigned)(255 - (ci1 * 16 + cj1))) : 0u;
            unsigned win = 0u;
#pragma unroll
            for (int r = 0; r < 16; ++r) {
                const unsigned m = half32_umax(ck0 > ck1 ? ck0 : ck1);
                if (l32 == r) win = m;
                if (ck0 == m) ck0 = 0u;
                if (ck1 == m) ck1 = 0u;
            }
            const float ts = pg8::ord2f(win & ~0xFFu); const int flat = 255 - (int)(win & 0xFFu);
            const float mx = __shfl(ts, hh * 32);
            const float e = (l32 < 16) ? __expf(ts - mx) : 0.f;
            const float sum = row16_sum(e);
            gw[i] = e / sum;
            const int e0 = __shfl(ix, hh * 32 + ((flat >> 4) & 15)), e1 = __shfl(ix, hh * 32 + 16 + (flat & 15));
            ex[i] = e0 * 128 + e1;
        }
        float acc[16];
#pragma unroll
        for (int j = 0; j < 16; ++j) acc[j] = 0.f;
#pragma unroll 1
        for (int b = 0; b < 16; ++b) {
            const int i = b >> 2, sl = ((b >> 1) & 1) * 32 + (b & 1) * 8;
            const int exv = i == 0 ? ex[0] : i == 1 ? ex[1] : i == 2 ? ex[2] : ex[3];
            const float gwv = i == 0 ? gw[0] : i == 1 ? gw[1] : i == 2 ? gw[2] : gw[3];
            u32x4 uu[8], vv[8];
#pragma unroll
            for (int q = 0; q < 8; ++q) { const int eid = __builtin_amdgcn_readlane(exv, sl + q); uu[q] = *(const u32x4*)(PU + (size_t)eid * 1024 + 16 * lane); vv[q] = *(const u32x4*)(PVt + (size_t)eid * 1024 + 16 * lane); }
            float d[8];
#pragma unroll
            for (int q = 0; q < 8; ++q) { float s_ = 0.f;
#pragma unroll
                for (int e = 0; e < 4; ++e) { const f32x2v lo = __builtin_amdgcn_cvt_pk_f32_fp8((int)uu[q][e], false), hi2 = __builtin_amdgcn_cvt_pk_f32_fp8((int)uu[q][e], true);
                    s_ += (lo[0] * hf[4 * e] + lo[1] * hf[4 * e + 1]) + (hi2[0] * hf[4 * e + 2] + hi2[1] * hf[4 * e + 3]); }
                d[q] = s_; }
            float z;
            { const bool b0 = lane & 1, b1 = lane & 2, b2 = lane & 4;
              float r4[4], r2[2];
#pragma unroll
              for (int q = 0; q < 4; ++q) { const float keep = b0 ? d[q + 4] : d[q], give = b0 ? d[q] : d[q + 4]; r4[q] = keep + dpp<0xB1>(give); }
#pragma unroll
              for (int q = 0; q < 2; ++q) { const float keep = b1 ? r4[q + 2] : r4[q], give = b1 ? r4[q] : r4[q + 2]; r2[q] = keep + dpp<0x4E>(give); }
              { const float keep = b2 ? r2[1] : r2[0], give = b2 ? r2[0] : r2[1];
                const float up = dpp<0x104>(give), dn = dpp<0x114>(give);
                z = keep + (b2 ? dn : up); }
              z += dpp<0x128>(z);
              auto s16 = __builtin_amdgcn_permlane16_swap(__float_as_uint(z), __float_as_uint(z), false, false); z = __uint_as_float(s16[0]) + __uint_as_float(s16[1]);
              auto s32 = __builtin_amdgcn_permlane32_swap(__float_as_uint(z), __float_as_uint(z), false, false); z = __uint_as_float(s32[0]) + __uint_as_float(s32[1]); }
            const int myq = 4 * (lane & 1) + 2 * ((lane >> 1) & 1) + ((lane >> 2) & 1);
            const float gmine = __shfl(gwv, sl + myq);
            z *= (1.0f / 128.0f);
            const float wl = gmine * 0.5f * z * (1.0f + erff(z * 0.70710678118654752f)) * (1.0f / 128.0f);
#pragma unroll
            for (int q = 0; q < 8; ++q) { const float w = __builtin_bit_cast(float, __builtin_amdgcn_readlane(__builtin_bit_cast(int, wl), ((q >> 2) & 1) | (((q >> 1) & 1) << 1) | ((q & 1) << 2)));
#pragma unroll
                for (int e = 0; e < 4; ++e) { const f32x2v lo = __builtin_amdgcn_cvt_pk_f32_fp8((int)vv[q][e], false), hi2 = __builtin_amdgcn_cvt_pk_f32_fp8((int)vv[q][e], true);
                    acc[4 * e] += w * lo[0]; acc[4 * e + 1] += w * lo[1]; acc[4 * e + 2] += w * hi2[0]; acc[4 * e + 3] += w * hi2[1]; } }
        }
        float s3 = 0.f;
#pragma unroll
        for (int j = 0; j < 4; ++j)
#pragma unroll
            for (int e = 0; e < 4; ++e) { xa[j][e] += acc[4 * j + e]; s3 += xa[j][e] * xa[j][e]; }
        s3 = wsum(s3);
        const float r3 = 1.0f / sqrtf(s3 * (1.0f / D) + 1e-6f);
        float* orow = OUTP + (size_t)tok * D + 16 * lane;
#pragma unroll
        for (int j = 0; j < 4; ++j) { const f32x4 gg = *(const f32x4*)(gO + 16 * lane + 4 * j); *(f32x4*)(orow + 4 * j) = xa[j] * r3 * gg; }
    }
}
}

#define XB_TMO      128
#define XB_XCNT(j)  (256  + 64 * (j))
#define XB_XSUB(j)  (1280 + 64 * (j))
#define XB_XGEN(j)  (2304 + 64 * (j))
#define XB_TOP      3328
#define XB_TOPGEN   3392
#define XCD_BAR_WORDS 3456
#define XB_SPIN_CAP (1u << 18)

__device__ __forceinline__ unsigned xb_ld(unsigned* p)              { return __hip_atomic_load(p, __ATOMIC_RELAXED, __HIP_MEMORY_SCOPE_AGENT); }
__device__ __forceinline__ unsigned xb_add(unsigned* p, unsigned v) { return __hip_atomic_fetch_add(p, v, __ATOMIC_RELAXED, __HIP_MEMORY_SCOPE_AGENT); }
__device__ __forceinline__ unsigned xb_xcc_id() { return (unsigned)__builtin_amdgcn_s_getreg((3 << 11) | 20) & 0xFu; }
#define XB_SPIN(cond, bar) do { unsigned _sp = 0; while (cond) { __builtin_amdgcn_s_sleep(1); \
    if ((++_sp & 255u) == 0u) { if (xb_ld(&(bar)[XB_TMO])) break; if (_sp > XB_SPIN_CAP) { atomicAdd(&(bar)[XB_TMO], 1u); break; } } } } while (0)

struct XcdBarrier {
    unsigned* bar; unsigned x;
    volatile LAS unsigned* st;
};

__device__ __forceinline__ XcdBarrier xcd_barrier_post(unsigned* bar, volatile LAS unsigned* st, int tid) {
    XcdBarrier b; b.bar = bar; b.x = xb_xcc_id(); b.st = st;
    if (tid == 0) (void)xb_add(&bar[XB_XCNT(b.x)], 1u);
    return b;
}
__device__ __forceinline__ void xcd_barrier_complete(unsigned* bar, unsigned x, unsigned& nloc, unsigned& nx) {
    const unsigned G = gridDim.x * gridDim.y * gridDim.z;
    unsigned sum, cnt, mine, sp = 0u;
    for (;;) {
        sum = 0u; cnt = 0u; mine = 0u;
#pragma unroll
        for (unsigned j = 0; j < 16; ++j) { const unsigned c = xb_ld(&bar[XB_XCNT(j)]); sum += c; cnt += (c > 0u) ? 1u : 0u; mine = (j == x) ? c : mine; }
        if (sum == G) break;
        __builtin_amdgcn_s_sleep(1);
        if ((++sp & 255u) == 0u) { if (xb_ld(&bar[XB_TMO])) break; if (sp > XB_SPIN_CAP) { atomicAdd(&bar[XB_TMO], 1u); break; } }
    }
    nloc = mine > 0u ? mine : 1u; nx = cnt > 0u ? cnt : 1u;
}

__device__ __forceinline__ void xcd_barrier(const XcdBarrier& b, int tid) {
    asm volatile("s_waitcnt vmcnt(0)" ::: "memory");
    __syncthreads();
    if (tid == 0) {
        unsigned* bar = b.bar;
        __builtin_amdgcn_s_waitcnt(0);
        unsigned nloc = b.st[0], nx = b.st[1];
        if (nloc == 0u) { xcd_barrier_complete(bar, b.x, nloc, nx); b.st[0] = nloc; b.st[1] = nx; }
        const unsigned old = xb_add(&bar[XB_XSUB(b.x)], 1u);
        const unsigned gen = old / nloc;
        if (old + 1u == (gen + 1u) * nloc) {
            __builtin_amdgcn_fence(__ATOMIC_RELEASE, "agent");
            asm volatile("s_waitcnt vmcnt(0)" ::: "memory");
            const unsigned og = xb_add(&bar[XB_TOP], 1u);
            const unsigned tg = og / nx;
            if (og + 1u == (tg + 1u) * nx) xb_add(&bar[XB_TOPGEN], 1u);
            else XB_SPIN(xb_ld(&bar[XB_TOPGEN]) == tg, bar);
            __builtin_amdgcn_fence(__ATOMIC_ACQUIRE, "agent");
            xb_add(&bar[XB_XGEN(b.x)], 1u);
            asm volatile("s_waitcnt vmcnt(0)" ::: "memory");
        } else {
            XB_SPIN(xb_ld(&bar[XB_XGEN(b.x)]) == gen, bar);
            __builtin_amdgcn_fence(__ATOMIC_ACQUIRE, "agent");
            asm volatile("s_waitcnt vmcnt(0)" ::: "memory");
        }
    }
    __syncthreads();
}

constexpr int LDS_BYTES = 147456, LDS_MISC = 139264;
__global__ void __launch_bounds__(512, 2) mk_fwd(Args a) {
    extern __shared__ __attribute__((aligned(16))) unsigned char lds_raw[];
    LAS unsigned char* lds = (LAS unsigned char*)lds_raw;
    unsigned char* ws = a.ws;
    const int G = gridDim.x, blk = blockIdx.x, wv = __builtin_amdgcn_readfirstlane(threadIdx.x >> 6);
    { const int t0 = opaque_tid(wv); if (t0 < 16) ((volatile LAS unsigned*)(lds + LDS_MISC))[t0] = 0u; }
    __syncthreads();
    XcdBarrier bar = xcd_barrier_post((unsigned*)(ws + WS_CTL), (volatile LAS unsigned*)(lds + LDS_MISC), opaque_tid(wv));
#define IN(k) (a.ph_lo <= (k) && (k) < a.ph_hi)
#define SEAM(k) do { if (IN(k) && IN((k) + 1)) xcd_barrier(bar, opaque_tid(wv)); } while (0)
    if (IN(0)) p0_prologue(wv, a, lds, blk, G);
    SEAM(0);
    if (IN(1)) {
        pg8::Gemm g{(const bf16*)(ws + WS_A0), (const bf16*)(ws + WS_WT_IN), S, NCOLS, D, D, D}; pg8::StaticOrder So; So.init(S, NCOLS, G, blk);
        pg8::EpiProj E{(const float*)(ws + WS_RSTD0), (bf16*)(ws + WS_A1), (bf16*)(ws + WS_A2), (bf16*)(ws + WS_A3), (bf16*)(ws + WS_A4), (bf16*)(ws + WS_A5), (bf16*)(ws + WS_A6), (bf16*)a.out, 0.125f * 1.4426950408889634f, (unsigned*)(ws + WS_KMAX), (PG8_LAS float*)(lds + 131072)};
        pg8::gemm_phase<pg8::EpiProj, pg8::StaticOrder, true, true>(wv, lds, g, So, E);
    }
    SEAM(1);
    if (IN(2)) { conv_phase(wv, a, blk, G);  att::attn_phase(wv, a, lds, blk, G, (bf16*)(ws + WS_A3)); }
    SEAM(2);
    if (IN(3)) {
        pg8::StaticOrder So; So.init(S, D, G, blk);
        { pg8::Gemm g{(const bf16*)(ws + WS_A1), (const bf16*)(ws + WS_WT_CONV), S, D, 2 * D, D, D};
          const pg8::Split sp{16, (long long)WS_A3 - (long long)WS_A1 - 16 * 128, (long long)WS_WT_ATTN - (long long)WS_WT_CONV - 16 * 128};
          pg8::EpiMergeK E{(const bf16*)(ws + WS_A6), (const bf16*)a.out, (bf16*)(ws + WS_A0)};
          pg8::gemm_phase<pg8::EpiMergeK, pg8::StaticOrder, true, true, true>(wv, lds, g, So, E, sp); }
    }
    SEAM(3);
    if (IN(4)) {
        cross_fold(wv, a, blk, G);
        peer_convert(wv, a, blk, G);
        pg8::Gemm g{(const bf16*)(ws + WS_A0), (const bf16*)(ws + WS_WT_MIX), S, D, D, D, D}; pg8::StaticOrder So; So.init(S, D, G, blk);
        pg8::EpiResid E{a.in[I_X], (bf16*)(ws + WS_A2), (float*)(ws + WS_SS1)};
        pg8::gemm_phase<pg8::EpiResid, pg8::StaticOrder, true, true>(wv, lds, g, So, E);
    }
    SEAM(4);
    if (IN(5)) {
        pg8::Gemm g{(const bf16*)(ws + WS_A2), (const bf16*)(ws + WS_WQK), S, D, D, D, D}; pg8::StaticOrder So; So.init(S, D, G, blk);
        pg8::EpiSoftmaxFull E{(const float*)(ws + WS_SS1), (bf16*)(ws + WS_A1), 0.0625f * 1.4426950408889634f};
        pg8::gemm_phase<pg8::EpiSoftmaxFull, pg8::StaticOrder, false, true>(wv, lds, g, So, E);
    }
    SEAM(5);
    if (IN(6)) {
        pg8::Gemm g{(const bf16*)(ws + WS_A1), (const bf16*)(ws + WS_VW), S, D, D, D, D}; pg8::StaticOrder So; So.init(S, D, G, blk);
        pg8::EpiResidB E{(bf16*)(ws + WS_A2), (float*)(ws + WS_SS2)};
        pg8::gemm_phase<pg8::EpiResidB, pg8::StaticOrder, true, true>(wv, lds, g, So, E);
    }
    SEAM(6);
    if (IN(7)) {
        pg8::StaticOrder So; So.init(S, 2048, G, blk);
        unsigned* KS = (unsigned*)(ws + WS_KS) + (size_t)blk * 65536;
        for (int i = 0;; ++i) { pg8::Unit u; if (!So.next(i, u)) break;
            { pg8::Gemm g{(const bf16*)(ws + WS_A2), (const bf16*)(ws + WS_WT_PQ), S, 2048, D, D, D}; pg8::OneUnit S1{u.pm, u.pn};
              pg8::EpiKeys E{(const float*)(ws + WS_SS2), KS};
              pg8::gemm_phase<pg8::EpiKeys, pg8::OneUnit, false, true>(wv, lds, g, S1, E); }
            pg8::topk_from_keys(opaque_tid(wv), KS, (unsigned*)(ws + WS_TOPK), u.pm * 256, u.pn);
            asm volatile("s_waitcnt vmcnt(0)" ::: "memory"); __syncthreads(); }
    }
    SEAM(7);
    if (IN(8)) peer::peer_phase(wv, a, blk, G, a.out);
#undef IN
#undef SEAM
}

extern "C" void kernel_launch(void* const* d_in, const int* in_sizes, int n_in, void* d_out, int out_size, void* d_ws, size_t ws_size, hipStream_t stream) {
    static int grid = 0;
    if (grid == 0) {
        if (ws_size < WS_END || n_in != 25 || out_size != S * D) { fprintf(stderr, "kernel_launch: unexpected ws_size %zu / n_in %d / out_size %d\n", ws_size, n_in, out_size); grid = -1; return; }
        if (hipFuncSetAttribute((const void*)mk_fwd, hipFuncAttributeMaxDynamicSharedMemorySize, LDS_BYTES) != hipSuccess) { fprintf(stderr, "kernel_launch: hipFuncSetAttribute failed\n"); grid = -1; return; }
        int dev = 0, cus = 0, per_cu = 0;
        if (hipGetDevice(&dev) != hipSuccess || hipDeviceGetAttribute(&cus, hipDeviceAttributeMultiprocessorCount, dev) != hipSuccess) { grid = -1; return; }
        if (hipOccupancyMaxActiveBlocksPerMultiprocessor(&per_cu, (const void*)mk_fwd, 512, LDS_BYTES) != hipSuccess || per_cu < 1) { fprintf(stderr, "kernel_launch: occupancy query says %d blocks per CU\n", per_cu); grid = -1; return; }
        grid = cus;
    }
    if (grid < 0) return;
    Args a{};
    for (int i = 0; i < 25; ++i) a.in[i] = (const float*)d_in[i];
    a.out = (float*)d_out; a.ws = (unsigned char*)d_ws; a.ph_lo = 0; a.ph_hi = 9;
    if (hipMemsetAsync(d_ws, 0, 65536, stream) != hipSuccess) { fprintf(stderr, "kernel_launch: hipMemsetAsync failed\n"); return; }
    void* kargs[] = {&a};
    hipError_t e = hipLaunchCooperativeKernel((const void*)mk_fwd, dim3(grid), dim3(512), kargs, LDS_BYTES, stream);
    if (e != hipSuccess) fprintf(stderr, "kernel_launch: cooperative launch failed: %s (grid %d)\n", hipGetErrorString(e), grid);
}
```

```cpp
#include <hip/hip_runtime.h>
#include <math.h>
#include <cstdio>
#include <cstdint>
namespace pg8 {
#define PG8_LAS __attribute__((address_space(3)))
typedef unsigned short bf16_t;
typedef short bf16x8 __attribute__((ext_vector_type(8)));
typedef float f32x4 __attribute__((ext_vector_type(4)));
typedef unsigned u32x4 __attribute__((ext_vector_type(4)));
constexpr int BM = 256, BK = 64, HALF = 128, HTB = HALF * BK * 2  , STAGE_BYTES = 8 * HTB, NXCD = 8, WGM = 8;

__host__ __device__ __forceinline__ int lds_byte(int r, int c) { const int st = (r >> 4) * 2 + (c >> 5), rr = r & 15, cc = c & 31, ob = rr * 64 + cc * 2; return st * 1024 + (ob ^ (((ob >> 9) & 1) << 5)); }
__host__ __device__ __forceinline__ void stage_rc(int b, int& R, int& C) { const int st = b / 1024, sb = b % 1024, swz = sb ^ (((sb >> 9) & 1) << 5); R = (st >> 1) * 16 + swz / 64; C = (st & 1) * 32 + (swz % 64) / 2; }
__host__ __device__ __forceinline__ int perm32(int rho) { const int n = rho >> 4, i = rho & 15; return 8 * (i >> 2) + 4 * n + (i & 3); }

struct Unit { int pm, pn; };
struct Gemm { const bf16_t* A; const bf16_t* Bt; int M, N, K, lda, ldb; };
struct Split { int ksplit; long long dA2, dB2; };

struct StaticOrder {
    int nM, nN, nwg, G, c;
    __host__ __device__ void init(int M, int N, int G_, int c_) { nM = M / BM; nN = N / BM; nwg = nM * nN; G = G_; c = c_; }
    __host__ __device__ bool next(int i, Unit& u) const {
        const long L = (long)i * G + c; if (L >= nwg) return false;
        int wgid = (int)L; { const int q = nwg / NXCD, r = nwg % NXCD, xcd = wgid % NXCD, off = wgid / NXCD; wgid = (xcd < r ? xcd * (q + 1) : r * (q + 1) + (xcd - r) * q) + off; }
        const int nig = WGM * nN, gid = wgid / nig, fm = gid * WGM, gsz = (nM - fm) < WGM ? (nM - fm) : WGM;
        u.pm = fm + ((wgid % nig) % gsz); u.pn = (wgid % nig) / gsz; return true;
    }
    __device__ __forceinline__ void a_ready(const Unit&) const {}
    __device__ __forceinline__ void done(const Unit&) const {}
};

typedef float f32x2 __attribute__((ext_vector_type(2)));
typedef __bf16 bf16x2v __attribute__((ext_vector_type(2)));
__device__ __forceinline__ unsigned cvt_pk_bf16(float lo, float hi) { const f32x2 v = {lo, hi}; const bf16x2v b = __builtin_convertvector(v, bf16x2v); return __builtin_bit_cast(unsigned, b); }
template <class E, class = void> struct HasPrefetch { static constexpr bool value = false; };
template <class E> struct HasPrefetch<E, decltype((void)&E::prefetch)> { static constexpr bool value = true; };
template <class Epi, class Sched, bool ALIGN_EPI = false, bool SP2 = false, bool SPLIT = false>
__device__ __forceinline__ void gemm_phase(int wv, PG8_LAS unsigned char* lds, const Gemm g, const Sched& S, const Epi& E, const Split sp = Split{0, 0, 0}) {
    int tid_; asm volatile("v_mbcnt_lo_u32_b32 %0, -1, 0\n\tv_mbcnt_hi_u32_b32 %0, -1, %0" : "=v"(tid_)); tid_ += wv * 64;
    const int tid = tid_, wid = __builtin_amdgcn_readfirstlane(tid >> 6), lane = tid & 63, wr = wid >> 2, wc = wid & 3, fr = lane & 15, fq = lane >> 4;
    const int K = g.K, nt = K / BK;
    unsigned voffA[2], voffB[2];
#pragma unroll
    for (int i = 0; i < 2; ++i) { int R, C; stage_rc(tid * 16 + i * 8192, R, C); const int Rb = Epi::PERM ? ((R & ~31) + perm32(R & 31)) : R;
        voffA[i] = (unsigned)(R * g.lda + C) * 2u; voffB[i] = (unsigned)(Rb * g.ldb + C) * 2u; }
    const size_t kstep = (size_t)(BK * 2);
    const size_t hstepA = (size_t)HALF * g.lda * 2, hstepB = (size_t)HALF * g.ldb * 2;
    const size_t tstepA = 2 * hstepA, tstepB = 2 * hstepB;
    const unsigned ldsw = (unsigned)wid * 1024u;
    const int aoff = lds_byte(wr * 64 + fr, fq * 8), boff = lds_byte(wc * 32 + fr, fq * 8);
#define PG8_SA(b, h) (((b) * 2 + (h)) * HTB)
#define PG8_SB(b, h) ((4 + (b) * 2 + (h)) * HTB)
#define PG8_STAGE(bufoff, gbase, voff) do { _Pragma("unroll") for (int _i = 0; _i < 2; ++_i) \
        __builtin_amdgcn_global_load_lds((const unsigned*)((const char*)(gbase) + (voff)[_i]), (PG8_LAS unsigned*)(lds + (bufoff) + ldsw + _i * 8192), 16, 0, 0); } while (0)
#define PG8_LDA(dst, b, h) do { _Pragma("unroll") for (int m = 0; m < 4; ++m) _Pragma("unroll") for (int k = 0; k < 2; ++k) dst[m][k] = *(const PG8_LAS bf16x8*)(lds + PG8_SA(b, h) + aoff + m * 2048 + k * 1024); } while (0)
#define PG8_LDB(dst, b, h) do { _Pragma("unroll") for (int n = 0; n < 2; ++n) _Pragma("unroll") for (int k = 0; k < 2; ++k) dst[n][k] = *(const PG8_LAS bf16x8*)(lds + PG8_SB(b, h) + boff + n * 2048 + k * 1024); } while (0)
#define PG8_MMA(ai, bj, At, Bt) do { __builtin_amdgcn_s_setprio(1); _Pragma("unroll") for (int m = 0; m < 4; ++m) _Pragma("unroll") for (int n = 0; n < 2; ++n) _Pragma("unroll") for (int k = 0; k < 2; ++k) \
        acc[ai][bj][m][n] = __builtin_amdgcn_mfma_f32_16x16x32_bf16(Bt[n][k], At[m][k], acc[ai][bj][m][n], 0, 0, 0); __builtin_amdgcn_s_setprio(0); } while (0)
#define PG8_WAIT_V(n) asm volatile("s_waitcnt vmcnt(" #n ")" ::: "memory")
#define PG8_WAIT_L(n) asm volatile("s_waitcnt lgkmcnt(" #n ")" ::: "memory")
#define PG8_BAR __builtin_amdgcn_s_barrier()
#define PG8_SCHED __builtin_amdgcn_sched_barrier(0)
    Unit cur, nxt; int ui = 0;
    if (!S.next(0, cur)) return;
    f32x4 acc[2][2][4][2];
#pragma unroll
    for (int a = 0; a < 2; ++a)
#pragma unroll
        for (int b = 0; b < 2; ++b)
#pragma unroll
            for (int m = 0; m < 4; ++m)
#pragma unroll
                for (int n = 0; n < 2; ++n) acc[a][b][m][n] = (f32x4){0.f, 0.f, 0.f, 0.f};
    bf16x8 At[4][2], B0[2][2], B1[2][2];
    const char* cA = (const char*)g.A + (size_t)cur.pm * tstepA; const char* cB = (const char*)g.Bt + (size_t)cur.pn * tstepB;
    S.a_ready(cur);
    if constexpr (HasPrefetch<Epi>::value) E.prefetch(cur, lds, wid);
    if constexpr (SP2) {
        PG8_STAGE(PG8_SB(0, 0), cB, voffB); PG8_STAGE(PG8_SB(0, 1), cB + hstepB, voffB); PG8_STAGE(PG8_SA(0, 0), cA, voffA); PG8_STAGE(PG8_SA(0, 1), cA + hstepA, voffA);
        if (wr == 1) PG8_BAR;
        PG8_WAIT_V(2); PG8_BAR;
        PG8_STAGE(PG8_SB(1, 0), cB + kstep, voffB); PG8_STAGE(PG8_SA(1, 0), cA + kstep, voffA); PG8_STAGE(PG8_SB(1, 1), cB + hstepB + kstep, voffB);
        PG8_WAIT_V(6); PG8_BAR;
    } else {
        PG8_STAGE(PG8_SB(0, 0), cB, voffB); PG8_STAGE(PG8_SA(0, 0), cA, voffA); PG8_STAGE(PG8_SB(0, 1), cB + hstepB, voffB); PG8_STAGE(PG8_SA(0, 1), cA + hstepA, voffA);
        if (wr == 1) PG8_BAR;
        PG8_WAIT_V(4); PG8_BAR;
        PG8_STAGE(PG8_SB(1, 0), cB + kstep, voffB); PG8_STAGE(PG8_SA(1, 0), cA + kstep, voffA); PG8_STAGE(PG8_SB(1, 1), cB + hstepB + kstep, voffB);
        PG8_WAIT_V(6); PG8_BAR;
    }
    for (;;) {
        const bool has_next = S.next(ui + 1, nxt);
        const char* nA = has_next ? (const char*)g.A + (size_t)nxt.pm * tstepA : cA; const char* nB = has_next ? (const char*)g.Bt + (size_t)nxt.pn * tstepB : cB;
        for (int t = 0; t < nt; t += 2) {
            const bool last = (t == nt - 2);
            long long oa1 = 0, oa2 = 0, ob2 = 0;
            if constexpr (SPLIT) { if (t == sp.ksplit) E.mid(acc, cur, wr, wc, fr, fq);
                if (t >= sp.ksplit) oa1 = sp.dA2; if (t + 2 >= sp.ksplit) { oa2 = sp.dA2; ob2 = sp.dB2; } }
            const char* a1 = cA + (size_t)(t + 1) * kstep + oa1;
            const char* a2 = last ? nA : cA + (size_t)(t + 2) * kstep + oa2; const char* b2 = last ? nB : cB + (size_t)(t + 2) * kstep + ob2;
            const char* a3 = a2 + kstep; const char* b3 = b2 + kstep;
            if (last && has_next) S.a_ready(nxt);
            if constexpr (SP2) {
            PG8_LDB(B0, 0, 0); PG8_LDB(B1, 0, 1); PG8_SCHED; PG8_LDA(At, 0, 0); PG8_STAGE(PG8_SA(1, 1), a1 + hstepA, voffA);
            PG8_WAIT_V(8); PG8_WAIT_L(0); PG8_BAR; PG8_MMA(0, 0, At, B0); PG8_MMA(0, 1, At, B1); PG8_BAR; PG8_SCHED;
            PG8_LDA(At, 0, 1); PG8_STAGE(PG8_SB(0, 0), b2, voffB); PG8_STAGE(PG8_SB(0, 1), b2 + hstepB, voffB); PG8_STAGE(PG8_SA(0, 0), a2, voffA);
            PG8_WAIT_V(8); PG8_WAIT_L(0); PG8_BAR; PG8_MMA(1, 0, At, B0); PG8_MMA(1, 1, At, B1); PG8_BAR; PG8_SCHED;
            PG8_LDB(B0, 1, 0); PG8_LDB(B1, 1, 1); PG8_SCHED; PG8_LDA(At, 1, 0); PG8_STAGE(PG8_SA(0, 1), a2 + hstepA, voffA);
            PG8_WAIT_V(8); PG8_WAIT_L(0); PG8_BAR; PG8_MMA(0, 0, At, B0); PG8_MMA(0, 1, At, B1); PG8_BAR; PG8_SCHED;
            PG8_LDA(At, 1, 1); PG8_STAGE(PG8_SB(1, 0), b3, voffB); PG8_STAGE(PG8_SB(1, 1), b3 + hstepB, voffB); PG8_STAGE(PG8_SA(1, 0), a3, voffA);
            PG8_WAIT_V(8); PG8_WAIT_L(0); PG8_BAR; PG8_MMA(1, 0, At, B0); PG8_MMA(1, 1, At, B1); PG8_BAR; PG8_SCHED;
            } else {
            PG8_LDB(B0, 0, 0); PG8_SCHED; PG8_LDA(At, 0, 0); PG8_STAGE(PG8_SA(1, 1), a1 + hstepA, voffA);
            PG8_WAIT_L(8); PG8_BAR; PG8_WAIT_L(0); PG8_MMA(0, 0, At, B0); PG8_BAR; PG8_SCHED;
            PG8_LDB(B1, 0, 1); PG8_STAGE(PG8_SB(0, 0), b2, voffB);
            PG8_BAR; PG8_WAIT_L(0); PG8_MMA(0, 1, At, B1); PG8_BAR;
            PG8_LDA(At, 0, 1); PG8_STAGE(PG8_SA(0, 0), a2, voffA);
            PG8_BAR; PG8_WAIT_L(0); PG8_MMA(1, 0, At, B0); PG8_BAR; PG8_SCHED;
            PG8_STAGE(PG8_SB(0, 1), b2 + hstepB, voffB);
            PG8_WAIT_V(6); PG8_BAR; PG8_MMA(1, 1, At, B1); PG8_BAR;
            PG8_LDB(B0, 1, 0); PG8_SCHED; PG8_LDA(At, 1, 0); PG8_STAGE(PG8_SA(0, 1), a2 + hstepA, voffA);
            PG8_WAIT_L(8); PG8_BAR; PG8_WAIT_L(0); PG8_MMA(0, 0, At, B0); PG8_BAR; PG8_SCHED;
            PG8_LDB(B1, 1, 1); PG8_STAGE(PG8_SB(1, 0), b3, voffB);
            PG8_BAR; PG8_WAIT_L(0); PG8_MMA(0, 1, At, B1); PG8_BAR;
            PG8_LDA(At, 1, 1); PG8_STAGE(PG8_SA(1, 0), a3, voffA);
            PG8_BAR; PG8_WAIT_L(0); PG8_MMA(1, 0, At, B0); PG8_BAR; PG8_SCHED;
            PG8_STAGE(PG8_SB(1, 1), b3 + hstepB, voffB);
            PG8_WAIT_V(6); PG8_BAR; PG8_MMA(1, 1, At, B1); PG8_BAR;
            }
        }
        if constexpr (ALIGN_EPI) { if (wr == 0) PG8_BAR; }
        if constexpr (!Epi::AFTER_DRAIN) { E(acc, cur, wr, wc, fr, fq); S.done(cur); }
        if (!has_next) break;
#pragma unroll
        for (int a = 0; a < 2; ++a)
#pragma unroll
            for (int b = 0; b < 2; ++b)
#pragma unroll
                for (int m = 0; m < 4; ++m)
#pragma unroll
                    for (int n = 0; n < 2; ++n) acc[a][b][m][n] = (f32x4){0.f, 0.f, 0.f, 0.f};
        cur = nxt; cA = nA; cB = nB; ++ui;
        if constexpr (HasPrefetch<Epi>::value) E.prefetch(cur, lds, wid);
        if constexpr (ALIGN_EPI) { if (wr == 1) PG8_BAR; }
    }
    PG8_WAIT_V(0);
    if constexpr (!ALIGN_EPI) { if (wr == 0) PG8_BAR; }
    PG8_BAR;
    if constexpr (Epi::AFTER_DRAIN) { E.fused(acc, cur, wr, wc, fr, fq, lds, wid, lane); S.done(cur); }
#undef PG8_SA
#undef PG8_SB
#undef PG8_STAGE
#undef PG8_LDA
#undef PG8_LDB
#undef PG8_MMA
#undef PG8_WAIT_V
#undef PG8_WAIT_L
#undef PG8_BAR
#undef PG8_SCHED
}
}


constexpr int S = 16384, D = 1024, NCOLS = 8192, MEMN = 256;
typedef unsigned short bf16;
typedef float f32x4 __attribute__((ext_vector_type(4)));
typedef unsigned u32x4 __attribute__((ext_vector_type(4)));
typedef unsigned u32x2 __attribute__((ext_vector_type(2)));
__device__ __forceinline__ void st16wt(void* p, u32x4 v) { asm volatile("global_store_dwordx4 %0, %1, off sc1\n\ts_nop 1" :: "v"(p), "v"(v) : "memory"); }
#define LAS __attribute__((address_space(3)))

__device__ const unsigned char T5_BUCKET[128] = {0, 1, 2, 3, 4, 5, 6, 7, 8, 9, 10, 11, 12, 13, 14, 15, 16, 16, 16, 17, 17, 18, 18, 18, 19, 19, 19, 20, 20, 20, 20, 21, 21, 21, 21, 22, 22, 22, 22, 22, 23, 23, 23, 23, 23, 23, 24, 24, 24, 24, 24, 24, 25, 25, 25, 25, 25, 25, 25, 26, 26, 26, 26, 26, 26, 26, 26, 27, 27, 27, 27, 27, 27, 27, 27, 27, 27, 28, 28, 28, 28, 28, 28, 28, 28, 28, 28, 29, 29, 29, 29, 29, 29, 29, 29, 29, 29, 29, 29, 30, 30, 30, 30, 30, 30, 30, 30, 30, 30, 30, 30, 30, 30, 31, 31, 31, 31, 31, 31, 31, 31, 31, 31, 31, 31, 31, 31, 31};

constexpr size_t MiB = 1u << 20;
constexpr size_t WS_CTL = 0, WS_KMAX = 32768  , WS_RSTD0 = 512 * 1024;
constexpr size_t WS_WT_IN = 1 * MiB, WS_WT_CONV = 17 * MiB, WS_WT_ATTN = 19 * MiB, WS_WT_MIX = 21 * MiB, WS_WT_CQ = 23 * MiB, WS_WT_CO = 25 * MiB, WS_WT_PQ = 27 * MiB;
constexpr size_t WS_SUBK = 31 * MiB, WS_KV = 32 * MiB, WS_SS1 = 34 * MiB, WS_SS2 = 35 * MiB;
constexpr size_t WS_TOPK = 36 * MiB  , WS_PU = 196 * MiB  , WS_PV = 228 * MiB  ;
constexpr size_t WS_WQK = 23 * MiB  , WS_VW = 212 * MiB  ;
constexpr size_t WS_PQS = 52 * MiB  , WS_KS = 132 * MiB  ;
constexpr size_t WS_A0 = 36 * MiB, WS_A1 = 68 * MiB, WS_A2 = 100 * MiB, WS_A3 = 132 * MiB, WS_A4 = 164 * MiB, WS_A5 = 196 * MiB, WS_A6 = 228 * MiB, WS_END = 260 * MiB;

__device__ __forceinline__ float wave_sum(float v) {
#pragma unroll
    for (int o = 1; o < 64; o <<= 1) v += __shfl_xor(v, o);
    return v;
}
__device__ __forceinline__ float wave_max(float v) {
#pragma unroll
    for (int o = 1; o < 64; o <<= 1) v = fmaxf(v, __shfl_xor(v, o));
    return v;
}
__device__ __forceinline__ int opaque_tid(int wv) { int t; asm volatile("v_mbcnt_lo_u32_b32 %0, -1, 0\n\tv_mbcnt_hi_u32_b32 %0, -1, %0" : "=v"(t)); return t + wv * 64; }
__device__ __forceinline__ unsigned f2bf(float f) { unsigned u = __builtin_bit_cast(unsigned, f); return (u + 0x7fffu + ((u >> 16) & 1u)) >> 16; }
__device__ __forceinline__ unsigned pk2(float lo, float hi) { return pg8::cvt_pk_bf16(lo, hi); }
__device__ __forceinline__ float bflo(unsigned w) { return __builtin_bit_cast(float, w << 16); }
__device__ __forceinline__ float bfhi(unsigned w) { return __builtin_bit_cast(float, w & 0xffff0000u); }
__device__ __forceinline__ float sigmoidf_(float x) { return __builtin_amdgcn_rcpf(1.0f + __builtin_amdgcn_exp2f(x * -1.4426950408889634f)); }

struct Args { const float* in[25]; float* out; unsigned char* ws; int ph_lo, ph_hi; };
enum { I_X = 0, I_MEM, I_NORM_MIX_G, I_W_IN, I_CONV_W, I_W_CONV_OUT, I_LQ1, I_LK1, I_LQ2, I_LK2, I_SUBLN_G, I_W_ATTN_OUT, I_W_MIX_OUT, I_REL_BIAS, I_NORM_CROSS_G, I_NORM_MEM_G,
       I_W_CQ, I_W_CKV, I_W_CO, I_NORM_FFN_G, I_W_PQ, I_SUB_KEYS, I_PEER_U, I_PEER_V, I_FINAL_G };

namespace pg8 {
template <int CTRL> __device__ __forceinline__ float dppf(float x) { return __builtin_bit_cast(float, __builtin_amdgcn_mov_dpp(__builtin_bit_cast(int, x), CTRL, 0xf, 0xf, true)); }
__device__ __forceinline__ float row16_max(float v) { v = fmaxf(v, dppf<0xB1>(v)); v = fmaxf(v, dppf<0x4E>(v)); v = fmaxf(v, dppf<0x141>(v)); return fmaxf(v, dppf<0x140>(v)); }
__device__ __forceinline__ float xrow16_max(float x) {
    auto s = __builtin_amdgcn_permlane16_swap(__float_as_uint(x), __float_as_uint(x), false, false); x = fmaxf(__uint_as_float(s[0]), __uint_as_float(s[1]));
    auto t = __builtin_amdgcn_permlane32_swap(__float_as_uint(x), __float_as_uint(x), false, false); return fmaxf(__uint_as_float(t[0]), __uint_as_float(t[1])); }
__device__ __forceinline__ float xrow16_sum(float x) {
    auto s = __builtin_amdgcn_permlane16_swap(__float_as_uint(x), __float_as_uint(x), false, false); x = __uint_as_float(s[0]) + __uint_as_float(s[1]);
    auto t = __builtin_amdgcn_permlane32_swap(__float_as_uint(x), __float_as_uint(x), false, false); return __uint_as_float(t[0]) + __uint_as_float(t[1]); }
__device__ __forceinline__ u32x4 pack8(const f32x4& v0, const f32x4& v1) { u32x4 w; w.x = cvt_pk_bf16(v0[0], v0[1]); w.y = cvt_pk_bf16(v0[2], v0[3]); w.z = cvt_pk_bf16(v1[0], v1[1]); w.w = cvt_pk_bf16(v1[2], v1[3]); return w; }
struct EpiProj {
    static constexpr bool PERM = true, AFTER_DRAIN = false;
    const float* rstd_g; bf16_t *CB, *U, *Q, *K, *V, *SGC, *SGA; float qscale; unsigned* KMAX; PG8_LAS float* rl;
    __device__ __forceinline__ void prefetch(const Unit& u, PG8_LAS unsigned char* lds, int wid) const {
        if (wid == 0) { int ln; asm volatile("v_mbcnt_lo_u32_b32 %0, -1, 0\n\tv_mbcnt_hi_u32_b32 %0, -1, %0" : "=v"(ln));
            __builtin_amdgcn_global_load_lds((const unsigned*)(rstd_g + u.pm * BM + ln * 4), (PG8_LAS unsigned*)rl, 16, 0, 0); }
    }
    __device__ __forceinline__ void operator()(const f32x4 (&acc)[2][2][4][2], const Unit& u, int wr, int wc, int fr0, int fq) const {
        int fr = fr0; asm volatile("" : "+v"(fr));
        const int row0 = u.pm * BM + wr * 64 + fr, pn = u.pn, colw = wc * 32 + 8 * fq;
        const PG8_LAS float* rstd = rl - u.pm * BM;
        if (pn >= 4 && pn < 12) {
            const int col = 128 * (pn - 4) + colw;
#pragma unroll
            for (int ai = 0; ai < 2; ++ai)
#pragma unroll
                for (int m = 0; m < 4; ++m) { const int row = row0 + ai * HALF + m * 16; const float rs = rstd[row], r2 = rs * rs;
                    const f32x4 v0 = acc[ai][0][m][0] * acc[ai][1][m][0] * r2, v1 = acc[ai][0][m][1] * acc[ai][1][m][1] * r2;
                    *(u32x4*)(U + (size_t)row * 1024 + col) = pack8(v0, v1); }
            return;
        }
        bf16_t* base; int cbase; float sc = 1.f; bool gate = false;
        if (pn < 4) { base = CB; cbase = pn * 256; }
        else if (pn < 16) { base = Q; cbase = (pn - 12) * 256; sc = qscale; }
        else if (pn < 20) { base = K; cbase = (pn - 16) * 256; }
        else if (pn < 24) { base = V; cbase = (pn - 20) * 256; }
        else if (pn < 28) { base = SGC; cbase = (pn - 24) * 256; gate = true; }
        else { base = SGA; cbase = (pn - 28) * 256; gate = true; }
#pragma unroll
        for (int ai = 0; ai < 2; ++ai)
#pragma unroll
            for (int m = 0; m < 4; ++m) { const int row = row0 + ai * HALF + m * 16; const float rs = rstd[row] * sc;
#pragma unroll
                for (int bj = 0; bj < 2; ++bj) { f32x4 v0 = acc[ai][bj][m][0] * rs, v1 = acc[ai][bj][m][1] * rs;
                    if (gate) {
#pragma unroll
                        for (int e = 0; e < 4; ++e) { v0[e] = sigmoidf_(v0[e]); v1[e] = sigmoidf_(v1[e]); } }
                    *(u32x4*)(base + (size_t)row * 1024 + cbase + bj * HALF + colw) = pack8(v0, v1); } }
        if (pn >= 16 && pn < 20) {
            float mx[2] = {0.f, 0.f};
#pragma unroll
            for (int ai = 0; ai < 2; ++ai)
#pragma unroll
                for (int m = 0; m < 4; ++m) { const float rs = rstd[row0 + ai * HALF + m * 16];
#pragma unroll
                    for (int bj = 0; bj < 2; ++bj) { const f32x4 v0 = acc[ai][bj][m][0] * rs, v1 = acc[ai][bj][m][1] * rs;
                        const float s = xrow16_sum(((v0[0] * v0[0] + v0[1] * v0[1]) + (v0[2] * v0[2] + v0[3] * v0[3])) + ((v1[0] * v1[0] + v1[1] * v1[1]) + (v1[2] * v1[2] + v1[3] * v1[3])));
                        mx[bj] = fmaxf(mx[bj], s); } }
#pragma unroll
            for (int bj = 0; bj < 2; ++bj) { float v = mx[bj];
                v = row16_max(v);
                if (fr == 0 && fq == 0) atomicMax(KMAX + (((pn - 16) * 2 + bj) * 2 + (wc >> 1)) * 2 + (wc & 1), __float_as_uint(v)); }
        }
    }
};
struct EpiGateT {
    static constexpr bool PERM = true, AFTER_DRAIN = false;
    const bf16_t* SG; float* T;
    __device__ __forceinline__ void operator()(const f32x4 (&acc)[2][2][4][2], const Unit& u, int wr, int wc, int fr0, int fq) const {
        int fr = fr0; asm volatile("" : "+v"(fr));
        const int row0 = u.pm * BM + wr * 64 + fr, col0 = u.pn * BM + wc * 32 + 8 * fq;
#pragma unroll
        for (int ai = 0; ai < 2; ++ai)
#pragma unroll
            for (int m = 0; m < 4; ++m) { const size_t off = (size_t)(row0 + ai * HALF + m * 16) * 1024 + col0;
#pragma unroll
                for (int bj = 0; bj < 2; ++bj) { const u32x4 g = *(const u32x4*)(SG + off + bj * HALF);
                    f32x4 g0 = {bflo(g.x), bfhi(g.x), bflo(g.y), bfhi(g.y)}, g1 = {bflo(g.z), bfhi(g.z), bflo(g.w), bfhi(g.w)};
                    *(f32x4*)(T + off + bj * HALF) = g0 * acc[ai][bj][m][0]; *(f32x4*)(T + off + bj * HALF + 4) = g1 * acc[ai][bj][m][1]; } }
    }
};
struct EpiMerge {
    static constexpr bool PERM = true, AFTER_DRAIN = false;
    const float* T; const bf16_t* SG; bf16_t* O;
    __device__ __forceinline__ void operator()(const f32x4 (&acc)[2][2][4][2], const Unit& u, int wr, int wc, int fr0, int fq) const {
        int fr = fr0; asm volatile("" : "+v"(fr));
        const int row0 = u.pm * BM + wr * 64 + fr, col0 = u.pn * BM + wc * 32 + 8 * fq;
#pragma unroll
        for (int ai = 0; ai < 2; ++ai)
#pragma unroll
            for (int m = 0; m < 4; ++m) { const size_t off = (size_t)(row0 + ai * HALF + m * 16) * 1024 + col0;
#pragma unroll
                for (int bj = 0; bj < 2; ++bj) { const u32x4 g = *(const u32x4*)(SG + off + bj * HALF);
                    f32x4 g0 = {bflo(g.x), bfhi(g.x), bflo(g.y), bfhi(g.y)}, g1 = {bflo(g.z), bfhi(g.z), bflo(g.w), bfhi(g.w)};
                    const f32x4 t0 = *(const f32x4*)(T + off + bj * HALF), t1 = *(const f32x4*)(T + off + bj * HALF + 4);
                    *(u32x4*)(O + off + bj * HALF) = pack8(t0 + g0 * acc[ai][bj][m][0], t1 + g1 * acc[ai][bj][m][1]); } }
    }
};
struct EpiMergeK {
    static constexpr bool PERM = true, AFTER_DRAIN = false;
    const bf16_t* SGc; const bf16_t* SGa; bf16_t* O;
    __device__ __forceinline__ void mid(f32x4 (&acc)[2][2][4][2], const Unit& u, int wr, int wc, int fr0, int fq) const {
        int fr = fr0; asm volatile("" : "+v"(fr));
        const int row0 = u.pm * BM + wr * 64 + fr, col0 = u.pn * BM + wc * 32 + 8 * fq;
#pragma unroll
        for (int ai = 0; ai < 2; ++ai)
#pragma unroll
            for (int m = 0; m < 4; ++m) { const size_t off = (size_t)(row0 + ai * HALF + m * 16) * 1024 + col0;
#pragma unroll
                for (int bj = 0; bj < 2; ++bj) { const u32x4 c = *(const u32x4*)(SGc + off + bj * HALF), g = *(const u32x4*)(SGa + off + bj * HALF);
                    const f32x4 c0 = {bflo(c.x), bfhi(c.x), bflo(c.y), bfhi(c.y)}, c1 = {bflo(c.z), bfhi(c.z), bflo(c.w), bfhi(c.w)};
                    f32x4 g0 = {bflo(g.x), bfhi(g.x), bflo(g.y), bfhi(g.y)}, g1 = {bflo(g.z), bfhi(g.z), bflo(g.w), bfhi(g.w)};
#pragma unroll
                    for (int e = 0; e < 4; ++e) { g0[e] = c0[e] * __builtin_amdgcn_rcpf(fmaxf(g0[e], 1e-20f)); g1[e] = c1[e] * __builtin_amdgcn_rcpf(fmaxf(g1[e], 1e-20f)); }
                    acc[ai][bj][m][0] *= g0; acc[ai][bj][m][1] *= g1; } }
    }
    __device__ __forceinline__ void operator()(const f32x4 (&acc)[2][2][4][2], const Unit& u, int wr, int wc, int fr0, int fq) const {
        int fr = fr0; asm volatile("" : "+v"(fr));
        const int row0 = u.pm * BM + wr * 64 + fr, col0 = u.pn * BM + wc * 32 + 8 * fq;
#pragma unroll
        for (int ai = 0; ai < 2; ++ai)
#pragma unroll
            for (int m = 0; m < 4; ++m) { const size_t off = (size_t)(row0 + ai * HALF + m * 16) * 1024 + col0;
#pragma unroll
                for (int bj = 0; bj < 2; ++bj) { const u32x4 g = *(const u32x4*)(SGa + off + bj * HALF);
                    f32x4 g0 = {bflo(g.x), bfhi(g.x), bflo(g.y), bfhi(g.y)}, g1 = {bflo(g.z), bfhi(g.z), bflo(g.w), bfhi(g.w)};
#pragma unroll
                    for (int e = 0; e < 4; ++e) { g0[e] = fmaxf(g0[e], 1e-20f); g1[e] = fmaxf(g1[e], 1e-20f); }
                    st16wt(O + off + bj * HALF, pack8(g0 * acc[ai][bj][m][0], g1 * acc[ai][bj][m][1])); } }
    }
};
struct EpiResid {
    static constexpr bool PERM = true, AFTER_DRAIN = false;
    const float* R; bf16_t* XB; float* SS;
    __device__ __forceinline__ void operator()(const f32x4 (&acc)[2][2][4][2], const Unit& u, int wr, int wc, int fr0, int fq) const {
        int fr = fr0; asm volatile("" : "+v"(fr));
        const int row0 = u.pm * BM + wr * 64 + fr, col0 = u.pn * BM + wc * 32 + 8 * fq;
#pragma unroll
        for (int ai = 0; ai < 2; ++ai)
#pragma unroll
            for (int m = 0; m < 4; ++m) { const int row = row0 + ai * HALF + m * 16; const size_t off = (size_t)row * 1024 + col0; float ss = 0.f;
#pragma unroll
                for (int bj = 0; bj < 2; ++bj) {
                    const f32x4 x0 = *(const f32x4*)(R + off + bj * HALF) + acc[ai][bj][m][0], x1 = *(const f32x4*)(R + off + bj * HALF + 4) + acc[ai][bj][m][1];
                    st16wt(XB + off + bj * HALF, pack8(x0, x1));
                    ss += (x0[0] * x0[0] + x0[1] * x0[1]) + (x0[2] * x0[2] + x0[3] * x0[3]) + (x1[0] * x1[0] + x1[1] * x1[1]) + (x1[2] * x1[2] + x1[3] * x1[3]); }
                ss = xrow16_sum(ss);
                if (fq == 0) SS[(size_t)row * 16 + u.pn * 4 + wc] = ss; }
    }
};
struct EpiResidB {
    static constexpr bool PERM = true, AFTER_DRAIN = false;
    bf16_t* XB; float* SS;
    __device__ __forceinline__ void operator()(const f32x4 (&acc)[2][2][4][2], const Unit& u, int wr, int wc, int fr0, int fq) const {
        int fr = fr0; asm volatile("" : "+v"(fr));
        const int row0 = u.pm * BM + wr * 64 + fr, col0 = u.pn * BM + wc * 32 + 8 * fq;
#pragma unroll
        for (int ai = 0; ai < 2; ++ai)
#pragma unroll
            for (int m = 0; m < 4; ++m) { const int row = row0 + ai * HALF + m * 16; const size_t off = (size_t)row * 1024 + col0; float ss = 0.f;
#pragma unroll
                for (int bj = 0; bj < 2; ++bj) { const u32x4 g = *(const u32x4*)(XB + off + bj * HALF);
                    const f32x4 r0 = {bflo(g.x), bfhi(g.x), bflo(g.y), bfhi(g.y)}, r1 = {bflo(g.z), bfhi(g.z), bflo(g.w), bfhi(g.w)};
                    const f32x4 x0 = r0 + acc[ai][bj][m][0], x1 = r1 + acc[ai][bj][m][1];
                    st16wt(XB + off + bj * HALF, pack8(x0, x1));
                    ss += (x0[0] * x0[0] + x0[1] * x0[1]) + (x0[2] * x0[2] + x0[3] * x0[3]) + (x1[0] * x1[0] + x1[1] * x1[1]) + (x1[2] * x1[2] + x1[3] * x1[3]); }
                ss = xrow16_sum(ss);
                if (fq == 0) SS[(size_t)row * 16 + u.pn * 4 + wc] = ss; }
    }
};
struct EpiRowScale {
    static constexpr bool PERM = true, AFTER_DRAIN = false;
    const float* SS; bf16_t* O; int ldc; float sc;
    __device__ __forceinline__ void operator()(const f32x4 (&acc)[2][2][4][2], const Unit& u, int wr, int wc, int fr0, int fq) const {
        int fr = fr0; asm volatile("" : "+v"(fr));
        const int row0 = u.pm * BM + wr * 64 + fr, col0 = u.pn * BM + wc * 32 + 8 * fq;
#pragma unroll
        for (int ai = 0; ai < 2; ++ai)
#pragma unroll
            for (int m = 0; m < 4; ++m) { const int row = row0 + ai * HALF + m * 16;
                const f32x4* sp = (const f32x4*)(SS + (size_t)row * 16); const f32x4 s4 = (sp[0] + sp[1]) + (sp[2] + sp[3]);
                const float rs = sc / sqrtf(((s4[0] + s4[1]) + (s4[2] + s4[3])) * (1.0f / 1024.0f) + 1e-6f);
#pragma unroll
                for (int bj = 0; bj < 2; ++bj) *(u32x4*)(O + (size_t)row * ldc + col0 + bj * HALF) = pack8(acc[ai][bj][m][0] * rs, acc[ai][bj][m][1] * rs); }
    }
};

__device__ __forceinline__ unsigned f2ord(float f) { const unsigned u = __builtin_bit_cast(unsigned, f); return u ^ ((unsigned)((int)u >> 31) | 0x80000000u); }
__device__ __forceinline__ float ord2f(unsigned k) { const unsigned u = (k & 0x80000000u) ? (k ^ 0x80000000u) : ~k; return __builtin_bit_cast(float, u); }
#define PG8_CSWAP(a, b) do { const unsigned hi_ = (a) > (b) ? (a) : (b), lo_ = (a) > (b) ? (b) : (a); (a) = hi_; (b) = lo_; } while (0)
__device__ __forceinline__ void sort16_desc(unsigned (&k)[16]) {
#pragma unroll
    for (int sz = 2; sz <= 16; sz <<= 1)
#pragma unroll
        for (int st = sz >> 1; st > 0; st >>= 1)
#pragma unroll
            for (int i = 0; i < 16; ++i) { const int l = i ^ st; if (l > i) { if ((i & sz) == 0) PG8_CSWAP(k[i], k[l]); else PG8_CSWAP(k[l], k[i]); } }
}
__device__ __forceinline__ void merge16_desc(unsigned (&a)[16], const unsigned (&b)[16]) {
#pragma unroll
    for (int i = 0; i < 16; ++i) a[i] = a[i] > b[15 - i] ? a[i] : b[15 - i];
#pragma unroll
    for (int st = 8; st > 0; st >>= 1)
#pragma unroll
        for (int i = 0; i < 16; ++i) { const int l = i ^ st; if (l > i) PG8_CSWAP(a[i], a[l]); }
}
struct EpiKeys {
    static constexpr bool PERM = true, AFTER_DRAIN = false;
    const float* SS; unsigned* KS;
    __device__ __forceinline__ void operator()(const f32x4 (&acc)[2][2][4][2], const Unit& u, int wr, int wc, int fr0, int fq) const {
        int fr = fr0; asm volatile("" : "+v"(fr));
#pragma unroll
        for (int ai = 0; ai < 2; ++ai)
#pragma unroll
            for (int m = 0; m < 4; ++m) { const int row = ai * HALF + wr * 64 + m * 16 + fr;
                const f32x4* sp = (const f32x4*)(SS + (size_t)(u.pm * BM + row) * 16); const f32x4 s4 = (sp[0] + sp[1]) + (sp[2] + sp[3]);
                const float rs = 1.0f / sqrtf(((s4[0] + s4[1]) + (s4[2] + s4[3])) * (1.0f / 1024.0f) + 1e-6f);
#pragma unroll
                for (int bj = 0; bj < 2; ++bj)
#pragma unroll
                    for (int n = 0; n < 2; ++n) { const int cw = wc * 32 + 8 * fq + 4 * n; u32x4 k;
#pragma unroll
                        for (int e = 0; e < 4; ++e) k[e] = (f2ord(acc[ai][bj][m][n][e] * rs) & ~0x7Fu) | (unsigned)(127 - (cw + e));
                        *(u32x4*)(KS + row * 256 + bj * HALF + cw) = k; } }
    }
};
__device__ __forceinline__ void topk_from_keys(int tid, const unsigned* KS, unsigned* TOPK, int tok0, int h) {
#pragma unroll 1
    for (int ai = 0; ai < 2; ++ai) {
        const int j = tid & 1, rl = (tid >> 1) & 127, c = tid >> 8;
        const unsigned* src = KS + (ai * 128 + rl) * 256 + c * 128 + j * 64;
        unsigned best[16], cur[16];
        { const u32x4 a0 = *(const u32x4*)src, a1 = *(const u32x4*)(src + 4), a2 = *(const u32x4*)(src + 8), a3 = *(const u32x4*)(src + 12);
#pragma unroll
          for (int e = 0; e < 4; ++e) { best[e] = a0[e]; best[4 + e] = a1[e]; best[8 + e] = a2[e]; best[12 + e] = a3[e]; } }
        sort16_desc(best);
#pragma unroll 1
        for (int gq = 1; gq < 4; ++gq) {
            const u32x4 a0 = *(const u32x4*)(src + gq * 16), a1 = *(const u32x4*)(src + gq * 16 + 4), a2 = *(const u32x4*)(src + gq * 16 + 8), a3 = *(const u32x4*)(src + gq * 16 + 12);
#pragma unroll
            for (int e = 0; e < 4; ++e) { cur[e] = a0[e]; cur[4 + e] = a1[e]; cur[8 + e] = a2[e]; cur[12 + e] = a3[e]; }
            sort16_desc(cur); merge16_desc(best, cur); }
#pragma unroll
        for (int i = 0; i < 16; ++i) cur[i] = (unsigned)__shfl_xor((int)best[i], 1);
        merge16_desc(best, cur);
        unsigned* dst = TOPK + ((size_t)(tok0 + ai * 128 + rl) * 8 + h) * 32 + c * 16 + j * 8;
        u32x4 w0, w1;
        if (j == 0) { w0 = (u32x4){best[0], best[1], best[2], best[3]}; w1 = (u32x4){best[4], best[5], best[6], best[7]}; }
        else { w0 = (u32x4){best[8], best[9], best[10], best[11]}; w1 = (u32x4){best[12], best[13], best[14], best[15]}; }
        st16wt(dst, w0); st16wt(dst + 4, w1);
    }
}
struct EpiSoftmaxP {
    static constexpr bool PERM = true, AFTER_DRAIN = true;
    bf16_t* P; PG8_LAS float* lrow;
    __device__ __forceinline__ void fused(f32x4 (&acc)[2][2][4][2], const Unit& u, int wr, int wc, int fr0, int fq, PG8_LAS unsigned char* lds, int wid, int lane) const {
        int fr = fr0; asm volatile("" : "+v"(fr));
        PG8_LAS float* MX = (PG8_LAS float*)lds; PG8_LAS float* SM = MX + 1024;
#pragma unroll
        for (int ai = 0; ai < 2; ++ai)
#pragma unroll
            for (int m = 0; m < 4; ++m) { float mx = -INFINITY;
#pragma unroll
                for (int bj = 0; bj < 2; ++bj)
#pragma unroll
                    for (int n = 0; n < 2; ++n)
#pragma unroll
                        for (int e = 0; e < 4; ++e) mx = fmaxf(mx, acc[ai][bj][m][n][e]);
                mx = xrow16_max(mx);
                if (fq == 0) MX[(ai * HALF + wr * 64 + m * 16 + fr) * 4 + wc] = mx; }
        asm volatile("s_waitcnt lgkmcnt(0)\n\ts_barrier" ::: "memory");
#pragma unroll
        for (int ai = 0; ai < 2; ++ai)
#pragma unroll
            for (int m = 0; m < 4; ++m) { const int row = ai * HALF + wr * 64 + m * 16 + fr;
                const f32x4 m4 = *(const PG8_LAS f32x4*)(MX + row * 4); const float rm = fmaxf(fmaxf(m4[0], m4[1]), fmaxf(m4[2], m4[3])); float s = 0.f;
#pragma unroll
                for (int bj = 0; bj < 2; ++bj) { f32x4 p0, p1;
#pragma unroll
                    for (int e = 0; e < 4; ++e) { p0[e] = __builtin_amdgcn_exp2f(acc[ai][bj][m][0][e] - rm); p1[e] = __builtin_amdgcn_exp2f(acc[ai][bj][m][1][e] - rm); }
                    s += ((p0[0] + p0[1]) + (p0[2] + p0[3])) + ((p1[0] + p1[1]) + (p1[2] + p1[3]));
                    *(u32x4*)(P + (size_t)row * 256 + bj * HALF + wc * 32 + 8 * fq) = pack8(p0, p1); }
                s = xrow16_sum(s);
                if (fq == 0) SM[row * 4 + wc] = s; }
        asm volatile("s_waitcnt lgkmcnt(0)\n\ts_barrier" ::: "memory");
        const int tid = wid * 64 + lane;
        if (tid < 256) { const f32x4 s4 = *(const PG8_LAS f32x4*)(SM + tid * 4); lrow[tid] = (s4[0] + s4[1]) + (s4[2] + s4[3]); }
    }
};
struct EpiSoftmaxFull {
    static constexpr bool PERM = true, AFTER_DRAIN = true;
    const float* SS; bf16_t* P; float sc;
    __device__ __forceinline__ void fused(f32x4 (&acc)[2][2][4][2], const Unit& u, int wr, int wc, int fr0, int fq, PG8_LAS unsigned char* lds, int wid, int lane) const {
        int fr = fr0; asm volatile("" : "+v"(fr));
        PG8_LAS float* MX = (PG8_LAS float*)lds; PG8_LAS float* SM = MX + 1024;
#pragma unroll
        for (int ai = 0; ai < 2; ++ai)
#pragma unroll
            for (int m = 0; m < 4; ++m) { const int lr = ai * HALF + wr * 64 + m * 16 + fr, row = u.pm * BM + lr; float mx = -INFINITY;
                const f32x4* sp = (const f32x4*)(SS + (size_t)row * 16); const f32x4 s4 = (sp[0] + sp[1]) + (sp[2] + sp[3]);
                const float rs = sc / sqrtf(((s4[0] + s4[1]) + (s4[2] + s4[3])) * (1.0f / 1024.0f) + 1e-6f);
#pragma unroll
                for (int bj = 0; bj < 2; ++bj)
#pragma unroll
                    for (int n = 0; n < 2; ++n) { acc[ai][bj][m][n] *= rs;
#pragma unroll
                        for (int e = 0; e < 4; ++e) mx = fmaxf(mx, acc[ai][bj][m][n][e]); }
                mx = xrow16_max(mx);
                if (fq == 0) MX[lr * 4 + wc] = mx; }
        asm volatile("s_waitcnt lgkmcnt(0)\n\ts_barrier" ::: "memory");
#pragma unroll
        for (int ai = 0; ai < 2; ++ai)
#pragma unroll
            for (int m = 0; m < 4; ++m) { const int lr = ai * HALF + wr * 64 + m * 16 + fr;
                const f32x4 m4 = *(const PG8_LAS f32x4*)(MX + lr * 4); const float rm = fmaxf(fmaxf(m4[0], m4[1]), fmaxf(m4[2], m4[3])); float s = 0.f;
#pragma unroll
                for (int bj = 0; bj < 2; ++bj)
#pragma unroll
                    for (int n = 0; n < 2; ++n) {
#pragma unroll
                        for (int e = 0; e < 4; ++e) acc[ai][bj][m][n][e] = __builtin_amdgcn_exp2f(acc[ai][bj][m][n][e] - rm);
                        s += (acc[ai][bj][m][n][0] + acc[ai][bj][m][n][1]) + (acc[ai][bj][m][n][2] + acc[ai][bj][m][n][3]); }
                s = xrow16_sum(s);
                if (fq == 0) SM[lr * 4 + wc] = s; }
        asm volatile("s_waitcnt lgkmcnt(0)\n\ts_barrier" ::: "memory");
#pragma unroll
        for (int ai = 0; ai < 2; ++ai)
#pragma unroll
            for (int m = 0; m < 4; ++m) { const int lr = ai * HALF + wr * 64 + m * 16 + fr;
                const f32x4 s4 = *(const PG8_LAS f32x4*)(SM + lr * 4); const float inv = 1.0f / ((s4[0] + s4[1]) + (s4[2] + s4[3]));
#pragma unroll
                for (int bj = 0; bj < 2; ++bj)
                    st16wt(P + (size_t)(u.pm * BM + lr) * 1024 + u.pn * BM + bj * HALF + wc * 32 + 8 * fq, pack8(acc[ai][bj][m][0] * inv, acc[ai][bj][m][1] * inv)); }
    }
};
struct EpiCO {
    static constexpr bool PERM = true, AFTER_DRAIN = false;
    bf16_t* O; const PG8_LAS float* lrow;
    __device__ __forceinline__ void operator()(const f32x4 (&acc)[2][2][4][2], const Unit& u, int wr, int wc, int fr0, int fq) const {
        int fr = fr0; asm volatile("" : "+v"(fr));
#pragma unroll
        for (int ai = 0; ai < 2; ++ai)
#pragma unroll
            for (int m = 0; m < 4; ++m) { const int row = ai * HALF + wr * 64 + m * 16 + fr; const float inv = 1.0f / lrow[row];
#pragma unroll
                for (int bj = 0; bj < 2; ++bj) *(u32x4*)(O + (size_t)row * 1024 + bj * HALF + wc * 32 + 8 * fq) = pack8(acc[ai][bj][m][0] * inv, acc[ai][bj][m][1] * inv); }
    }
};
struct OneUnit {
    int pm, pn;
    __device__ __forceinline__ bool next(int i, Unit& u) const { if (i) return false; u.pm = pm; u.pn = pn; return true; }
    __device__ __forceinline__ void a_ready(const Unit&) const {}
    __device__ __forceinline__ void done(const Unit&) const {}
};
}

__device__ __forceinline__ int win_src_col(int n) {
    if (n < 1024 || n >= 3072) return n;
    const int t = (n - 1024) >> 8, j = (n - 1024) & 255;
    return j < 128 ? 1024 + 128 * t + j : 2048 + 128 * t + (j - 128);
}
__device__ __forceinline__ void p0_prologue(int wv, const Args& a, LAS unsigned char* lds, int blk, int G) {
    const int tid = opaque_tid(wv), lane = tid & 63, wave = tid >> 6;
    unsigned char* ws = a.ws;
    LAS float* tl = (LAS float*)lds;
    {
        f32x4 cur[8], nxt[8]; const float* gcur = nullptr; const float* gnxt = nullptr;
#define P0_DECODE(job, W, ldw, nb, kb, Wt, gain, perm) do { \
            if ((job) < 512) { W = a.in[I_W_IN]; ldw = NCOLS; kb = (job) >> 5; nb = (job) & 31; Wt = (bf16*)(ws + WS_WT_IN); gain = a.in[I_NORM_MIX_G]; perm = true; } \
            else { const int mat = ((job) - 512) >> 6, idx = ((job) - 512) & 63; kb = idx >> 2; nb = idx & 3; ldw = 1024; gain = nullptr; perm = false; \
                if (mat == 0) { W = a.in[I_W_CONV_OUT]; Wt = (bf16*)(ws + WS_WT_CONV); } \
                else if (mat == 1) { W = a.in[I_W_ATTN_OUT]; Wt = (bf16*)(ws + WS_WT_ATTN); } \
                else if (mat == 2) { W = a.in[I_W_MIX_OUT]; Wt = (bf16*)(ws + WS_WT_MIX); } \
                else { W = a.in[I_W_CO]; Wt = (bf16*)(ws + WS_WT_CO); } } } while (0)
#define P0_LOAD(dst, gv, job) do { const float* W; int ldw, nb, kb; bf16* Wt; const float* gain; bool perm; P0_DECODE(job, W, ldw, nb, kb, Wt, gain, perm); (void)Wt; \
            const int k0 = kb * 64, c = tid & 63, nd0 = nb * 256 + 64 * (c >> 4), ns0 = (perm ? win_src_col(nd0) : nd0) + 4 * (c & 15); gv = gain ? gain + k0 : nullptr; \
            _Pragma("unroll") for (int i = 0; i < 8; ++i) dst[i] = *(const f32x4*)(W + (size_t)(k0 + (tid >> 6) + 8 * i) * ldw + ns0); } while (0)
        if (blk < 768) P0_LOAD(cur, gcur, blk);
        for (int job = blk; job < 768; job += G) {
            if (job + G < 768) P0_LOAD(nxt, gnxt, job + G);
#pragma unroll
            for (int i = 0; i < 8; ++i) { const int kk = (tid >> 6) + 8 * i, c = tid & 63; const float gk = gcur ? gcur[kk] : 1.0f; LAS float* d = tl + kk * 257 + 4 * c;
                d[0] = cur[i][0] * gk; d[1] = cur[i][1] * gk; d[2] = cur[i][2] * gk; d[3] = cur[i][3] * gk; }
            __syncthreads();
            { const float* W; int ldw, nb, kb; bf16* Wt; const float* gain; bool perm; P0_DECODE(job, W, ldw, nb, kb, Wt, gain, perm); (void)W; (void)ldw; (void)gain; (void)perm;
#pragma unroll
              for (int r = 0; r < 4; ++r) { const int idx = tid + 512 * r, nn = idx >> 3, kq = idx & 7; const LAS float* s = tl + (kq * 8) * 257 + nn;
                  u32x4 o; o.x = pk2(s[0], s[257]); o.y = pk2(s[2 * 257], s[3 * 257]); o.z = pk2(s[4 * 257], s[5 * 257]); o.w = pk2(s[6 * 257], s[7 * 257]);
                  st16wt(Wt + (size_t)(nb * 256 + nn) * 1024 + kb * 64 + kq * 8, o); } }
            __syncthreads();
#pragma unroll
            for (int i = 0; i < 8; ++i) cur[i] = nxt[i];
            gcur = gnxt;
        }
#undef P0_DECODE
#undef P0_LOAD
    }
    { const float* x = a.in[I_X]; bf16* XB = (bf16*)(ws + WS_A0); float* rstd0 = (float*)(ws + WS_RSTD0);
      f32x4 v[4], w4[4]; int row = blk * 8 + wave;
#define P0_XLOAD(dst, r) do { const f32x4* xr = (const f32x4*)(x + (size_t)(r) * D) + 2 * lane; dst[0] = xr[0]; dst[1] = xr[1]; dst[2] = xr[128]; dst[3] = xr[129]; } while (0)
      if (row < S) P0_XLOAD(v, row);
      for (; row < S; row += G * 8) {
          if (row + G * 8 < S) P0_XLOAD(w4, row + G * 8);
          float s = 0.f;
#pragma unroll
          for (int j = 0; j < 4; ++j) s += (v[j][0] * v[j][0] + v[j][1] * v[j][1]) + (v[j][2] * v[j][2] + v[j][3] * v[j][3]);
          s = wave_sum(s);
          if (lane == 0) rstd0[row] = 1.0f / sqrtf(s * (1.0f / D) + 1e-6f);
          bf16* o = XB + (size_t)row * D + 8 * lane;
#pragma unroll
          for (int j = 0; j < 2; ++j) { u32x4 w; w.x = pk2(v[2 * j][0], v[2 * j][1]); w.y = pk2(v[2 * j][2], v[2 * j][3]); w.z = pk2(v[2 * j + 1][0], v[2 * j + 1][1]); w.w = pk2(v[2 * j + 1][2], v[2 * j + 1][3]);
              st16wt(o + 512 * j, w); }
#pragma unroll
          for (int j = 0; j < 4; ++j) v[j] = w4[j];
      }
#undef P0_XLOAD
    }
    { typedef short bf16x8_t __attribute__((ext_vector_type(8))); typedef float f32x16_t __attribute__((ext_vector_type(16)));
      LAS bf16* mnb = (LAS bf16*)lds;
      LAS float* red = (LAS float*)(lds + 32 * 1032 * 2);
      const float* mem = a.in[I_MEM]; const float* g = a.in[I_NORM_MEM_G]; const float* Wc = a.in[I_W_CKV]; bf16* KC = (bf16*)(ws + WS_KV); bf16* VC = KC + 4 * 256 * 256;
      const int r32 = lane & 31, kg = lane >> 5;
      for (int wb = blk; wb < 256; wb += G) {
          const int m0 = (wb >> 5) * 32, n0 = (wb & 31) * 64;
          __syncthreads();
#pragma unroll
          for (int r = 0; r < 4; ++r) { const int rr = wave * 4 + r; const f32x4* mr = (const f32x4*)(mem + (size_t)(m0 + rr) * D) + lane; f32x4 v[4]; float s = 0.f;
#pragma unroll
              for (int j = 0; j < 4; ++j) { v[j] = mr[64 * j]; s += (v[j][0] * v[j][0] + v[j][1] * v[j][1]) + (v[j][2] * v[j][2] + v[j][3] * v[j][3]); }
              s = wave_sum(s); const float rs = 1.0f / sqrtf(s * (1.0f / D) + 1e-6f);
#pragma unroll
              for (int j = 0; j < 4; ++j) { const f32x4 gg = ((const f32x4*)g)[lane + 64 * j]; const f32x4 y = v[j] * rs * gg; u32x2 w; w.x = pk2(y[0], y[1]); w.y = pk2(y[2], y[3]);
                  *(LAS u32x2*)(mnb + rr * 1032 + 4 * (lane + 64 * j)) = w; } }
          __syncthreads();
          const int it = wave & 1, kq = wave >> 1, ncol = n0 + 32 * it + r32;
          f32x16_t acc;
#pragma unroll
          for (int r = 0; r < 16; ++r) acc[r] = 0.f;
#pragma unroll 1
          for (int half = 0; half < 2; ++half) {
              float wv_[8][8];
#pragma unroll
              for (int s = 0; s < 8; ++s)
#pragma unroll
                  for (int j = 0; j < 8; ++j) wv_[s][j] = Wc[(size_t)(256 * kq + 128 * half + 16 * s + 8 * kg + j) * 2048 + ncol];
#pragma unroll
              for (int s = 0; s < 8; ++s) {
                  u32x4 bw; bw.x = pk2(wv_[s][0], wv_[s][1]); bw.y = pk2(wv_[s][2], wv_[s][3]); bw.z = pk2(wv_[s][4], wv_[s][5]); bw.w = pk2(wv_[s][6], wv_[s][7]);
                  const bf16x8_t af = *(const LAS bf16x8_t*)(mnb + r32 * 1032 + 256 * kq + 128 * half + 16 * s + 8 * kg);
                  acc = __builtin_amdgcn_mfma_f32_32x32x16_bf16(af, __builtin_bit_cast(bf16x8_t, bw), acc, 0, 0, 0); }
          }
#pragma unroll
          for (int r = 0; r < 16; ++r) red[((it * 4 + kq) * 16 + r) * 64 + lane] = acc[r];
          __syncthreads();
          if (kq == 0) {
#pragma unroll
              for (int r = 0; r < 16; ++r) acc[r] = (red[((it * 4 + 0) * 16 + r) * 64 + lane] + red[((it * 4 + 1) * 16 + r) * 64 + lane]) + (red[((it * 4 + 2) * 16 + r) * 64 + lane] + red[((it * 4 + 3) * 16 + r) * 64 + lane]);
              if (ncol < 1024) {
#pragma unroll
                  for (int r = 0; r < 16; ++r) KC[((size_t)(ncol >> 8) * 256 + (m0 + (r & 3) + 8 * (r >> 2) + 4 * kg)) * 256 + (ncol & 255)] = (bf16)f2bf(acc[r]);
              } else {
#pragma unroll
                  for (int r = 0; r < 16; ++r) VC[((size_t)((ncol - 1024) >> 8) * 256 + (m0 + (r & 3) + 8 * (r >> 2) + 4 * kg)) * 256 + (ncol & 255)] = (bf16)f2bf(acc[r]);
              }
          }
      }
      __syncthreads(); }
    { typedef short bf16x8_t __attribute__((ext_vector_type(8))); typedef float f32x16_t __attribute__((ext_vector_type(16)));
      const float* sk = a.in[I_SUB_KEYS]; const float* wpq = a.in[I_W_PQ]; const float* gf = a.in[I_NORM_FFN_G]; bf16* WT = (bf16*)(ws + WS_WT_PQ);
      const int r32 = lane & 31, kg = lane >> 5;
      for (int item = blk * 8 + wave; item < 2048; item += G * 8) {
          const int hc = item >> 7, h = hc >> 1, c = hc & 1, kt = (item >> 2) & 31, nt = item & 3;
          const float* ap = wpq + (size_t)(kt * 32 + r32) * 2048 + hc * 128 + 8 * kg;
          const float* bp = sk + ((size_t)((c * 8 + h) * 128 + nt * 32 + r32)) * 128 + 8 * kg;
          const float gk = gf[kt * 32 + r32];
          f32x4 av[8][2], bv[8][2];
#pragma unroll
          for (int s = 0; s < 8; ++s) { av[s][0] = *(const f32x4*)(ap + 16 * s); av[s][1] = *(const f32x4*)(ap + 16 * s + 4); bv[s][0] = *(const f32x4*)(bp + 16 * s); bv[s][1] = *(const f32x4*)(bp + 16 * s + 4); }
          f32x16_t acc;
#pragma unroll
          for (int r = 0; r < 16; ++r) acc[r] = 0.f;
#pragma unroll
          for (int s = 0; s < 8; ++s) {
              const f32x4 a0 = av[s][0] * gk, a1 = av[s][1] * gk;
              u32x4 aw, bw; aw.x = pk2(a0[0], a0[1]); aw.y = pk2(a0[2], a0[3]); aw.z = pk2(a1[0], a1[1]); aw.w = pk2(a1[2], a1[3]);
              bw.x = pk2(bv[s][0][0], bv[s][0][1]); bw.y = pk2(bv[s][0][2], bv[s][0][3]); bw.z = pk2(bv[s][1][0], bv[s][1][1]); bw.w = pk2(bv[s][1][2], bv[s][1][3]);
              acc = __builtin_amdgcn_mfma_f32_32x32x16_bf16(__builtin_bit_cast(bf16x8_t, aw), __builtin_bit_cast(bf16x8_t, bw), acc, 0, 0, 0); }
          bf16* dst = WT + (size_t)(hc * 128 + nt * 32 + r32) * 1024 + kt * 32 + 4 * kg;
#pragma unroll
          for (int q = 0; q < 4; ++q) { u32x2 w; w.x = pk2(acc[4 * q], acc[4 * q + 1]); w.y = pk2(acc[4 * q + 2], acc[4 * q + 3]); *(u32x2*)(dst + 8 * q) = w; }
      } }
}

__device__ __forceinline__ void cross_fold(int wv, const Args& a, int blk, int G) {
    typedef short bf16x8_t __attribute__((ext_vector_type(8))); typedef float f32x16_t __attribute__((ext_vector_type(16)));
    const int tid = opaque_tid(wv), lane = tid & 63, wave = tid >> 6, r32 = lane & 31, kg = lane >> 5;
    const bf16* KC = (const bf16*)(a.ws + WS_KV); const bf16* VC = KC + 4 * 256 * 256;
    for (int item = blk * 8 + wave; item < 2048; item += G * 8) {
        f32x16_t acc;
#pragma unroll
        for (int r = 0; r < 16; ++r) acc[r] = 0.f;
        bf16* dst;
        if (item < 1024) {
            const int h = item >> 8, kt = (item >> 3) & 31, mt = item & 7;
            const float* ap = a.in[I_W_CQ] + (size_t)(kt * 32 + r32) * 1024 + h * 256 + 8 * kg;
            const bf16* bp = KC + ((size_t)h * 256 + mt * 32 + r32) * 256 + 8 * kg;
            const float gk = a.in[I_NORM_CROSS_G][kt * 32 + r32];
#pragma unroll 1
            for (int half = 0; half < 2; ++half) {
                f32x4 av[8][2]; u32x4 bv[8];
#pragma unroll
                for (int s = 0; s < 8; ++s) { av[s][0] = *(const f32x4*)(ap + 128 * half + 16 * s); av[s][1] = *(const f32x4*)(ap + 128 * half + 16 * s + 4); bv[s] = *(const u32x4*)(bp + 128 * half + 16 * s); }
#pragma unroll
                for (int s = 0; s < 8; ++s) { const f32x4 a0 = av[s][0] * gk, a1 = av[s][1] * gk;
                    u32x4 aw; aw.x = pk2(a0[0], a0[1]); aw.y = pk2(a0[2], a0[3]); aw.z = pk2(a1[0], a1[1]); aw.w = pk2(a1[2], a1[3]);
                    acc = __builtin_amdgcn_mfma_f32_32x32x16_bf16(__builtin_bit_cast(bf16x8_t, aw), __builtin_bit_cast(bf16x8_t, bv[s]), acc, 0, 0, 0); }
            }
            dst = (bf16*)(a.ws + WS_WQK) + (size_t)(h * 256 + mt * 32 + r32) * 1024 + kt * 32 + 4 * kg;
        } else {
            const int it = item - 1024, h = it >> 8, mt = (it >> 5) & 7, nt = it & 31;
            const bf16* ap = VC + ((size_t)h * 256 + mt * 32 + r32) * 256 + 8 * kg;
            const bf16* bp = (const bf16*)(a.ws + WS_WT_CO) + (size_t)(nt * 32 + r32) * 1024 + h * 256 + 8 * kg;
            u32x4 av[16], bv[16];
#pragma unroll
            for (int s = 0; s < 16; ++s) { av[s] = *(const u32x4*)(ap + 16 * s); bv[s] = *(const u32x4*)(bp + 16 * s); }
#pragma unroll
            for (int s = 0; s < 16; ++s) acc = __builtin_amdgcn_mfma_f32_32x32x16_bf16(__builtin_bit_cast(bf16x8_t, av[s]), __builtin_bit_cast(bf16x8_t, bv[s]), acc, 0, 0, 0);
            dst = (bf16*)(a.ws + WS_VW) + (size_t)(nt * 32 + r32) * 1024 + h * 256 + mt * 32 + 4 * kg;
        }
#pragma unroll
        for (int q = 0; q < 4; ++q) { u32x2 w; w.x = pk2(acc[4 * q], acc[4 * q + 1]); w.y = pk2(acc[4 * q + 2], acc[4 * q + 3]); *(u32x2*)(dst + 8 * q) = w; }
    }
}

__device__ __forceinline__ void conv_phase(int wv, const Args& a, int blk, int G) {
    bf16* CB = (bf16*)(a.ws + WS_A1); const bf16* U = (const bf16*)(a.ws + WS_A2); const float* cw = a.in[I_CONV_W];
    const int tid = opaque_tid(wv);
    const int c = (tid & 127) * 8;
    float w0[8], w1[8], w2[8];
#pragma unroll
    for (int e = 0; e < 8; ++e) { w0[e] = cw[c + e]; w1[e] = cw[D + c + e]; w2[e] = cw[2 * D + c + e]; }
    const size_t step = (size_t)G * 512, total = (size_t)S * D / 8;
    for (size_t i0 = (size_t)blk * 512 + tid; i0 < total; i0 += 4 * step) {
        u32x4 cb[4], u2[4], u1[4], u0[4];
#pragma unroll
        for (int q = 0; q < 4; ++q) { const size_t i = i0 + q * step; const int r = (int)(i >> 7);
            cb[q] = u2[q] = u1[q] = u0[q] = (u32x4){0, 0, 0, 0};
            if (i < total) { cb[q] = *(const u32x4*)(CB + i * 8); u2[q] = *(const u32x4*)(U + i * 8);
                if (r >= 1) u1[q] = *(const u32x4*)(U + i * 8 - D);
                if (r >= 2) u0[q] = *(const u32x4*)(U + i * 8 - 2 * D); } }
#pragma unroll
        for (int q = 0; q < 4; ++q) { const size_t i = i0 + q * step;
            u32x4 o;
#pragma unroll
            for (int e = 0; e < 4; ++e) {
                const float lo = bflo(cb[q][e]) * (w0[2 * e] * bflo(u0[q][e]) + w1[2 * e] * bflo(u1[q][e]) + w2[2 * e] * bflo(u2[q][e]));
                const float hi = bfhi(cb[q][e]) * (w0[2 * e + 1] * bfhi(u0[q][e]) + w1[2 * e + 1] * bfhi(u1[q][e]) + w2[2 * e + 1] * bfhi(u2[q][e]));
                o[e] = pk2(lo, hi);
            }
            if (i < total) st16wt(CB + i * 8, o); }
    }
}


namespace att {
typedef short bf16x8 __attribute__((ext_vector_type(8)));
typedef short s16x4 __attribute__((ext_vector_type(4)));
typedef float f32x16 __attribute__((ext_vector_type(16)));
typedef short v4i16_t __attribute__((ext_vector_type(4)));
typedef LAS const char* lds_cptr;
constexpr int SLOT = 16384, LDS_K = 0, LDS_V = 4 * SLOT, LDS_WSF = 8 * SLOT, LDS_BT = LDS_WSF + 2048, LDS_TOTAL = LDS_BT + 1024;
constexpr int LDS_XCH = 0, LDS_OST = 65536;
constexpr float LOG2E = 1.4426950408889634f, THR = 8.0f;
__device__ __forceinline__ int crow(int r, int hi) { return (r & 3) + 8 * (r >> 2) + 4 * hi; }
typedef float f32x2_t __attribute__((ext_vector_type(2))); typedef __bf16 bf16x2_t __attribute__((ext_vector_type(2)));
__device__ __forceinline__ unsigned cvtpk(float lo, float hi) { const f32x2_t v = {lo, hi}; const bf16x2_t b = __builtin_convertvector(v, bf16x2_t); return __builtin_bit_cast(unsigned, b); }
__device__ __forceinline__ void glds16(const void* g, unsigned lds_base) {
    unsigned sv; asm volatile("s_mov_b32 %0, m0\n\ts_mov_b32 m0, %2\n\ts_nop 0\n\tglobal_load_lds_dwordx4 %1, off\n\ts_mov_b32 m0, %0" : "=&s"(sv) : "v"(g), "s"(lds_base) : "memory"); }
template <int IMM> __device__ __forceinline__ void glds16s(unsigned voff, const void* sbase, unsigned lds_base) {
    unsigned sv; asm volatile("s_mov_b32 %0, m0\n\ts_mov_b32 m0, %3\n\ts_nop 0\n\tglobal_load_lds_dwordx4 %1, %2 offset:%c4\n\ts_mov_b32 m0, %0" : "=&s"(sv) : "v"(voff), "s"(sbase), "s"(lds_base), "i"(IMM) : "memory"); }
__device__ __forceinline__ s16x4 vtr(lds_cptr p) { return __builtin_bit_cast(s16x4, __builtin_amdgcn_ds_read_tr16_b64_v4i16((LAS v4i16_t*)p)); }
#define ATT_MX3(a, b, c) __builtin_fmaxf(__builtin_fmaxf((a), (b)), (c))
__device__ __forceinline__ float rowmax(const f32x16& p0, const f32x16& p1) {
    float a = ATT_MX3(p0[0], p0[1], p1[0]), b = ATT_MX3(p0[2], p0[3], p1[1]); a = ATT_MX3(a, p1[2], p1[3]);
#pragma unroll
    for (int r = 4; r < 16; r += 4) { a = ATT_MX3(a, p0[r], p0[r + 1]); b = ATT_MX3(b, p0[r + 2], p0[r + 3]); a = ATT_MX3(a, p1[r], p1[r + 1]); b = ATT_MX3(b, p1[r + 2], p1[r + 3]); }
    float m = __builtin_fmaxf(a, b); auto rr = __builtin_amdgcn_permlane32_swap(__float_as_uint(m), __float_as_uint(m), false, false);
    return __builtin_fmaxf(__uint_as_float(rr[0]), __uint_as_float(rr[1])); }
#define ATT_WAIT_BAR(N) asm volatile("s_waitcnt vmcnt(" #N ") lgkmcnt(0)\n\ts_barrier" ::: "memory")
#define ATT_LBAR() asm volatile("s_waitcnt lgkmcnt(0)\n\ts_barrier" ::: "memory")
#define ATT_MFMA(a, b, c) __builtin_amdgcn_mfma_f32_32x32x16_bf16(a, b, c, 0, 0, 0)

__device__ __forceinline__ void attn_unit_pipe(int wv, int h, int qb, const bf16* Q, const bf16* __restrict__ K, const bf16* __restrict__ V, bf16* O, LAS unsigned char* lds,
                                               float lam, const float* rel_bias, const float* subln_g, const unsigned* KMAX) {
    const int tid = opaque_tid(wv), lane = tid & 63, r32 = lane & 31, hi = lane >> 5;
    const int wid = __builtin_amdgcn_readfirstlane(tid >> 6), comp = wid >> 2, rg = wid & 3;
    const int q0 = qb * 128, qw0 = q0 + 32 * rg, NT = 2 * qb + 2;
    const unsigned lds0 = (unsigned)(unsigned long long)lds;
    LAS float* wsf = (LAS float*)(lds + LDS_WSF) + wid * 64;
    LAS float* bt = (LAS float*)(lds + LDS_BT);
    const float bfar = rel_bias[31 * 8 + h] * LOG2E;
    float bmax = -INFINITY;
    if (tid < 129) { const int b = tid < 128 ? (int)T5_BUCKET[tid] : 31; bt[tid] = (rel_bias[b * 8 + h] - rel_bias[31 * 8 + h]) * LOG2E; }
#pragma unroll
    for (int b = 0; b < 32; ++b) bmax = fmaxf(bmax, rel_bias[b * 8 + h] * LOG2E);
    const float kmx = sqrtf(__uint_as_float(KMAX[(h * 2 + comp) * 2]) + __uint_as_float(KMAX[(h * 2 + comp) * 2 + 1])) * 1.02f;
    const unsigned kvoff = (unsigned)lane * 2048u + (unsigned)wid * 16u;
    const unsigned vvoff = (unsigned)(16 * (wid & 3) + (lane >> 2)) * 2048u + (unsigned)((wid >> 2) * 32 + (lane & 3) * 8) * 2u;
    const char* kbase = (const char*)(K + h * 128); const char* vbase = (const char*)(V + h * 128);
    const unsigned kdst = lds0 + LDS_K + wid * 1024, vdst = lds0 + LDS_V + wid * 1024;
#define ATT_RFL(x) ((unsigned)__builtin_amdgcn_readfirstlane((int)(x)))
#define DMA_K(t, so) do { const char* b_ = kbase + (size_t)(t) * 131072; glds16s<0>(kvoff, b_, ATT_RFL(kdst + (so))); glds16s<128>(kvoff, b_, ATT_RFL(kdst + (so) + 8192 - 128)); } while (0)
#define DMA_V(t, so) do { const char* b_ = vbase + (size_t)(t) * 131072; glds16s<0>(vvoff, b_, ATT_RFL(vdst + (so))); glds16s<128>(vvoff, b_, ATT_RFL(vdst + (so) + 8192 - 128)); } while (0)
    bf16x8 qr[4];
    float cfar;
    { const bf16* Qw = Q + (size_t)(qw0 + r32) * 1024 + h * 128 + comp * 64 + hi * 8;
#pragma unroll
      for (int d0 = 0; d0 < 4; ++d0) qr[d0] = *(const bf16x8*)(Qw + d0 * 16);
      float s = 0.f;
#pragma unroll
      for (int d0 = 0; d0 < 4; ++d0)
#pragma unroll
          for (int e2 = 0; e2 < 8; ++e2) { const float f = __builtin_bit_cast(float, (unsigned)(unsigned short)qr[d0][e2] << 16); s += f * f; }
      auto rr = __builtin_amdgcn_permlane32_swap(__float_as_uint(s), __float_as_uint(s), false, false); s = __uint_as_float(rr[0]) + __uint_as_float(rr[1]);
      cfar = bfar - (sqrtf(s) * 1.01f * kmx + bmax); }
    DMA_K(0, 0); DMA_K(1, SLOT); DMA_V(0, 0); if (NT > 2) DMA_K(2, 2 * SLOT);
    const lds_cptr kp0 = (lds_cptr)(lds + LDS_K) + comp * 8192 + hi * 1024 + r32 * 16;
    const lds_cptr vp0 = (lds_cptr)(lds + LDS_V) + ((lane >> 4) & 1) * 32 + (lane & 3) * 8 + (4 * hi + ((lane & 15) >> 2)) * 64;
    float l_reg = 0.f;
    f32x16 o[4];
#pragma unroll
    for (int d0 = 0; d0 < 4; ++d0)
#pragma unroll
        for (int r = 0; r < 16; ++r) o[d0][r] = 0.f;
    bf16x8 kf[8];
    f32x16 pA0, pA1, pB0, pB1;
    u32x4 pw0, pw1, pw2, pw3;
    s16x4 vl0, vh0, vl1, vh1;
#define SBAR() __builtin_amdgcn_sched_barrier(0)
#define PIN(x) asm volatile("" : "+v"(x))
#define PKW(P, B) cvtpk(P[B], P[B + 1])
#define PAF(k) __builtin_bit_cast(bf16x8, pw##k)
#define EX(v) __builtin_amdgcn_exp2f(v)
#define ROT3() do { const int t_ = s0; s0 = s1; s1 = s2; s2 = t_; } while (0)
#define ENDW(t) do { if ((t) + 3 < NT) { ATT_WAIT_BAR(4); } else if ((t) + 1 < NT) { ATT_WAIT_BAR(2); } else { ATT_WAIT_BAR(0); } } while (0)
#define KLD(f, kp_) kf[f] = *(LAS const bf16x8*)((kp_) + ((f) >> 1) * 2048 + ((f) & 1) * 512)
#define BANDFIX(C0, C1, t) do { if (__builtin_expect(64 * (t) + 63 + 128 > qw0, 0)) { const int ln_ = opaque_tid(0);   \
        const int dq = qw0 + (ln_ & 31) - 64 * (t) - 4 * (ln_ >> 5); \
        _Pragma("unroll") for (int r = 0; r < 16; ++r) { const int d0_ = dq - ((r & 3) + 8 * (r >> 2)), d1_ = d0_ - 32; \
            const float b0 = bt[min(max(d0_, 0), 128)], b1 = bt[min(max(d1_, 0), 128)]; \
            C0[r] = d0_ < 0 ? -INFINITY : C0[r] + b0; C1[r] = d1_ < 0 ? -INFINITY : C1[r] + b1; } } } while (0)
#define VRD(j, i, vp_) do { vl##j = vtr((vp_) + ((i) & 3) * 4096 + ((i) >> 2) * 1024); vh##j = vtr((vp_) + ((i) & 3) * 4096 + ((i) >> 2) * 1024 + 512); } while (0)
#define VFR(j) (bf16x8){vl##j[0], vl##j[1], vl##j[2], vl##j[3], vh##j[0], vh##j[1], vh##j[2], vh##j[3]}
#define GAPA(MF, A0, A1, A2, A3, W0, W1, PWX) do { MF; sacc += A0; sacc += A1; sacc += A2; sacc += A3; PIN(sacc); W0; W1; PIN(PWX); SBAR(); } while (0)
#define PHASE_A(C0, C1, P0, P1, vp_) do { float sacc = P0[0] + P0[1]; \
        GAPA(C0 = ATT_MFMA(kf[0], qr[0], C0), P0[2], P0[3], P0[4], P0[5],     pw0[0] = PKW(P0, 0), pw0[1] = PKW(P0, 2), pw0); \
        GAPA(C1 = ATT_MFMA(kf[1], qr[0], C1), P0[6], P0[7], P0[8], P0[9],     pw0[2] = PKW(P0, 4), pw0[3] = PKW(P0, 6), pw0); \
        GAPA(C0 = ATT_MFMA(kf[2], qr[1], C0), P0[10], P0[11], P0[12], P0[13], pw1[0] = PKW(P0, 8), pw1[1] = PKW(P0, 10), pw1); \
        GAPA(C1 = ATT_MFMA(kf[3], qr[1], C1), P0[14], P0[15], P1[0], P1[1],   pw1[2] = PKW(P0, 12), pw1[3] = PKW(P0, 14), pw1); \
        GAPA(C0 = ATT_MFMA(kf[4], qr[2], C0), P1[2], P1[3], P1[4], P1[5],     pw2[0] = PKW(P1, 0), pw2[1] = PKW(P1, 2), pw2); \
        GAPA(C1 = ATT_MFMA(kf[5], qr[2], C1), P1[6], P1[7], P1[8], P1[9],     pw2[2] = PKW(P1, 4), pw2[3] = PKW(P1, 6), pw2); \
        GAPA(C0 = ATT_MFMA(kf[6], qr[3], C0), P1[10], P1[11], P1[12], P1[13], pw3[0] = PKW(P1, 8), pw3[1] = PKW(P1, 10), pw3); \
        VRD(0, 0, vp_); SBAR(); \
        GAPA(C1 = ATT_MFMA(kf[7], qr[3], C1), P1[14], P1[15], 0.f, 0.f,       pw3[2] = PKW(P1, 12), pw3[3] = PKW(P1, 14), pw3); \
        l_reg += sacc; } while (0)
#define GAPB(i, j, jn, X, XB, DOEX, GL, vp_, kp_, N0, N1, DOSP) do { if ((i) + 1 < 16) { VRD(jn, (i) + 1, vp_); } \
        if ((GL) && ((i) & 1)) { KLD((i) >> 1, kp_); } SBAR(); \
        o[(i) & 3] = ATT_MFMA(PAF_SEL((i) >> 2), VFR(j), o[(i) & 3]); \
        if (DOEX) { X[XB] = EX(X[XB]); X[XB + 1] = EX(X[XB + 1]); PIN(X); } \
        if (DOSP) { N0[(i)] = cfar; N1[(i)] = cfar; } SBAR(); } while (0)
#define PAF_SEL(k) ((k) == 0 ? PAF(0) : (k) == 1 ? PAF(1) : (k) == 2 ? PAF(2) : PAF(3))
#define PHASE_B(C0, C1, DOEX, GL, vp_, kp_, N0, N1, DOSP) do { \
        GAPB(0, 0, 1, C0, 0, DOEX, GL, vp_, kp_, N0, N1, DOSP); GAPB(1, 1, 0, C0, 2, DOEX, GL, vp_, kp_, N0, N1, DOSP); GAPB(2, 0, 1, C0, 4, DOEX, GL, vp_, kp_, N0, N1, DOSP); GAPB(3, 1, 0, C0, 6, DOEX, GL, vp_, kp_, N0, N1, DOSP); \
        GAPB(4, 0, 1, C0, 8, DOEX, GL, vp_, kp_, N0, N1, DOSP); GAPB(5, 1, 0, C0, 10, DOEX, GL, vp_, kp_, N0, N1, DOSP); GAPB(6, 0, 1, C0, 12, DOEX, GL, vp_, kp_, N0, N1, DOSP); GAPB(7, 1, 0, C0, 14, DOEX, GL, vp_, kp_, N0, N1, DOSP); \
        GAPB(8, 0, 1, C1, 0, DOEX, GL, vp_, kp_, N0, N1, DOSP); GAPB(9, 1, 0, C1, 2, DOEX, GL, vp_, kp_, N0, N1, DOSP); GAPB(10, 0, 1, C1, 4, DOEX, GL, vp_, kp_, N0, N1, DOSP); GAPB(11, 1, 0, C1, 6, DOEX, GL, vp_, kp_, N0, N1, DOSP); \
        GAPB(12, 0, 1, C1, 8, DOEX, GL, vp_, kp_, N0, N1, DOSP); GAPB(13, 1, 0, C1, 10, DOEX, GL, vp_, kp_, N0, N1, DOSP); GAPB(14, 0, 1, C1, 12, DOEX, GL, vp_, kp_, N0, N1, DOSP); GAPB(15, 1, 0, C1, 14, DOEX, GL, vp_, kp_, N0, N1, DOSP); \
        } while (0)
#define KSL(t) ((((t) & 3)) * SLOT)
#define DMA_GROUP(t) do { if ((t) + 3 < NT) DMA_K((t) + 3, KSL((t) + 3)); if ((t) + 1 < NT) DMA_V((t) + 1, KSL((t) + 1)); } while (0)
#define STEP(C0, C1, P0, P1, t) do { const lds_cptr vpp = vp0 + KSL((t) - 1); const lds_cptr kpn = kp0 + KSL((t) + 1); \
        PHASE_A(C0, C1, P0, P1, vpp); \
        BANDFIX(C0, C1, t); \
        if (comp == 0) { DMA_GROUP(t); } else { ENDW(t); } \
        SBAR(); \
        PHASE_B(C0, C1, true, true, vpp, kpn, P0, P1, true); PIN(P0); PIN(P1); \
        if (comp == 0) { ENDW(t); } else { DMA_GROUP((t) + 1); } } while (0)
#define PACKSUM(P0, P1) do { float sacc = 0.f; _Pragma("unroll") for (int r = 0; r < 16; ++r) sacc += P0[r] + P1[r]; l_reg += sacc; \
        pw0 = (u32x4){PKW(P0, 0), PKW(P0, 2), PKW(P0, 4), PKW(P0, 6)}; pw1 = (u32x4){PKW(P0, 8), PKW(P0, 10), PKW(P0, 12), PKW(P0, 14)}; \
        pw2 = (u32x4){PKW(P1, 0), PKW(P1, 2), PKW(P1, 4), PKW(P1, 6)}; pw3 = (u32x4){PKW(P1, 8), PKW(P1, 10), PKW(P1, 12), PKW(P1, 14)}; } while (0)

    if (NT > 2) { ATT_WAIT_BAR(4); } else { ATT_WAIT_BAR(2); }
    if (comp != 0) { DMA_GROUP(0); }
    {
#pragma unroll
      for (int f = 0; f < 8; ++f) KLD(f, kp0);
#pragma unroll
      for (int r = 0; r < 16; ++r) { pA0[r] = cfar; pA1[r] = cfar; pB0[r] = cfar; pB1[r] = cfar; }
#pragma unroll
      for (int d0 = 0; d0 < 4; ++d0) { pA0 = ATT_MFMA(kf[2 * d0], qr[d0], pA0); pA1 = ATT_MFMA(kf[2 * d0 + 1], qr[d0], pA1); } }
    SBAR();
    BANDFIX(pA0, pA1, 0);
    if (comp == 0) { DMA_GROUP(0); } else { ENDW(0); }
    {
#pragma unroll
        for (int r = 0; r < 16; ++r) { pA0[r] = EX(pA0[r]); pA1[r] = EX(pA1[r]); }
#pragma unroll
        for (int f = 0; f < 8; ++f) KLD(f, kp0 + KSL(1));
    }
    if (comp == 0) { ENDW(0); } else { DMA_GROUP(1); }
    {
        int t = 1;
        for (; t + 2 < NT; t += 2) { STEP(pB0, pB1, pA0, pA1, t); STEP(pA0, pA1, pB0, pB1, t + 1); }
        STEP(pB0, pB1, pA0, pA1, t);
        PACKSUM(pB0, pB1);
        VRD(0, 0, vp0 + KSL(NT - 1)); SBAR();
        PHASE_B(pA0, pA1, false, false, vp0 + KSL(NT - 1), kp0, pA0, pA1, false);
    }
    float l = l_reg;
    { auto rr = __builtin_amdgcn_permlane32_swap(__float_as_uint(l), __float_as_uint(l), false, false); l = __uint_as_float(rr[0]) + __uint_as_float(rr[1]); }
    if (hi == 0) wsf[32 + r32] = l;
    float rli[16];
#pragma unroll
    for (int r = 0; r < 16; ++r) rli[r] = 1.0f / wsf[32 + crow(r, hi)];
    ATT_LBAR();
    LAS float* xch = (LAS float*)(lds + LDS_XCH) + rg * 4096;
    if (comp == 1) {
#pragma unroll
        for (int d0 = 0; d0 < 4; ++d0)
#pragma unroll
            for (int r = 0; r < 16; ++r) xch[(d0 * 16 + r) * 64 + lane] = o[d0][r] * rli[r] * lam;
    }
    ATT_LBAR();
    if (comp == 0) {
        float ss[16];
#pragma unroll
        for (int r = 0; r < 16; ++r) { float s_ = 0.f;
#pragma unroll
            for (int d0 = 0; d0 < 4; ++d0) { const float v = o[d0][r] * rli[r] - xch[(d0 * 16 + r) * 64 + lane]; o[d0][r] = v; s_ += v * v; }
            ss[r] = s_; }
#pragma unroll
        for (int r = 0; r < 16; ++r) {
            float v = ss[r]; v += pg8::dppf<0xB1>(v); v += pg8::dppf<0x4E>(v); v += pg8::dppf<0x141>(v); v += pg8::dppf<0x140>(v);
            auto sw = __builtin_amdgcn_permlane16_swap(__float_as_uint(v), __float_as_uint(v), false, false); ss[r] = __uint_as_float(sw[0]) + __uint_as_float(sw[1]); }
        LAS bf16* stg = (LAS bf16*)(lds + LDS_OST) + rg * 4096;
        float g4[4];
#pragma unroll
        for (int d0 = 0; d0 < 4; ++d0) g4[d0] = subln_g[d0 * 32 + r32];
#pragma unroll
        for (int r = 0; r < 16; ++r) { const float rs = 0.8f / sqrtf(ss[r] * (1.0f / 128.0f) + 1e-5f); const int orow = crow(r, hi);
#pragma unroll
            for (int d0 = 0; d0 < 4; ++d0) stg[orow * 128 + d0 * 32 + r32] = (bf16)f2bf(o[d0][r] * rs * g4[d0]); }
#pragma unroll
        for (int i = 0; i < 8; ++i) { const int row = i * 4 + (lane >> 4), ch = lane & 15;
            const u32x4 v = *(LAS const u32x4*)(stg + row * 128 + ch * 8);
            st16wt(O + (size_t)(qw0 + row) * 1024 + h * 128 + ch * 8, v); }
    }
    ATT_LBAR();
#undef ATT_RFL
#undef DMA_K
#undef DMA_V
#undef SBAR
#undef PIN
#undef PKW
#undef PAF
#undef EX
#undef ROT3
#undef ENDW
#undef KLD
#undef BANDFIX
#undef VRD
#undef VFR
#undef GAPA
#undef PHASE_A
#undef GAPB
#undef PAF_SEL
#undef PHASE_B
#undef STEP
#undef PACKSUM
#undef KSL
#undef DMA_GROUP
}

__device__ __forceinline__ void attn_phase(int wv, const Args& a, LAS unsigned char* lds, int blk, int G, bf16* Odst) {
    float s1 = 0.f, s2 = 0.f;
    for (int i = 0; i < 64; ++i) { s1 += a.in[I_LQ1][i] * a.in[I_LK1][i]; s2 += a.in[I_LQ2][i] * a.in[I_LK2][i]; }
    const float lam = __builtin_bit_cast(float, __builtin_amdgcn_readfirstlane(__builtin_bit_cast(int, expf(s1) - expf(s2) + 0.2f)));
    const bf16* Q = (const bf16*)(a.ws + WS_A3); const bf16* K = (const bf16*)(a.ws + WS_A4); const bf16* V = (const bf16*)(a.ws + WS_A5);
    const bool snake = (1024 % G) == 0;
    for (int j = 0;; ++j) {
        const int idx = j * G + blk; if (idx >= 1024) break;
        const int rank = (snake && (j & 1)) ? (j * G + (G - 1 - blk)) : idx;
        attn_unit_pipe(wv, rank & 7, 127 - (rank >> 3), Q, K, V, Odst, lds, lam, a.in[I_REL_BIAS], a.in[I_SUBLN_G], (const unsigned*)(a.ws + WS_KMAX));
    }
}
}


__device__ __forceinline__ void peer_convert(int wv, const Args& a, int blk, int G) {
    const int tid = opaque_tid(wv), lane = tid & 63, gw = blk * 8 + (tid >> 6);
    for (int which = 0; which < 2; ++which) {
        const float* src = a.in[which ? I_PEER_V : I_PEER_U]; unsigned* dst = (unsigned*)(a.ws + (which ? WS_PV : WS_PU));
        const size_t nchunk = (size_t)16384 * 1024 / 1024, stride = (size_t)G * 8;
        for (size_t c = gw; c < nchunk; c += 2 * stride) {
            const size_t c1 = c + stride; const bool two = c1 < nchunk;
            f32x4 v[8];
#pragma unroll
            for (int j = 0; j < 4; ++j) v[j] = __builtin_nontemporal_load((const f32x4*)(src + c * 1024 + 256 * j + 4 * lane));
            if (two) {
#pragma unroll
                for (int j = 0; j < 4; ++j) v[4 + j] = __builtin_nontemporal_load((const f32x4*)(src + c1 * 1024 + 256 * j + 4 * lane)); }
#pragma unroll
            for (int j = 0; j < 4; ++j) { const f32x4 x = v[j] * 128.0f; int w = __builtin_amdgcn_cvt_pk_fp8_f32(x[0], x[1], 0, false); w = __builtin_amdgcn_cvt_pk_fp8_f32(x[2], x[3], w, true);
                dst[c * 256 + 64 * j + lane] = (unsigned)w; }
            if (two) {
#pragma unroll
                for (int j = 0; j < 4; ++j) { const f32x4 x = v[4 + j] * 128.0f; int w = __builtin_amdgcn_cvt_pk_fp8_f32(x[0], x[1], 0, false); w = __builtin_amdgcn_cvt_pk_fp8_f32(x[2], x[3], w, true);
                    dst[c1 * 256 + 64 * j + lane] = (unsigned)w; } }
        } }
}
namespace peer {
typedef float f32x2v __attribute__((ext_vector_type(2)));
template <int CTRL> __device__ __forceinline__ float dpp(float x) { return __builtin_bit_cast(float, __builtin_amdgcn_mov_dpp(__builtin_bit_cast(int, x), CTRL, 0xf, 0xf, true)); }
template <int CTRL> __device__ __forceinline__ unsigned dppu(unsigned x) { return (unsigned)__builtin_amdgcn_mov_dpp((int)x, CTRL, 0xf, 0xf, true); }
__device__ __forceinline__ unsigned half32_umax(unsigned m) {
    unsigned t = dppu<0xB1>(m); m = t > m ? t : m; t = dppu<0x4E>(m); m = t > m ? t : m; t = dppu<0x141>(m); m = t > m ? t : m; t = dppu<0x140>(m); m = t > m ? t : m;
    auto s = __builtin_amdgcn_permlane16_swap(m, m, false, false); return s[0] > s[1] ? s[0] : s[1]; }
__device__ __forceinline__ float row16_sum(float x) { x += dpp<0xB1>(x); x += dpp<0x4E>(x); x += dpp<0x141>(x); x += dpp<0x140>(x); return x; }
__device__ __forceinline__ float wsum(float x) {
    x += dpp<0xB1>(x); x += dpp<0x4E>(x); x += dpp<0x141>(x); x += dpp<0x140>(x);
    auto s = __builtin_amdgcn_permlane16_swap(__float_as_uint(x), __float_as_uint(x), false, false); x = __uint_as_float(s[0]) + __uint_as_float(s[1]);
    auto t = __builtin_amdgcn_permlane32_swap(__float_as_uint(x), __float_as_uint(x), false, false); return __uint_as_float(t[0]) + __uint_as_float(t[1]);
}
__device__ __forceinline__ void peer_phase(int wv, const Args& a, int blk, int G, float* OUTP) {
    const int tid = opaque_tid(wv), lane = tid & 63, wave = tid >> 6, hh = lane >> 5, l32 = lane & 31;
    const unsigned* TK = (const unsigned*)(a.ws + WS_TOPK); const unsigned char* PU = (const unsigned char*)(a.ws + WS_PU); const unsigned char* PVt = (const unsigned char*)(a.ws + WS_PV);
    const float* gF = a.in[I_NORM_FFN_G]; const float* gO = a.in[I_FINAL_G];
    int ci0 = 0, cj0 = 0, ci1 = 0, cj1 = 0; bool valid1 = false;
    { int p = 0;
      for (int i = 0; i < 16; ++i) for (int j = 0; j < 16; ++j) if ((i + 1) * (j + 1) <= 16) { if (p == l32) { ci0 = i; cj0 = j; } if (p == l32 + 32) { ci1 = i; cj1 = j; valid1 = true; } ++p; } }
    for (int tok = blk * 8 + wave; tok < S; tok += G * 8) {
        const unsigned short* xrow = (const unsigned short*)(a.ws + WS_A2) + (size_t)tok * D + 16 * lane;
        f32x4 xa[4];
        { const u32x4 r0 = *(const u32x4*)xrow, r1 = *(const u32x4*)(xrow + 8);
          xa[0] = (f32x4){bflo(r0.x), bfhi(r0.x), bflo(r0.y), bfhi(r0.y)}; xa[1] = (f32x4){bflo(r0.z), bfhi(r0.z), bflo(r0.w), bfhi(r0.w)};
          xa[2] = (f32x4){bflo(r1.x), bfhi(r1.x), bflo(r1.y), bfhi(r1.y)}; xa[3] = (f32x4){bflo(r1.z), bfhi(r1.z), bflo(r1.w), bfhi(r1.w)}; }
        unsigned key[4];
#pragma unroll
        for (int i = 0; i < 4; ++i) key[i] = TK[(size_t)tok * 256 + lane + 64 * i];
        float ss = 0.f;
#pragma unroll
        for (int j = 0; j < 4; ++j) ss += (xa[j][0] * xa[j][0] + xa[j][1] * xa[j][1]) + (xa[j][2] * xa[j][2] + xa[j][3] * xa[j][3]);
        ss = wsum(ss);
        const float rstd = 1.0f / sqrtf(ss * (1.0f / D) + 1e-6f);
        float hf[16];
#pragma unroll
        for (int j = 0; j < 4; ++j) { const f32x4 gg = *(const f32x4*)(gF + 16 * lane + 4 * j);
#pragma unroll
            for (int e = 0; e < 4; ++e) hf[4 * j + e] = xa[j][e] * rstd * gg[e]; }
        int ex[4]; float gw[4];
#pragma unroll
        for (int i = 0; i < 4; ++i) {
            const unsigned k = key[i];
            const float v = pg8::ord2f(k & ~0x7Fu); const int ix = 127 - (int)(k & 0x7Fu);
            const float s0 = __shfl(v, hh * 32 + ci0) + __shfl(v, hh * 32 + 16 + cj0);
            const float s1 = __shfl(v, hh * 32 + ci1) + __shfl(v, hh * 32 + 16 + cj1);
            unsigned ck0 = (pg8::f2ord(s0) & ~0xFFu) | (unsigned)(255 - (ci0 * 16 + cj0));
            unsigned ck1 = valid1 ? ((pg8::f2ord(s1) & ~0xFFu) | (unsigned)(255 - (ci1 * 16 + cj1))) : 0u;
            unsigned win = 0u;
#pragma unroll
            for (int r = 0; r < 16; ++r) {
                const unsigned m = half32_umax(ck0 > ck1 ? ck0 : ck1);
                if (l32 == r) win = m;
                if (ck0 == m) ck0 = 0u;
                if (ck1 == m) ck1 = 0u;
            }
            const float ts = pg8::ord2f(win & ~0xFFu); const int flat = 255 - (int)(win & 0xFFu);
            const float mx = __shfl(ts, hh * 32);
            const float e = (l32 < 16) ? __expf(ts - mx) : 0.f;
            const float sum = row16_sum(e);
            gw[i] = e / sum;
            const int e0 = __shfl(ix, hh * 32 + ((flat >> 4) & 15)), e1 = __shfl(ix, hh * 32 + 16 + (flat & 15));
            ex[i] = e0 * 128 + e1;
        }
        float acc[16];
#pragma unroll
        for (int j = 0; j < 16; ++j) acc[j] = 0.f;
#pragma unroll 1
        for (int b = 0; b < 16; ++b) {
            const int i = b >> 2, sl = ((b >> 1) & 1) * 32 + (b & 1) * 8;
            const int exv = i == 0 ? ex[0] : i == 1 ? ex[1] : i == 2 ? ex[2] : ex[3];
            const float gwv = i == 0 ? gw[0] : i == 1 ? gw[1] : i == 2 ? gw[2] : gw[3];
            u32x4 uu[8], vv[8];
#pragma unroll
            for (int q = 0; q < 8; ++q) { const int eid = __builtin_amdgcn_readlane(exv, sl + q); uu[q] = *(const u32x4*)(PU + (size_t)eid * 1024 + 16 * lane); vv[q] = *(const u32x4*)(PVt + (size_t)eid * 1024 + 16 * lane); }
            float d[8];
#pragma unroll
            for (int q = 0; q < 8; ++q) { float s_ = 0.f;
#pragma unroll
                for (int e = 0; e < 4; ++e) { const f32x2v lo = __builtin_amdgcn_cvt_pk_f32_fp8((int)uu[q][e], false), hi2 = __builtin_amdgcn_cvt_pk_f32_fp8((int)uu[q][e], true);
                    s_ += (lo[0] * hf[4 * e] + lo[1] * hf[4 * e + 1]) + (hi2[0] * hf[4 * e + 2] + hi2[1] * hf[4 * e + 3]); }
                d[q] = s_; }
            float z;
            { const bool b0 = lane & 1, b1 = lane & 2, b2 = lane & 4;
              float r4[4], r2[2];
#pragma unroll
              for (int q = 0; q < 4; ++q) { const float keep = b0 ? d[q + 4] : d[q], give = b0 ? d[q] : d[q + 4]; r4[q] = keep + dpp<0xB1>(give); }
#pragma unroll
              for (int q = 0; q < 2; ++q) { const float keep = b1 ? r4[q + 2] : r4[q], give = b1 ? r4[q] : r4[q + 2]; r2[q] = keep + dpp<0x4E>(give); }
              { const float keep = b2 ? r2[1] : r2[0], give = b2 ? r2[0] : r2[1];
                const float up = dpp<0x104>(give), dn = dpp<0x114>(give);
                z = keep + (b2 ? dn : up); }
              z += dpp<0x128>(z);
              auto s16 = __builtin_amdgcn_permlane16_swap(__float_as_uint(z), __float_as_uint(z), false, false); z = __uint_as_float(s16[0]) + __uint_as_float(s16[1]);
              auto s32 = __builtin_amdgcn_permlane32_swap(__float_as_uint(z), __float_as_uint(z), false, false); z = __uint_as_float(s32[0]) + __uint_as_float(s32[1]); }
            const int myq = 4 * (lane & 1) + 2 * ((lane >> 1) & 1) + ((lane >> 2) & 1);
            const float gmine = __shfl(gwv, sl + myq);
            z *= (1.0f / 128.0f);
            const float wl = gmine * 0.5f * z * (1.0f + erff(z * 0.70710678118654752f)) * (1.0f / 128.0f);
#pragma unroll
            for (int q = 0; q < 8; ++q) { const float w = __builtin_bit_cast(float, __builtin_amdgcn_readlane(__builtin_bit_cast(int, wl), ((q >> 2) & 1) | (((q >> 1) & 1) << 1) | ((q & 1) << 2)));
#pragma unroll
                for (int e = 0; e < 4; ++e) { const f32x2v lo = __builtin_amdgcn_cvt_pk_f32_fp8((int)vv[q][e], false), hi2 = __builtin_amdgcn_cvt_pk_f32_fp8((int)vv[q][e], true);
                    acc[4 * e] += w * lo[0]; acc[4 * e + 1] += w * lo[1]; acc[4 * e + 2] += w * hi2[0]; acc[4 * e + 3] += w * hi2[1]; } }
        }
        float s3 = 0.f;
#pragma unroll
        for (int j = 0; j < 4; ++j)
#pragma unroll
            for (int e = 0; e < 4; ++e) { xa[j][e] += acc[4 * j + e]; s3 += xa[j][e] * xa[j][e]; }
        s3 = wsum(s3);
        const float r3 = 1.0f / sqrtf(s3 * (1.0f / D) + 1e-6f);
        float* orow = OUTP + (size_t)tok * D + 16 * lane;
#pragma unroll
        for (int j = 0; j < 4; ++j) { const f32x4 gg = *(const f32x4*)(gO + 16 * lane + 4 * j); *(f32x4*)(orow + 4 * j) = xa[j] * r3 * gg; }
    }
}
}

#define XB_TMO      128
#define XB_XCNT(j)  (256  + 64 * (j))
#define XB_XSUB(j)  (1280 + 64 * (j))
#define XB_XGEN(j)  (2304 + 64 * (j))
#define XB_TOP      3328
#define XB_TOPGEN   3392
#define XCD_BAR_WORDS 3456
#define XB_SPIN_CAP (1u << 18)

__device__ __forceinline__ unsigned xb_ld(unsigned* p)              { return __hip_atomic_load(p, __ATOMIC_RELAXED, __HIP_MEMORY_SCOPE_AGENT); }
__device__ __forceinline__ unsigned xb_add(unsigned* p, unsigned v) { return __hip_atomic_fetch_add(p, v, __ATOMIC_RELAXED, __HIP_MEMORY_SCOPE_AGENT); }
__device__ __forceinline__ unsigned xb_xcc_id() { return (unsigned)__builtin_amdgcn_s_getreg((3 << 11) | 20) & 0xFu; }
#define XB_SPIN(cond, bar) do { unsigned _sp = 0; while (cond) { __builtin_amdgcn_s_sleep(1); \
    if ((++_sp & 255u) == 0u) { if (xb_ld(&(bar)[XB_TMO])) break; if (_sp > XB_SPIN_CAP) { atomicAdd(&(bar)[XB_TMO], 1u); break; } } } } while (0)

struct XcdBarrier {
    unsigned* bar; unsigned x;
    volatile LAS unsigned* st;
};

__device__ __forceinline__ XcdBarrier xcd_barrier_post(unsigned* bar, volatile LAS unsigned* st, int tid) {
    XcdBarrier b; b.bar = bar; b.x = xb_xcc_id(); b.st = st;
    if (tid == 0) (void)xb_add(&bar[XB_XCNT(b.x)], 1u);
    return b;
}
__device__ __forceinline__ void xcd_barrier_complete(unsigned* bar, unsigned x, unsigned& nloc, unsigned& nx) {
    const unsigned G = gridDim.x * gridDim.y * gridDim.z;
    unsigned sum, cnt, mine, sp = 0u;
    for (;;) {
        sum = 0u; cnt = 0u; mine = 0u;
#pragma unroll
        for (unsigned j = 0; j < 16; ++j) { const unsigned c = xb_ld(&bar[XB_XCNT(j)]); sum += c; cnt += (c > 0u) ? 1u : 0u; mine = (j == x) ? c : mine; }
        if (sum == G) break;
        __builtin_amdgcn_s_sleep(1);
        if ((++sp & 255u) == 0u) { if (xb_ld(&bar[XB_TMO])) break; if (sp > XB_SPIN_CAP) { atomicAdd(&bar[XB_TMO], 1u); break; } }
    }
    nloc = mine > 0u ? mine : 1u; nx = cnt > 0u ? cnt : 1u;
}

__device__ __forceinline__ void xcd_barrier(const XcdBarrier& b, int tid) {
    asm volatile("s_waitcnt vmcnt(0)" ::: "memory");
    __syncthreads();
    if (tid == 0) {
        unsigned* bar = b.bar;
        __builtin_amdgcn_s_waitcnt(0);
        unsigned nloc = b.st[0], nx = b.st[1];
        if (nloc == 0u) { xcd_barrier_complete(bar, b.x, nloc, nx); b.st[0] = nloc; b.st[1] = nx; }
        const unsigned old = xb_add(&bar[XB_XSUB(b.x)], 1u);
        const unsigned gen = old / nloc;
        if (old + 1u == (gen + 1u) * nloc) {
            __builtin_amdgcn_fence(__ATOMIC_RELEASE, "agent");
            asm volatile("s_waitcnt vmcnt(0)" ::: "memory");
            const unsigned og = xb_add(&bar[XB_TOP], 1u);
            const unsigned tg = og / nx;
            if (og + 1u == (tg + 1u) * nx) xb_add(&bar[XB_TOPGEN], 1u);
            else XB_SPIN(xb_ld(&bar[XB_TOPGEN]) == tg, bar);
            __builtin_amdgcn_fence(__ATOMIC_ACQUIRE, "agent");
            xb_add(&bar[XB_XGEN(b.x)], 1u);
            asm volatile("s_waitcnt vmcnt(0)" ::: "memory");
        } else {
            XB_SPIN(xb_ld(&bar[XB_XGEN(b.x)]) == gen, bar);
            __builtin_amdgcn_fence(__ATOMIC_ACQUIRE, "agent");
            asm volatile("s_waitcnt vmcnt(0)" ::: "memory");
        }
    }
    __syncthreads();
}

constexpr int LDS_BYTES = 147456, LDS_MISC = 139264;
__global__ void __launch_bounds__(512, 2) mk_fwd(Args a) {
    extern __shared__ __attribute__((aligned(16))) unsigned char lds_raw[];
    LAS unsigned char* lds = (LAS unsigned char*)lds_raw;
    unsigned char* ws = a.ws;
    const int G = gridDim.x, blk = blockIdx.x, wv = __builtin_amdgcn_readfirstlane(threadIdx.x >> 6);
    { const int t0 = opaque_tid(wv); if (t0 < 16) ((volatile LAS unsigned*)(lds + LDS_MISC))[t0] = 0u; }
    __syncthreads();
    XcdBarrier bar = xcd_barrier_post((unsigned*)(ws + WS_CTL), (volatile LAS unsigned*)(lds + LDS_MISC), opaque_tid(wv));
#define IN(k) (a.ph_lo <= (k) && (k) < a.ph_hi)
#define SEAM(k) do { if (IN(k) && IN((k) + 1)) xcd_barrier(bar, opaque_tid(wv)); } while (0)
    if (IN(0)) p0_prologue(wv, a, lds, blk, G);
    SEAM(0);
    if (IN(1)) {
        pg8::Gemm g{(const bf16*)(ws + WS_A0), (const bf16*)(ws + WS_WT_IN), S, NCOLS, D, D, D}; pg8::StaticOrder So; So.init(S, NCOLS, G, blk);
        pg8::EpiProj E{(const float*)(ws + WS_RSTD0), (bf16*)(ws + WS_A1), (bf16*)(ws + WS_A2), (bf16*)(ws + WS_A3), (bf16*)(ws + WS_A4), (bf16*)(ws + WS_A5), (bf16*)(ws + WS_A6), (bf16*)a.out, 0.125f * 1.4426950408889634f, (unsigned*)(ws + WS_KMAX), (PG8_LAS float*)(lds + 131072)};
        pg8::gemm_phase<pg8::EpiProj, pg8::StaticOrder, true, true>(wv, lds, g, So, E);
    }
    SEAM(1);
    if (IN(2)) { conv_phase(wv, a, blk, G);  att::attn_phase(wv, a, lds, blk, G, (bf16*)(ws + WS_A3)); }
    SEAM(2);
    if (IN(3)) {
        pg8::StaticOrder So; So.init(S, D, G, blk);
        { pg8::Gemm g{(const bf16*)(ws + WS_A1), (const bf16*)(ws + WS_WT_CONV), S, D, 2 * D, D, D};
          const pg8::Split sp{16, (long long)WS_A3 - (long long)WS_A1 - 16 * 128, (long long)WS_WT_ATTN - (long long)WS_WT_CONV - 16 * 128};
          pg8::EpiMergeK E{(const bf16*)(ws + WS_A6), (const bf16*)a.out, (bf16*)(ws + WS_A0)};
          pg8::gemm_phase<pg8::EpiMergeK, pg8::StaticOrder, true, true, true>(wv, lds, g, So, E, sp); }
    }
    SEAM(3);
    if (IN(4)) {
        cross_fold(wv, a, blk, G);
        peer_convert(wv, a, blk, G);
        pg8::Gemm g{(const bf16*)(ws + WS_A0), (const bf16*)(ws + WS_WT_MIX), S, D, D, D, D}; pg8::StaticOrder So; So.init(S, D, G, blk);
        pg8::EpiResid E{a.in[I_X], (bf16*)(ws + WS_A2), (float*)(ws + WS_SS1)};
        pg8::gemm_phase<pg8::EpiResid, pg8::StaticOrder, true, true>(wv, lds, g, So, E);
    }
    SEAM(4);
    if (IN(5)) {
        pg8::Gemm g{(const bf16*)(ws + WS_A2), (const bf16*)(ws + WS_WQK), S, D, D, D, D}; pg8::StaticOrder So; So.init(S, D, G, blk);
        pg8::EpiSoftmaxFull E{(const float*)(ws + WS_SS1), (bf16*)(ws + WS_A1), 0.0625f * 1.4426950408889634f};
        pg8::gemm_phase<pg8::EpiSoftmaxFull, pg8::StaticOrder, false, true>(wv, lds, g, So, E);
    }
    SEAM(5);
    if (IN(6)) {
        pg8::Gemm g{(const bf16*)(ws + WS_A1), (const bf16*)(ws + WS_VW), S, D, D, D, D}; pg8::StaticOrder So; So.init(S, D, G, blk);
        pg8::EpiResidB E{(bf16*)(ws + WS_A2), (float*)(ws + WS_SS2)};
        pg8::gemm_phase<pg8::EpiResidB, pg8::StaticOrder, true, true>(wv, lds, g, So, E);
    }
    SEAM(6);
    if (IN(7)) {
        pg8::StaticOrder So; So.init(S, 2048, G, blk);
        unsigned* KS = (unsigned*)(ws + WS_KS) + (size_t)blk * 65536;
        for (int i = 0;; ++i) { pg8::Unit u; if (!So.next(i, u)) break;
            { pg8::Gemm g{(const bf16*)(ws + WS_A2), (const bf16*)(ws + WS_WT_PQ), S, 2048, D, D, D}; pg8::OneUnit S1{u.pm, u.pn};
              pg8::EpiKeys E{(const float*)(ws + WS_SS2), KS};
              pg8::gemm_phase<pg8::EpiKeys, pg8::OneUnit, false, true>(wv, lds, g, S1, E); }
            pg8::topk_from_keys(opaque_tid(wv), KS, (unsigned*)(ws + WS_TOPK), u.pm * 256, u.pn);
            asm volatile("s_waitcnt vmcnt(0)" ::: "memory"); __syncthreads(); }
    }
    SEAM(7);
    if (IN(8)) peer::peer_phase(wv, a, blk, G, a.out);
#undef IN
#undef SEAM
}

extern "C" void kernel_launch(void* const* d_in, const int* in_sizes, int n_in, void* d_out, int out_size, void* d_ws, size_t ws_size, hipStream_t stream) {
    static int grid = 0;
    if (grid == 0) {
        if (ws_size < WS_END || n_in != 25 || out_size != S * D) { fprintf(stderr, "kernel_launch: unexpected ws_size %zu / n_in %d / out_size %d\n", ws_size, n_in, out_size); grid = -1; return; }
        if (hipFuncSetAttribute((const void*)mk_fwd, hipFuncAttributeMaxDynamicSharedMemorySize, LDS_BYTES) != hipSuccess) { fprintf(stderr, "kernel_launch: hipFuncSetAttribute failed\n"); grid = -1; return; }
        int dev = 0, cus = 0, per_cu = 0;
        if (hipGetDevice(&dev) != hipSuccess || hipDeviceGetAttribute(&cus, hipDeviceAttributeMultiprocessorCount, dev) != hipSuccess) { grid = -1; return; }
        if (hipOccupancyMaxActiveBlocksPerMultiprocessor(&per_cu, (const void*)mk_fwd, 512, LDS_BYTES) != hipSuccess || per_cu < 1) { fprintf(stderr, "kernel_launch: occupancy query says %d blocks per CU\n", per_cu); grid = -1; return; }
        grid = cus;
    }
    if (grid < 0) return;
    Args a{};
    for (int i = 0; i < 25; ++i) a.in[i] = (const float*)d_in[i];
    a.out = (float*)d_out; a.ws = (unsigned char*)d_ws; a.ph_lo = 0; a.ph_hi = 9;
    if (hipMemsetAsync(d_ws, 0, 65536, stream) != hipSuccess) { fprintf(stderr, "kernel_launch: hipMemsetAsync failed\n"); return; }
    void* kargs[] = {&a};
    hipError_t e = hipLaunchCooperativeKernel((const void*)mk_fwd, dim3(grid), dim3(512), kargs, LDS_BYTES, stream);
    if (e != hipSuccess) fprintf(stderr, "kernel_launch: cooperative launch failed: %s (grid %d)\n", hipGetErrorString(e), grid);
}
```

```cpp
#include <hip/hip_runtime.h>
#include <math.h>
#include <cstdio>
#include <cstdint>
namespace pg8 {
#define PG8_LAS __attribute__((address_space(3)))
typedef unsigned short bf16_t;
typedef short bf16x8 __attribute__((ext_vector_type(8)));
typedef float f32x4 __attribute__((ext_vector_type(4)));
typedef unsigned u32x4 __attribute__((ext_vector_type(4)));
constexpr int BM = 256, BK = 64, HALF = 128, HTB = HALF * BK * 2  , STAGE_BYTES = 8 * HTB, NXCD = 8, WGM = 8;

__host__ __device__ __forceinline__ int lds_byte(int r, int c) { const int st = (r >> 4) * 2 + (c >> 5), rr = r & 15, cc = c & 31, ob = rr * 64 + cc * 2; return st * 1024 + (ob ^ (((ob >> 9) & 1) << 5)); }
__host__ __device__ __forceinline__ void stage_rc(int b, int& R, int& C) { const int st = b / 1024, sb = b % 1024, swz = sb ^ (((sb >> 9) & 1) << 5); R = (st >> 1) * 16 + swz / 64; C = (st & 1) * 32 + (swz % 64) / 2; }
__host__ __device__ __forceinline__ int perm32(int rho) { const int n = rho >> 4, i = rho & 15; return 8 * (i >> 2) + 4 * n + (i & 3); }

struct Unit { int pm, pn; };
struct Gemm { const bf16_t* A; const bf16_t* Bt; int M, N, K, lda, ldb; };
struct Split { int ksplit; long long dA2, dB2; };

struct StaticOrder {
    int nM, nN, nwg, G, c;
    __host__ __device__ void init(int M, int N, int G_, int c_) { nM = M / BM; nN = N / BM; nwg = nM * nN; G = G_; c = c_; }
    __host__ __device__ bool next(int i, Unit& u) const {
        const long L = (long)i * G + c; if (L >= nwg) return false;
        int wgid = (int)L; { const int q = nwg / NXCD, r = nwg % NXCD, xcd = wgid % NXCD, off = wgid / NXCD; wgid = (xcd < r ? xcd * (q + 1) : r * (q + 1) + (xcd - r) * q) + off; }
        const int nig = WGM * nN, gid = wgid / nig, fm = gid * WGM, gsz = (nM - fm) < WGM ? (nM - fm) : WGM;
        u.pm = fm + ((wgid % nig) % gsz); u.pn = (wgid % nig) / gsz; return true;
    }
    __device__ __forceinline__ void a_ready(const Unit&) const {}
    __device__ __forceinline__ void done(const Unit&) const {}
};

typedef float f32x2 __attribute__((ext_vector_type(2)));
typedef __bf16 bf16x2v __attribute__((ext_vector_type(2)));
__device__ __forceinline__ unsigned cvt_pk_bf16(float lo, float hi) { const f32x2 v = {lo, hi}; const bf16x2v b = __builtin_convertvector(v, bf16x2v); return __builtin_bit_cast(unsigned, b); }
template <class E, class = void> struct HasPrefetch { static constexpr bool value = false; };
template <class E> struct HasPrefetch<E, decltype((void)&E::prefetch)> { static constexpr bool value = true; };
template <class Epi, class Sched, bool ALIGN_EPI = false, bool SP2 = false, bool SPLIT = false>
__device__ __forceinline__ void gemm_phase(int wv, PG8_LAS unsigned char* lds, const Gemm g, const Sched& S, const Epi& E, const Split sp = Split{0, 0, 0}) {
    int tid_; asm volatile("v_mbcnt_lo_u32_b32 %0, -1, 0\n\tv_mbcnt_hi_u32_b32 %0, -1, %0" : "=v"(tid_)); tid_ += wv * 64;
    const int tid = tid_, wid = __builtin_amdgcn_readfirstlane(tid >> 6), lane = tid & 63, wr = wid >> 2, wc = wid & 3, fr = lane & 15, fq = lane >> 4;
    const int K = g.K, nt = K / BK;
    unsigned voffA[2], voffB[2];
#pragma unroll
    for (int i = 0; i < 2; ++i) { int R, C; stage_rc(tid * 16 + i * 8192, R, C); const int Rb = Epi::PERM ? ((R & ~31) + perm32(R & 31)) : R;
        voffA[i] = (unsigned)(R * g.lda + C) * 2u; voffB[i] = (unsigned)(Rb * g.ldb + C) * 2u; }
    const size_t kstep = (size_t)(BK * 2);
    const size_t hstepA = (size_t)HALF * g.lda * 2, hstepB = (size_t)HALF * g.ldb * 2;
    const size_t tstepA = 2 * hstepA, tstepB = 2 * hstepB;
    const unsigned ldsw = (unsigned)wid * 1024u;
    const int aoff = lds_byte(wr * 64 + fr, fq * 8), boff = lds_byte(wc * 32 + fr, fq * 8);
#define PG8_SA(b, h) (((b) * 2 + (h)) * HTB)
#define PG8_SB(b, h) ((4 + (b) * 2 + (h)) * HTB)
#define PG8_STAGE(bufoff, gbase, voff) do { _Pragma("unroll") for (int _i = 0; _i < 2; ++_i) \
        __builtin_amdgcn_global_load_lds((const unsigned*)((const char*)(gbase) + (voff)[_i]), (PG8_LAS unsigned*)(lds + (bufoff) + ldsw + _i * 8192), 16, 0, 0); } while (0)
#define PG8_LDA(dst, b, h) do { _Pragma("unroll") for (int m = 0; m < 4; ++m) _Pragma("unroll") for (int k = 0; k < 2; ++k) dst[m][k] = *(const PG8_LAS bf16x8*)(lds + PG8_SA(b, h) + aoff + m * 2048 + k * 1024); } while (0)
#define PG8_LDB(dst, b, h) do { _Pragma("unroll") for (int n = 0; n < 2; ++n) _Pragma("unroll") for (int k = 0; k < 2; ++k) dst[n][k] = *(const PG8_LAS bf16x8*)(lds + PG8_SB(b, h) + boff + n * 2048 + k * 1024); } while (0)
#define PG8_MMA(ai, bj, At, Bt) do { __builtin_amdgcn_s_setprio(1); _Pragma("unroll") for (int m = 0; m < 4; ++m) _Pragma("unroll") for (int n = 0; n < 2; ++n) _Pragma("unroll") for (int k = 0; k < 2; ++k) \
        acc[ai][bj][m][n] = __builtin_amdgcn_mfma_f32_16x16x32_bf16(Bt[n][k], At[m][k], acc[ai][bj][m][n], 0, 0, 0); __builtin_amdgcn_s_setprio(0); } while (0)
#define PG8_WAIT_V(n) asm volatile("s_waitcnt vmcnt(" #n ")" ::: "memory")
#define PG8_WAIT_L(n) asm volatile("s_waitcnt lgkmcnt(" #n ")" ::: "memory")
#define PG8_BAR __builtin_amdgcn_s_barrier()
#define PG8_SCHED __builtin_amdgcn_sched_barrier(0)
    Unit cur, nxt; int ui = 0;
    if (!S.next(0, cur)) return;
    f32x4 acc[2][2][4][2];
#pragma unroll
    for (int a = 0; a < 2; ++a)
#pragma unroll
        for (int b = 0; b < 2; ++b)
#pragma unroll
            for (int m = 0; m < 4; ++m)
#pragma unroll
                for (int n = 0; n < 2; ++n) acc[a][b][m][n] = (f32x4){0.f, 0.f, 0.f, 0.f};
    bf16x8 At[4][2], B0[2][2], B1[2][2];
    const char* cA = (const char*)g.A + (size_t)cur.pm * tstepA; const char* cB = (const char*)g.Bt + (size_t)cur.pn * tstepB;
    S.a_ready(cur);
    if constexpr (HasPrefetch<Epi>::value) E.prefetch(cur, lds, wid);
    if constexpr (SP2) {
        PG8_STAGE(PG8_SB(0, 0), cB, voffB); PG8_STAGE(PG8_SB(0, 1), cB + hstepB, voffB); PG8_STAGE(PG8_SA(0, 0), cA, voffA); PG8_STAGE(PG8_SA(0, 1), cA + hstepA, voffA);
        if (wr == 1) PG8_BAR;
        PG8_WAIT_V(2); PG8_BAR;
        PG8_STAGE(PG8_SB(1, 0), cB + kstep, voffB); PG8_STAGE(PG8_SA(1, 0), cA + kstep, voffA); PG8_STAGE(PG8_SB(1, 1), cB + hstepB + kstep, voffB);
        PG8_WAIT_V(6); PG8_BAR;
    } else {
        PG8_STAGE(PG8_SB(0, 0), cB, voffB); PG8_STAGE(PG8_SA(0, 0), cA, voffA); PG8_STAGE(PG8_SB(0, 1), cB + hstepB, voffB); PG8_STAGE(PG8_SA(0, 1), cA + hstepA, voffA);
        if (wr == 1) PG8_BAR;
        PG8_WAIT_V(4); PG8_BAR;
        PG8_STAGE(PG8_SB(1, 0), cB + kstep, voffB); PG8_STAGE(PG8_SA(1, 0), cA + kstep, voffA); PG8_STAGE(PG8_SB(1, 1), cB + hstepB + kstep, voffB);
        PG8_WAIT_V(6); PG8_BAR;
    }
    for (;;) {
        const bool has_next = S.next(ui + 1, nxt);
        const char* nA = has_next ? (const char*)g.A + (size_t)nxt.pm * tstepA : cA; const char* nB = has_next ? (const char*)g.Bt + (size_t)nxt.pn * tstepB : cB;
        for (int t = 0; t < nt; t += 2) {
            const bool last = (t == nt - 2);
            long long oa1 = 0, oa2 = 0, ob2 = 0;
            if constexpr (SPLIT) { if (t == sp.ksplit) E.mid(acc, cur, wr, wc, fr, fq);
                if (t >= sp.ksplit) oa1 = sp.dA2; if (t + 2 >= sp.ksplit) { oa2 = sp.dA2; ob2 = sp.dB2; } }
            const char* a1 = cA + (size_t)(t + 1) * kstep + oa1;
            const char* a2 = last ? nA : cA + (size_t)(t + 2) * kstep + oa2; const char* b2 = last ? nB : cB + (size_t)(t + 2) * kstep + ob2;
            const char* a3 = a2 + kstep; const char* b3 = b2 + kstep;
            if (last && has_next) S.a_ready(nxt);
            if constexpr (SP2) {
            PG8_LDB(B0, 0, 0); PG8_LDB(B1, 0, 1); PG8_SCHED; PG8_LDA(At, 0, 0); PG8_STAGE(PG8_SA(1, 1), a1 + hstepA, voffA);
            PG8_WAIT_V(8); PG8_WAIT_L(0); PG8_BAR; PG8_MMA(0, 0, At, B0); PG8_MMA(0, 1, At, B1); PG8_BAR; PG8_SCHED;
            PG8_LDA(At, 0, 1); PG8_STAGE(PG8_SB(0, 0), b2, voffB); PG8_STAGE(PG8_SB(0, 1), b2 + hstepB, voffB); PG8_STAGE(PG8_SA(0, 0), a2, voffA);
            PG8_WAIT_V(8); PG8_WAIT_L(0); PG8_BAR; PG8_MMA(1, 0, At, B0); PG8_MMA(1, 1, At, B1); PG8_BAR; PG8_SCHED;
            PG8_LDB(B0, 1, 0); PG8_LDB(B1, 1, 1); PG8_SCHED; PG8_LDA(At, 1, 0); PG8_STAGE(PG8_SA(0, 1), a2 + hstepA, voffA);
            PG8_WAIT_V(8); PG8_WAIT_L(0); PG8_BAR; PG8_MMA(0, 0, At, B0); PG8_MMA(0, 1, At, B1); PG8_BAR; PG8_SCHED;
            PG8_LDA(At, 1, 1); PG8_STAGE(PG8_SB(1, 0), b3, voffB); PG8_STAGE(PG8_SB(1, 1), b3 + hstepB, voffB); PG8_STAGE(PG8_SA(1, 0), a3, voffA);
            PG8_WAIT_V(8); PG8_WAIT_L(0); PG8_BAR; PG8_MMA(1, 0, At, B0); PG8_MMA(1, 1, At, B1); PG8_BAR; PG8_SCHED;
            } else {
            PG8_LDB(B0, 0, 0); PG8_SCHED; PG8_LDA(At, 0, 0); PG8_STAGE(PG8_SA(1, 1), a1 + hstepA, voffA);
            PG8_WAIT_L(8); PG8_BAR; PG8_WAIT_L(0); PG8_MMA(0, 0, At, B0); PG8_BAR; PG8_SCHED;
            PG8_LDB(B1, 0, 1); PG8_STAGE(PG8_SB(0, 0), b2, voffB);
            PG8_BAR; PG8_WAIT_L(0); PG8_MMA(0, 1, At, B1); PG8_BAR;
            PG8_LDA(At, 0, 1); PG8_STAGE(PG8_SA(0, 0), a2, voffA);
            PG8_BAR; PG8_WAIT_L(0); PG8_MMA(1, 0, At, B0); PG8_BAR; PG8_SCHED;
            PG8_STAGE(PG8_SB(0, 1), b2 + hstepB, voffB);
            PG8_WAIT_V(6); PG8_BAR; PG8_MMA(1, 1, At, B1); PG8_BAR;
            PG8_LDB(B0, 1, 0); PG8_SCHED; PG8_LDA(At, 1, 0); PG8_STAGE(PG8_SA(0, 1), a2 + hstepA, voffA);
            PG8_WAIT_L(8); PG8_BAR; PG8_WAIT_L(0); PG8_MMA(0, 0, At, B0); PG8_BAR; PG8_SCHED;
            PG8_LDB(B1, 1, 1); PG8_STAGE(PG8_SB(1, 0), b3, voffB);
            PG8_BAR; PG8_WAIT_L(0); PG8_MMA(0, 1, At, B1); PG8_BAR;
            PG8_LDA(At, 1, 1); PG8_STAGE(PG8_SA(1, 0), a3, voffA);
            PG8_BAR; PG8_WAIT_L(0); PG8_MMA(1, 0, At, B0); PG8_BAR; PG8_SCHED;
            PG8_STAGE(PG8_SB(1, 1), b3 + hstepB, voffB);
            PG8_WAIT_V(6); PG8_BAR; PG8_MMA(1, 1, At, B1); PG8_BAR;
            }
        }
        if constexpr (ALIGN_EPI) { if (wr == 0) PG8_BAR; }
        if constexpr (!Epi::AFTER_DRAIN) { E(acc, cur, wr, wc, fr, fq); S.done(cur); }
        if (!has_next) break;
#pragma unroll
        for (int a = 0; a < 2; ++a)
#pragma unroll
            for (int b = 0; b < 2; ++b)
#pragma unroll
                for (int m = 0; m < 4; ++m)
#pragma unroll
                    for (int n = 0; n < 2; ++n) acc[a][b][m][n] = (f32x4){0.f, 0.f, 0.f, 0.f};
        cur = nxt; cA = nA; cB = nB; ++ui;
        if constexpr (HasPrefetch<Epi>::value) E.prefetch(cur, lds, wid);
        if constexpr (ALIGN_EPI) { if (wr == 1) PG8_BAR; }
    }
    PG8_WAIT_V(0);
    if constexpr (!ALIGN_EPI) { if (wr == 0) PG8_BAR; }
    PG8_BAR;
    if constexpr (Epi::AFTER_DRAIN) { E.fused(acc, cur, wr, wc, fr, fq, lds, wid, lane); S.done(cur); }
#undef PG8_SA
#undef PG8_SB
#undef PG8_STAGE
#undef PG8_LDA
#undef PG8_LDB
#undef PG8_MMA
#undef PG8_WAIT_V
#undef PG8_WAIT_L
#undef PG8_BAR
#undef PG8_SCHED
}
}


constexpr int S = 16384, D = 1024, NCOLS = 8192, MEMN = 256;
typedef unsigned short bf16;
typedef float f32x4 __attribute__((ext_vector_type(4)));
typedef unsigned u32x4 __attribute__((ext_vector_type(4)));
typedef unsigned u32x2 __attribute__((ext_vector_type(2)));
__device__ __forceinline__ void st16wt(void* p, u32x4 v) { asm volatile("global_store_dwordx4 %0, %1, off sc1\n\ts_nop 1" :: "v"(p), "v"(v) : "memory"); }
#define LAS __attribute__((address_space(3)))

__device__ const unsigned char T5_BUCKET[128] = {0, 1, 2, 3, 4, 5, 6, 7, 8, 9, 10, 11, 12, 13, 14, 15, 16, 16, 16, 17, 17, 18, 18, 18, 19, 19, 19, 20, 20, 20, 20, 21, 21, 21, 21, 22, 22, 22, 22, 22, 23, 23, 23, 23, 23, 23, 24, 24, 24, 24, 24, 24, 25, 25, 25, 25, 25, 25, 25, 26, 26, 26, 26, 26, 26, 26, 26, 27, 27, 27, 27, 27, 27, 27, 27, 27, 27, 28, 28, 28, 28, 28, 28, 28, 28, 28, 28, 29, 29, 29, 29, 29, 29, 29, 29, 29, 29, 29, 29, 30, 30, 30, 30, 30, 30, 30, 30, 30, 30, 30, 30, 30, 30, 31, 31, 31, 31, 31, 31, 31, 31, 31, 31, 31, 31, 31, 31, 31};

constexpr size_t MiB = 1u << 20;
constexpr size_t WS_CTL = 0, WS_KMAX = 32768  , WS_RSTD0 = 512 * 1024;
constexpr size_t WS_WT_IN = 1 * MiB, WS_WT_CONV = 17 * MiB, WS_WT_ATTN = 19 * MiB, WS_WT_MIX = 21 * MiB, WS_WT_CQ = 23 * MiB, WS_WT_CO = 25 * MiB, WS_WT_PQ = 27 * MiB;
constexpr size_t WS_SUBK = 31 * MiB, WS_KV = 32 * MiB, WS_SS1 = 34 * MiB, WS_SS2 = 35 * MiB;
constexpr size_t WS_TOPK = 36 * MiB  , WS_PU = 196 * MiB  , WS_PV = 228 * MiB  ;
constexpr size_t WS_WQK = 23 * MiB  , WS_VW = 212 * MiB  ;
constexpr size_t WS_BTAB = 640 * 1024  ;
constexpr size_t WS_PQS = 52 * MiB  , WS_KS = 132 * MiB  ;
constexpr size_t WS_A0 = 36 * MiB, WS_A1 = 68 * MiB, WS_A2 = 100 * MiB, WS_A3 = 132 * MiB, WS_A4 = 164 * MiB, WS_A5 = 196 * MiB, WS_A6 = 228 * MiB, WS_END = 260 * MiB;

__device__ __forceinline__ float wave_sum(float v) {
#pragma unroll
    for (int o = 1; o < 64; o <<= 1) v += __shfl_xor(v, o);
    return v;
}
__device__ __forceinline__ float wave_max(float v) {
#pragma unroll
    for (int o = 1; o < 64; o <<= 1) v = fmaxf(v, __shfl_xor(v, o));
    return v;
}
__device__ __forceinline__ int opaque_tid(int wv) { int t; asm volatile("v_mbcnt_lo_u32_b32 %0, -1, 0\n\tv_mbcnt_hi_u32_b32 %0, -1, %0" : "=v"(t)); return t + wv * 64; }
__device__ __forceinline__ unsigned f2bf(float f) { unsigned u = __builtin_bit_cast(unsigned, f); return (u + 0x7fffu + ((u >> 16) & 1u)) >> 16; }
__device__ __forceinline__ unsigned pk2(float lo, float hi) { return pg8::cvt_pk_bf16(lo, hi); }
__device__ __forceinline__ float bflo(unsigned w) { return __builtin_bit_cast(float, w << 16); }
__device__ __forceinline__ float bfhi(unsigned w) { return __builtin_bit_cast(float, w & 0xffff0000u); }
__device__ __forceinline__ float sigmoidf_(float x) { return __builtin_amdgcn_rcpf(1.0f + __builtin_amdgcn_exp2f(x * -1.4426950408889634f)); }

struct Args { const float* in[25]; float* out; unsigned char* ws; int ph_lo, ph_hi; };
enum { I_X = 0, I_MEM, I_NORM_MIX_G, I_W_IN, I_CONV_W, I_W_CONV_OUT, I_LQ1, I_LK1, I_LQ2, I_LK2, I_SUBLN_G, I_W_ATTN_OUT, I_W_MIX_OUT, I_REL_BIAS, I_NORM_CROSS_G, I_NORM_MEM_G,
       I_W_CQ, I_W_CKV, I_W_CO, I_NORM_FFN_G, I_W_PQ, I_SUB_KEYS, I_PEER_U, I_PEER_V, I_FINAL_G };

namespace pg8 {
template <int CTRL> __device__ __forceinline__ float dppf(float x) { return __builtin_bit_cast(float, __builtin_amdgcn_mov_dpp(__builtin_bit_cast(int, x), CTRL, 0xf, 0xf, true)); }
__device__ __forceinline__ float row16_max(float v) { v = fmaxf(v, dppf<0xB1>(v)); v = fmaxf(v, dppf<0x4E>(v)); v = fmaxf(v, dppf<0x141>(v)); return fmaxf(v, dppf<0x140>(v)); }
__device__ __forceinline__ float xrow16_max(float x) {
    auto s = __builtin_amdgcn_permlane16_swap(__float_as_uint(x), __float_as_uint(x), false, false); x = fmaxf(__uint_as_float(s[0]), __uint_as_float(s[1]));
    auto t = __builtin_amdgcn_permlane32_swap(__float_as_uint(x), __float_as_uint(x), false, false); return fmaxf(__uint_as_float(t[0]), __uint_as_float(t[1])); }
__device__ __forceinline__ float xrow16_sum(float x) {
    auto s = __builtin_amdgcn_permlane16_swap(__float_as_uint(x), __float_as_uint(x), false, false); x = __uint_as_float(s[0]) + __uint_as_float(s[1]);
    auto t = __builtin_amdgcn_permlane32_swap(__float_as_uint(x), __float_as_uint(x), false, false); return __uint_as_float(t[0]) + __uint_as_float(t[1]); }
__device__ __forceinline__ u32x4 pack8(const f32x4& v0, const f32x4& v1) { u32x4 w; w.x = cvt_pk_bf16(v0[0], v0[1]); w.y = cvt_pk_bf16(v0[2], v0[3]); w.z = cvt_pk_bf16(v1[0], v1[1]); w.w = cvt_pk_bf16(v1[2], v1[3]); return w; }
struct EpiProj {
    static constexpr bool PERM = true, AFTER_DRAIN = false;
    const float* rstd_g; bf16_t *CB, *U, *Q, *K, *V, *SGC, *SGA; float qscale; unsigned* KMAX; PG8_LAS float* rl;
    __device__ __forceinline__ void prefetch(const Unit& u, PG8_LAS unsigned char* lds, int wid) const {
        if (wid == 0) { int ln; asm volatile("v_mbcnt_lo_u32_b32 %0, -1, 0\n\tv_mbcnt_hi_u32_b32 %0, -1, %0" : "=v"(ln));
            __builtin_amdgcn_global_load_lds((const unsigned*)(rstd_g + u.pm * BM + ln * 4), (PG8_LAS unsigned*)rl, 16, 0, 0); }
    }
    __device__ __forceinline__ void operator()(const f32x4 (&acc)[2][2][4][2], const Unit& u, int wr, int wc, int fr0, int fq) const {
        int fr = fr0; asm volatile("" : "+v"(fr));
        const int row0 = u.pm * BM + wr * 64 + fr, pn = u.pn, colw = wc * 32 + 8 * fq;
        const PG8_LAS float* rstd = rl - u.pm * BM;
        if (pn >= 4 && pn < 12) {
            const int col = 128 * (pn - 4) + colw;
#pragma unroll
            for (int ai = 0; ai < 2; ++ai)
#pragma unroll
                for (int m = 0; m < 4; ++m) { const int row = row0 + ai * HALF + m * 16; const float rs = rstd[row], r2 = rs * rs;
                    const f32x4 v0 = acc[ai][0][m][0] * acc[ai][1][m][0] * r2, v1 = acc[ai][0][m][1] * acc[ai][1][m][1] * r2;
                    *(u32x4*)(U + (size_t)row * 1024 + col) = pack8(v0, v1); }
            return;
        }
        bf16_t* base; int cbase; float sc = 1.f; bool gate = false;
        if (pn < 4) { base = CB; cbase = pn * 256; }
        else if (pn < 16) { base = Q; cbase = (pn - 12) * 256; sc = qscale; }
        else if (pn < 20) { base = K; cbase = (pn - 16) * 256; }
        else if (pn < 24) { base = V; cbase = (pn - 20) * 256; }
        else if (pn < 28) { base = SGC; cbase = (pn - 24) * 256; gate = true; }
        else { base = SGA; cbase = (pn - 28) * 256; gate = true; }
#pragma unroll
        for (int ai = 0; ai < 2; ++ai)
#pragma unroll
            for (int m = 0; m < 4; ++m) { const int row = row0 + ai * HALF + m * 16; const float rs = rstd[row] * sc;
#pragma unroll
                for (int bj = 0; bj < 2; ++bj) { f32x4 v0 = acc[ai][bj][m][0] * rs, v1 = acc[ai][bj][m][1] * rs;
                    if (gate) {
#pragma unroll
                        for (int e = 0; e < 4; ++e) { v0[e] = sigmoidf_(v0[e]); v1[e] = sigmoidf_(v1[e]); } }
                    *(u32x4*)(base + (size_t)row * 1024 + cbase + bj * HALF + colw) = pack8(v0, v1); } }
        if (pn >= 16 && pn < 20) {
            float mx[2] = {0.f, 0.f};
#pragma unroll
            for (int ai = 0; ai < 2; ++ai)
#pragma unroll
                for (int m = 0; m < 4; ++m) { const float rs = rstd[row0 + ai * HALF + m * 16];
#pragma unroll
                    for (int bj = 0; bj < 2; ++bj) { const f32x4 v0 = acc[ai][bj][m][0] * rs, v1 = acc[ai][bj][m][1] * rs;
                        const float s = xrow16_sum(((v0[0] * v0[0] + v0[1] * v0[1]) + (v0[2] * v0[2] + v0[3] * v0[3])) + ((v1[0] * v1[0] + v1[1] * v1[1]) + (v1[2] * v1[2] + v1[3] * v1[3])));
                        mx[bj] = fmaxf(mx[bj], s); } }
#pragma unroll
            for (int bj = 0; bj < 2; ++bj) { float v = mx[bj];
                v = row16_max(v);
                if (fr == 0 && fq == 0) atomicMax(KMAX + (((pn - 16) * 2 + bj) * 2 + (wc >> 1)) * 2 + (wc & 1), __float_as_uint(v)); }
        }
    }
};
struct EpiGateT {
    static constexpr bool PERM = true, AFTER_DRAIN = false;
    const bf16_t* SG; float* T;
    __device__ __forceinline__ void operator()(const f32x4 (&acc)[2][2][4][2], const Unit& u, int wr, int wc, int fr0, int fq) const {
        int fr = fr0; asm volatile("" : "+v"(fr));
        const int row0 = u.pm * BM + wr * 64 + fr, col0 = u.pn * BM + wc * 32 + 8 * fq;
#pragma unroll
        for (int ai = 0; ai < 2; ++ai)
#pragma unroll
            for (int m = 0; m < 4; ++m) { const size_t off = (size_t)(row0 + ai * HALF + m * 16) * 1024 + col0;
#pragma unroll
                for (int bj = 0; bj < 2; ++bj) { const u32x4 g = *(const u32x4*)(SG + off + bj * HALF);
                    f32x4 g0 = {bflo(g.x), bfhi(g.x), bflo(g.y), bfhi(g.y)}, g1 = {bflo(g.z), bfhi(g.z), bflo(g.w), bfhi(g.w)};
                    *(f32x4*)(T + off + bj * HALF) = g0 * acc[ai][bj][m][0]; *(f32x4*)(T + off + bj * HALF + 4) = g1 * acc[ai][bj][m][1]; } }
    }
};
struct EpiMerge {
    static constexpr bool PERM = true, AFTER_DRAIN = false;
    const float* T; const bf16_t* SG; bf16_t* O;
    __device__ __forceinline__ void operator()(const f32x4 (&acc)[2][2][4][2], const Unit& u, int wr, int wc, int fr0, int fq) const {
        int fr = fr0; asm volatile("" : "+v"(fr));
        const int row0 = u.pm * BM + wr * 64 + fr, col0 = u.pn * BM + wc * 32 + 8 * fq;
#pragma unroll
        for (int ai = 0; ai < 2; ++ai)
#pragma unroll
            for (int m = 0; m < 4; ++m) { const size_t off = (size_t)(row0 + ai * HALF + m * 16) * 1024 + col0;
#pragma unroll
                for (int bj = 0; bj < 2; ++bj) { const u32x4 g = *(const u32x4*)(SG + off + bj * HALF);
                    f32x4 g0 = {bflo(g.x), bfhi(g.x), bflo(g.y), bfhi(g.y)}, g1 = {bflo(g.z), bfhi(g.z), bflo(g.w), bfhi(g.w)};
                    const f32x4 t0 = *(const f32x4*)(T + off + bj * HALF), t1 = *(const f32x4*)(T + off + bj * HALF + 4);
                    *(u32x4*)(O + off + bj * HALF) = pack8(t0 + g0 * acc[ai][bj][m][0], t1 + g1 * acc[ai][bj][m][1]); } }
    }
};
struct EpiMergeK {
    static constexpr bool PERM = true, AFTER_DRAIN = false;
    const bf16_t* SGc; const bf16_t* SGa; bf16_t* O;
    __device__ __forceinline__ void mid(f32x4 (&acc)[2][2][4][2], const Unit& u, int wr, int wc, int fr0, int fq) const {
        int fr = fr0; asm volatile("" : "+v"(fr));
        const int row0 = u.pm * BM + wr * 64 + fr, col0 = u.pn * BM + wc * 32 + 8 * fq;
#pragma unroll
        for (int ai = 0; ai < 2; ++ai)
#pragma unroll
            for (int m = 0; m < 4; ++m) { const size_t off = (size_t)(row0 + ai * HALF + m * 16) * 1024 + col0;
#pragma unroll
                for (int bj = 0; bj < 2; ++bj) { const u32x4 c = *(const u32x4*)(SGc + off + bj * HALF), g = *(const u32x4*)(SGa + off + bj * HALF);
                    const f32x4 c0 = {bflo(c.x), bfhi(c.x), bflo(c.y), bfhi(c.y)}, c1 = {bflo(c.z), bfhi(c.z), bflo(c.w), bfhi(c.w)};
                    f32x4 g0 = {bflo(g.x), bfhi(g.x), bflo(g.y), bfhi(g.y)}, g1 = {bflo(g.z), bfhi(g.z), bflo(g.w), bfhi(g.w)};
#pragma unroll
                    for (int e = 0; e < 4; ++e) { g0[e] = c0[e] * __builtin_amdgcn_rcpf(fmaxf(g0[e], 1e-20f)); g1[e] = c1[e] * __builtin_amdgcn_rcpf(fmaxf(g1[e], 1e-20f)); }
                    acc[ai][bj][m][0] *= g0; acc[ai][bj][m][1] *= g1; } }
    }
    __device__ __forceinline__ void operator()(const f32x4 (&acc)[2][2][4][2], const Unit& u, int wr, int wc, int fr0, int fq) const {
        int fr = fr0; asm volatile("" : "+v"(fr));
        const int row0 = u.pm * BM + wr * 64 + fr, col0 = u.pn * BM + wc * 32 + 8 * fq;
#pragma unroll
        for (int ai = 0; ai < 2; ++ai)
#pragma unroll
            for (int m = 0; m < 4; ++m) { const size_t off = (size_t)(row0 + ai * HALF + m * 16) * 1024 + col0;
#pragma unroll
                for (int bj = 0; bj < 2; ++bj) { const u32x4 g = *(const u32x4*)(SGa + off + bj * HALF);
                    f32x4 g0 = {bflo(g.x), bfhi(g.x), bflo(g.y), bfhi(g.y)}, g1 = {bflo(g.z), bfhi(g.z), bflo(g.w), bfhi(g.w)};
#pragma unroll
                    for (int e = 0; e < 4; ++e) { g0[e] = fmaxf(g0[e], 1e-20f); g1[e] = fmaxf(g1[e], 1e-20f); }
                    st16wt(O + off + bj * HALF, pack8(g0 * acc[ai][bj][m][0], g1 * acc[ai][bj][m][1])); } }
    }
};
struct EpiResid {
    static constexpr bool PERM = true, AFTER_DRAIN = false;
    const float* R; bf16_t* XB; float* SS;
    __device__ __forceinline__ void operator()(const f32x4 (&acc)[2][2][4][2], const Unit& u, int wr, int wc, int fr0, int fq) const {
        int fr = fr0; asm volatile("" : "+v"(fr));
        const int row0 = u.pm * BM + wr * 64 + fr, col0 = u.pn * BM + wc * 32 + 8 * fq;
#pragma unroll
        for (int ai = 0; ai < 2; ++ai)
#pragma unroll
            for (int m = 0; m < 4; ++m) { const int row = row0 + ai * HALF + m * 16; const size_t off = (size_t)row * 1024 + col0; float ss = 0.f;
#pragma unroll
                for (int bj = 0; bj < 2; ++bj) {
                    const f32x4 x0 = *(const f32x4*)(R + off + bj * HALF) + acc[ai][bj][m][0], x1 = *(const f32x4*)(R + off + bj * HALF + 4) + acc[ai][bj][m][1];
                    st16wt(XB + off + bj * HALF, pack8(x0, x1));
                    ss += (x0[0] * x0[0] + x0[1] * x0[1]) + (x0[2] * x0[2] + x0[3] * x0[3]) + (x1[0] * x1[0] + x1[1] * x1[1]) + (x1[2] * x1[2] + x1[3] * x1[3]); }
                ss = xrow16_sum(ss);
                if (fq == 0) SS[(size_t)row * 16 + u.pn * 4 + wc] = ss; }
    }
};
struct EpiResidB {
    static constexpr bool PERM = true, AFTER_DRAIN = false;
    bf16_t* XB; float* SS;
    __device__ __forceinline__ void operator()(const f32x4 (&acc)[2][2][4][2], const Unit& u, int wr, int wc, int fr0, int fq) const {
        int fr = fr0; asm volatile("" : "+v"(fr));
        const int row0 = u.pm * BM + wr * 64 + fr, col0 = u.pn * BM + wc * 32 + 8 * fq;
#pragma unroll
        for (int ai = 0; ai < 2; ++ai)
#pragma unroll
            for (int m = 0; m < 4; ++m) { const int row = row0 + ai * HALF + m * 16; const size_t off = (size_t)row * 1024 + col0; float ss = 0.f;
#pragma unroll
                for (int bj = 0; bj < 2; ++bj) { const u32x4 g = *(const u32x4*)(XB + off + bj * HALF);
                    const f32x4 r0 = {bflo(g.x), bfhi(g.x), bflo(g.y), bfhi(g.y)}, r1 = {bflo(g.z), bfhi(g.z), bflo(g.w), bfhi(g.w)};
                    const f32x4 x0 = r0 + acc[ai][bj][m][0], x1 = r1 + acc[ai][bj][m][1];
                    st16wt(XB + off + bj * HALF, pack8(x0, x1));
                    ss += (x0[0] * x0[0] + x0[1] * x0[1]) + (x0[2] * x0[2] + x0[3] * x0[3]) + (x1[0] * x1[0] + x1[1] * x1[1]) + (x1[2] * x1[2] + x1[3] * x1[3]); }
                ss = xrow16_sum(ss);
                if (fq == 0) SS[(size_t)row * 16 + u.pn * 4 + wc] = ss; }
    }
};
struct EpiRowScale {
    static constexpr bool PERM = true, AFTER_DRAIN = false;
    const float* SS; bf16_t* O; int ldc; float sc;
    __device__ __forceinline__ void operator()(const f32x4 (&acc)[2][2][4][2], const Unit& u, int wr, int wc, int fr0, int fq) const {
        int fr = fr0; asm volatile("" : "+v"(fr));
        const int row0 = u.pm * BM + wr * 64 + fr, col0 = u.pn * BM + wc * 32 + 8 * fq;
#pragma unroll
        for (int ai = 0; ai < 2; ++ai)
#pragma unroll
            for (int m = 0; m < 4; ++m) { const int row = row0 + ai * HALF + m * 16;
                const f32x4* sp = (const f32x4*)(SS + (size_t)row * 16); const f32x4 s4 = (sp[0] + sp[1]) + (sp[2] + sp[3]);
                const float rs = sc / sqrtf(((s4[0] + s4[1]) + (s4[2] + s4[3])) * (1.0f / 1024.0f) + 1e-6f);
#pragma unroll
                for (int bj = 0; bj < 2; ++bj) *(u32x4*)(O + (size_t)row * ldc + col0 + bj * HALF) = pack8(acc[ai][bj][m][0] * rs, acc[ai][bj][m][1] * rs); }
    }
};

__device__ __forceinline__ unsigned f2ord(float f) { const unsigned u = __builtin_bit_cast(unsigned, f); return u ^ ((unsigned)((int)u >> 31) | 0x80000000u); }
__device__ __forceinline__ float ord2f(unsigned k) { const unsigned u = (k & 0x80000000u) ? (k ^ 0x80000000u) : ~k; return __builtin_bit_cast(float, u); }
#define PG8_CSWAP(a, b) do { const unsigned hi_ = (a) > (b) ? (a) : (b), lo_ = (a) > (b) ? (b) : (a); (a) = hi_; (b) = lo_; } while (0)
__device__ __forceinline__ void sort16_desc(unsigned (&k)[16]) {
#pragma unroll
    for (int sz = 2; sz <= 16; sz <<= 1)
#pragma unroll
        for (int st = sz >> 1; st > 0; st >>= 1)
#pragma unroll
            for (int i = 0; i < 16; ++i) { const int l = i ^ st; if (l > i) { if ((i & sz) == 0) PG8_CSWAP(k[i], k[l]); else PG8_CSWAP(k[l], k[i]); } }
}
__device__ __forceinline__ void merge16_desc(unsigned (&a)[16], const unsigned (&b)[16]) {
#pragma unroll
    for (int i = 0; i < 16; ++i) a[i] = a[i] > b[15 - i] ? a[i] : b[15 - i];
#pragma unroll
    for (int st = 8; st > 0; st >>= 1)
#pragma unroll
        for (int i = 0; i < 16; ++i) { const int l = i ^ st; if (l > i) PG8_CSWAP(a[i], a[l]); }
}
struct EpiKeys {
    static constexpr bool PERM = true, AFTER_DRAIN = false;
    const float* SS; unsigned* KS;
    __device__ __forceinline__ void operator()(const f32x4 (&acc)[2][2][4][2], const Unit& u, int wr, int wc, int fr0, int fq) const {
        int fr = fr0; asm volatile("" : "+v"(fr));
#pragma unroll
        for (int ai = 0; ai < 2; ++ai)
#pragma unroll
            for (int m = 0; m < 4; ++m) { const int row = ai * HALF + wr * 64 + m * 16 + fr;
                const f32x4* sp = (const f32x4*)(SS + (size_t)(u.pm * BM + row) * 16); const f32x4 s4 = (sp[0] + sp[1]) + (sp[2] + sp[3]);
                const float rs = 1.0f / sqrtf(((s4[0] + s4[1]) + (s4[2] + s4[3])) * (1.0f / 1024.0f) + 1e-6f);
#pragma unroll
                for (int bj = 0; bj < 2; ++bj)
#pragma unroll
                    for (int n = 0; n < 2; ++n) { const int cw = wc * 32 + 8 * fq + 4 * n; u32x4 k;
#pragma unroll
                        for (int e = 0; e < 4; ++e) k[e] = (f2ord(acc[ai][bj][m][n][e] * rs) & ~0x7Fu) | (unsigned)(127 - (cw + e));
                        *(u32x4*)(KS + row * 256 + bj * HALF + cw) = k; } }
    }
};
__device__ __forceinline__ void topk_from_keys(int tid, const unsigned* KS, unsigned* TOPK, int tok0, int h) {
#pragma unroll 1
    for (int ai = 0; ai < 2; ++ai) {
        const int j = tid & 1, rl = (tid >> 1) & 127, c = tid >> 8;
        const unsigned* src = KS + (ai * 128 + rl) * 256 + c * 128 + j * 64;
        unsigned best[16], cur[16];
        { const u32x4 a0 = *(const u32x4*)src, a1 = *(const u32x4*)(src + 4), a2 = *(const u32x4*)(src + 8), a3 = *(const u32x4*)(src + 12);
#pragma unroll
          for (int e = 0; e < 4; ++e) { best[e] = a0[e]; best[4 + e] = a1[e]; best[8 + e] = a2[e]; best[12 + e] = a3[e]; } }
        sort16_desc(best);
#pragma unroll 1
        for (int gq = 1; gq < 4; ++gq) {
            const u32x4 a0 = *(const u32x4*)(src + gq * 16), a1 = *(const u32x4*)(src + gq * 16 + 4), a2 = *(const u32x4*)(src + gq * 16 + 8), a3 = *(const u32x4*)(src + gq * 16 + 12);
#pragma unroll
            for (int e = 0; e < 4; ++e) { cur[e] = a0[e]; cur[4 + e] = a1[e]; cur[8 + e] = a2[e]; cur[12 + e] = a3[e]; }
            sort16_desc(cur); merge16_desc(best, cur); }
#pragma unroll
        for (int i = 0; i < 16; ++i) cur[i] = (unsigned)__shfl_xor((int)best[i], 1);
        merge16_desc(best, cur);
        unsigned* dst = TOPK + ((size_t)(tok0 + ai * 128 + rl) * 8 + h) * 32 + c * 16 + j * 8;
        u32x4 w0, w1;
        if (j == 0) { w0 = (u32x4){best[0], best[1], best[2], best[3]}; w1 = (u32x4){best[4], best[5], best[6], best[7]}; }
        else { w0 = (u32x4){best[8], best[9], best[10], best[11]}; w1 = (u32x4){best[12], best[13], best[14], best[15]}; }
        st16wt(dst, w0); st16wt(dst + 4, w1);
    }
}
struct EpiSoftmaxP {
    static constexpr bool PERM = true, AFTER_DRAIN = true;
    bf16_t* P; PG8_LAS float* lrow;
    __device__ __forceinline__ void fused(f32x4 (&acc)[2][2][4][2], const Unit& u, int wr, int wc, int fr0, int fq, PG8_LAS unsigned char* lds, int wid, int lane) const {
        int fr = fr0; asm volatile("" : "+v"(fr));
        PG8_LAS float* MX = (PG8_LAS float*)lds; PG8_LAS float* SM = MX + 1024;
#pragma unroll
        for (int ai = 0; ai < 2; ++ai)
#pragma unroll
            for (int m = 0; m < 4; ++m) { float mx = -INFINITY;
#pragma unroll
                for (int bj = 0; bj < 2; ++bj)
#pragma unroll
                    for (int n = 0; n < 2; ++n)
#pragma unroll
                        for (int e = 0; e < 4; ++e) mx = fmaxf(mx, acc[ai][bj][m][n][e]);
                mx = xrow16_max(mx);
                if (fq == 0) MX[(ai * HALF + wr * 64 + m * 16 + fr) * 4 + wc] = mx; }
        asm volatile("s_waitcnt lgkmcnt(0)\n\ts_barrier" ::: "memory");
#pragma unroll
        for (int ai = 0; ai < 2; ++ai)
#pragma unroll
            for (int m = 0; m < 4; ++m) { const int row = ai * HALF + wr * 64 + m * 16 + fr;
                const f32x4 m4 = *(const PG8_LAS f32x4*)(MX + row * 4); const float rm = fmaxf(fmaxf(m4[0], m4[1]), fmaxf(m4[2], m4[3])); float s = 0.f;
#pragma unroll
                for (int bj = 0; bj < 2; ++bj) { f32x4 p0, p1;
#pragma unroll
                    for (int e = 0; e < 4; ++e) { p0[e] = __builtin_amdgcn_exp2f(acc[ai][bj][m][0][e] - rm); p1[e] = __builtin_amdgcn_exp2f(acc[ai][bj][m][1][e] - rm); }
                    s += ((p0[0] + p0[1]) + (p0[2] + p0[3])) + ((p1[0] + p1[1]) + (p1[2] + p1[3]));
                    *(u32x4*)(P + (size_t)row * 256 + bj * HALF + wc * 32 + 8 * fq) = pack8(p0, p1); }
                s = xrow16_sum(s);
                if (fq == 0) SM[row * 4 + wc] = s; }
        asm volatile("s_waitcnt lgkmcnt(0)\n\ts_barrier" ::: "memory");
        const int tid = wid * 64 + lane;
        if (tid < 256) { const f32x4 s4 = *(const PG8_LAS f32x4*)(SM + tid * 4); lrow[tid] = (s4[0] + s4[1]) + (s4[2] + s4[3]); }
    }
};
struct EpiSoftmaxFull {
    static constexpr bool PERM = true, AFTER_DRAIN = true;
    const float* SS; bf16_t* P; float sc;
    __device__ __forceinline__ void fused(f32x4 (&acc)[2][2][4][2], const Unit& u, int wr, int wc, int fr0, int fq, PG8_LAS unsigned char* lds, int wid, int lane) const {
        int fr = fr0; asm volatile("" : "+v"(fr));
        PG8_LAS float* MX = (PG8_LAS float*)lds; PG8_LAS float* SM = MX + 1024;
#pragma unroll
        for (int ai = 0; ai < 2; ++ai)
#pragma unroll
            for (int m = 0; m < 4; ++m) { const int lr = ai * HALF + wr * 64 + m * 16 + fr, row = u.pm * BM + lr; float mx = -INFINITY;
                const f32x4* sp = (const f32x4*)(SS + (size_t)row * 16); const f32x4 s4 = (sp[0] + sp[1]) + (sp[2] + sp[3]);
                const float rs = sc / sqrtf(((s4[0] + s4[1]) + (s4[2] + s4[3])) * (1.0f / 1024.0f) + 1e-6f);
#pragma unroll
                for (int bj = 0; bj < 2; ++bj)
#pragma unroll
                    for (int n = 0; n < 2; ++n) { acc[ai][bj][m][n] *= rs;
#pragma unroll
                        for (int e = 0; e < 4; ++e) mx = fmaxf(mx, acc[ai][bj][m][n][e]); }
                mx = xrow16_max(mx);
                if (fq == 0) MX[lr * 4 + wc] = mx; }
        asm volatile("s_waitcnt lgkmcnt(0)\n\ts_barrier" ::: "memory");
#pragma unroll
        for (int ai = 0; ai < 2; ++ai)
#pragma unroll
            for (int m = 0; m < 4; ++m) { const int lr = ai * HALF + wr * 64 + m * 16 + fr;
                const f32x4 m4 = *(const PG8_LAS f32x4*)(MX + lr * 4); const float rm = fmaxf(fmaxf(m4[0], m4[1]), fmaxf(m4[2], m4[3])); float s = 0.f;
#pragma unroll
                for (int bj = 0; bj < 2; ++bj)
#pragma unroll
                    for (int n = 0; n < 2; ++n) {
#pragma unroll
                        for (int e = 0; e < 4; ++e) acc[ai][bj][m][n][e] = __builtin_amdgcn_exp2f(acc[ai][bj][m][n][e] - rm);
                        s += (acc[ai][bj][m][n][0] + acc[ai][bj][m][n][1]) + (acc[ai][bj][m][n][2] + acc[ai][bj][m][n][3]); }
                s = xrow16_sum(s);
                if (fq == 0) SM[lr * 4 + wc] = s; }
        asm volatile("s_waitcnt lgkmcnt(0)\n\ts_barrier" ::: "memory");
#pragma unroll
        for (int ai = 0; ai < 2; ++ai)
#pragma unroll
            for (int m = 0; m < 4; ++m) { const int lr = ai * HALF + wr * 64 + m * 16 + fr;
                const f32x4 s4 = *(const PG8_LAS f32x4*)(SM + lr * 4); const float inv = 1.0f / ((s4[0] + s4[1]) + (s4[2] + s4[3]));
#pragma unroll
                for (int bj = 0; bj < 2; ++bj)
                    st16wt(P + (size_t)(u.pm * BM + lr) * 1024 + u.pn * BM + bj * HALF + wc * 32 + 8 * fq, pack8(acc[ai][bj][m][0] * inv, acc[ai][bj][m][1] * inv)); }
    }
};
struct EpiCO {
    static constexpr bool PERM = true, AFTER_DRAIN = false;
    bf16_t* O; const PG8_LAS float* lrow;
    __device__ __forceinline__ void operator()(const f32x4 (&acc)[2][2][4][2], const Unit& u, int wr, int wc, int fr0, int fq) const {
        int fr = fr0; asm volatile("" : "+v"(fr));
#pragma unroll
        for (int ai = 0; ai < 2; ++ai)
#pragma unroll
            for (int m = 0; m < 4; ++m) { const int row = ai * HALF + wr * 64 + m * 16 + fr; const float inv = 1.0f / lrow[row];
#pragma unroll
                for (int bj = 0; bj < 2; ++bj) *(u32x4*)(O + (size_t)row * 1024 + bj * HALF + wc * 32 + 8 * fq) = pack8(acc[ai][bj][m][0] * inv, acc[ai][bj][m][1] * inv); }
    }
};
struct OneUnit {
    int pm, pn;
    __device__ __forceinline__ bool next(int i, Unit& u) const { if (i) return false; u.pm = pm; u.pn = pn; return true; }
    __device__ __forceinline__ void a_ready(const Unit&) const {}
    __device__ __forceinline__ void done(const Unit&) const {}
};
}

__device__ __forceinline__ int win_src_col(int n) {
    if (n < 1024 || n >= 3072) return n;
    const int t = (n - 1024) >> 8, j = (n - 1024) & 255;
    return j < 128 ? 1024 + 128 * t + j : 2048 + 128 * t + (j - 128);
}
__device__ __forceinline__ void p0_prologue(int wv, const Args& a, LAS unsigned char* lds, int blk, int G) {
    const int tid = opaque_tid(wv), lane = tid & 63, wave = tid >> 6;
    unsigned char* ws = a.ws;
    LAS float* tl = (LAS float*)lds;
    {
        f32x4 cur[8], nxt[8]; const float* gcur = nullptr; const float* gnxt = nullptr;
#define P0_DECODE(job, W, ldw, nb, kb, Wt, gain, perm) do { \
            if ((job) < 512) { W = a.in[I_W_IN]; ldw = NCOLS; kb = (job) >> 5; nb = (job) & 31; Wt = (bf16*)(ws + WS_WT_IN); gain = a.in[I_NORM_MIX_G]; perm = true; } \
            else { const int mat = ((job) - 512) >> 6, idx = ((job) - 512) & 63; kb = idx >> 2; nb = idx & 3; ldw = 1024; gain = nullptr; perm = false; \
                if (mat == 0) { W = a.in[I_W_CONV_OUT]; Wt = (bf16*)(ws + WS_WT_CONV); } \
                else if (mat == 1) { W = a.in[I_W_ATTN_OUT]; Wt = (bf16*)(ws + WS_WT_ATTN); } \
                else if (mat == 2) { W = a.in[I_W_MIX_OUT]; Wt = (bf16*)(ws + WS_WT_MIX); } \
                else { W = a.in[I_W_CO]; Wt = (bf16*)(ws + WS_WT_CO); } } } while (0)
#define P0_LOAD(dst, gv, job) do { const float* W; int ldw, nb, kb; bf16* Wt; const float* gain; bool perm; P0_DECODE(job, W, ldw, nb, kb, Wt, gain, perm); (void)Wt; \
            const int k0 = kb * 64, c = tid & 63, nd0 = nb * 256 + 64 * (c >> 4), ns0 = (perm ? win_src_col(nd0) : nd0) + 4 * (c & 15); gv = gain ? gain + k0 : nullptr; \
            _Pragma("unroll") for (int i = 0; i < 8; ++i) dst[i] = *(const f32x4*)(W + (size_t)(k0 + (tid >> 6) + 8 * i) * ldw + ns0); } while (0)
        if (blk < 768) P0_LOAD(cur, gcur, blk);
        for (int job = blk; job < 768; job += G) {
            if (job + G < 768) P0_LOAD(nxt, gnxt, job + G);
#pragma unroll
            for (int i = 0; i < 8; ++i) { const int kk = (tid >> 6) + 8 * i, c = tid & 63; const float gk = gcur ? gcur[kk] : 1.0f; LAS float* d = tl + kk * 257 + 4 * c;
                d[0] = cur[i][0] * gk; d[1] = cur[i][1] * gk; d[2] = cur[i][2] * gk; d[3] = cur[i][3] * gk; }
            __syncthreads();
            { const float* W; int ldw, nb, kb; bf16* Wt; const float* gain; bool perm; P0_DECODE(job, W, ldw, nb, kb, Wt, gain, perm); (void)W; (void)ldw; (void)gain; (void)perm;
#pragma unroll
              for (int r = 0; r < 4; ++r) { const int idx = tid + 512 * r, nn = idx >> 3, kq = idx & 7; const LAS float* s = tl + (kq * 8) * 257 + nn;
                  u32x4 o; o.x = pk2(s[0], s[257]); o.y = pk2(s[2 * 257], s[3 * 257]); o.z = pk2(s[4 * 257], s[5 * 257]); o.w = pk2(s[6 * 257], s[7 * 257]);
                  st16wt(Wt + (size_t)(nb * 256 + nn) * 1024 + kb * 64 + kq * 8, o); } }
            __syncthreads();
#pragma unroll
            for (int i = 0; i < 8; ++i) cur[i] = nxt[i];
            gcur = gnxt;
        }
#undef P0_DECODE
#undef P0_LOAD
    }
    { const float* x = a.in[I_X]; bf16* XB = (bf16*)(ws + WS_A0); float* rstd0 = (float*)(ws + WS_RSTD0);
      f32x4 v[4], w4[4]; int row = blk * 8 + wave;
#define P0_XLOAD(dst, r) do { const f32x4* xr = (const f32x4*)(x + (size_t)(r) * D) + 2 * lane; dst[0] = xr[0]; dst[1] = xr[1]; dst[2] = xr[128]; dst[3] = xr[129]; } while (0)
      if (row < S) P0_XLOAD(v, row);
      for (; row < S; row += G * 8) {
          if (row + G * 8 < S) P0_XLOAD(w4, row + G * 8);
          float s = 0.f;
#pragma unroll
          for (int j = 0; j < 4; ++j) s += (v[j][0] * v[j][0] + v[j][1] * v[j][1]) + (v[j][2] * v[j][2] + v[j][3] * v[j][3]);
          s = wave_sum(s);
          if (lane == 0) rstd0[row] = 1.0f / sqrtf(s * (1.0f / D) + 1e-6f);
          bf16* o = XB + (size_t)row * D + 8 * lane;
#pragma unroll
          for (int j = 0; j < 2; ++j) { u32x4 w; w.x = pk2(v[2 * j][0], v[2 * j][1]); w.y = pk2(v[2 * j][2], v[2 * j][3]); w.z = pk2(v[2 * j + 1][0], v[2 * j + 1][1]); w.w = pk2(v[2 * j + 1][2], v[2 * j + 1][3]);
              st16wt(o + 512 * j, w); }
#pragma unroll
          for (int j = 0; j < 4; ++j) v[j] = w4[j];
      }
#undef P0_XLOAD
    }
    { typedef short bf16x8_t __attribute__((ext_vector_type(8))); typedef float f32x16_t __attribute__((ext_vector_type(16)));
      LAS bf16* mnb = (LAS bf16*)lds;
      LAS float* red = (LAS float*)(lds + 32 * 1032 * 2);
      const float* mem = a.in[I_MEM]; const float* g = a.in[I_NORM_MEM_G]; const float* Wc = a.in[I_W_CKV]; bf16* KC = (bf16*)(ws + WS_KV); bf16* VC = KC + 4 * 256 * 256;
      const int r32 = lane & 31, kg = lane >> 5;
      for (int wb = blk; wb < 256; wb += G) {
          const int m0 = (wb >> 5) * 32, n0 = (wb & 31) * 64;
          __syncthreads();
#pragma unroll
          for (int r = 0; r < 4; ++r) { const int rr = wave * 4 + r; const f32x4* mr = (const f32x4*)(mem + (size_t)(m0 + rr) * D) + lane; f32x4 v[4]; float s = 0.f;
#pragma unroll
              for (int j = 0; j < 4; ++j) { v[j] = mr[64 * j]; s += (v[j][0] * v[j][0] + v[j][1] * v[j][1]) + (v[j][2] * v[j][2] + v[j][3] * v[j][3]); }
              s = wave_sum(s); const float rs = 1.0f / sqrtf(s * (1.0f / D) + 1e-6f);
#pragma unroll
              for (int j = 0; j < 4; ++j) { const f32x4 gg = ((const f32x4*)g)[lane + 64 * j]; const f32x4 y = v[j] * rs * gg; u32x2 w; w.x = pk2(y[0], y[1]); w.y = pk2(y[2], y[3]);
                  *(LAS u32x2*)(mnb + rr * 1032 + 4 * (lane + 64 * j)) = w; } }
          __syncthreads();
          const int it = wave & 1, kq = wave >> 1, ncol = n0 + 32 * it + r32;
          f32x16_t acc;
#pragma unroll
          for (int r = 0; r < 16; ++r) acc[r] = 0.f;
#pragma unroll 1
          for (int half = 0; half < 2; ++half) {
              float wv_[8][8];
#pragma unroll
              for (int s = 0; s < 8; ++s)
#pragma unroll
                  for (int j = 0; j < 8; ++j) wv_[s][j] = Wc[(size_t)(256 * kq + 128 * half + 16 * s + 8 * kg + j) * 2048 + ncol];
#pragma unroll
              for (int s = 0; s < 8; ++s) {
                  u32x4 bw; bw.x = pk2(wv_[s][0], wv_[s][1]); bw.y = pk2(wv_[s][2], wv_[s][3]); bw.z = pk2(wv_[s][4], wv_[s][5]); bw.w = pk2(wv_[s][6], wv_[s][7]);
                  const bf16x8_t af = *(const LAS bf16x8_t*)(mnb + r32 * 1032 + 256 * kq + 128 * half + 16 * s + 8 * kg);
                  acc = __builtin_amdgcn_mfma_f32_32x32x16_bf16(af, __builtin_bit_cast(bf16x8_t, bw), acc, 0, 0, 0); }
          }
#pragma unroll
          for (int r = 0; r < 16; ++r) red[((it * 4 + kq) * 16 + r) * 64 + lane] = acc[r];
          __syncthreads();
          if (kq == 0) {
#pragma unroll
              for (int r = 0; r < 16; ++r) acc[r] = (red[((it * 4 + 0) * 16 + r) * 64 + lane] + red[((it * 4 + 1) * 16 + r) * 64 + lane]) + (red[((it * 4 + 2) * 16 + r) * 64 + lane] + red[((it * 4 + 3) * 16 + r) * 64 + lane]);
              if (ncol < 1024) {
#pragma unroll
                  for (int r = 0; r < 16; ++r) KC[((size_t)(ncol >> 8) * 256 + (m0 + (r & 3) + 8 * (r >> 2) + 4 * kg)) * 256 + (ncol & 255)] = (bf16)f2bf(acc[r]);
              } else {
#pragma unroll
                  for (int r = 0; r < 16; ++r) VC[((size_t)((ncol - 1024) >> 8) * 256 + (m0 + (r & 3) + 8 * (r >> 2) + 4 * kg)) * 256 + (ncol & 255)] = (bf16)f2bf(acc[r]);
              }
          }
      }
      __syncthreads(); }
    { typedef short bf16x8_t __attribute__((ext_vector_type(8))); typedef float f32x16_t __attribute__((ext_vector_type(16)));
      const float* sk = a.in[I_SUB_KEYS]; const float* wpq = a.in[I_W_PQ]; const float* gf = a.in[I_NORM_FFN_G]; bf16* WT = (bf16*)(ws + WS_WT_PQ);
      const int r32 = lane & 31, kg = lane >> 5;
      for (int item = blk * 8 + wave; item < 2048; item += G * 8) {
          const int hc = item >> 7, h = hc >> 1, c = hc & 1, kt = (item >> 2) & 31, nt = item & 3;
          const float* ap = wpq + (size_t)(kt * 32 + r32) * 2048 + hc * 128 + 8 * kg;
          const float* bp = sk + ((size_t)((c * 8 + h) * 128 + nt * 32 + r32)) * 128 + 8 * kg;
          const float gk = gf[kt * 32 + r32];
          f32x4 av[8][2], bv[8][2];
#pragma unroll
          for (int s = 0; s < 8; ++s) { av[s][0] = *(const f32x4*)(ap + 16 * s); av[s][1] = *(const f32x4*)(ap + 16 * s + 4); bv[s][0] = *(const f32x4*)(bp + 16 * s); bv[s][1] = *(const f32x4*)(bp + 16 * s + 4); }
          f32x16_t acc;
#pragma unroll
          for (int r = 0; r < 16; ++r) acc[r] = 0.f;
#pragma unroll
          for (int s = 0; s < 8; ++s) {
              const f32x4 a0 = av[s][0] * gk, a1 = av[s][1] * gk;
              u32x4 aw, bw; aw.x = pk2(a0[0], a0[1]); aw.y = pk2(a0[2], a0[3]); aw.z = pk2(a1[0], a1[1]); aw.w = pk2(a1[2], a1[3]);
              bw.x = pk2(bv[s][0][0], bv[s][0][1]); bw.y = pk2(bv[s][0][2], bv[s][0][3]); bw.z = pk2(bv[s][1][0], bv[s][1][1]); bw.w = pk2(bv[s][1][2], bv[s][1][3]);
              acc = __builtin_amdgcn_mfma_f32_32x32x16_bf16(__builtin_bit_cast(bf16x8_t, aw), __builtin_bit_cast(bf16x8_t, bw), acc, 0, 0, 0); }
          bf16* dst = WT + (size_t)(hc * 128 + nt * 32 + r32) * 1024 + kt * 32 + 4 * kg;
#pragma unroll
          for (int q = 0; q < 4; ++q) { u32x2 w; w.x = pk2(acc[4 * q], acc[4 * q + 1]); w.y = pk2(acc[4 * q + 2], acc[4 * q + 3]); *(u32x2*)(dst + 8 * q) = w; }
      } }
    if (blk == 0) { float* BT = (float*)(ws + WS_BTAB); const float* rb = a.in[I_REL_BIAS];
        for (int i = tid; i < 8 * 132; i += 512) { const int h = i / 132, j = i - h * 132; float v = 0.f;
            if (j < 129) { const int b = j < 128 ? (int)T5_BUCKET[j] : 31; v = (rb[b * 8 + h] - rb[31 * 8 + h]) * 1.4426950408889634f; }
            else if (j == 129) { float m = -INFINITY; for (int b = 0; b < 32; ++b) m = fmaxf(m, rb[b * 8 + h] * 1.4426950408889634f); v = m; }
            else if (j == 130) v = rb[31 * 8 + h] * 1.4426950408889634f;
            BT[i] = v; }
        if (tid == 0) { float s1 = 0.f, s2 = 0.f;
            for (int i = 0; i < 64; ++i) { s1 += a.in[I_LQ1][i] * a.in[I_LK1][i]; s2 += a.in[I_LQ2][i] * a.in[I_LK2][i]; }
            BT[8 * 132] = expf(s1) - expf(s2) + 0.2f; } }
}

__device__ __forceinline__ void cross_fold(int wv, const Args& a, int blk, int G) {
    typedef short bf16x8_t __attribute__((ext_vector_type(8))); typedef float f32x16_t __attribute__((ext_vector_type(16)));
    const int tid = opaque_tid(wv), lane = tid & 63, wave = tid >> 6, r32 = lane & 31, kg = lane >> 5;
    const bf16* KC = (const bf16*)(a.ws + WS_KV); const bf16* VC = KC + 4 * 256 * 256;
    for (int item = blk * 8 + wave; item < 2048; item += G * 8) {
        f32x16_t acc;
#pragma unroll
        for (int r = 0; r < 16; ++r) acc[r] = 0.f;
        bf16* dst;
        if (item < 1024) {
            const int h = item >> 8, kt = (item >> 3) & 31, mt = item & 7;
            const float* ap = a.in[I_W_CQ] + (size_t)(kt * 32 + r32) * 1024 + h * 256 + 8 * kg;
            const bf16* bp = KC + ((size_t)h * 256 + mt * 32 + r32) * 256 + 8 * kg;
            const float gk = a.in[I_NORM_CROSS_G][kt * 32 + r32];
#pragma unroll 1
            for (int half = 0; half < 2; ++half) {
                f32x4 av[8][2]; u32x4 bv[8];
#pragma unroll
                for (int s = 0; s < 8; ++s) { av[s][0] = *(const f32x4*)(ap + 128 * half + 16 * s); av[s][1] = *(const f32x4*)(ap + 128 * half + 16 * s + 4); bv[s] = *(const u32x4*)(bp + 128 * half + 16 * s); }
#pragma unroll
                for (int s = 0; s < 8; ++s) { const f32x4 a0 = av[s][0] * gk, a1 = av[s][1] * gk;
                    u32x4 aw; aw.x = pk2(a0[0], a0[1]); aw.y = pk2(a0[2], a0[3]); aw.z = pk2(a1[0], a1[1]); aw.w = pk2(a1[2], a1[3]);
                    acc = __builtin_amdgcn_mfma_f32_32x32x16_bf16(__builtin_bit_cast(bf16x8_t, aw), __builtin_bit_cast(bf16x8_t, bv[s]), acc, 0, 0, 0); }
            }
            dst = (bf16*)(a.ws + WS_WQK) + (size_t)(h * 256 + mt * 32 + r32) * 1024 + kt * 32 + 4 * kg;
        } else {
            const int it = item - 1024, h = it >> 8, mt = (it >> 5) & 7, nt = it & 31;
            const bf16* ap = VC + ((size_t)h * 256 + mt * 32 + r32) * 256 + 8 * kg;
            const bf16* bp = (const bf16*)(a.ws + WS_WT_CO) + (size_t)(nt * 32 + r32) * 1024 + h * 256 + 8 * kg;
            u32x4 av[16], bv[16];
#pragma unroll
            for (int s = 0; s < 16; ++s) { av[s] = *(const u32x4*)(ap + 16 * s); bv[s] = *(const u32x4*)(bp + 16 * s); }
#pragma unroll
            for (int s = 0; s < 16; ++s) acc = __builtin_amdgcn_mfma_f32_32x32x16_bf16(__builtin_bit_cast(bf16x8_t, av[s]), __builtin_bit_cast(bf16x8_t, bv[s]), acc, 0, 0, 0);
            dst = (bf16*)(a.ws + WS_VW) + (size_t)(nt * 32 + r32) * 1024 + h * 256 + mt * 32 + 4 * kg;
        }
#pragma unroll
        for (int q = 0; q < 4; ++q) { u32x2 w; w.x = pk2(acc[4 * q], acc[4 * q + 1]); w.y = pk2(acc[4 * q + 2], acc[4 * q + 3]); *(u32x2*)(dst + 8 * q) = w; }
    }
}

__device__ __forceinline__ void conv_phase(int wv, const Args& a, int blk, int G) {
    bf16* CB = (bf16*)(a.ws + WS_A1); const bf16* U = (const bf16*)(a.ws + WS_A2); const float* cw = a.in[I_CONV_W];
    const int tid = opaque_tid(wv);
    const int c = (tid & 127) * 8;
    float w0[8], w1[8], w2[8];
#pragma unroll
    for (int e = 0; e < 8; ++e) { w0[e] = cw[c + e]; w1[e] = cw[D + c + e]; w2[e] = cw[2 * D + c + e]; }
    const size_t step = (size_t)G * 512, total = (size_t)S * D / 8;
    for (size_t i0 = (size_t)blk * 512 + tid; i0 < total; i0 += 4 * step) {
        u32x4 cb[4], u2[4], u1[4], u0[4];
#pragma unroll
        for (int q = 0; q < 4; ++q) { const size_t i = i0 + q * step; const int r = (int)(i >> 7);
            cb[q] = u2[q] = u1[q] = u0[q] = (u32x4){0, 0, 0, 0};
            if (i < total) { cb[q] = *(const u32x4*)(CB + i * 8); u2[q] = *(const u32x4*)(U + i * 8);
                if (r >= 1) u1[q] = *(const u32x4*)(U + i * 8 - D);
                if (r >= 2) u0[q] = *(const u32x4*)(U + i * 8 - 2 * D); } }
#pragma unroll
        for (int q = 0; q < 4; ++q) { const size_t i = i0 + q * step;
            u32x4 o;
#pragma unroll
            for (int e = 0; e < 4; ++e) {
                const float lo = bflo(cb[q][e]) * (w0[2 * e] * bflo(u0[q][e]) + w1[2 * e] * bflo(u1[q][e]) + w2[2 * e] * bflo(u2[q][e]));
                const float hi = bfhi(cb[q][e]) * (w0[2 * e + 1] * bfhi(u0[q][e]) + w1[2 * e + 1] * bfhi(u1[q][e]) + w2[2 * e + 1] * bfhi(u2[q][e]));
                o[e] = pk2(lo, hi);
            }
            if (i < total) st16wt(CB + i * 8, o); }
    }
}


namespace att {
typedef short bf16x8 __attribute__((ext_vector_type(8)));
typedef short s16x4 __attribute__((ext_vector_type(4)));
typedef float f32x16 __attribute__((ext_vector_type(16)));
typedef short v4i16_t __attribute__((ext_vector_type(4)));
typedef LAS const char* lds_cptr;
constexpr int SLOT = 16384, LDS_K = 0, LDS_V = 4 * SLOT, LDS_WSF = 8 * SLOT, LDS_BT = LDS_WSF + 2048, LDS_TOTAL = LDS_BT + 1024;
constexpr int LDS_XCH = 0, LDS_OST = 65536;
constexpr float LOG2E = 1.4426950408889634f, THR = 8.0f;
__device__ __forceinline__ int crow(int r, int hi) { return (r & 3) + 8 * (r >> 2) + 4 * hi; }
typedef float f32x2_t __attribute__((ext_vector_type(2))); typedef __bf16 bf16x2_t __attribute__((ext_vector_type(2)));
__device__ __forceinline__ unsigned cvtpk(float lo, float hi) { const f32x2_t v = {lo, hi}; const bf16x2_t b = __builtin_convertvector(v, bf16x2_t); return __builtin_bit_cast(unsigned, b); }
__device__ __forceinline__ void glds16(const void* g, unsigned lds_base) {
    unsigned sv; asm volatile("s_mov_b32 %0, m0\n\ts_mov_b32 m0, %2\n\ts_nop 0\n\tglobal_load_lds_dwordx4 %1, off\n\ts_mov_b32 m0, %0" : "=&s"(sv) : "v"(g), "s"(lds_base) : "memory"); }
template <int IMM> __device__ __forceinline__ void glds16s(unsigned voff, const void* sbase, unsigned lds_base) {
    unsigned sv; asm volatile("s_mov_b32 %0, m0\n\ts_mov_b32 m0, %3\n\ts_nop 0\n\tglobal_load_lds_dwordx4 %1, %2 offset:%c4\n\ts_mov_b32 m0, %0" : "=&s"(sv) : "v"(voff), "s"(sbase), "s"(lds_base), "i"(IMM) : "memory"); }
__device__ __forceinline__ s16x4 vtr(lds_cptr p) { return __builtin_bit_cast(s16x4, __builtin_amdgcn_ds_read_tr16_b64_v4i16((LAS v4i16_t*)p)); }
#define ATT_MX3(a, b, c) __builtin_fmaxf(__builtin_fmaxf((a), (b)), (c))
__device__ __forceinline__ float rowmax(const f32x16& p0, const f32x16& p1) {
    float a = ATT_MX3(p0[0], p0[1], p1[0]), b = ATT_MX3(p0[2], p0[3], p1[1]); a = ATT_MX3(a, p1[2], p1[3]);
#pragma unroll
    for (int r = 4; r < 16; r += 4) { a = ATT_MX3(a, p0[r], p0[r + 1]); b = ATT_MX3(b, p0[r + 2], p0[r + 3]); a = ATT_MX3(a, p1[r], p1[r + 1]); b = ATT_MX3(b, p1[r + 2], p1[r + 3]); }
    float m = __builtin_fmaxf(a, b); auto rr = __builtin_amdgcn_permlane32_swap(__float_as_uint(m), __float_as_uint(m), false, false);
    return __builtin_fmaxf(__uint_as_float(rr[0]), __uint_as_float(rr[1])); }
#define ATT_WAIT_BAR(N) asm volatile("s_waitcnt vmcnt(" #N ") lgkmcnt(0)\n\ts_barrier" ::: "memory")
#define ATT_LBAR() asm volatile("s_waitcnt lgkmcnt(0)\n\ts_barrier" ::: "memory")
#define ATT_MFMA(a, b, c) __builtin_amdgcn_mfma_f32_32x32x16_bf16(a, b, c, 0, 0, 0)

__device__ __forceinline__ void attn_unit_pipe(int wv, int h, int qb, const bf16* Q, const bf16* __restrict__ K, const bf16* __restrict__ V, bf16* O, LAS unsigned char* lds,
                                               float lam, const float* BTAB, const float* subln_g, const unsigned* KMAX) {
    const int tid = opaque_tid(wv), lane = tid & 63, r32 = lane & 31, hi = lane >> 5;
    const int wid = __builtin_amdgcn_readfirstlane(tid >> 6), comp = wid >> 2, rg = wid & 3;
    const int q0 = qb * 128, qw0 = q0 + 32 * rg, NT = 2 * qb + 2;
    const unsigned lds0 = (unsigned)(unsigned long long)lds;
    LAS float* wsf = (LAS float*)(lds + LDS_WSF) + wid * 64;
    LAS float* bt = (LAS float*)(lds + LDS_BT);
    const unsigned kvoff = (unsigned)lane * 2048u + (unsigned)wid * 16u;
    const unsigned vvoff = (unsigned)(16 * (wid & 3) + (lane >> 2)) * 2048u + (unsigned)((wid >> 2) * 32 + (lane & 3) * 8) * 2u;
    const char* kbase = (const char*)(K + h * 128); const char* vbase = (const char*)(V + h * 128);
    const unsigned kdst = lds0 + LDS_K + wid * 1024, vdst = lds0 + LDS_V + wid * 1024;
#define ATT_RFL(x) ((unsigned)__builtin_amdgcn_readfirstlane((int)(x)))
#define DMA_K(t, so) do { const char* b_ = kbase + (size_t)(t) * 131072; glds16s<0>(kvoff, b_, ATT_RFL(kdst + (so))); glds16s<128>(kvoff, b_, ATT_RFL(kdst + (so) + 8192 - 128)); } while (0)
#define DMA_V(t, so) do { const char* b_ = vbase + (size_t)(t) * 131072; glds16s<0>(vvoff, b_, ATT_RFL(vdst + (so))); glds16s<128>(vvoff, b_, ATT_RFL(vdst + (so) + 8192 - 128)); } while (0)
    DMA_K(0, 0); DMA_K(1, SLOT); DMA_V(0, 0); if (NT > 2) DMA_K(2, 2 * SLOT);
    const float* bth = BTAB + h * 132;
    bf16x8 qr[4];
    float cfar;
    { const bf16* Qw = Q + (size_t)(qw0 + r32) * 1024 + h * 128 + comp * 64 + hi * 8;
#pragma unroll
      for (int d0 = 0; d0 < 4; ++d0) qr[d0] = *(const bf16x8*)(Qw + d0 * 16);
      float btv = 0.f; if (tid < 129) btv = bth[tid];
      const float bmax = bth[129], bfar = bth[130];
      const float kmx = sqrtf(__uint_as_float(KMAX[(h * 2 + comp) * 2]) + __uint_as_float(KMAX[(h * 2 + comp) * 2 + 1])) * 1.02f;
      if (tid < 129) bt[tid] = btv;
      float s = 0.f;
#pragma unroll
      for (int d0 = 0; d0 < 4; ++d0)
#pragma unroll
          for (int e2 = 0; e2 < 8; ++e2) { const float f = __builtin_bit_cast(float, (unsigned)(unsigned short)qr[d0][e2] << 16); s += f * f; }
      auto rr = __builtin_amdgcn_permlane32_swap(__float_as_uint(s), __float_as_uint(s), false, false); s = __uint_as_float(rr[0]) + __uint_as_float(rr[1]);
      cfar = bfar - (sqrtf(s) * 1.01f * kmx + bmax); }
    const lds_cptr kp0 = (lds_cptr)(lds + LDS_K) + comp * 8192 + hi * 1024 + r32 * 16;
    const lds_cptr vp0 = (lds_cptr)(lds + LDS_V) + ((lane >> 4) & 1) * 32 + (lane & 3) * 8 + (4 * hi + ((lane & 15) >> 2)) * 64;
    float l_reg = 0.f;
    f32x16 o[4];
#pragma unroll
    for (int d0 = 0; d0 < 4; ++d0)
#pragma unroll
        for (int r = 0; r < 16; ++r) o[d0][r] = 0.f;
    bf16x8 kf[8];
    f32x16 pA0, pA1, pB0, pB1;
    u32x4 pw0, pw1, pw2, pw3;
    s16x4 vl0, vh0, vl1, vh1;
#define SBAR() __builtin_amdgcn_sched_barrier(0)
#define PIN(x) asm volatile("" : "+v"(x))
#define PKW(P, B) cvtpk(P[B], P[B + 1])
#define PAF(k) __builtin_bit_cast(bf16x8, pw##k)
#define EX(v) __builtin_amdgcn_exp2f(v)
#define ROT3() do { const int t_ = s0; s0 = s1; s1 = s2; s2 = t_; } while (0)
#define ENDW(t) do { if ((t) + 3 < NT) { ATT_WAIT_BAR(4); } else if ((t) + 1 < NT) { ATT_WAIT_BAR(2); } else { ATT_WAIT_BAR(0); } } while (0)
#define KLD(f, kp_) kf[f] = *(LAS const bf16x8*)((kp_) + ((f) >> 1) * 2048 + ((f) & 1) * 512)
#define BANDFIX(C0, C1, t) do { if (__builtin_expect(64 * (t) + 63 + 128 > qw0, 0)) { const int ln_ = opaque_tid(0);   \
        const int dq = qw0 + (ln_ & 31) - 64 * (t) - 4 * (ln_ >> 5); \
        _Pragma("unroll") for (int r = 0; r < 16; ++r) { const int d0_ = dq - ((r & 3) + 8 * (r >> 2)), d1_ = d0_ - 32; \
            const float b0 = bt[min(max(d0_, 0), 128)], b1 = bt[min(max(d1_, 0), 128)]; \
            C0[r] = d0_ < 0 ? -INFINITY : C0[r] + b0; C1[r] = d1_ < 0 ? -INFINITY : C1[r] + b1; } } } while (0)
#define VRD(j, i, vp_) do { vl##j = vtr((vp_) + ((i) & 3) * 4096 + ((i) >> 2) * 1024); vh##j = vtr((vp_) + ((i) & 3) * 4096 + ((i) >> 2) * 1024 + 512); } while (0)
#define VFR(j) (bf16x8){vl##j[0], vl##j[1], vl##j[2], vl##j[3], vh##j[0], vh##j[1], vh##j[2], vh##j[3]}
#define GAPA(MF, A0, A1, A2, A3, W0, W1, PWX) do { MF; sacc += A0; sacc += A1; sacc += A2; sacc += A3; PIN(sacc); W0; W1; PIN(PWX); SBAR(); } while (0)
#define PHASE_A(C0, C1, P0, P1, vp_) do { float sacc = P0[0] + P0[1]; \
        GAPA(C0 = ATT_MFMA(kf[0], qr[0], C0), P0[2], P0[3], P0[4], P0[5],     pw0[0] = PKW(P0, 0), pw0[1] = PKW(P0, 2), pw0); \
        GAPA(C1 = ATT_MFMA(kf[1], qr[0], C1), P0[6], P0[7], P0[8], P0[9],     pw0[2] = PKW(P0, 4), pw0[3] = PKW(P0, 6), pw0); \
        GAPA(C0 = ATT_MFMA(kf[2], qr[1], C0), P0[10], P0[11], P0[12], P0[13], pw1[0] = PKW(P0, 8), pw1[1] = PKW(P0, 10), pw1); \
        GAPA(C1 = ATT_MFMA(kf[3], qr[1], C1), P0[14], P0[15], P1[0], P1[1],   pw1[2] = PKW(P0, 12), pw1[3] = PKW(P0, 14), pw1); \
        GAPA(C0 = ATT_MFMA(kf[4], qr[2], C0), P1[2], P1[3], P1[4], P1[5],     pw2[0] = PKW(P1, 0), pw2[1] = PKW(P1, 2), pw2); \
        GAPA(C1 = ATT_MFMA(kf[5], qr[2], C1), P1[6], P1[7], P1[8], P1[9],     pw2[2] = PKW(P1, 4), pw2[3] = PKW(P1, 6), pw2); \
        GAPA(C0 = ATT_MFMA(kf[6], qr[3], C0), P1[10], P1[11], P1[12], P1[13], pw3[0] = PKW(P1, 8), pw3[1] = PKW(P1, 10), pw3); \
        VRD(0, 0, vp_); SBAR(); \
        GAPA(C1 = ATT_MFMA(kf[7], qr[3], C1), P1[14], P1[15], 0.f, 0.f,       pw3[2] = PKW(P1, 12), pw3[3] = PKW(P1, 14), pw3); \
        l_reg += sacc; } while (0)
#define GAPB(i, j, jn, X, XB, DOEX, GL, vp_, kp_, N0, N1, DOSP) do { if ((i) + 1 < 16) { VRD(jn, (i) + 1, vp_); } \
        if ((GL) && ((i) & 1)) { KLD((i) >> 1, kp_); } SBAR(); \
        o[(i) & 3] = ATT_MFMA(PAF_SEL((i) >> 2), VFR(j), o[(i) & 3]); \
        if (DOEX) { X[XB] = EX(X[XB]); X[XB + 1] = EX(X[XB + 1]); PIN(X); } \
        if (DOSP) { N0[(i)] = cfar; N1[(i)] = cfar; } SBAR(); } while (0)
#define PAF_SEL(k) ((k) == 0 ? PAF(0) : (k) == 1 ? PAF(1) : (k) == 2 ? PAF(2) : PAF(3))
#define PHASE_B(C0, C1, DOEX, GL, vp_, kp_, N0, N1, DOSP) do { \
        GAPB(0, 0, 1, C0, 0, DOEX, GL, vp_, kp_, N0, N1, DOSP); GAPB(1, 1, 0, C0, 2, DOEX, GL, vp_, kp_, N0, N1, DOSP); GAPB(2, 0, 1, C0, 4, DOEX, GL, vp_, kp_, N0, N1, DOSP); GAPB(3, 1, 0, C0, 6, DOEX, GL, vp_, kp_, N0, N1, DOSP); \
        GAPB(4, 0, 1, C0, 8, DOEX, GL, vp_, kp_, N0, N1, DOSP); GAPB(5, 1, 0, C0, 10, DOEX, GL, vp_, kp_, N0, N1, DOSP); GAPB(6, 0, 1, C0, 12, DOEX, GL, vp_, kp_, N0, N1, DOSP); GAPB(7, 1, 0, C0, 14, DOEX, GL, vp_, kp_, N0, N1, DOSP); \
        GAPB(8, 0, 1, C1, 0, DOEX, GL, vp_, kp_, N0, N1, DOSP); GAPB(9, 1, 0, C1, 2, DOEX, GL, vp_, kp_, N0, N1, DOSP); GAPB(10, 0, 1, C1, 4, DOEX, GL, vp_, kp_, N0, N1, DOSP); GAPB(11, 1, 0, C1, 6, DOEX, GL, vp_, kp_, N0, N1, DOSP); \
        GAPB(12, 0, 1, C1, 8, DOEX, GL, vp_, kp_, N0, N1, DOSP); GAPB(13, 1, 0, C1, 10, DOEX, GL, vp_, kp_, N0, N1, DOSP); GAPB(14, 0, 1, C1, 12, DOEX, GL, vp_, kp_, N0, N1, DOSP); GAPB(15, 1, 0, C1, 14, DOEX, GL, vp_, kp_, N0, N1, DOSP); \
        } while (0)
#define KSL(t) ((((t) & 3)) * SLOT)
#define DMA_GROUP(t) do { if ((t) + 3 < NT) DMA_K((t) + 3, KSL((t) + 3)); if ((t) + 1 < NT) DMA_V((t) + 1, KSL((t) + 1)); } while (0)
#define STEP(C0, C1, P0, P1, t) do { const lds_cptr vpp = vp0 + KSL((t) - 1); const lds_cptr kpn = kp0 + KSL((t) + 1); \
        PHASE_A(C0, C1, P0, P1, vpp); \
        BANDFIX(C0, C1, t); \
        if (comp == 0) { DMA_GROUP(t); } else { ENDW(t); } \
        SBAR(); \
        PHASE_B(C0, C1, true, true, vpp, kpn, P0, P1, true); PIN(P0); PIN(P1); \
        if (comp == 0) { ENDW(t); } else { DMA_GROUP((t) + 1); } } while (0)
#define PACKSUM(P0, P1) do { float sacc = 0.f; _Pragma("unroll") for (int r = 0; r < 16; ++r) sacc += P0[r] + P1[r]; l_reg += sacc; \
        pw0 = (u32x4){PKW(P0, 0), PKW(P0, 2), PKW(P0, 4), PKW(P0, 6)}; pw1 = (u32x4){PKW(P0, 8), PKW(P0, 10), PKW(P0, 12), PKW(P0, 14)}; \
        pw2 = (u32x4){PKW(P1, 0), PKW(P1, 2), PKW(P1, 4), PKW(P1, 6)}; pw3 = (u32x4){PKW(P1, 8), PKW(P1, 10), PKW(P1, 12), PKW(P1, 14)}; } while (0)

    if (NT > 2) { ATT_WAIT_BAR(4); } else { ATT_WAIT_BAR(2); }
    if (comp != 0) { DMA_GROUP(0); }
    {
#pragma unroll
      for (int f = 0; f < 8; ++f) KLD(f, kp0);
#pragma unroll
      for (int r = 0; r < 16; ++r) { pA0[r] = cfar; pA1[r] = cfar; pB0[r] = cfar; pB1[r] = cfar; }
#pragma unroll
      for (int d0 = 0; d0 < 4; ++d0) { pA0 = ATT_MFMA(kf[2 * d0], qr[d0], pA0); pA1 = ATT_MFMA(kf[2 * d0 + 1], qr[d0], pA1); } }
    SBAR();
    BANDFIX(pA0, pA1, 0);
    if (comp == 0) { DMA_GROUP(0); } else { ENDW(0); }
    {
#pragma unroll
        for (int r = 0; r < 16; ++r) { pA0[r] = EX(pA0[r]); pA1[r] = EX(pA1[r]); }
#pragma unroll
        for (int f = 0; f < 8; ++f) KLD(f, kp0 + KSL(1));
    }
    if (comp == 0) { ENDW(0); } else { DMA_GROUP(1); }
    {
        int t = 1;
        for (; t + 2 < NT; t += 2) { STEP(pB0, pB1, pA0, pA1, t); STEP(pA0, pA1, pB0, pB1, t + 1); }
        STEP(pB0, pB1, pA0, pA1, t);
        PACKSUM(pB0, pB1);
        VRD(0, 0, vp0 + KSL(NT - 1)); SBAR();
        PHASE_B(pA0, pA1, false, false, vp0 + KSL(NT - 1), kp0, pA0, pA1, false);
    }
    float l = l_reg;
    { auto rr = __builtin_amdgcn_permlane32_swap(__float_as_uint(l), __float_as_uint(l), false, false); l = __uint_as_float(rr[0]) + __uint_as_float(rr[1]); }
    if (hi == 0) wsf[32 + r32] = l;
    float rli[16];
#pragma unroll
    for (int r = 0; r < 16; ++r) rli[r] = 1.0f / wsf[32 + crow(r, hi)];
    ATT_LBAR();
    LAS float* xch = (LAS float*)(lds + LDS_XCH) + rg * 4096;
    if (comp == 1) {
#pragma unroll
        for (int d0 = 0; d0 < 4; ++d0)
#pragma unroll
            for (int r = 0; r < 16; ++r) xch[(d0 * 16 + r) * 64 + lane] = o[d0][r] * rli[r] * lam;
    }
    ATT_LBAR();
    if (comp == 0) {
        float ss[16];
#pragma unroll
        for (int r = 0; r < 16; ++r) { float s_ = 0.f;
#pragma unroll
            for (int d0 = 0; d0 < 4; ++d0) { const float v = o[d0][r] * rli[r] - xch[(d0 * 16 + r) * 64 + lane]; o[d0][r] = v; s_ += v * v; }
            ss[r] = s_; }
#pragma unroll
        for (int r = 0; r < 16; ++r) {
            float v = ss[r]; v += pg8::dppf<0xB1>(v); v += pg8::dppf<0x4E>(v); v += pg8::dppf<0x141>(v); v += pg8::dppf<0x140>(v);
            auto sw = __builtin_amdgcn_permlane16_swap(__float_as_uint(v), __float_as_uint(v), false, false); ss[r] = __uint_as_float(sw[0]) + __uint_as_float(sw[1]); }
        LAS bf16* stg = (LAS bf16*)(lds + LDS_OST) + rg * 4096;
        float g4[4];
#pragma unroll
        for (int d0 = 0; d0 < 4; ++d0) g4[d0] = subln_g[d0 * 32 + r32];
#pragma unroll
        for (int r = 0; r < 16; ++r) { const float rs = 0.8f / sqrtf(ss[r] * (1.0f / 128.0f) + 1e-5f); const int orow = crow(r, hi);
#pragma unroll
            for (int d0 = 0; d0 < 4; ++d0) stg[orow * 128 + d0 * 32 + r32] = (bf16)f2bf(o[d0][r] * rs * g4[d0]); }
#pragma unroll
        for (int i = 0; i < 8; ++i) { const int row = i * 4 + (lane >> 4), ch = lane & 15;
            const u32x4 v = *(LAS const u32x4*)(stg + row * 128 + ch * 8);
            st16wt(O + (size_t)(qw0 + row) * 1024 + h * 128 + ch * 8, v); }
    }
    ATT_LBAR();
#undef ATT_RFL
#undef DMA_K
#undef DMA_V
#undef SBAR
#undef PIN
#undef PKW
#undef PAF
#undef EX
#undef ROT3
#undef ENDW
#undef KLD
#undef BANDFIX
#undef VRD
#undef VFR
#undef GAPA
#undef PHASE_A
#undef GAPB
#undef PAF_SEL
#undef PHASE_B
#undef STEP
#undef PACKSUM
#undef KSL
#undef DMA_GROUP
}

__device__ __forceinline__ void attn_phase(int wv, const Args& a, LAS unsigned char* lds, int blk, int G, bf16* Odst) {
    const float* BTAB = (const float*)(a.ws + WS_BTAB);
    const float lam = __builtin_bit_cast(float, __builtin_amdgcn_readfirstlane(__builtin_bit_cast(int, BTAB[8 * 132])));
    const bf16* Q = (const bf16*)(a.ws + WS_A3); const bf16* K = (const bf16*)(a.ws + WS_A4); const bf16* V = (const bf16*)(a.ws + WS_A5);
    const bool snake = (1024 % G) == 0;
    for (int j = 0;; ++j) {
        const int idx = j * G + blk; if (idx >= 1024) break;
        const int rank = (snake && (j & 1)) ? (j * G + (G - 1 - blk)) : idx;
        attn_unit_pipe(wv, rank & 7, 127 - (rank >> 3), Q, K, V, Odst, lds, lam, BTAB, a.in[I_SUBLN_G], (const unsigned*)(a.ws + WS_KMAX));
    }
}
}


__device__ __forceinline__ void peer_convert(int wv, const Args& a, int blk, int G) {
    const int tid = opaque_tid(wv), lane = tid & 63, gw = blk * 8 + (tid >> 6);
    for (int which = 0; which < 2; ++which) {
        const float* src = a.in[which ? I_PEER_V : I_PEER_U]; unsigned* dst = (unsigned*)(a.ws + (which ? WS_PV : WS_PU));
        const size_t nchunk = (size_t)16384 * 1024 / 1024, stride = (size_t)G * 8;
        for (size_t c = gw; c < nchunk; c += 2 * stride) {
            const size_t c1 = c + stride; const bool two = c1 < nchunk;
            f32x4 v[8];
#pragma unroll
            for (int j = 0; j < 4; ++j) v[j] = __builtin_nontemporal_load((const f32x4*)(src + c * 1024 + 256 * j + 4 * lane));
            if (two) {
#pragma unroll
                for (int j = 0; j < 4; ++j) v[4 + j] = __builtin_nontemporal_load((const f32x4*)(src + c1 * 1024 + 256 * j + 4 * lane)); }
#pragma unroll
            for (int j = 0; j < 4; ++j) { const f32x4 x = v[j] * 128.0f; int w = __builtin_amdgcn_cvt_pk_fp8_f32(x[0], x[1], 0, false); w = __builtin_amdgcn_cvt_pk_fp8_f32(x[2], x[3], w, true);
                dst[c * 256 + 64 * j + lane] = (unsigned)w; }
            if (two) {
#pragma unroll
                for (int j = 0; j < 4; ++j) { const f32x4 x = v[4 + j] * 128.0f; int w = __builtin_amdgcn_cvt_pk_fp8_f32(x[0], x[1], 0, false); w = __builtin_amdgcn_cvt_pk_fp8_f32(x[2], x[3], w, true);
                    dst[c1 * 256 + 64 * j + lane] = (unsigned)w; } }
        } }
}
namespace peer {
typedef float f32x2v __attribute__((ext_vector_type(2)));
template <int CTRL> __device__ __forceinline__ float dpp(float x) { return __builtin_bit_cast(float, __builtin_amdgcn_mov_dpp(__builtin_bit_cast(int, x), CTRL, 0xf, 0xf, true)); }
template <int CTRL> __device__ __forceinline__ unsigned dppu(unsigned x) { return (unsigned)__builtin_amdgcn_mov_dpp((int)x, CTRL, 0xf, 0xf, true); }
__device__ __forceinline__ unsigned half32_umax(unsigned m) {
    unsigned t = dppu<0xB1>(m); m = t > m ? t : m; t = dppu<0x4E>(m); m = t > m ? t : m; t = dppu<0x141>(m); m = t > m ? t : m; t = dppu<0x140>(m); m = t > m ? t : m;
    auto s = __builtin_amdgcn_permlane16_swap(m, m, false, false); return s[0] > s[1] ? s[0] : s[1]; }
__device__ __forceinline__ float row16_sum(float x) { x += dpp<0xB1>(x); x += dpp<0x4E>(x); x += dpp<0x141>(x); x += dpp<0x140>(x); return x; }
__device__ __forceinline__ float wsum(float x) {
    x += dpp<0xB1>(x); x += dpp<0x4E>(x); x += dpp<0x141>(x); x += dpp<0x140>(x);
    auto s = __builtin_amdgcn_permlane16_swap(__float_as_uint(x), __float_as_uint(x), false, false); x = __uint_as_float(s[0]) + __uint_as_float(s[1]);
    auto t = __builtin_amdgcn_permlane32_swap(__float_as_uint(x), __float_as_uint(x), false, false); return __uint_as_float(t[0]) + __uint_as_float(t[1]);
}
__device__ __forceinline__ void peer_phase(int wv, const Args& a, int blk, int G, float* OUTP) {
    const int tid = opaque_tid(wv), lane = tid & 63, wave = tid >> 6, hh = lane >> 5, l32 = lane & 31;
    const unsigned* TK = (const unsigned*)(a.ws + WS_TOPK); const unsigned char* PU = (const unsigned char*)(a.ws + WS_PU); const unsigned char* PVt = (const unsigned char*)(a.ws + WS_PV);
    const float* gF = a.in[I_NORM_FFN_G]; const float* gO = a.in[I_FINAL_G];
    int ci0 = 0, cj0 = 0, ci1 = 0, cj1 = 0; bool valid1 = false;
    { int p = 0;
      for (int i = 0; i < 16; ++i) for (int j = 0; j < 16; ++j) if ((i + 1) * (j + 1) <= 16) { if (p == l32) { ci0 = i; cj0 = j; } if (p == l32 + 32) { ci1 = i; cj1 = j; valid1 = true; } ++p; } }
    for (int tok = blk * 8 + wave; tok < S; tok += G * 8) {
        const unsigned short* xrow = (const unsigned short*)(a.ws + WS_A2) + (size_t)tok * D + 16 * lane;
        f32x4 xa[4];
        { const u32x4 r0 = *(const u32x4*)xrow, r1 = *(const u32x4*)(xrow + 8);
          xa[0] = (f32x4){bflo(r0.x), bfhi(r0.x), bflo(r0.y), bfhi(r0.y)}; xa[1] = (f32x4){bflo(r0.z), bfhi(r0.z), bflo(r0.w), bfhi(r0.w)};
          xa[2] = (f32x4){bflo(r1.x), bfhi(r1.x), bflo(r1.y), bfhi(r1.y)}; xa[3] = (f32x4){bflo(r1.z), bfhi(r1.z), bflo(r1.w), bfhi(r1.w)}; }
        unsigned key[4];
#pragma unroll
        for (int i = 0; i < 4; ++i) key[i] = TK[(size_t)tok * 256 + lane + 64 * i];
        float ss = 0.f;
#pragma unroll
        for (int j = 0; j < 4; ++j) ss += (xa[j][0] * xa[j][0] + xa[j][1] * xa[j][1]) + (xa[j][2] * xa[j][2] + xa[j][3] * xa[j][3]);
        ss = wsum(ss);
        const float rstd = 1.0f / sqrtf(ss * (1.0f / D) + 1e-6f);
        float hf[16];
#pragma unroll
        for (int j = 0; j < 4; ++j) { const f32x4 gg = *(const f32x4*)(gF + 16 * lane + 4 * j);
#pragma unroll
            for (int e = 0; e < 4; ++e) hf[4 * j + e] = xa[j][e] * rstd * gg[e]; }
        int ex[4]; float gw[4];
#pragma unroll
        for (int i = 0; i < 4; ++i) {
            const unsigned k = key[i];
            const float v = pg8::ord2f(k & ~0x7Fu); const int ix = 127 - (int)(k & 0x7Fu);
            const float s0 = __shfl(v, hh * 32 + ci0) + __shfl(v, hh * 32 + 16 + cj0);
            const float s1 = __shfl(v, hh * 32 + ci1) + __shfl(v, hh * 32 + 16 + cj1);
            unsigned ck0 = (pg8::f2ord(s0) & ~0xFFu) | (unsigned)(255 - (ci0 * 16 + cj0));
            unsigned ck1 = valid1 ? ((pg8::f2ord(s1) & ~0xFFu) | (unsigned)(255 - (ci1 * 16 + cj1))) : 0u;
            unsigned win = 0u;
#pragma unroll
            for (int r = 0; r < 16; ++r) {
                const unsigned m = half32_umax(ck0 > ck1 ? ck0 : ck1);
                if (l32 == r) win = m;
                if (ck0 == m) ck0 = 0u;
                if (ck1 == m) ck1 = 0u;
            }
            const float ts = pg8::ord2f(win & ~0xFFu); const int flat = 255 - (int)(win & 0xFFu);
            const float mx = __shfl(ts, hh * 32);
            const float e = (l32 < 16) ? __expf(ts - mx) : 0.f;
            const float sum = row16_sum(e);
            gw[i] = e / sum;
            const int e0 = __shfl(ix, hh * 32 + ((flat >> 4) & 15)), e1 = __shfl(ix, hh * 32 + 16 + (flat & 15));
            ex[i] = e0 * 128 + e1;
        }
        float acc[16];
#pragma unroll
        for (int j = 0; j < 16; ++j) acc[j] = 0.f;
#pragma unroll 1
        for (int b = 0; b < 16; ++b) {
            const int i = b >> 2, sl = ((b >> 1) & 1) * 32 + (b & 1) * 8;
            const int exv = i == 0 ? ex[0] : i == 1 ? ex[1] : i == 2 ? ex[2] : ex[3];
            const float gwv = i == 0 ? gw[0] : i == 1 ? gw[1] : i == 2 ? gw[2] : gw[3];
            u32x4 uu[8], vv[8];
#pragma unroll
            for (int q = 0; q < 8; ++q) { const int eid = __builtin_amdgcn_readlane(exv, sl + q); uu[q] = *(const u32x4*)(PU + (size_t)eid * 1024 + 16 * lane); vv[q] = *(const u32x4*)(PVt + (size_t)eid * 1024 + 16 * lane); }
            float d[8];
#pragma unroll
            for (int q = 0; q < 8; ++q) { float s_ = 0.f;
#pragma unroll
                for (int e = 0; e < 4; ++e) { const f32x2v lo = __builtin_amdgcn_cvt_pk_f32_fp8((int)uu[q][e], false), hi2 = __builtin_amdgcn_cvt_pk_f32_fp8((int)uu[q][e], true);
                    s_ += (lo[0] * hf[4 * e] + lo[1] * hf[4 * e + 1]) + (hi2[0] * hf[4 * e + 2] + hi2[1] * hf[4 * e + 3]); }
                d[q] = s_; }
            float z;
            { const bool b0 = lane & 1, b1 = lane & 2, b2 = lane & 4;
              float r4[4], r2[2];
#pragma unroll
              for (int q = 0; q < 4; ++q) { const float keep = b0 ? d[q + 4] : d[q], give = b0 ? d[q] : d[q + 4]; r4[q] = keep + dpp<0xB1>(give); }
#pragma unroll
              for (int q = 0; q < 2; ++q) { const float keep = b1 ? r4[q + 2] : r4[q], give = b1 ? r4[q] : r4[q + 2]; r2[q] = keep + dpp<0x4E>(give); }
              { const float keep = b2 ? r2[1] : r2[0], give = b2 ? r2[0] : r2[1];
                const float up = dpp<0x104>(give), dn = dpp<0x114>(give);
                z = keep + (b2 ? dn : up); }
              z += dpp<0x128>(z);
              auto s16 = __builtin_amdgcn_permlane16_swap(__float_as_uint(z), __float_as_uint(z), false, false); z = __uint_as_float(s16[0]) + __uint_as_float(s16[1]);
              auto s32 = __builtin_amdgcn_permlane32_swap(__float_as_uint(z), __float_as_uint(z), false, false); z = __uint_as_float(s32[0]) + __uint_as_float(s32[1]); }
            const int myq = 4 * (lane & 1) + 2 * ((lane >> 1) & 1) + ((lane >> 2) & 1);
            const float gmine = __shfl(gwv, sl + myq);
            z *= (1.0f / 128.0f);
            const float wl = gmine * 0.5f * z * (1.0f + erff(z * 0.70710678118654752f)) * (1.0f / 128.0f);
#pragma unroll
            for (int q = 0; q < 8; ++q) { const float w = __builtin_bit_cast(float, __builtin_amdgcn_readlane(__builtin_bit_cast(int, wl), ((q >> 2) & 1) | (((q >> 1) & 1) << 1) | ((q & 1) << 2)));
#pragma unroll
                for (int e = 0; e < 4; ++e) { const f32x2v lo = __builtin_amdgcn_cvt_pk_f32_fp8((int)vv[q][e], false), hi2 = __builtin_amdgcn_cvt_pk_f32_fp8((int)vv[q][e], true);
                    acc[4 * e] += w * lo[0]; acc[4 * e + 1] += w * lo[1]; acc[4 * e + 2] += w * hi2[0]; acc[4 * e + 3] += w * hi2[1]; } }
        }
        float s3 = 0.f;
#pragma unroll
        for (int j = 0; j < 4; ++j)
#pragma unroll
            for (int e = 0; e < 4; ++e) { xa[j][e] += acc[4 * j + e]; s3 += xa[j][e] * xa[j][e]; }
        s3 = wsum(s3);
        const float r3 = 1.0f / sqrtf(s3 * (1.0f / D) + 1e-6f);
        float* orow = OUTP + (size_t)tok * D + 16 * lane;
#pragma unroll
        for (int j = 0; j < 4; ++j) { const f32x4 gg = *(const f32x4*)(gO + 16 * lane + 4 * j); *(f32x4*)(orow + 4 * j) = xa[j] * r3 * gg; }
    }
}
}

#define XB_TMO      128
#define XB_XCNT(j)  (256  + 64 * (j))
#define XB_XSUB(j)  (1280 + 64 * (j))
#define XB_XGEN(j)  (2304 + 64 * (j))
#define XB_TOP      3328
#define XB_TOPGEN   3392
#define XCD_BAR_WORDS 3456
#define XB_SPIN_CAP (1u << 18)

__device__ __forceinline__ unsigned xb_ld(unsigned* p)              { return __hip_atomic_load(p, __ATOMIC_RELAXED, __HIP_MEMORY_SCOPE_AGENT); }
__device__ __forceinline__ unsigned xb_add(unsigned* p, unsigned v) { return __hip_atomic_fetch_add(p, v, __ATOMIC_RELAXED, __HIP_MEMORY_SCOPE_AGENT); }
__device__ __forceinline__ unsigned xb_xcc_id() { return (unsigned)__builtin_amdgcn_s_getreg((3 << 11) | 20) & 0xFu; }
#define XB_SPIN(cond, bar) do { unsigned _sp = 0; while (cond) { __builtin_amdgcn_s_sleep(1); \
    if ((++_sp & 255u) == 0u) { if (xb_ld(&(bar)[XB_TMO])) break; if (_sp > XB_SPIN_CAP) { atomicAdd(&(bar)[XB_TMO], 1u); break; } } } } while (0)

struct XcdBarrier {
    unsigned* bar; unsigned x;
    volatile LAS unsigned* st;
};

__device__ __forceinline__ XcdBarrier xcd_barrier_post(unsigned* bar, volatile LAS unsigned* st, int tid) {
    XcdBarrier b; b.bar = bar; b.x = xb_xcc_id(); b.st = st;
    if (tid == 0) (void)xb_add(&bar[XB_XCNT(b.x)], 1u);
    return b;
}
__device__ __forceinline__ void xcd_barrier_complete(unsigned* bar, unsigned x, unsigned& nloc, unsigned& nx) {
    const unsigned G = gridDim.x * gridDim.y * gridDim.z;
    unsigned sum, cnt, mine, sp = 0u;
    for (;;) {
        sum = 0u; cnt = 0u; mine = 0u;
#pragma unroll
        for (unsigned j = 0; j < 16; ++j) { const unsigned c = xb_ld(&bar[XB_XCNT(j)]); sum += c; cnt += (c > 0u) ? 1u : 0u; mine = (j == x) ? c : mine; }
        if (sum == G) break;
        __builtin_amdgcn_s_sleep(1);
        if ((++sp & 255u) == 0u) { if (xb_ld(&bar[XB_TMO])) break; if (sp > XB_SPIN_CAP) { atomicAdd(&bar[XB_TMO], 1u); break; } }
    }
    nloc = mine > 0u ? mine : 1u; nx = cnt > 0u ? cnt : 1u;
}

__device__ __forceinline__ void xcd_barrier(const XcdBarrier& b, int tid) {
    asm volatile("s_waitcnt vmcnt(0)" ::: "memory");
    __syncthreads();
    if (tid == 0) {
        unsigned* bar = b.bar;
        __builtin_amdgcn_s_waitcnt(0);
        unsigned nloc = b.st[0], nx = b.st[1];
        if (nloc == 0u) { xcd_barrier_complete(bar, b.x, nloc, nx); b.st[0] = nloc; b.st[1] = nx; }
        const unsigned old = xb_add(&bar[XB_XSUB(b.x)], 1u);
        const unsigned gen = old / nloc;
        if (old + 1u == (gen + 1u) * nloc) {
            __builtin_amdgcn_fence(__ATOMIC_RELEASE, "agent");
            asm volatile("s_waitcnt vmcnt(0)" ::: "memory");
            const unsigned og = xb_add(&bar[XB_TOP], 1u);
            const unsigned tg = og / nx;
            if (og + 1u == (tg + 1u) * nx) xb_add(&bar[XB_TOPGEN], 1u);
            else XB_SPIN(xb_ld(&bar[XB_TOPGEN]) == tg, bar);
            __builtin_amdgcn_fence(__ATOMIC_ACQUIRE, "agent");
            xb_add(&bar[XB_XGEN(b.x)], 1u);
            asm volatile("s_waitcnt vmcnt(0)" ::: "memory");
        } else {
            XB_SPIN(xb_ld(&bar[XB_XGEN(b.x)]) == gen, bar);
            __builtin_amdgcn_fence(__ATOMIC_ACQUIRE, "agent");
            asm volatile("s_waitcnt vmcnt(0)" ::: "memory");
        }
    }
    __syncthreads();
}

constexpr int LDS_BYTES = 147456, LDS_MISC = 139264;
__global__ void __launch_bounds__(512, 2) mk_fwd(Args a) {
    extern __shared__ __attribute__((aligned(16))) unsigned char lds_raw[];
    LAS unsigned char* lds = (LAS unsigned char*)lds_raw;
    unsigned char* ws = a.ws;
    const int G = gridDim.x, blk = blockIdx.x, wv = __builtin_amdgcn_readfirstlane(threadIdx.x >> 6);
    { const int t0 = opaque_tid(wv); if (t0 < 16) ((volatile LAS unsigned*)(lds + LDS_MISC))[t0] = 0u; }
    __syncthreads();
    XcdBarrier bar = xcd_barrier_post((unsigned*)(ws + WS_CTL), (volatile LAS unsigned*)(lds + LDS_MISC), opaque_tid(wv));
#define IN(k) (a.ph_lo <= (k) && (k) < a.ph_hi)
#define SEAM(k) do { if (IN(k) && IN((k) + 1)) xcd_barrier(bar, opaque_tid(wv)); } while (0)
    if (IN(0)) p0_prologue(wv, a, lds, blk, G);
    SEAM(0);
    if (IN(1)) {
        pg8::Gemm g{(const bf16*)(ws + WS_A0), (const bf16*)(ws + WS_WT_IN), S, NCOLS, D, D, D}; pg8::StaticOrder So; So.init(S, NCOLS, G, blk);
        pg8::EpiProj E{(const float*)(ws + WS_RSTD0), (bf16*)(ws + WS_A1), (bf16*)(ws + WS_A2), (bf16*)(ws + WS_A3), (bf16*)(ws + WS_A4), (bf16*)(ws + WS_A5), (bf16*)(ws + WS_A6), (bf16*)a.out, 0.125f * 1.4426950408889634f, (unsigned*)(ws + WS_KMAX), (PG8_LAS float*)(lds + 131072)};
        pg8::gemm_phase<pg8::EpiProj, pg8::StaticOrder, true, true>(wv, lds, g, So, E);
    }
    SEAM(1);
    if (IN(2)) { conv_phase(wv, a, blk, G);  att::attn_phase(wv, a, lds, blk, G, (bf16*)(ws + WS_A3)); }
    SEAM(2);
    if (IN(3)) {
        pg8::StaticOrder So; So.init(S, D, G, blk);
        { pg8::Gemm g{(const bf16*)(ws + WS_A1), (const bf16*)(ws + WS_WT_CONV), S, D, 2 * D, D, D};
          const pg8::Split sp{16, (long long)WS_A3 - (long long)WS_A1 - 16 * 128, (long long)WS_WT_ATTN - (long long)WS_WT_CONV - 16 * 128};
          pg8::EpiMergeK E{(const bf16*)(ws + WS_A6), (const bf16*)a.out, (bf16*)(ws + WS_A0)};
          pg8::gemm_phase<pg8::EpiMergeK, pg8::StaticOrder, true, true, true>(wv, lds, g, So, E, sp); }
    }
    SEAM(3);
    if (IN(4)) {
        cross_fold(wv, a, blk, G);
        peer_convert(wv, a, blk, G);
        pg8::Gemm g{(const bf16*)(ws + WS_A0), (const bf16*)(ws + WS_WT_MIX), S, D, D, D, D}; pg8::StaticOrder So; So.init(S, D, G, blk);
        pg8::EpiResid E{a.in[I_X], (bf16*)(ws + WS_A2), (float*)(ws + WS_SS1)};
        pg8::gemm_phase<pg8::EpiResid, pg8::StaticOrder, true, true>(wv, lds, g, So, E);
    }
    SEAM(4);
    if (IN(5)) {
        pg8::Gemm g{(const bf16*)(ws + WS_A2), (const bf16*)(ws + WS_WQK), S, D, D, D, D}; pg8::StaticOrder So; So.init(S, D, G, blk);
        pg8::EpiSoftmaxFull E{(const float*)(ws + WS_SS1), (bf16*)(ws + WS_A1), 0.0625f * 1.4426950408889634f};
        pg8::gemm_phase<pg8::EpiSoftmaxFull, pg8::StaticOrder, false, true>(wv, lds, g, So, E);
    }
    SEAM(5);
    if (IN(6)) {
        pg8::Gemm g{(const bf16*)(ws + WS_A1), (const bf16*)(ws + WS_VW), S, D, D, D, D}; pg8::StaticOrder So; So.init(S, D, G, blk);
        pg8::EpiResidB E{(bf16*)(ws + WS_A2), (float*)(ws + WS_SS2)};
        pg8::gemm_phase<pg8::EpiResidB, pg8::StaticOrder, true, true>(wv, lds, g, So, E);
    }
    SEAM(6);
    if (IN(7)) {
        pg8::StaticOrder So; So.init(S, 2048, G, blk);
        unsigned* KS = (unsigned*)(ws + WS_KS) + (size_t)blk * 65536;
        for (int i = 0;; ++i) { pg8::Unit u; if (!So.next(i, u)) break;
            { pg8::Gemm g{(const bf16*)(ws + WS_A2), (const bf16*)(ws + WS_WT_PQ), S, 2048, D, D, D}; pg8::OneUnit S1{u.pm, u.pn};
              pg8::EpiKeys E{(const float*)(ws + WS_SS2), KS};
              pg8::gemm_phase<pg8::EpiKeys, pg8::OneUnit, false, true>(wv, lds, g, S1, E); }
            pg8::topk_from_keys(opaque_tid(wv), KS, (unsigned*)(ws + WS_TOPK), u.pm * 256, u.pn);
            asm volatile("s_waitcnt vmcnt(0)" ::: "memory"); __syncthreads(); }
    }
    SEAM(7);
    if (IN(8)) peer::peer_phase(wv, a, blk, G, a.out);
#undef IN
#undef SEAM
}

extern "C" void kernel_launch(void* const* d_in, const int* in_sizes, int n_in, void* d_out, int out_size, void* d_ws, size_t ws_size, hipStream_t stream) {
    static int grid = 0;
    if (grid == 0) {
        if (ws_size < WS_END || n_in != 25 || out_size != S * D) { fprintf(stderr, "kernel_launch: unexpected ws_size %zu / n_in %d / out_size %d\n", ws_size, n_in, out_size); grid = -1; return; }
        if (hipFuncSetAttribute((const void*)mk_fwd, hipFuncAttributeMaxDynamicSharedMemorySize, LDS_BYTES) != hipSuccess) { fprintf(stderr, "kernel_launch: hipFuncSetAttribute failed\n"); grid = -1; return; }
        int dev = 0, cus = 0, per_cu = 0;
        if (hipGetDevice(&dev) != hipSuccess || hipDeviceGetAttribute(&cus, hipDeviceAttributeMultiprocessorCount, dev) != hipSuccess) { grid = -1; return; }
        if (hipOccupancyMaxActiveBlocksPerMultiprocessor(&per_cu, (const void*)mk_fwd, 512, LDS_BYTES) != hipSuccess || per_cu < 1) { fprintf(stderr, "kernel_launch: occupancy query says %d blocks per CU\n", per_cu); grid = -1; return; }
        grid = cus;
    }
    if (grid < 0) return;
    Args a{};
    for (int i = 0; i < 25; ++i) a.in[i] = (const float*)d_in[i];
    a.out = (float*)d_out; a.ws = (unsigned char*)d_ws; a.ph_lo = 0; a.ph_hi = 9;
    if (hipMemsetAsync(d_ws, 0, 65536, stream) != hipSuccess) { fprintf(stderr, "kernel_launch: hipMemsetAsync failed\n"); return; }
    void* kargs[] = {&a};
    hipError_t e = hipLaunchCooperativeKernel((const void*)mk_fwd, dim3(grid), dim3(512), kargs, LDS_BYTES, stream);
    if (e != hipSuccess) fprintf(stderr, "kernel_launch: cooperative launch failed: %s (grid %d)\n", hipGetErrorString(e), grid);
}
```

```cpp
#include <hip/hip_runtime.h>
#include <math.h>
#include <cstdio>
#include <cstdint>
namespace pg8 {
#define PG8_LAS __attribute__((address_space(3)))
typedef unsigned short bf16_t;
typedef short bf16x8 __attribute__((ext_vector_type(8)));
typedef float f32x4 __attribute__((ext_vector_type(4)));
typedef unsigned u32x4 __attribute__((ext_vector_type(4)));
constexpr int BM = 256, BK = 64, HALF = 128, HTB = HALF * BK * 2  , STAGE_BYTES = 8 * HTB, NXCD = 8, WGM = 8;

__host__ __device__ __forceinline__ int lds_byte(int r, int c) { const int st = (r >> 4) * 2 + (c >> 5), rr = r & 15, cc = c & 31, ob = rr * 64 + cc * 2; return st * 1024 + (ob ^ (((ob >> 9) & 1) << 5)); }
__host__ __device__ __forceinline__ void stage_rc(int b, int& R, int& C) { const int st = b / 1024, sb = b % 1024, swz = sb ^ (((sb >> 9) & 1) << 5); R = (st >> 1) * 16 + swz / 64; C = (st & 1) * 32 + (swz % 64) / 2; }
__host__ __device__ __forceinline__ int perm32(int rho) { const int n = rho >> 4, i = rho & 15; return 8 * (i >> 2) + 4 * n + (i & 3); }

struct Unit { int pm, pn; };
struct Gemm { const bf16_t* A; const bf16_t* Bt; int M, N, K, lda, ldb; };
struct Split { int ksplit; long long dA2, dB2; };

struct StaticOrder {
    int nM, nN, nwg, G, c;
    __host__ __device__ void init(int M, int N, int G_, int c_) { nM = M / BM; nN = N / BM; nwg = nM * nN; G = G_; c = c_; }
    __host__ __device__ bool next(int i, Unit& u) const {
        const long L = (long)i * G + c; if (L >= nwg) return false;
        int wgid = (int)L; { const int q = nwg / NXCD, r = nwg % NXCD, xcd = wgid % NXCD, off = wgid / NXCD; wgid = (xcd < r ? xcd * (q + 1) : r * (q + 1) + (xcd - r) * q) + off; }
        const int nig = WGM * nN, gid = wgid / nig, fm = gid * WGM, gsz = (nM - fm) < WGM ? (nM - fm) : WGM;
        u.pm = fm + ((wgid % nig) % gsz); u.pn = (wgid % nig) / gsz; return true;
    }
    __device__ __forceinline__ void a_ready(const Unit&) const {}
    __device__ __forceinline__ void done(const Unit&) const {}
};

typedef float f32x2 __attribute__((ext_vector_type(2)));
typedef __bf16 bf16x2v __attribute__((ext_vector_type(2)));
__device__ __forceinline__ unsigned cvt_pk_bf16(float lo, float hi) { const f32x2 v = {lo, hi}; const bf16x2v b = __builtin_convertvector(v, bf16x2v); return __builtin_bit_cast(unsigned, b); }
template <class E, class = void> struct HasPrefetch { static constexpr bool value = false; };
template <class E> struct HasPrefetch<E, decltype((void)&E::prefetch)> { static constexpr bool value = true; };
template <class Epi, class Sched, bool ALIGN_EPI = false, bool SP2 = false, bool SPLIT = false>
__device__ __forceinline__ void gemm_phase(int wv, PG8_LAS unsigned char* lds, const Gemm g, const Sched& S, const Epi& E, const Split sp = Split{0, 0, 0}) {
    int tid_; asm volatile("v_mbcnt_lo_u32_b32 %0, -1, 0\n\tv_mbcnt_hi_u32_b32 %0, -1, %0" : "=v"(tid_)); tid_ += wv * 64;
    const int tid = tid_, wid = __builtin_amdgcn_readfirstlane(tid >> 6), lane = tid & 63, wr = wid >> 2, wc = wid & 3, fr = lane & 15, fq = lane >> 4;
    const int K = g.K, nt = K / BK;
    unsigned voffA[2], voffB[2];
#pragma unroll
    for (int i = 0; i < 2; ++i) { int R, C; stage_rc(tid * 16 + i * 8192, R, C); const int Rb = Epi::PERM ? ((R & ~31) + perm32(R & 31)) : R;
        voffA[i] = (unsigned)(R * g.lda + C) * 2u; voffB[i] = (unsigned)(Rb * g.ldb + C) * 2u; }
    const size_t kstep = (size_t)(BK * 2);
    const size_t hstepA = (size_t)HALF * g.lda * 2, hstepB = (size_t)HALF * g.ldb * 2;
    const size_t tstepA = 2 * hstepA, tstepB = 2 * hstepB;
    const unsigned ldsw = (unsigned)wid * 1024u;
    const int aoff = lds_byte(wr * 64 + fr, fq * 8), boff = lds_byte(wc * 32 + fr, fq * 8);
#define PG8_SA(b, h) (((b) * 2 + (h)) * HTB)
#define PG8_SB(b, h) ((4 + (b) * 2 + (h)) * HTB)
#define PG8_STAGE(bufoff, gbase, voff) do { _Pragma("unroll") for (int _i = 0; _i < 2; ++_i) \
        __builtin_amdgcn_global_load_lds((const unsigned*)((const char*)(gbase) + (voff)[_i]), (PG8_LAS unsigned*)(lds + (bufoff) + ldsw + _i * 8192), 16, 0, 0); } while (0)
#define PG8_LDA(dst, b, h) do { _Pragma("unroll") for (int m = 0; m < 4; ++m) _Pragma("unroll") for (int k = 0; k < 2; ++k) dst[m][k] = *(const PG8_LAS bf16x8*)(lds + PG8_SA(b, h) + aoff + m * 2048 + k * 1024); } while (0)
#define PG8_LDB(dst, b, h) do { _Pragma("unroll") for (int n = 0; n < 2; ++n) _Pragma("unroll") for (int k = 0; k < 2; ++k) dst[n][k] = *(const PG8_LAS bf16x8*)(lds + PG8_SB(b, h) + boff + n * 2048 + k * 1024); } while (0)
#define PG8_MMA(ai, bj, At, Bt) do { __builtin_amdgcn_s_setprio(1); _Pragma("unroll") for (int m = 0; m < 4; ++m) _Pragma("unroll") for (int n = 0; n < 2; ++n) _Pragma("unroll") for (int k = 0; k < 2; ++k) \
        acc[ai][bj][m][n] = __builtin_amdgcn_mfma_f32_16x16x32_bf16(Bt[n][k], At[m][k], acc[ai][bj][m][n], 0, 0, 0); __builtin_amdgcn_s_setprio(0); } while (0)
#define PG8_WAIT_V(n) asm volatile("s_waitcnt vmcnt(" #n ")" ::: "memory")
#define PG8_WAIT_L(n) asm volatile("s_waitcnt lgkmcnt(" #n ")" ::: "memory")
#define PG8_BAR __builtin_amdgcn_s_barrier()
#define PG8_SCHED __builtin_amdgcn_sched_barrier(0)
    Unit cur, nxt; int ui = 0;
    if (!S.next(0, cur)) return;
    f32x4 acc[2][2][4][2];
#pragma unroll
    for (int a = 0; a < 2; ++a)
#pragma unroll
        for (int b = 0; b < 2; ++b)
#pragma unroll
            for (int m = 0; m < 4; ++m)
#pragma unroll
                for (int n = 0; n < 2; ++n) acc[a][b][m][n] = (f32x4){0.f, 0.f, 0.f, 0.f};
    bf16x8 At[4][2], B0[2][2], B1[2][2];
    const char* cA = (const char*)g.A + (size_t)cur.pm * tstepA; const char* cB = (const char*)g.Bt + (size_t)cur.pn * tstepB;
    S.a_ready(cur);
    if constexpr (HasPrefetch<Epi>::value) E.prefetch(cur, lds, wid);
    if constexpr (SP2) {
        PG8_STAGE(PG8_SB(0, 0), cB, voffB); PG8_STAGE(PG8_SB(0, 1), cB + hstepB, voffB); PG8_STAGE(PG8_SA(0, 0), cA, voffA); PG8_STAGE(PG8_SA(0, 1), cA + hstepA, voffA);
        if (wr == 1) PG8_BAR;
        PG8_WAIT_V(2); PG8_BAR;
        PG8_STAGE(PG8_SB(1, 0), cB + kstep, voffB); PG8_STAGE(PG8_SA(1, 0), cA + kstep, voffA); PG8_STAGE(PG8_SB(1, 1), cB + hstepB + kstep, voffB);
        PG8_WAIT_V(6); PG8_BAR;
    } else {
        PG8_STAGE(PG8_SB(0, 0), cB, voffB); PG8_STAGE(PG8_SA(0, 0), cA, voffA); PG8_STAGE(PG8_SB(0, 1), cB + hstepB, voffB); PG8_STAGE(PG8_SA(0, 1), cA + hstepA, voffA);
        if (wr == 1) PG8_BAR;
        PG8_WAIT_V(4); PG8_BAR;
        PG8_STAGE(PG8_SB(1, 0), cB + kstep, voffB); PG8_STAGE(PG8_SA(1, 0), cA + kstep, voffA); PG8_STAGE(PG8_SB(1, 1), cB + hstepB + kstep, voffB);
        PG8_WAIT_V(6); PG8_BAR;
    }
    for (;;) {
        const bool has_next = S.next(ui + 1, nxt);
        const char* nA = has_next ? (const char*)g.A + (size_t)nxt.pm * tstepA : cA; const char* nB = has_next ? (const char*)g.Bt + (size_t)nxt.pn * tstepB : cB;
        for (int t = 0; t < nt; t += 2) {
            const bool last = (t == nt - 2);
            long long oa1 = 0, oa2 = 0, ob2 = 0;
            if constexpr (SPLIT) { if (t == sp.ksplit) E.mid(acc, cur, wr, wc, fr, fq);
                if (t >= sp.ksplit) oa1 = sp.dA2; if (t + 2 >= sp.ksplit) { oa2 = sp.dA2; ob2 = sp.dB2; } }
            const char* a1 = cA + (size_t)(t + 1) * kstep + oa1;
            const char* a2 = last ? nA : cA + (size_t)(t + 2) * kstep + oa2; const char* b2 = last ? nB : cB + (size_t)(t + 2) * kstep + ob2;
            const char* a3 = a2 + kstep; const char* b3 = b2 + kstep;
            if (last && has_next) S.a_ready(nxt);
            if constexpr (SP2) {
            PG8_LDB(B0, 0, 0); PG8_LDB(B1, 0, 1); PG8_SCHED; PG8_LDA(At, 0, 0); PG8_STAGE(PG8_SA(1, 1), a1 + hstepA, voffA);
            PG8_WAIT_V(8); PG8_WAIT_L(0); PG8_BAR; PG8_MMA(0, 0, At, B0); PG8_MMA(0, 1, At, B1); PG8_BAR; PG8_SCHED;
            PG8_LDA(At, 0, 1); PG8_STAGE(PG8_SB(0, 0), b2, voffB); PG8_STAGE(PG8_SB(0, 1), b2 + hstepB, voffB); PG8_STAGE(PG8_SA(0, 0), a2, voffA);
            PG8_WAIT_V(8); PG8_WAIT_L(0); PG8_BAR; PG8_MMA(1, 0, At, B0); PG8_MMA(1, 1, At, B1); PG8_BAR; PG8_SCHED;
            PG8_LDB(B0, 1, 0); PG8_LDB(B1, 1, 1); PG8_SCHED; PG8_LDA(At, 1, 0); PG8_STAGE(PG8_SA(0, 1), a2 + hstepA, voffA);
            PG8_WAIT_V(8); PG8_WAIT_L(0); PG8_BAR; PG8_MMA(0, 0, At, B0); PG8_MMA(0, 1, At, B1); PG8_BAR; PG8_SCHED;
            PG8_LDA(At, 1, 1); PG8_STAGE(PG8_SB(1, 0), b3, voffB); PG8_STAGE(PG8_SB(1, 1), b3 + hstepB, voffB); PG8_STAGE(PG8_SA(1, 0), a3, voffA);
            PG8_WAIT_V(8); PG8_WAIT_L(0); PG8_BAR; PG8_MMA(1, 0, At, B0); PG8_MMA(1, 1, At, B1); PG8_BAR; PG8_SCHED;
            } else {
            PG8_LDB(B0, 0, 0); PG8_SCHED; PG8_LDA(At, 0, 0); PG8_STAGE(PG8_SA(1, 1), a1 + hstepA, voffA);
            PG8_WAIT_L(8); PG8_BAR; PG8_WAIT_L(0); PG8_MMA(0, 0, At, B0); PG8_BAR; PG8_SCHED;
            PG8_LDB(B1, 0, 1); PG8_STAGE(PG8_SB(0, 0), b2, voffB);
            PG8_BAR; PG8_WAIT_L(0); PG8_MMA(0, 1, At, B1); PG8_BAR;
            PG8_LDA(At, 0, 1); PG8_STAGE(PG8_SA(0, 0), a2, voffA);
            PG8_BAR; PG8_WAIT_L(0); PG8_MMA(1, 0, At, B0); PG8_BAR; PG8_SCHED;
            PG8_STAGE(PG8_SB(0, 1), b2 + hstepB, voffB);
            PG8_WAIT_V(6); PG8_BAR; PG8_MMA(1, 1, At, B1); PG8_BAR;
            PG8_LDB(B0, 1, 0); PG8_SCHED; PG8_LDA(At, 1, 0); PG8_STAGE(PG8_SA(0, 1), a2 + hstepA, voffA);
            PG8_WAIT_L(8); PG8_BAR; PG8_WAIT_L(0); PG8_MMA(0, 0, At, B0); PG8_BAR; PG8_SCHED;
            PG8_LDB(B1, 1, 1); PG8_STAGE(PG8_SB(1, 0), b3, voffB);
            PG8_BAR; PG8_WAIT_L(0); PG8_MMA(0, 1, At, B1); PG8_BAR;
            PG8_LDA(At, 1, 1); PG8_STAGE(PG8_SA(1, 0), a3, voffA);
            PG8_BAR; PG8_WAIT_L(0); PG8_MMA(1, 0, At, B0); PG8_BAR; PG8_SCHED;
            PG8_STAGE(PG8_SB(1, 1), b3 + hstepB, voffB);
            PG8_WAIT_V(6); PG8_BAR; PG8_MMA(1, 1, At, B1); PG8_BAR;
            }
        }
        if constexpr (ALIGN_EPI) { if (wr == 0) PG8_BAR; }
        if constexpr (!Epi::AFTER_DRAIN) { E(acc, cur, wr, wc, fr, fq); S.done(cur); }
        if (!has_next) break;
#pragma unroll
        for (int a = 0; a < 2; ++a)
#pragma unroll
            for (int b = 0; b < 2; ++b)
#pragma unroll
                for (int m = 0; m < 4; ++m)
#pragma unroll
                    for (int n = 0; n < 2; ++n) acc[a][b][m][n] = (f32x4){0.f, 0.f, 0.f, 0.f};
        cur = nxt; cA = nA; cB = nB; ++ui;
        if constexpr (HasPrefetch<Epi>::value) E.prefetch(cur, lds, wid);
        if constexpr (ALIGN_EPI) { if (wr == 1) PG8_BAR; }
    }
    PG8_WAIT_V(0);
    if constexpr (!ALIGN_EPI) { if (wr == 0) PG8_BAR; }
    PG8_BAR;
    if constexpr (Epi::AFTER_DRAIN) { E.fused(acc, cur, wr, wc, fr, fq, lds, wid, lane); S.done(cur); }
#undef PG8_SA
#undef PG8_SB
#undef PG8_STAGE
#undef PG8_LDA
#undef PG8_LDB
#undef PG8_MMA
#undef PG8_WAIT_V
#undef PG8_WAIT_L
#undef PG8_BAR
#undef PG8_SCHED
}
}


constexpr int S = 16384, D = 1024, NCOLS = 8192, MEMN = 256;
typedef unsigned short bf16;
typedef float f32x4 __attribute__((ext_vector_type(4)));
typedef unsigned u32x4 __attribute__((ext_vector_type(4)));
typedef unsigned u32x2 __attribute__((ext_vector_type(2)));
__device__ __forceinline__ void st16wt(void* p, u32x4 v) { asm volatile("global_store_dwordx4 %0, %1, off sc1\n\ts_nop 1" :: "v"(p), "v"(v) : "memory"); }
#define LAS __attribute__((address_space(3)))

__device__ const unsigned char T5_BUCKET[128] = {0, 1, 2, 3, 4, 5, 6, 7, 8, 9, 10, 11, 12, 13, 14, 15, 16, 16, 16, 17, 17, 18, 18, 18, 19, 19, 19, 20, 20, 20, 20, 21, 21, 21, 21, 22, 22, 22, 22, 22, 23, 23, 23, 23, 23, 23, 24, 24, 24, 24, 24, 24, 25, 25, 25, 25, 25, 25, 25, 26, 26, 26, 26, 26, 26, 26, 26, 27, 27, 27, 27, 27, 27, 27, 27, 27, 27, 28, 28, 28, 28, 28, 28, 28, 28, 28, 28, 29, 29, 29, 29, 29, 29, 29, 29, 29, 29, 29, 29, 30, 30, 30, 30, 30, 30, 30, 30, 30, 30, 30, 30, 30, 30, 31, 31, 31, 31, 31, 31, 31, 31, 31, 31, 31, 31, 31, 31, 31};

constexpr size_t MiB = 1u << 20;
constexpr size_t WS_CTL = 0, WS_KMAX = 32768  , WS_RSTD0 = 512 * 1024;
constexpr size_t WS_WT_IN = 1 * MiB, WS_WT_CONV = 17 * MiB, WS_WT_ATTN = 19 * MiB, WS_WT_MIX = 21 * MiB, WS_WT_CQ = 23 * MiB, WS_WT_CO = 25 * MiB, WS_WT_PQ = 27 * MiB;
constexpr size_t WS_SUBK = 31 * MiB, WS_KV = 32 * MiB, WS_SS1 = 34 * MiB, WS_SS2 = 35 * MiB;
constexpr size_t WS_TOPK = 36 * MiB  , WS_PU = 196 * MiB  , WS_PV = 228 * MiB  ;
constexpr size_t WS_WQK = 23 * MiB  , WS_VW = 212 * MiB  ;
constexpr size_t WS_BTAB = 640 * 1024  ;
constexpr size_t WS_PQS = 52 * MiB  , WS_KS = 132 * MiB  ;
constexpr size_t WS_A0 = 36 * MiB, WS_A1 = 68 * MiB, WS_A2 = 100 * MiB, WS_A3 = 132 * MiB, WS_A4 = 164 * MiB, WS_A5 = 196 * MiB, WS_A6 = 228 * MiB, WS_END = 260 * MiB;

__device__ __forceinline__ float wave_sum(float v) {
#pragma unroll
    for (int o = 1; o < 64; o <<= 1) v += __shfl_xor(v, o);
    return v;
}
__device__ __forceinline__ float wave_max(float v) {
#pragma unroll
    for (int o = 1; o < 64; o <<= 1) v = fmaxf(v, __shfl_xor(v, o));
    return v;
}
__device__ __forceinline__ int opaque_tid(int wv) { int t; asm volatile("v_mbcnt_lo_u32_b32 %0, -1, 0\n\tv_mbcnt_hi_u32_b32 %0, -1, %0" : "=v"(t)); return t + wv * 64; }
__device__ __forceinline__ unsigned f2bf(float f) { unsigned u = __builtin_bit_cast(unsigned, f); return (u + 0x7fffu + ((u >> 16) & 1u)) >> 16; }
__device__ __forceinline__ unsigned pk2(float lo, float hi) { return pg8::cvt_pk_bf16(lo, hi); }
__device__ __forceinline__ float bflo(unsigned w) { return __builtin_bit_cast(float, w << 16); }
__device__ __forceinline__ float bfhi(unsigned w) { return __builtin_bit_cast(float, w & 0xffff0000u); }
__device__ __forceinline__ float sigmoidf_(float x) { return __builtin_amdgcn_rcpf(1.0f + __builtin_amdgcn_exp2f(x * -1.4426950408889634f)); }

struct Args { const float* in[25]; float* out; unsigned char* ws; int ph_lo, ph_hi; };
enum { I_X = 0, I_MEM, I_NORM_MIX_G, I_W_IN, I_CONV_W, I_W_CONV_OUT, I_LQ1, I_LK1, I_LQ2, I_LK2, I_SUBLN_G, I_W_ATTN_OUT, I_W_MIX_OUT, I_REL_BIAS, I_NORM_CROSS_G, I_NORM_MEM_G,
       I_W_CQ, I_W_CKV, I_W_CO, I_NORM_FFN_G, I_W_PQ, I_SUB_KEYS, I_PEER_U, I_PEER_V, I_FINAL_G };

namespace pg8 {
template <int CTRL> __device__ __forceinline__ float dppf(float x) { return __builtin_bit_cast(float, __builtin_amdgcn_mov_dpp(__builtin_bit_cast(int, x), CTRL, 0xf, 0xf, true)); }
__device__ __forceinline__ float row16_max(float v) { v = fmaxf(v, dppf<0xB1>(v)); v = fmaxf(v, dppf<0x4E>(v)); v = fmaxf(v, dppf<0x141>(v)); return fmaxf(v, dppf<0x140>(v)); }
__device__ __forceinline__ float xrow16_max(float x) {
    auto s = __builtin_amdgcn_permlane16_swap(__float_as_uint(x), __float_as_uint(x), false, false); x = fmaxf(__uint_as_float(s[0]), __uint_as_float(s[1]));
    auto t = __builtin_amdgcn_permlane32_swap(__float_as_uint(x), __float_as_uint(x), false, false); return fmaxf(__uint_as_float(t[0]), __uint_as_float(t[1])); }
__device__ __forceinline__ float xrow16_sum(float x) {
    auto s = __builtin_amdgcn_permlane16_swap(__float_as_uint(x), __float_as_uint(x), false, false); x = __uint_as_float(s[0]) + __uint_as_float(s[1]);
    auto t = __builtin_amdgcn_permlane32_swap(__float_as_uint(x), __float_as_uint(x), false, false); return __uint_as_float(t[0]) + __uint_as_float(t[1]); }
__device__ __forceinline__ u32x4 pack8(const f32x4& v0, const f32x4& v1) { u32x4 w; w.x = cvt_pk_bf16(v0[0], v0[1]); w.y = cvt_pk_bf16(v0[2], v0[3]); w.z = cvt_pk_bf16(v1[0], v1[1]); w.w = cvt_pk_bf16(v1[2], v1[3]); return w; }
struct EpiProj {
    static constexpr bool PERM = true, AFTER_DRAIN = false;
    const float* rstd_g; bf16_t *CB, *U, *Q, *K, *V, *SGC, *SGA; float qscale; unsigned* KMAX; PG8_LAS float* rl;
    __device__ __forceinline__ void prefetch(const Unit& u, PG8_LAS unsigned char* lds, int wid) const {
        if (wid == 0) { int ln; asm volatile("v_mbcnt_lo_u32_b32 %0, -1, 0\n\tv_mbcnt_hi_u32_b32 %0, -1, %0" : "=v"(ln));
            __builtin_amdgcn_global_load_lds((const unsigned*)(rstd_g + u.pm * BM + ln * 4), (PG8_LAS unsigned*)rl, 16, 0, 0); }
    }
    __device__ __forceinline__ void operator()(const f32x4 (&acc)[2][2][4][2], const Unit& u, int wr, int wc, int fr0, int fq) const {
        int fr = fr0; asm volatile("" : "+v"(fr));
        const int row0 = u.pm * BM + wr * 64 + fr, pn = u.pn, colw = wc * 32 + 8 * fq;
        const PG8_LAS float* rstd = rl - u.pm * BM;
        if (pn >= 4 && pn < 12) {
            const int col = 128 * (pn - 4) + colw;
#pragma unroll
            for (int ai = 0; ai < 2; ++ai)
#pragma unroll
                for (int m = 0; m < 4; ++m) { const int row = row0 + ai * HALF + m * 16; const float rs = rstd[row], r2 = rs * rs;
                    const f32x4 v0 = acc[ai][0][m][0] * acc[ai][1][m][0] * r2, v1 = acc[ai][0][m][1] * acc[ai][1][m][1] * r2;
                    *(u32x4*)(U + (size_t)row * 1024 + col) = pack8(v0, v1); }
            return;
        }
        bf16_t* base; int cbase; float sc = 1.f; bool gate = false;
        if (pn < 4) { base = CB; cbase = pn * 256; }
        else if (pn < 16) { base = Q; cbase = (pn - 12) * 256; sc = qscale; }
        else if (pn < 20) { base = K; cbase = (pn - 16) * 256; }
        else if (pn < 24) { base = V; cbase = (pn - 20) * 256; }
        else if (pn < 28) { base = SGC; cbase = (pn - 24) * 256; gate = true; }
        else { base = SGA; cbase = (pn - 28) * 256; gate = true; }
#pragma unroll
        for (int ai = 0; ai < 2; ++ai)
#pragma unroll
            for (int m = 0; m < 4; ++m) { const int row = row0 + ai * HALF + m * 16; const float rs = rstd[row] * sc;
#pragma unroll
                for (int bj = 0; bj < 2; ++bj) { f32x4 v0 = acc[ai][bj][m][0] * rs, v1 = acc[ai][bj][m][1] * rs;
                    if (gate) {
#pragma unroll
                        for (int e = 0; e < 4; ++e) { v0[e] = sigmoidf_(v0[e]); v1[e] = sigmoidf_(v1[e]); } }
                    *(u32x4*)(base + (size_t)row * 1024 + cbase + bj * HALF + colw) = pack8(v0, v1); } }
        if (pn >= 16 && pn < 20) {
            float mx[2] = {0.f, 0.f};
#pragma unroll
            for (int ai = 0; ai < 2; ++ai)
#pragma unroll
                for (int m = 0; m < 4; ++m) { const float rs = rstd[row0 + ai * HALF + m * 16];
#pragma unroll
                    for (int bj = 0; bj < 2; ++bj) { const f32x4 v0 = acc[ai][bj][m][0] * rs, v1 = acc[ai][bj][m][1] * rs;
                        const float s = xrow16_sum(((v0[0] * v0[0] + v0[1] * v0[1]) + (v0[2] * v0[2] + v0[3] * v0[3])) + ((v1[0] * v1[0] + v1[1] * v1[1]) + (v1[2] * v1[2] + v1[3] * v1[3])));
                        mx[bj] = fmaxf(mx[bj], s); } }
#pragma unroll
            for (int bj = 0; bj < 2; ++bj) { float v = mx[bj];
                v = row16_max(v);
                if (fr == 0 && fq == 0) atomicMax(KMAX + (((pn - 16) * 2 + bj) * 2 + (wc >> 1)) * 2 + (wc & 1), __float_as_uint(v)); }
        }
    }
};
struct EpiGateT {
    static constexpr bool PERM = true, AFTER_DRAIN = false;
    const bf16_t* SG; float* T;
    __device__ __forceinline__ void operator()(const f32x4 (&acc)[2][2][4][2], const Unit& u, int wr, int wc, int fr0, int fq) const {
        int fr = fr0; asm volatile("" : "+v"(fr));
        const int row0 = u.pm * BM + wr * 64 + fr, col0 = u.pn * BM + wc * 32 + 8 * fq;
#pragma unroll
        for (int ai = 0; ai < 2; ++ai)
#pragma unroll
            for (int m = 0; m < 4; ++m) { const size_t off = (size_t)(row0 + ai * HALF + m * 16) * 1024 + col0;
#pragma unroll
                for (int bj = 0; bj < 2; ++bj) { const u32x4 g = *(const u32x4*)(SG + off + bj * HALF);
                    f32x4 g0 = {bflo(g.x), bfhi(g.x), bflo(g.y), bfhi(g.y)}, g1 = {bflo(g.z), bfhi(g.z), bflo(g.w), bfhi(g.w)};
                    *(f32x4*)(T + off + bj * HALF) = g0 * acc[ai][bj][m][0]; *(f32x4*)(T + off + bj * HALF + 4) = g1 * acc[ai][bj][m][1]; } }
    }
};
struct EpiMerge {
    static constexpr bool PERM = true, AFTER_DRAIN = false;
    const float* T; const bf16_t* SG; bf16_t* O;
    __device__ __forceinline__ void operator()(const f32x4 (&acc)[2][2][4][2], const Unit& u, int wr, int wc, int fr0, int fq) const {
        int fr = fr0; asm volatile("" : "+v"(fr));
        const int row0 = u.pm * BM + wr * 64 + fr, col0 = u.pn * BM + wc * 32 + 8 * fq;
#pragma unroll
        for (int ai = 0; ai < 2; ++ai)
#pragma unroll
            for (int m = 0; m < 4; ++m) { const size_t off = (size_t)(row0 + ai * HALF + m * 16) * 1024 + col0;
#pragma unroll
                for (int bj = 0; bj < 2; ++bj) { const u32x4 g = *(const u32x4*)(SG + off + bj * HALF);
                    f32x4 g0 = {bflo(g.x), bfhi(g.x), bflo(g.y), bfhi(g.y)}, g1 = {bflo(g.z), bfhi(g.z), bflo(g.w), bfhi(g.w)};
                    const f32x4 t0 = *(const f32x4*)(T + off + bj * HALF), t1 = *(const f32x4*)(T + off + bj * HALF + 4);
                    *(u32x4*)(O + off + bj * HALF) = pack8(t0 + g0 * acc[ai][bj][m][0], t1 + g1 * acc[ai][bj][m][1]); } }
    }
};
struct EpiMergeK {
    static constexpr bool PERM = true, AFTER_DRAIN = false;
    const bf16_t* SGc; const bf16_t* SGa; bf16_t* O;
    __device__ __forceinline__ void mid(f32x4 (&acc)[2][2][4][2], const Unit& u, int wr, int wc, int fr0, int fq) const {
        int fr = fr0; asm volatile("" : "+v"(fr));
        const int row0 = u.pm * BM + wr * 64 + fr, col0 = u.pn * BM + wc * 32 + 8 * fq;
#pragma unroll
        for (int ai = 0; ai < 2; ++ai)
#pragma unroll
            for (int m = 0; m < 4; ++m) { const size_t off = (size_t)(row0 + ai * HALF + m * 16) * 1024 + col0;
#pragma unroll
                for (int bj = 0; bj < 2; ++bj) { const u32x4 c = *(const u32x4*)(SGc + off + bj * HALF), g = *(const u32x4*)(SGa + off + bj * HALF);
                    const f32x4 c0 = {bflo(c.x), bfhi(c.x), bflo(c.y), bfhi(c.y)}, c1 = {bflo(c.z), bfhi(c.z), bflo(c.w), bfhi(c.w)};
                    f32x4 g0 = {bflo(g.x), bfhi(g.x), bflo(g.y), bfhi(g.y)}, g1 = {bflo(g.z), bfhi(g.z), bflo(g.w), bfhi(g.w)};
#pragma unroll
                    for (int e = 0; e < 4; ++e) { g0[e] = c0[e] * __builtin_amdgcn_rcpf(fmaxf(g0[e], 1e-20f)); g1[e] = c1[e] * __builtin_amdgcn_rcpf(fmaxf(g1[e], 1e-20f)); }
                    acc[ai][bj][m][0] *= g0; acc[ai][bj][m][1] *= g1; } }
    }
    __device__ __forceinline__ void operator()(const f32x4 (&acc)[2][2][4][2], const Unit& u, int wr, int wc, int fr0, int fq) const {
        int fr = fr0; asm volatile("" : "+v"(fr));
        const int row0 = u.pm * BM + wr * 64 + fr, col0 = u.pn * BM + wc * 32 + 8 * fq;
#pragma unroll
        for (int ai = 0; ai < 2; ++ai)
#pragma unroll
            for (int m = 0; m < 4; ++m) { const size_t off = (size_t)(row0 + ai * HALF + m * 16) * 1024 + col0;
#pragma unroll
                for (int bj = 0; bj < 2; ++bj) { const u32x4 g = *(const u32x4*)(SGa + off + bj * HALF);
                    f32x4 g0 = {bflo(g.x), bfhi(g.x), bflo(g.y), bfhi(g.y)}, g1 = {bflo(g.z), bfhi(g.z), bflo(g.w), bfhi(g.w)};
#pragma unroll
                    for (int e = 0; e < 4; ++e) { g0[e] = fmaxf(g0[e], 1e-20f); g1[e] = fmaxf(g1[e], 1e-20f); }
                    st16wt(O + off + bj * HALF, pack8(g0 * acc[ai][bj][m][0], g1 * acc[ai][bj][m][1])); } }
    }
};
struct EpiResid {
    static constexpr bool PERM = true, AFTER_DRAIN = false;
    const float* R; bf16_t* XB; float* SS;
    __device__ __forceinline__ void operator()(const f32x4 (&acc)[2][2][4][2], const Unit& u, int wr, int wc, int fr0, int fq) const {
        int fr = fr0; asm volatile("" : "+v"(fr));
        const int row0 = u.pm * BM + wr * 64 + fr, col0 = u.pn * BM + wc * 32 + 8 * fq;
#pragma unroll
        for (int ai = 0; ai < 2; ++ai)
#pragma unroll
            for (int m = 0; m < 4; ++m) { const int row = row0 + ai * HALF + m * 16; const size_t off = (size_t)row * 1024 + col0; float ss = 0.f;
#pragma unroll
                for (int bj = 0; bj < 2; ++bj) {
                    const f32x4 x0 = *(const f32x4*)(R + off + bj * HALF) + acc[ai][bj][m][0], x1 = *(const f32x4*)(R + off + bj * HALF + 4) + acc[ai][bj][m][1];
                    st16wt(XB + off + bj * HALF, pack8(x0, x1));
                    ss += (x0[0] * x0[0] + x0[1] * x0[1]) + (x0[2] * x0[2] + x0[3] * x0[3]) + (x1[0] * x1[0] + x1[1] * x1[1]) + (x1[2] * x1[2] + x1[3] * x1[3]); }
                ss = xrow16_sum(ss);
                if (fq == 0) SS[(size_t)row * 16 + u.pn * 4 + wc] = ss; }
    }
};
struct EpiResidB {
    static constexpr bool PERM = true, AFTER_DRAIN = false;
    bf16_t* XB; float* SS;
    __device__ __forceinline__ void operator()(const f32x4 (&acc)[2][2][4][2], const Unit& u, int wr, int wc, int fr0, int fq) const {
        int fr = fr0; asm volatile("" : "+v"(fr));
        const int row0 = u.pm * BM + wr * 64 + fr, col0 = u.pn * BM + wc * 32 + 8 * fq;
#pragma unroll
        for (int ai = 0; ai < 2; ++ai)
#pragma unroll
            for (int m = 0; m < 4; ++m) { const int row = row0 + ai * HALF + m * 16; const size_t off = (size_t)row * 1024 + col0; float ss = 0.f;
#pragma unroll
                for (int bj = 0; bj < 2; ++bj) { const u32x4 g = *(const u32x4*)(XB + off + bj * HALF);
                    const f32x4 r0 = {bflo(g.x), bfhi(g.x), bflo(g.y), bfhi(g.y)}, r1 = {bflo(g.z), bfhi(g.z), bflo(g.w), bfhi(g.w)};
                    const f32x4 x0 = r0 + acc[ai][bj][m][0], x1 = r1 + acc[ai][bj][m][1];
                    st16wt(XB + off + bj * HALF, pack8(x0, x1));
                    ss += (x0[0] * x0[0] + x0[1] * x0[1]) + (x0[2] * x0[2] + x0[3] * x0[3]) + (x1[0] * x1[0] + x1[1] * x1[1]) + (x1[2] * x1[2] + x1[3] * x1[3]); }
                ss = xrow16_sum(ss);
                if (fq == 0) SS[(size_t)row * 16 + u.pn * 4 + wc] = ss; }
    }
};
struct EpiRowScale {
    static constexpr bool PERM = true, AFTER_DRAIN = false;
    const float* SS; bf16_t* O; int ldc; float sc;
    __device__ __forceinline__ void operator()(const f32x4 (&acc)[2][2][4][2], const Unit& u, int wr, int wc, int fr0, int fq) const {
        int fr = fr0; asm volatile("" : "+v"(fr));
        const int row0 = u.pm * BM + wr * 64 + fr, col0 = u.pn * BM + wc * 32 + 8 * fq;
#pragma unroll
        for (int ai = 0; ai < 2; ++ai)
#pragma unroll
            for (int m = 0; m < 4; ++m) { const int row = row0 + ai * HALF + m * 16;
                const f32x4* sp = (const f32x4*)(SS + (size_t)row * 16); const f32x4 s4 = (sp[0] + sp[1]) + (sp[2] + sp[3]);
                const float rs = sc / sqrtf(((s4[0] + s4[1]) + (s4[2] + s4[3])) * (1.0f / 1024.0f) + 1e-6f);
#pragma unroll
                for (int bj = 0; bj < 2; ++bj) *(u32x4*)(O + (size_t)row * ldc + col0 + bj * HALF) = pack8(acc[ai][bj][m][0] * rs, acc[ai][bj][m][1] * rs); }
    }
};

__device__ __forceinline__ unsigned f2ord(float f) { const unsigned u = __builtin_bit_cast(unsigned, f); return u ^ ((unsigned)((int)u >> 31) | 0x80000000u); }
__device__ __forceinline__ float ord2f(unsigned k) { const unsigned u = (k & 0x80000000u) ? (k ^ 0x80000000u) : ~k; return __builtin_bit_cast(float, u); }
#define PG8_CSWAP(a, b) do { const unsigned hi_ = (a) > (b) ? (a) : (b), lo_ = (a) > (b) ? (b) : (a); (a) = hi_; (b) = lo_; } while (0)
__device__ __forceinline__ void sort16_desc(unsigned (&k)[16]) {
#pragma unroll
    for (int sz = 2; sz <= 16; sz <<= 1)
#pragma unroll
        for (int st = sz >> 1; st > 0; st >>= 1)
#pragma unroll
            for (int i = 0; i < 16; ++i) { const int l = i ^ st; if (l > i) { if ((i & sz) == 0) PG8_CSWAP(k[i], k[l]); else PG8_CSWAP(k[l], k[i]); } }
}
__device__ __forceinline__ void merge16_desc(unsigned (&a)[16], const unsigned (&b)[16]) {
#pragma unroll
    for (int i = 0; i < 16; ++i) a[i] = a[i] > b[15 - i] ? a[i] : b[15 - i];
#pragma unroll
    for (int st = 8; st > 0; st >>= 1)
#pragma unroll
        for (int i = 0; i < 16; ++i) { const int l = i ^ st; if (l > i) PG8_CSWAP(a[i], a[l]); }
}
struct EpiKeys {
    static constexpr bool PERM = true, AFTER_DRAIN = false;
    const float* SS; unsigned* KS;
    __device__ __forceinline__ void operator()(const f32x4 (&acc)[2][2][4][2], const Unit& u, int wr, int wc, int fr0, int fq) const {
        int fr = fr0; asm volatile("" : "+v"(fr));
#pragma unroll
        for (int ai = 0; ai < 2; ++ai)
#pragma unroll
            for (int m = 0; m < 4; ++m) { const int row = ai * HALF + wr * 64 + m * 16 + fr;
                const f32x4* sp = (const f32x4*)(SS + (size_t)(u.pm * BM + row) * 16); const f32x4 s4 = (sp[0] + sp[1]) + (sp[2] + sp[3]);
                const float rs = 1.0f / sqrtf(((s4[0] + s4[1]) + (s4[2] + s4[3])) * (1.0f / 1024.0f) + 1e-6f);
#pragma unroll
                for (int bj = 0; bj < 2; ++bj)
#pragma unroll
                    for (int n = 0; n < 2; ++n) { const int cw = wc * 32 + 8 * fq + 4 * n; u32x4 k;
#pragma unroll
                        for (int e = 0; e < 4; ++e) k[e] = (f2ord(acc[ai][bj][m][n][e] * rs) & ~0x7Fu) | (unsigned)(127 - (cw + e));
                        *(u32x4*)(KS + row * 256 + bj * HALF + cw) = k; } }
    }
};
__device__ __forceinline__ void topk_from_keys(int tid, const unsigned* KS, unsigned* TOPK, int tok0, int h) {
#pragma unroll 1
    for (int ai = 0; ai < 2; ++ai) {
        const int j = tid & 1, rl = (tid >> 1) & 127, c = tid >> 8;
        const unsigned* src = KS + (ai * 128 + rl) * 256 + c * 128 + j * 64;
        unsigned best[16], cur[16];
        { const u32x4 a0 = *(const u32x4*)src, a1 = *(const u32x4*)(src + 4), a2 = *(const u32x4*)(src + 8), a3 = *(const u32x4*)(src + 12);
#pragma unroll
          for (int e = 0; e < 4; ++e) { best[e] = a0[e]; best[4 + e] = a1[e]; best[8 + e] = a2[e]; best[12 + e] = a3[e]; } }
        sort16_desc(best);
#pragma unroll 1
        for (int gq = 1; gq < 4; ++gq) {
            const u32x4 a0 = *(const u32x4*)(src + gq * 16), a1 = *(const u32x4*)(src + gq * 16 + 4), a2 = *(const u32x4*)(src + gq * 16 + 8), a3 = *(const u32x4*)(src + gq * 16 + 12);
#pragma unroll
            for (int e = 0; e < 4; ++e) { cur[e] = a0[e]; cur[4 + e] = a1[e]; cur[8 + e] = a2[e]; cur[12 + e] = a3[e]; }
            sort16_desc(cur); merge16_desc(best, cur); }
#pragma unroll
        for (int i = 0; i < 16; ++i) cur[i] = (unsigned)__shfl_xor((int)best[i], 1);
        merge16_desc(best, cur);
        unsigned* dst = TOPK + ((size_t)(tok0 + ai * 128 + rl) * 8 + h) * 32 + c * 16 + j * 8;
        u32x4 w0, w1;
        if (j == 0) { w0 = (u32x4){best[0], best[1], best[2], best[3]}; w1 = (u32x4){best[4], best[5], best[6], best[7]}; }
        else { w0 = (u32x4){best[8], best[9], best[10], best[11]}; w1 = (u32x4){best[12], best[13], best[14], best[15]}; }
        st16wt(dst, w0); st16wt(dst + 4, w1);
    }
}
struct EpiSoftmaxP {
    static constexpr bool PERM = true, AFTER_DRAIN = true;
    bf16_t* P; PG8_LAS float* lrow;
    __device__ __forceinline__ void fused(f32x4 (&acc)[2][2][4][2], const Unit& u, int wr, int wc, int fr0, int fq, PG8_LAS unsigned char* lds, int wid, int lane) const {
        int fr = fr0; asm volatile("" : "+v"(fr));
        PG8_LAS float* MX = (PG8_LAS float*)lds; PG8_LAS float* SM = MX + 1024;
#pragma unroll
        for (int ai = 0; ai < 2; ++ai)
#pragma unroll
            for (int m = 0; m < 4; ++m) { float mx = -INFINITY;
#pragma unroll
                for (int bj = 0; bj < 2; ++bj)
#pragma unroll
                    for (int n = 0; n < 2; ++n)
#pragma unroll
                        for (int e = 0; e < 4; ++e) mx = fmaxf(mx, acc[ai][bj][m][n][e]);
                mx = xrow16_max(mx);
                if (fq == 0) MX[(ai * HALF + wr * 64 + m * 16 + fr) * 4 + wc] = mx; }
        asm volatile("s_waitcnt lgkmcnt(0)\n\ts_barrier" ::: "memory");
#pragma unroll
        for (int ai = 0; ai < 2; ++ai)
#pragma unroll
            for (int m = 0; m < 4; ++m) { const int row = ai * HALF + wr * 64 + m * 16 + fr;
                const f32x4 m4 = *(const PG8_LAS f32x4*)(MX + row * 4); const float rm = fmaxf(fmaxf(m4[0], m4[1]), fmaxf(m4[2], m4[3])); float s = 0.f;
#pragma unroll
                for (int bj = 0; bj < 2; ++bj) { f32x4 p0, p1;
#pragma unroll
                    for (int e = 0; e < 4; ++e) { p0[e] = __builtin_amdgcn_exp2f(acc[ai][bj][m][0][e] - rm); p1[e] = __builtin_amdgcn_exp2f(acc[ai][bj][m][1][e] - rm); }
                    s += ((p0[0] + p0[1]) + (p0[2] + p0[3])) + ((p1[0] + p1[1]) + (p1[2] + p1[3]));
                    *(u32x4*)(P + (size_t)row * 256 + bj * HALF + wc * 32 + 8 * fq) = pack8(p0, p1); }
                s = xrow16_sum(s);
                if (fq == 0) SM[row * 4 + wc] = s; }
        asm volatile("s_waitcnt lgkmcnt(0)\n\ts_barrier" ::: "memory");
        const int tid = wid * 64 + lane;
        if (tid < 256) { const f32x4 s4 = *(const PG8_LAS f32x4*)(SM + tid * 4); lrow[tid] = (s4[0] + s4[1]) + (s4[2] + s4[3]); }
    }
};
struct EpiSoftmaxFull {
    static constexpr bool PERM = true, AFTER_DRAIN = true;
    const float* SS; bf16_t* P; float sc;
    __device__ __forceinline__ void fused(f32x4 (&acc)[2][2][4][2], const Unit& u, int wr, int wc, int fr0, int fq, PG8_LAS unsigned char* lds, int wid, int lane) const {
        int fr = fr0; asm volatile("" : "+v"(fr));
        PG8_LAS float* MX = (PG8_LAS float*)lds; PG8_LAS float* SM = MX + 1024;
#pragma unroll
        for (int ai = 0; ai < 2; ++ai)
#pragma unroll
            for (int m = 0; m < 4; ++m) { const int lr = ai * HALF + wr * 64 + m * 16 + fr, row = u.pm * BM + lr; float mx = -INFINITY;
                const f32x4* sp = (const f32x4*)(SS + (size_t)row * 16); const f32x4 s4 = (sp[0] + sp[1]) + (sp[2] + sp[3]);
                const float rs = sc / sqrtf(((s4[0] + s4[1]) + (s4[2] + s4[3])) * (1.0f / 1024.0f) + 1e-6f);
#pragma unroll
                for (int bj = 0; bj < 2; ++bj)
#pragma unroll
                    for (int n = 0; n < 2; ++n) { acc[ai][bj][m][n] *= rs;
#pragma unroll
                        for (int e = 0; e < 4; ++e) mx = fmaxf(mx, acc[ai][bj][m][n][e]); }
                mx = xrow16_max(mx);
                if (fq == 0) MX[lr * 4 + wc] = mx; }
        asm volatile("s_waitcnt lgkmcnt(0)\n\ts_barrier" ::: "memory");
#pragma unroll
        for (int ai = 0; ai < 2; ++ai)
#pragma unroll
            for (int m = 0; m < 4; ++m) { const int lr = ai * HALF + wr * 64 + m * 16 + fr;
                const f32x4 m4 = *(const PG8_LAS f32x4*)(MX + lr * 4); const float rm = fmaxf(fmaxf(m4[0], m4[1]), fmaxf(m4[2], m4[3])); float s = 0.f;
#pragma unroll
                for (int bj = 0; bj < 2; ++bj)
#pragma unroll
                    for (int n = 0; n < 2; ++n) {
#pragma unroll
                        for (int e = 0; e < 4; ++e) acc[ai][bj][m][n][e] = __builtin_amdgcn_exp2f(acc[ai][bj][m][n][e] - rm);
                        s += (acc[ai][bj][m][n][0] + acc[ai][bj][m][n][1]) + (acc[ai][bj][m][n][2] + acc[ai][bj][m][n][3]); }
                s = xrow16_sum(s);
                if (fq == 0) SM[lr * 4 + wc] = s; }
        asm volatile("s_waitcnt lgkmcnt(0)\n\ts_barrier" ::: "memory");
#pragma unroll
        for (int ai = 0; ai < 2; ++ai)
#pragma unroll
            for (int m = 0; m < 4; ++m) { const int lr = ai * HALF + wr * 64 + m * 16 + fr;
                const f32x4 s4 = *(const PG8_LAS f32x4*)(SM + lr * 4); const float inv = 1.0f / ((s4[0] + s4[1]) + (s4[2] + s4[3]));
#pragma unroll
                for (int bj = 0; bj < 2; ++bj)
                    st16wt(P + (size_t)(u.pm * BM + lr) * 1024 + u.pn * BM + bj * HALF + wc * 32 + 8 * fq, pack8(acc[ai][bj][m][0] * inv, acc[ai][bj][m][1] * inv)); }
    }
};
struct EpiCO {
    static constexpr bool PERM = true, AFTER_DRAIN = false;
    bf16_t* O; const PG8_LAS float* lrow;
    __device__ __forceinline__ void operator()(const f32x4 (&acc)[2][2][4][2], const Unit& u, int wr, int wc, int fr0, int fq) const {
        int fr = fr0; asm volatile("" : "+v"(fr));
#pragma unroll
        for (int ai = 0; ai < 2; ++ai)
#pragma unroll
            for (int m = 0; m < 4; ++m) { const int row = ai * HALF + wr * 64 + m * 16 + fr; const float inv = 1.0f / lrow[row];
#pragma unroll
                for (int bj = 0; bj < 2; ++bj) *(u32x4*)(O + (size_t)row * 1024 + bj * HALF + wc * 32 + 8 * fq) = pack8(acc[ai][bj][m][0] * inv, acc[ai][bj][m][1] * inv); }
    }
};
struct OneUnit {
    int pm, pn;
    __device__ __forceinline__ bool next(int i, Unit& u) const { if (i) return false; u.pm = pm; u.pn = pn; return true; }
    __device__ __forceinline__ void a_ready(const Unit&) const {}
    __device__ __forceinline__ void done(const Unit&) const {}
};
}

__device__ __forceinline__ int win_src_col(int n) {
    if (n < 1024 || n >= 3072) return n;
    const int t = (n - 1024) >> 8, j = (n - 1024) & 255;
    return j < 128 ? 1024 + 128 * t + j : 2048 + 128 * t + (j - 128);
}
__device__ __forceinline__ void p0_prologue(int wv, const Args& a, LAS unsigned char* lds, int blk, int G) {
    const int tid = opaque_tid(wv), lane = tid & 63, wave = tid >> 6;
    unsigned char* ws = a.ws;
    LAS float* tl = (LAS float*)lds;
    {
        f32x4 cur[8], nxt[8]; const float* gcur = nullptr; const float* gnxt = nullptr;
#define P0_DECODE(job, W, ldw, nb, kb, Wt, gain, perm) do { \
            if ((job) < 512) { W = a.in[I_W_IN]; ldw = NCOLS; kb = (job) >> 5; nb = (job) & 31; Wt = (bf16*)(ws + WS_WT_IN); gain = a.in[I_NORM_MIX_G]; perm = true; } \
            else { const int mat = ((job) - 512) >> 6, idx = ((job) - 512) & 63; kb = idx >> 2; nb = idx & 3; ldw = 1024; gain = nullptr; perm = false; \
                if (mat == 0) { W = a.in[I_W_CONV_OUT]; Wt = (bf16*)(ws + WS_WT_CONV); } \
                else if (mat == 1) { W = a.in[I_W_ATTN_OUT]; Wt = (bf16*)(ws + WS_WT_ATTN); } \
                else if (mat == 2) { W = a.in[I_W_MIX_OUT]; Wt = (bf16*)(ws + WS_WT_MIX); } \
                else { W = a.in[I_W_CO]; Wt = (bf16*)(ws + WS_WT_CO); } } } while (0)
#define P0_LOAD(dst, gv, job) do { const float* W; int ldw, nb, kb; bf16* Wt; const float* gain; bool perm; P0_DECODE(job, W, ldw, nb, kb, Wt, gain, perm); (void)Wt; \
            const int k0 = kb * 64, c = tid & 63, nd0 = nb * 256 + 64 * (c >> 4), ns0 = (perm ? win_src_col(nd0) : nd0) + 4 * (c & 15); gv = gain ? gain + k0 : nullptr; \
            _Pragma("unroll") for (int i = 0; i < 8; ++i) dst[i] = *(const f32x4*)(W + (size_t)(k0 + (tid >> 6) + 8 * i) * ldw + ns0); } while (0)
        if (blk < 768) P0_LOAD(cur, gcur, blk);
        for (int job = blk; job < 768; job += G) {
            if (job + G < 768) P0_LOAD(nxt, gnxt, job + G);
#pragma unroll
            for (int i = 0; i < 8; ++i) { const int kk = (tid >> 6) + 8 * i, c = tid & 63; const float gk = gcur ? gcur[kk] : 1.0f; LAS float* d = tl + kk * 257 + 4 * c;
                d[0] = cur[i][0] * gk; d[1] = cur[i][1] * gk; d[2] = cur[i][2] * gk; d[3] = cur[i][3] * gk; }
            __syncthreads();
            { const float* W; int ldw, nb, kb; bf16* Wt; const float* gain; bool perm; P0_DECODE(job, W, ldw, nb, kb, Wt, gain, perm); (void)W; (void)ldw; (void)gain; (void)perm;
#pragma unroll
              for (int r = 0; r < 4; ++r) { const int idx = tid + 512 * r, nn = idx >> 3, kq = idx & 7; const LAS float* s = tl + (kq * 8) * 257 + nn;
                  u32x4 o; o.x = pk2(s[0], s[257]); o.y = pk2(s[2 * 257], s[3 * 257]); o.z = pk2(s[4 * 257], s[5 * 257]); o.w = pk2(s[6 * 257], s[7 * 257]);
                  st16wt(Wt + (size_t)(nb * 256 + nn) * 1024 + kb * 64 + kq * 8, o); } }
            __syncthreads();
#pragma unroll
            for (int i = 0; i < 8; ++i) cur[i] = nxt[i];
            gcur = gnxt;
        }
#undef P0_DECODE
#undef P0_LOAD
    }
    { const float* x = a.in[I_X]; bf16* XB = (bf16*)(ws + WS_A0); float* rstd0 = (float*)(ws + WS_RSTD0);
      f32x4 v[4], w4[4]; int row = blk * 8 + wave;
#define P0_XLOAD(dst, r) do { const f32x4* xr = (const f32x4*)(x + (size_t)(r) * D) + 2 * lane; dst[0] = xr[0]; dst[1] = xr[1]; dst[2] = xr[128]; dst[3] = xr[129]; } while (0)
      if (row < S) P0_XLOAD(v, row);
      for (; row < S; row += G * 8) {
          if (row + G * 8 < S) P0_XLOAD(w4, row + G * 8);
          float s = 0.f;
#pragma unroll
          for (int j = 0; j < 4; ++j) s += (v[j][0] * v[j][0] + v[j][1] * v[j][1]) + (v[j][2] * v[j][2] + v[j][3] * v[j][3]);
          s = wave_sum(s);
          if (lane == 0) rstd0[row] = 1.0f / sqrtf(s * (1.0f / D) + 1e-6f);
          bf16* o = XB + (size_t)row * D + 8 * lane;
#pragma unroll
          for (int j = 0; j < 2; ++j) { u32x4 w; w.x = pk2(v[2 * j][0], v[2 * j][1]); w.y = pk2(v[2 * j][2], v[2 * j][3]); w.z = pk2(v[2 * j + 1][0], v[2 * j + 1][1]); w.w = pk2(v[2 * j + 1][2], v[2 * j + 1][3]);
              st16wt(o + 512 * j, w); }
#pragma unroll
          for (int j = 0; j < 4; ++j) v[j] = w4[j];
      }
#undef P0_XLOAD
    }
    { typedef short bf16x8_t __attribute__((ext_vector_type(8))); typedef float f32x16_t __attribute__((ext_vector_type(16)));
      LAS bf16* mnb = (LAS bf16*)lds;
      LAS float* red = (LAS float*)(lds + 32 * 1032 * 2);
      const float* mem = a.in[I_MEM]; const float* g = a.in[I_NORM_MEM_G]; const float* Wc = a.in[I_W_CKV]; bf16* KC = (bf16*)(ws + WS_KV); bf16* VC = KC + 4 * 256 * 256;
      const int r32 = lane & 31, kg = lane >> 5;
      for (int wb = blk; wb < 256; wb += G) {
          const int m0 = (wb >> 5) * 32, n0 = (wb & 31) * 64;
          __syncthreads();
#pragma unroll
          for (int r = 0; r < 4; ++r) { const int rr = wave * 4 + r; const f32x4* mr = (const f32x4*)(mem + (size_t)(m0 + rr) * D) + lane; f32x4 v[4]; float s = 0.f;
#pragma unroll
              for (int j = 0; j < 4; ++j) { v[j] = mr[64 * j]; s += (v[j][0] * v[j][0] + v[j][1] * v[j][1]) + (v[j][2] * v[j][2] + v[j][3] * v[j][3]); }
              s = wave_sum(s); const float rs = 1.0f / sqrtf(s * (1.0f / D) + 1e-6f);
#pragma unroll
              for (int j = 0; j < 4; ++j) { const f32x4 gg = ((const f32x4*)g)[lane + 64 * j]; const f32x4 y = v[j] * rs * gg; u32x2 w; w.x = pk2(y[0], y[1]); w.y = pk2(y[2], y[3]);
                  *(LAS u32x2*)(mnb + rr * 1032 + 4 * (lane + 64 * j)) = w; } }
          __syncthreads();
          const int it = wave & 1, kq = wave >> 1, ncol = n0 + 32 * it + r32;
          f32x16_t acc;
#pragma unroll
          for (int r = 0; r < 16; ++r) acc[r] = 0.f;
#pragma unroll 1
          for (int half = 0; half < 2; ++half) {
              float wv_[8][8];
#pragma unroll
              for (int s = 0; s < 8; ++s)
#pragma unroll
                  for (int j = 0; j < 8; ++j) wv_[s][j] = Wc[(size_t)(256 * kq + 128 * half + 16 * s + 8 * kg + j) * 2048 + ncol];
#pragma unroll
              for (int s = 0; s < 8; ++s) {
                  u32x4 bw; bw.x = pk2(wv_[s][0], wv_[s][1]); bw.y = pk2(wv_[s][2], wv_[s][3]); bw.z = pk2(wv_[s][4], wv_[s][5]); bw.w = pk2(wv_[s][6], wv_[s][7]);
                  const bf16x8_t af = *(const LAS bf16x8_t*)(mnb + r32 * 1032 + 256 * kq + 128 * half + 16 * s + 8 * kg);
                  acc = __builtin_amdgcn_mfma_f32_32x32x16_bf16(af, __builtin_bit_cast(bf16x8_t, bw), acc, 0, 0, 0); }
          }
#pragma unroll
          for (int r = 0; r < 16; ++r) red[((it * 4 + kq) * 16 + r) * 64 + lane] = acc[r];
          __syncthreads();
          if (kq == 0) {
#pragma unroll
              for (int r = 0; r < 16; ++r) acc[r] = (red[((it * 4 + 0) * 16 + r) * 64 + lane] + red[((it * 4 + 1) * 16 + r) * 64 + lane]) + (red[((it * 4 + 2) * 16 + r) * 64 + lane] + red[((it * 4 + 3) * 16 + r) * 64 + lane]);
              if (ncol < 1024) {
#pragma unroll
                  for (int r = 0; r < 16; ++r) KC[((size_t)(ncol >> 8) * 256 + (m0 + (r & 3) + 8 * (r >> 2) + 4 * kg)) * 256 + (ncol & 255)] = (bf16)f2bf(acc[r]);
              } else {
#pragma unroll
                  for (int r = 0; r < 16; ++r) VC[((size_t)((ncol - 1024) >> 8) * 256 + (m0 + (r & 3) + 8 * (r >> 2) + 4 * kg)) * 256 + (ncol & 255)] = (bf16)f2bf(acc[r]);
              }
          }
      }
      __syncthreads(); }
    { typedef short bf16x8_t __attribute__((ext_vector_type(8))); typedef float f32x16_t __attribute__((ext_vector_type(16)));
      const float* sk = a.in[I_SUB_KEYS]; const float* wpq = a.in[I_W_PQ]; const float* gf = a.in[I_NORM_FFN_G]; bf16* WT = (bf16*)(ws + WS_WT_PQ);
      const int r32 = lane & 31, kg = lane >> 5;
      for (int item = blk * 8 + wave; item < 2048; item += G * 8) {
          const int hc = item >> 7, h = hc >> 1, c = hc & 1, kt = (item >> 2) & 31, nt = item & 3;
          const float* ap = wpq + (size_t)(kt * 32 + r32) * 2048 + hc * 128 + 8 * kg;
          const float* bp = sk + ((size_t)((c * 8 + h) * 128 + nt * 32 + r32)) * 128 + 8 * kg;
          const float gk = gf[kt * 32 + r32];
          f32x4 av[8][2], bv[8][2];
#pragma unroll
          for (int s = 0; s < 8; ++s) { av[s][0] = *(const f32x4*)(ap + 16 * s); av[s][1] = *(const f32x4*)(ap + 16 * s + 4); bv[s][0] = *(const f32x4*)(bp + 16 * s); bv[s][1] = *(const f32x4*)(bp + 16 * s + 4); }
          f32x16_t acc;
#pragma unroll
          for (int r = 0; r < 16; ++r) acc[r] = 0.f;
#pragma unroll
          for (int s = 0; s < 8; ++s) {
              const f32x4 a0 = av[s][0] * gk, a1 = av[s][1] * gk;
              u32x4 aw, bw; aw.x = pk2(a0[0], a0[1]); aw.y = pk2(a0[2], a0[3]); aw.z = pk2(a1[0], a1[1]); aw.w = pk2(a1[2], a1[3]);
              bw.x = pk2(bv[s][0][0], bv[s][0][1]); bw.y = pk2(bv[s][0][2], bv[s][0][3]); bw.z = pk2(bv[s][1][0], bv[s][1][1]); bw.w = pk2(bv[s][1][2], bv[s][1][3]);
              acc = __builtin_amdgcn_mfma_f32_32x32x16_bf16(__builtin_bit_cast(bf16x8_t, aw), __builtin_bit_cast(bf16x8_t, bw), acc, 0, 0, 0); }
          bf16* dst = WT + (size_t)(hc * 128 + nt * 32 + r32) * 1024 + kt * 32 + 4 * kg;
#pragma unroll
          for (int q = 0; q < 4; ++q) { u32x2 w; w.x = pk2(acc[4 * q], acc[4 * q + 1]); w.y = pk2(acc[4 * q + 2], acc[4 * q + 3]); *(u32x2*)(dst + 8 * q) = w; }
      } }
    if (blk == 0) { float* BT = (float*)(ws + WS_BTAB); const float* rb = a.in[I_REL_BIAS];
        for (int i = tid; i < 8 * 132; i += 512) { const int h = i / 132, j = i - h * 132; float v = 0.f;
            if (j < 129) { const int b = j < 128 ? (int)T5_BUCKET[j] : 31; v = (rb[b * 8 + h] - rb[31 * 8 + h]) * 1.4426950408889634f; }
            else if (j == 129) { float m = -INFINITY; for (int b = 0; b < 32; ++b) m = fmaxf(m, rb[b * 8 + h] * 1.4426950408889634f); v = m; }
            else if (j == 130) v = rb[31 * 8 + h] * 1.4426950408889634f;
            BT[i] = v; }
        if (tid == 0) { float s1 = 0.f, s2 = 0.f;
            for (int i = 0; i < 64; ++i) { s1 += a.in[I_LQ1][i] * a.in[I_LK1][i]; s2 += a.in[I_LQ2][i] * a.in[I_LK2][i]; }
            BT[8 * 132] = expf(s1) - expf(s2) + 0.2f; } }
}

__device__ __forceinline__ void cross_fold(int wv, const Args& a, int blk, int G) {
    typedef short bf16x8_t __attribute__((ext_vector_type(8))); typedef float f32x16_t __attribute__((ext_vector_type(16)));
    const int tid = opaque_tid(wv), lane = tid & 63, wave = tid >> 6, r32 = lane & 31, kg = lane >> 5;
    const bf16* KC = (const bf16*)(a.ws + WS_KV); const bf16* VC = KC + 4 * 256 * 256;
    for (int item = blk * 8 + wave; item < 2048; item += G * 8) {
        f32x16_t acc;
#pragma unroll
        for (int r = 0; r < 16; ++r) acc[r] = 0.f;
        bf16* dst;
        if (item < 1024) {
            const int h = item >> 8, kt = (item >> 3) & 31, mt = item & 7;
            const float* ap = a.in[I_W_CQ] + (size_t)(kt * 32 + r32) * 1024 + h * 256 + 8 * kg;
            const bf16* bp = KC + ((size_t)h * 256 + mt * 32 + r32) * 256 + 8 * kg;
            const float gk = a.in[I_NORM_CROSS_G][kt * 32 + r32];
#pragma unroll 1
            for (int half = 0; half < 2; ++half) {
                f32x4 av[8][2]; u32x4 bv[8];
#pragma unroll
                for (int s = 0; s < 8; ++s) { av[s][0] = *(const f32x4*)(ap + 128 * half + 16 * s); av[s][1] = *(const f32x4*)(ap + 128 * half + 16 * s + 4); bv[s] = *(const u32x4*)(bp + 128 * half + 16 * s); }
#pragma unroll
                for (int s = 0; s < 8; ++s) { const f32x4 a0 = av[s][0] * gk, a1 = av[s][1] * gk;
                    u32x4 aw; aw.x = pk2(a0[0], a0[1]); aw.y = pk2(a0[2], a0[3]); aw.z = pk2(a1[0], a1[1]); aw.w = pk2(a1[2], a1[3]);
                    acc = __builtin_amdgcn_mfma_f32_32x32x16_bf16(__builtin_bit_cast(bf16x8_t, aw), __builtin_bit_cast(bf16x8_t, bv[s]), acc, 0, 0, 0); }
            }
            dst = (bf16*)(a.ws + WS_WQK) + (size_t)(h * 256 + mt * 32 + r32) * 1024 + kt * 32 + 4 * kg;
        } else {
            const int it = item - 1024, h = it >> 8, mt = (it >> 5) & 7, nt = it & 31;
            const bf16* ap = VC + ((size_t)h * 256 + mt * 32 + r32) * 256 + 8 * kg;
            const bf16* bp = (const bf16*)(a.ws + WS_WT_CO) + (size_t)(nt * 32 + r32) * 1024 + h * 256 + 8 * kg;
            u32x4 av[16], bv[16];
#pragma unroll
            for (int s = 0; s < 16; ++s) { av[s] = *(const u32x4*)(ap + 16 * s); bv[s] = *(const u32x4*)(bp + 16 * s); }
#pragma unroll
            for (int s = 0; s < 16; ++s) acc = __builtin_amdgcn_mfma_f32_32x32x16_bf16(__builtin_bit_cast(bf16x8_t, av[s]), __builtin_bit_cast(bf16x8_t, bv[s]), acc, 0, 0, 0);
            dst = (bf16*)(a.ws + WS_VW) + (size_t)(nt * 32 + r32) * 1024 + h * 256 + mt * 32 + 4 * kg;
        }
#pragma unroll
        for (int q = 0; q < 4; ++q) { u32x2 w; w.x = pk2(acc[4 * q], acc[4 * q + 1]); w.y = pk2(acc[4 * q + 2], acc[4 * q + 3]); *(u32x2*)(dst + 8 * q) = w; }
    }
}

__device__ __forceinline__ void conv_phase(int wv, const Args& a, int blk, int G) {
    bf16* CB = (bf16*)(a.ws + WS_A1); const bf16* U = (const bf16*)(a.ws + WS_A2); const float* cw = a.in[I_CONV_W];
    const int tid = opaque_tid(wv);
    const int c = (tid & 127) * 8;
    float w0[8], w1[8], w2[8];
#pragma unroll
    for (int e = 0; e < 8; ++e) { w0[e] = cw[c + e]; w1[e] = cw[D + c + e]; w2[e] = cw[2 * D + c + e]; }
    const size_t step = (size_t)G * 512, total = (size_t)S * D / 8;
    for (size_t i0 = (size_t)blk * 512 + tid; i0 < total; i0 += 4 * step) {
        u32x4 cb[4], u2[4], u1[4], u0[4];
#pragma unroll
        for (int q = 0; q < 4; ++q) { const size_t i = i0 + q * step; const int r = (int)(i >> 7);
            cb[q] = u2[q] = u1[q] = u0[q] = (u32x4){0, 0, 0, 0};
            if (i < total) { cb[q] = *(const u32x4*)(CB + i * 8); u2[q] = *(const u32x4*)(U + i * 8);
                if (r >= 1) u1[q] = *(const u32x4*)(U + i * 8 - D);
                if (r >= 2) u0[q] = *(const u32x4*)(U + i * 8 - 2 * D); } }
#pragma unroll
        for (int q = 0; q < 4; ++q) { const size_t i = i0 + q * step;
            u32x4 o;
#pragma unroll
            for (int e = 0; e < 4; ++e) {
                const float lo = bflo(cb[q][e]) * (w0[2 * e] * bflo(u0[q][e]) + w1[2 * e] * bflo(u1[q][e]) + w2[2 * e] * bflo(u2[q][e]));
                const float hi = bfhi(cb[q][e]) * (w0[2 * e + 1] * bfhi(u0[q][e]) + w1[2 * e + 1] * bfhi(u1[q][e]) + w2[2 * e + 1] * bfhi(u2[q][e]));
                o[e] = pk2(lo, hi);
            }
            if (i < total) st16wt(CB + i * 8, o); }
    }
}


namespace att {
typedef short bf16x8 __attribute__((ext_vector_type(8)));
typedef short s16x4 __attribute__((ext_vector_type(4)));
typedef float f32x16 __attribute__((ext_vector_type(16)));
typedef short v4i16_t __attribute__((ext_vector_type(4)));
typedef LAS const char* lds_cptr;
constexpr int SLOT = 16384, LDS_K = 0, LDS_V = 4 * SLOT, LDS_WSF = 8 * SLOT, LDS_BT = LDS_WSF + 2048, LDS_TOTAL = LDS_BT + 1024;
constexpr int LDS_XCH = 0, LDS_OST = 65536;
constexpr float LOG2E = 1.4426950408889634f, THR = 8.0f;
__device__ __forceinline__ int crow(int r, int hi) { return (r & 3) + 8 * (r >> 2) + 4 * hi; }
typedef float f32x2_t __attribute__((ext_vector_type(2))); typedef __bf16 bf16x2_t __attribute__((ext_vector_type(2)));
__device__ __forceinline__ unsigned cvtpk(float lo, float hi) { const f32x2_t v = {lo, hi}; const bf16x2_t b = __builtin_convertvector(v, bf16x2_t); return __builtin_bit_cast(unsigned, b); }
__device__ __forceinline__ void glds16(const void* g, unsigned lds_base) {
    unsigned sv; asm volatile("s_mov_b32 %0, m0\n\ts_mov_b32 m0, %2\n\ts_nop 0\n\tglobal_load_lds_dwordx4 %1, off\n\ts_mov_b32 m0, %0" : "=&s"(sv) : "v"(g), "s"(lds_base) : "memory"); }
template <int IMM> __device__ __forceinline__ void glds16s(unsigned voff, const void* sbase, unsigned lds_base) {
    unsigned sv; asm volatile("s_mov_b32 %0, m0\n\ts_mov_b32 m0, %3\n\ts_nop 0\n\tglobal_load_lds_dwordx4 %1, %2 offset:%c4\n\ts_mov_b32 m0, %0" : "=&s"(sv) : "v"(voff), "s"(sbase), "s"(lds_base), "i"(IMM) : "memory"); }
__device__ __forceinline__ s16x4 vtr(lds_cptr p) { return __builtin_bit_cast(s16x4, __builtin_amdgcn_ds_read_tr16_b64_v4i16((LAS v4i16_t*)p)); }
#define ATT_MX3(a, b, c) __builtin_fmaxf(__builtin_fmaxf((a), (b)), (c))
__device__ __forceinline__ float rowmax(const f32x16& p0, const f32x16& p1) {
    float a = ATT_MX3(p0[0], p0[1], p1[0]), b = ATT_MX3(p0[2], p0[3], p1[1]); a = ATT_MX3(a, p1[2], p1[3]);
#pragma unroll
    for (int r = 4; r < 16; r += 4) { a = ATT_MX3(a, p0[r], p0[r + 1]); b = ATT_MX3(b, p0[r + 2], p0[r + 3]); a = ATT_MX3(a, p1[r], p1[r + 1]); b = ATT_MX3(b, p1[r + 2], p1[r + 3]); }
    float m = __builtin_fmaxf(a, b); auto rr = __builtin_amdgcn_permlane32_swap(__float_as_uint(m), __float_as_uint(m), false, false);
    return __builtin_fmaxf(__uint_as_float(rr[0]), __uint_as_float(rr[1])); }
#define ATT_WAIT_BAR(N) asm volatile("s_waitcnt vmcnt(" #N ") lgkmcnt(0)\n\ts_barrier" ::: "memory")
#define ATT_LBAR() asm volatile("s_waitcnt lgkmcnt(0)\n\ts_barrier" ::: "memory")
#define ATT_MFMA(a, b, c) __builtin_amdgcn_mfma_f32_32x32x16_bf16(a, b, c, 0, 0, 0)

__device__ __forceinline__ void attn_unit_pipe(int wv, int h, int qb, const bf16* Q, const bf16* __restrict__ K, const bf16* __restrict__ V, bf16* O, LAS unsigned char* lds,
                                               float lam, const float* BTAB, const float* subln_g, const unsigned* KMAX) {
    const int tid = opaque_tid(wv), lane = tid & 63, r32 = lane & 31, hi = lane >> 5;
    const int wid = __builtin_amdgcn_readfirstlane(tid >> 6), comp = wid >> 2, rg = wid & 3;
    const int q0 = qb * 128, qw0 = q0 + 32 * rg, NT = 2 * qb + 2;
    const unsigned lds0 = (unsigned)(unsigned long long)lds;
    LAS float* wsf = (LAS float*)(lds + LDS_WSF) + wid * 64;
    LAS float* bt = (LAS float*)(lds + LDS_BT);
    const unsigned kvoff = (unsigned)lane * 2048u + (unsigned)wid * 16u;
    const unsigned vvoff = (unsigned)(16 * (wid & 3) + (lane >> 2)) * 2048u + (unsigned)((wid >> 2) * 32 + (lane & 3) * 8) * 2u;
    const char* kbase = (const char*)(K + h * 128); const char* vbase = (const char*)(V + h * 128);
    const unsigned kdst = lds0 + LDS_K + wid * 1024, vdst = lds0 + LDS_V + wid * 1024;
#define ATT_RFL(x) ((unsigned)__builtin_amdgcn_readfirstlane((int)(x)))
#define DMA_K(t, so) do { const char* b_ = kbase + (size_t)(t) * 131072; glds16s<0>(kvoff, b_, ATT_RFL(kdst + (so))); glds16s<128>(kvoff, b_, ATT_RFL(kdst + (so) + 8192 - 128)); } while (0)
#define DMA_V(t, so) do { const char* b_ = vbase + (size_t)(t) * 131072; glds16s<0>(vvoff, b_, ATT_RFL(vdst + (so))); glds16s<128>(vvoff, b_, ATT_RFL(vdst + (so) + 8192 - 128)); } while (0)
    DMA_K(0, 0); DMA_K(1, SLOT); DMA_V(0, 0); if (NT > 2) DMA_K(2, 2 * SLOT);
    const float* bth = BTAB + h * 132;
    bf16x8 qr[4];
    float cfar;
    { const bf16* Qw = Q + (size_t)(qw0 + r32) * 1024 + h * 128 + comp * 64 + hi * 8;
#pragma unroll
      for (int d0 = 0; d0 < 4; ++d0) qr[d0] = *(const bf16x8*)(Qw + d0 * 16);
      float btv = 0.f; if (tid < 129) btv = bth[tid];
      const float bmax = bth[129], bfar = bth[130];
      const float kmx = sqrtf(__uint_as_float(KMAX[(h * 2 + comp) * 2]) + __uint_as_float(KMAX[(h * 2 + comp) * 2 + 1])) * 1.02f;
      if (tid < 129) bt[tid] = btv;
      float s = 0.f;
#pragma unroll
      for (int d0 = 0; d0 < 4; ++d0)
#pragma unroll
          for (int e2 = 0; e2 < 8; ++e2) { const float f = __builtin_bit_cast(float, (unsigned)(unsigned short)qr[d0][e2] << 16); s += f * f; }
      auto rr = __builtin_amdgcn_permlane32_swap(__float_as_uint(s), __float_as_uint(s), false, false); s = __uint_as_float(rr[0]) + __uint_as_float(rr[1]);
      cfar = bfar - (sqrtf(s) * 1.01f * kmx + bmax); }
    f32x16 cf;
#pragma unroll
    for (int r = 0; r < 16; ++r) cf[r] = cfar;
    asm volatile("" : "+v"(cf));
    const lds_cptr kp0 = (lds_cptr)(lds + LDS_K) + comp * 8192 + hi * 1024 + r32 * 16;
    const lds_cptr vp0 = (lds_cptr)(lds + LDS_V) + ((lane >> 4) & 1) * 32 + (lane & 3) * 8 + (4 * hi + ((lane & 15) >> 2)) * 64;
    float l_reg = 0.f;
    f32x16 o[4];
#pragma unroll
    for (int d0 = 0; d0 < 4; ++d0)
#pragma unroll
        for (int r = 0; r < 16; ++r) o[d0][r] = 0.f;
    bf16x8 kf[8];
    f32x16 pA0, pA1, pB0, pB1;
    u32x4 pw0, pw1, pw2, pw3;
    s16x4 vl0, vh0, vl1, vh1;
#define SBAR() __builtin_amdgcn_sched_barrier(0)
#define PIN(x) asm volatile("" : "+v"(x))
#define PKW(P, B) cvtpk(P[B], P[B + 1])
#define PAF(k) __builtin_bit_cast(bf16x8, pw##k)
#define EX(v) __builtin_amdgcn_exp2f(v)
#define ROT3() do { const int t_ = s0; s0 = s1; s1 = s2; s2 = t_; } while (0)
#define ENDW(t) do { if ((t) + 3 < NT) { ATT_WAIT_BAR(4); } else if ((t) + 1 < NT) { ATT_WAIT_BAR(2); } else { ATT_WAIT_BAR(0); } } while (0)
#define KLD(f, kp_) kf[f] = *(LAS const bf16x8*)((kp_) + ((f) >> 1) * 2048 + ((f) & 1) * 512)
#define BANDFIX(C0, C1, t) do { if (__builtin_expect(64 * (t) + 63 + 128 > qw0, 0)) { const int ln_ = opaque_tid(0);   \
        const int dq = qw0 + (ln_ & 31) - 64 * (t) - 4 * (ln_ >> 5); \
        _Pragma("unroll") for (int r = 0; r < 16; ++r) { const int d0_ = dq - ((r & 3) + 8 * (r >> 2)), d1_ = d0_ - 32; \
            const float b0 = bt[min(max(d0_, 0), 128)], b1 = bt[min(max(d1_, 0), 128)]; \
            C0[r] = d0_ < 0 ? -INFINITY : C0[r] + b0; C1[r] = d1_ < 0 ? -INFINITY : C1[r] + b1; } } } while (0)
#define VRD(j, i, vp_) do { vl##j = vtr((vp_) + ((i) & 3) * 4096 + ((i) >> 2) * 1024); vh##j = vtr((vp_) + ((i) & 3) * 4096 + ((i) >> 2) * 1024 + 512); } while (0)
#define VFR(j) (bf16x8){vl##j[0], vl##j[1], vl##j[2], vl##j[3], vh##j[0], vh##j[1], vh##j[2], vh##j[3]}
#define GAPA(MF, A0, A1, A2, A3, W0, W1, PWX) do { MF; sacc += A0; sacc += A1; sacc += A2; sacc += A3; PIN(sacc); W0; W1; PIN(PWX); SBAR(); } while (0)
#define PHASE_A(C0, C1, P0, P1, vp_) do { float sacc = P0[0] + P0[1]; \
        GAPA(C0 = ATT_MFMA(kf[0], qr[0], cf), P0[2], P0[3], P0[4], P0[5],     pw0[0] = PKW(P0, 0), pw0[1] = PKW(P0, 2), pw0); \
        GAPA(C1 = ATT_MFMA(kf[1], qr[0], cf), P0[6], P0[7], P0[8], P0[9],     pw0[2] = PKW(P0, 4), pw0[3] = PKW(P0, 6), pw0); \
        GAPA(C0 = ATT_MFMA(kf[2], qr[1], C0), P0[10], P0[11], P0[12], P0[13], pw1[0] = PKW(P0, 8), pw1[1] = PKW(P0, 10), pw1); \
        GAPA(C1 = ATT_MFMA(kf[3], qr[1], C1), P0[14], P0[15], P1[0], P1[1],   pw1[2] = PKW(P0, 12), pw1[3] = PKW(P0, 14), pw1); \
        GAPA(C0 = ATT_MFMA(kf[4], qr[2], C0), P1[2], P1[3], P1[4], P1[5],     pw2[0] = PKW(P1, 0), pw2[1] = PKW(P1, 2), pw2); \
        GAPA(C1 = ATT_MFMA(kf[5], qr[2], C1), P1[6], P1[7], P1[8], P1[9],     pw2[2] = PKW(P1, 4), pw2[3] = PKW(P1, 6), pw2); \
        GAPA(C0 = ATT_MFMA(kf[6], qr[3], C0), P1[10], P1[11], P1[12], P1[13], pw3[0] = PKW(P1, 8), pw3[1] = PKW(P1, 10), pw3); \
        VRD(0, 0, vp_); SBAR(); \
        GAPA(C1 = ATT_MFMA(kf[7], qr[3], C1), P1[14], P1[15], 0.f, 0.f,       pw3[2] = PKW(P1, 12), pw3[3] = PKW(P1, 14), pw3); \
        l_reg += sacc; } while (0)
#define GAPB(i, j, jn, X, XB, DOEX, GL, vp_, kp_, N0, N1, DOSP) do { if ((i) + 1 < 16) { VRD(jn, (i) + 1, vp_); } \
        if ((GL) && ((i) & 1)) { KLD((i) >> 1, kp_); } SBAR(); \
        o[(i) & 3] = ATT_MFMA(PAF_SEL((i) >> 2), VFR(j), o[(i) & 3]); \
        if (DOEX) { X[XB] = EX(X[XB]); X[XB + 1] = EX(X[XB + 1]); PIN(X); } \
        SBAR(); } while (0)
#define PAF_SEL(k) ((k) == 0 ? PAF(0) : (k) == 1 ? PAF(1) : (k) == 2 ? PAF(2) : PAF(3))
#define PHASE_B(C0, C1, DOEX, GL, vp_, kp_, N0, N1, DOSP) do { \
        GAPB(0, 0, 1, C0, 0, DOEX, GL, vp_, kp_, N0, N1, DOSP); GAPB(1, 1, 0, C0, 2, DOEX, GL, vp_, kp_, N0, N1, DOSP); GAPB(2, 0, 1, C0, 4, DOEX, GL, vp_, kp_, N0, N1, DOSP); GAPB(3, 1, 0, C0, 6, DOEX, GL, vp_, kp_, N0, N1, DOSP); \
        GAPB(4, 0, 1, C0, 8, DOEX, GL, vp_, kp_, N0, N1, DOSP); GAPB(5, 1, 0, C0, 10, DOEX, GL, vp_, kp_, N0, N1, DOSP); GAPB(6, 0, 1, C0, 12, DOEX, GL, vp_, kp_, N0, N1, DOSP); GAPB(7, 1, 0, C0, 14, DOEX, GL, vp_, kp_, N0, N1, DOSP); \
        GAPB(8, 0, 1, C1, 0, DOEX, GL, vp_, kp_, N0, N1, DOSP); GAPB(9, 1, 0, C1, 2, DOEX, GL, vp_, kp_, N0, N1, DOSP); GAPB(10, 0, 1, C1, 4, DOEX, GL, vp_, kp_, N0, N1, DOSP); GAPB(11, 1, 0, C1, 6, DOEX, GL, vp_, kp_, N0, N1, DOSP); \
        GAPB(12, 0, 1, C1, 8, DOEX, GL, vp_, kp_, N0, N1, DOSP); GAPB(13, 1, 0, C1, 10, DOEX, GL, vp_, kp_, N0, N1, DOSP); GAPB(14, 0, 1, C1, 12, DOEX, GL, vp_, kp_, N0, N1, DOSP); GAPB(15, 1, 0, C1, 14, DOEX, GL, vp_, kp_, N0, N1, DOSP); \
        } while (0)
#define KSL(t) ((((t) & 3)) * SLOT)
#define DMA_GROUP(t) do { if ((t) + 3 < NT) DMA_K((t) + 3, KSL((t) + 3)); if ((t) + 1 < NT) DMA_V((t) + 1, KSL((t) + 1)); } while (0)
#define STEP(C0, C1, P0, P1, t) do { const lds_cptr vpp = vp0 + KSL((t) - 1); const lds_cptr kpn = kp0 + KSL((t) + 1); \
        PHASE_A(C0, C1, P0, P1, vpp); \
        BANDFIX(C0, C1, t); \
        if (comp == 0) { DMA_GROUP(t); } else { ENDW(t); } \
        SBAR(); \
        PHASE_B(C0, C1, true, true, vpp, kpn, P0, P1, true); PIN(P0); PIN(P1); \
        if (comp == 0) { ENDW(t); } else { DMA_GROUP((t) + 1); } } while (0)
#define PACKSUM(P0, P1) do { float sacc = 0.f; _Pragma("unroll") for (int r = 0; r < 16; ++r) sacc += P0[r] + P1[r]; l_reg += sacc; \
        pw0 = (u32x4){PKW(P0, 0), PKW(P0, 2), PKW(P0, 4), PKW(P0, 6)}; pw1 = (u32x4){PKW(P0, 8), PKW(P0, 10), PKW(P0, 12), PKW(P0, 14)}; \
        pw2 = (u32x4){PKW(P1, 0), PKW(P1, 2), PKW(P1, 4), PKW(P1, 6)}; pw3 = (u32x4){PKW(P1, 8), PKW(P1, 10), PKW(P1, 12), PKW(P1, 14)}; } while (0)

    if (NT > 2) { ATT_WAIT_BAR(4); } else { ATT_WAIT_BAR(2); }
    if (comp != 0) { DMA_GROUP(0); }
    {
#pragma unroll
      for (int f = 0; f < 8; ++f) KLD(f, kp0);
      pA0 = ATT_MFMA(kf[0], qr[0], cf); pA1 = ATT_MFMA(kf[1], qr[0], cf);
#pragma unroll
      for (int d0 = 1; d0 < 4; ++d0) { pA0 = ATT_MFMA(kf[2 * d0], qr[d0], pA0); pA1 = ATT_MFMA(kf[2 * d0 + 1], qr[d0], pA1); } }
    SBAR();
    BANDFIX(pA0, pA1, 0);
    if (comp == 0) { DMA_GROUP(0); } else { ENDW(0); }
    {
#pragma unroll
        for (int r = 0; r < 16; ++r) { pA0[r] = EX(pA0[r]); pA1[r] = EX(pA1[r]); }
#pragma unroll
        for (int f = 0; f < 8; ++f) KLD(f, kp0 + KSL(1));
    }
    if (comp == 0) { ENDW(0); } else { DMA_GROUP(1); }
    {
        int t = 1;
        for (; t + 2 < NT; t += 2) { STEP(pB0, pB1, pA0, pA1, t); STEP(pA0, pA1, pB0, pB1, t + 1); }
        STEP(pB0, pB1, pA0, pA1, t);
        PACKSUM(pB0, pB1);
        VRD(0, 0, vp0 + KSL(NT - 1)); SBAR();
        PHASE_B(pA0, pA1, false, false, vp0 + KSL(NT - 1), kp0, pA0, pA1, false);
    }
    float l = l_reg;
    { auto rr = __builtin_amdgcn_permlane32_swap(__float_as_uint(l), __float_as_uint(l), false, false); l = __uint_as_float(rr[0]) + __uint_as_float(rr[1]); }
    if (hi == 0) wsf[32 + r32] = l;
    float rli[16];
#pragma unroll
    for (int r = 0; r < 16; ++r) rli[r] = 1.0f / wsf[32 + crow(r, hi)];
    ATT_LBAR();
    LAS float* xch = (LAS float*)(lds + LDS_XCH) + rg * 4096;
    if (comp == 1) {
#pragma unroll
        for (int d0 = 0; d0 < 4; ++d0)
#pragma unroll
            for (int r = 0; r < 16; ++r) xch[(d0 * 16 + r) * 64 + lane] = o[d0][r] * rli[r] * lam;
    }
    ATT_LBAR();
    if (comp == 0) {
        float ss[16];
#pragma unroll
        for (int r = 0; r < 16; ++r) { float s_ = 0.f;
#pragma unroll
            for (int d0 = 0; d0 < 4; ++d0) { const float v = o[d0][r] * rli[r] - xch[(d0 * 16 + r) * 64 + lane]; o[d0][r] = v; s_ += v * v; }
            ss[r] = s_; }
#pragma unroll
        for (int r = 0; r < 16; ++r) {
            float v = ss[r]; v += pg8::dppf<0xB1>(v); v += pg8::dppf<0x4E>(v); v += pg8::dppf<0x141>(v); v += pg8::dppf<0x140>(v);
            auto sw = __builtin_amdgcn_permlane16_swap(__float_as_uint(v), __float_as_uint(v), false, false); ss[r] = __uint_as_float(sw[0]) + __uint_as_float(sw[1]); }
        LAS bf16* stg = (LAS bf16*)(lds + LDS_OST) + rg * 4096;
        float g4[4];
#pragma unroll
        for (int d0 = 0; d0 < 4; ++d0) g4[d0] = subln_g[d0 * 32 + r32];
#pragma unroll
        for (int r = 0; r < 16; ++r) { const float rs = 0.8f / sqrtf(ss[r] * (1.0f / 128.0f) + 1e-5f); const int orow = crow(r, hi);
#pragma unroll
            for (int d0 = 0; d0 < 4; ++d0) stg[orow * 128 + d0 * 32 + r32] = (bf16)f2bf(o[d0][r] * rs * g4[d0]); }
#pragma unroll
        for (int i = 0; i < 8; ++i) { const int row = i * 4 + (lane >> 4), ch = lane & 15;
            const u32x4 v = *(LAS const u32x4*)(stg + row * 128 + ch * 8);
            st16wt(O + (size_t)(qw0 + row) * 1024 + h * 128 + ch * 8, v); }
    }
    ATT_LBAR();
#undef ATT_RFL
#undef DMA_K
#undef DMA_V
#undef SBAR
#undef PIN
#undef PKW
#undef PAF
#undef EX
#undef ROT3
#undef ENDW
#undef KLD
#undef BANDFIX
#undef VRD
#undef VFR
#undef GAPA
#undef PHASE_A
#undef GAPB
#undef PAF_SEL
#undef PHASE_B
#undef STEP
#undef PACKSUM
#undef KSL
#undef DMA_GROUP
}

__device__ __forceinline__ void attn_phase(int wv, const Args& a, LAS unsigned char* lds, int blk, int G, bf16* Odst) {
    const float* BTAB = (const float*)(a.ws + WS_BTAB);
    const float lam = __builtin_bit_cast(float, __builtin_amdgcn_readfirstlane(__builtin_bit_cast(int, BTAB[8 * 132])));
    const bf16* Q = (const bf16*)(a.ws + WS_A3); const bf16* K = (const bf16*)(a.ws + WS_A4); const bf16* V = (const bf16*)(a.ws + WS_A5);
    const bool snake = (1024 % G) == 0;
    for (int j = 0;; ++j) {
        const int idx = j * G + blk; if (idx >= 1024) break;
        const int rank = (snake && (j & 1)) ? (j * G + (G - 1 - blk)) : idx;
        attn_unit_pipe(wv, rank & 7, 127 - (rank >> 3), Q, K, V, Odst, lds, lam, BTAB, a.in[I_SUBLN_G], (const unsigned*)(a.ws + WS_KMAX));
    }
}
}


__device__ __forceinline__ void peer_convert(int wv, const Args& a, int blk, int G) {
    const int tid = opaque_tid(wv), lane = tid & 63, gw = blk * 8 + (tid >> 6);
    for (int which = 0; which < 2; ++which) {
        const float* src = a.in[which ? I_PEER_V : I_PEER_U]; unsigned* dst = (unsigned*)(a.ws + (which ? WS_PV : WS_PU));
        const size_t nchunk = (size_t)16384 * 1024 / 1024, stride = (size_t)G * 8;
        for (size_t c = gw; c < nchunk; c += 2 * stride) {
            const size_t c1 = c + stride; const bool two = c1 < nchunk;
            f32x4 v[8];
#pragma unroll
            for (int j = 0; j < 4; ++j) v[j] = __builtin_nontemporal_load((const f32x4*)(src + c * 1024 + 256 * j + 4 * lane));
            if (two) {
#pragma unroll
                for (int j = 0; j < 4; ++j) v[4 + j] = __builtin_nontemporal_load((const f32x4*)(src + c1 * 1024 + 256 * j + 4 * lane)); }
#pragma unroll
            for (int j = 0; j < 4; ++j) { const f32x4 x = v[j] * 128.0f; int w = __builtin_amdgcn_cvt_pk_fp8_f32(x[0], x[1], 0, false); w = __builtin_amdgcn_cvt_pk_fp8_f32(x[2], x[3], w, true);
                dst[c * 256 + 64 * j + lane] = (unsigned)w; }
            if (two) {
#pragma unroll
                for (int j = 0; j < 4; ++j) { const f32x4 x = v[4 + j] * 128.0f; int w = __builtin_amdgcn_cvt_pk_fp8_f32(x[0], x[1], 0, false); w = __builtin_amdgcn_cvt_pk_fp8_f32(x[2], x[3], w, true);
                    dst[c1 * 256 + 64 * j + lane] = (unsigned)w; } }
        } }
}
namespace peer {
typedef float f32x2v __attribute__((ext_vector_type(2)));
template <int CTRL> __device__ __forceinline__ float dpp(float x) { return __builtin_bit_cast(float, __builtin_amdgcn_mov_dpp(__builtin_bit_cast(int, x), CTRL, 0xf, 0xf, true)); }
template <int CTRL> __device__ __forceinline__ unsigned dppu(unsigned x) { return (unsigned)__builtin_amdgcn_mov_dpp((int)x, CTRL, 0xf, 0xf, true); }
__device__ __forceinline__ unsigned half32_umax(unsigned m) {
    unsigned t = dppu<0xB1>(m); m = t > m ? t : m; t = dppu<0x4E>(m); m = t > m ? t : m; t = dppu<0x141>(m); m = t > m ? t : m; t = dppu<0x140>(m); m = t > m ? t : m;
    auto s = __builtin_amdgcn_permlane16_swap(m, m, false, false); return s[0] > s[1] ? s[0] : s[1]; }
__device__ __forceinline__ float row16_sum(float x) { x += dpp<0xB1>(x); x += dpp<0x4E>(x); x += dpp<0x141>(x); x += dpp<0x140>(x); return x; }
__device__ __forceinline__ float wsum(float x) {
    x += dpp<0xB1>(x); x += dpp<0x4E>(x); x += dpp<0x141>(x); x += dpp<0x140>(x);
    auto s = __builtin_amdgcn_permlane16_swap(__float_as_uint(x), __float_as_uint(x), false, false); x = __uint_as_float(s[0]) + __uint_as_float(s[1]);
    auto t = __builtin_amdgcn_permlane32_swap(__float_as_uint(x), __float_as_uint(x), false, false); return __uint_as_float(t[0]) + __uint_as_float(t[1]);
}
__device__ __forceinline__ void peer_phase(int wv, const Args& a, int blk, int G, float* OUTP) {
    const int tid = opaque_tid(wv), lane = tid & 63, wave = tid >> 6, hh = lane >> 5, l32 = lane & 31;
    const unsigned* TK = (const unsigned*)(a.ws + WS_TOPK); const unsigned char* PU = (const unsigned char*)(a.ws + WS_PU); const unsigned char* PVt = (const unsigned char*)(a.ws + WS_PV);
    const float* gF = a.in[I_NORM_FFN_G]; const float* gO = a.in[I_FINAL_G];
    int ci0 = 0, cj0 = 0, ci1 = 0, cj1 = 0; bool valid1 = false;
    { int p = 0;
      for (int i = 0; i < 16; ++i) for (int j = 0; j < 16; ++j) if ((i + 1) * (j + 1) <= 16) { if (p == l32) { ci0 = i; cj0 = j; } if (p == l32 + 32) { ci1 = i; cj1 = j; valid1 = true; } ++p; } }
    for (int tok = blk * 8 + wave; tok < S; tok += G * 8) {
        const unsigned short* xrow = (const unsigned short*)(a.ws + WS_A2) + (size_t)tok * D + 16 * lane;
        f32x4 xa[4];
        { const u32x4 r0 = *(const u32x4*)xrow, r1 = *(const u32x4*)(xrow + 8);
          xa[0] = (f32x4){bflo(r0.x), bfhi(r0.x), bflo(r0.y), bfhi(r0.y)}; xa[1] = (f32x4){bflo(r0.z), bfhi(r0.z), bflo(r0.w), bfhi(r0.w)};
          xa[2] = (f32x4){bflo(r1.x), bfhi(r1.x), bflo(r1.y), bfhi(r1.y)}; xa[3] = (f32x4){bflo(r1.z), bfhi(r1.z), bflo(r1.w), bfhi(r1.w)}; }
        unsigned key[4];
#pragma unroll
        for (int i = 0; i < 4; ++i) key[i] = TK[(size_t)tok * 256 + lane + 64 * i];
        float ss = 0.f;
#pragma unroll
        for (int j = 0; j < 4; ++j) ss += (xa[j][0] * xa[j][0] + xa[j][1] * xa[j][1]) + (xa[j][2] * xa[j][2] + xa[j][3] * xa[j][3]);
        ss = wsum(ss);
        const float rstd = 1.0f / sqrtf(ss * (1.0f / D) + 1e-6f);
        float hf[16];
#pragma unroll
        for (int j = 0; j < 4; ++j) { const f32x4 gg = *(const f32x4*)(gF + 16 * lane + 4 * j);
#pragma unroll
            for (int e = 0; e < 4; ++e) hf[4 * j + e] = xa[j][e] * rstd * gg[e]; }
        int ex[4]; float gw[4];
#pragma unroll
        for (int i = 0; i < 4; ++i) {
            const unsigned k = key[i];
            const float v = pg8::ord2f(k & ~0x7Fu); const int ix = 127 - (int)(k & 0x7Fu);
            const float s0 = __shfl(v, hh * 32 + ci0) + __shfl(v, hh * 32 + 16 + cj0);
            const float s1 = __shfl(v, hh * 32 + ci1) + __shfl(v, hh * 32 + 16 + cj1);
            unsigned ck0 = (pg8::f2ord(s0) & ~0xFFu) | (unsigned)(255 - (ci0 * 16 + cj0));
            unsigned ck1 = valid1 ? ((pg8::f2ord(s1) & ~0xFFu) | (unsigned)(255 - (ci1 * 16 + cj1))) : 0u;
            unsigned win = 0u;
#pragma unroll
            for (int r = 0; r < 16; ++r) {
                const unsigned m = half32_umax(ck0 > ck1 ? ck0 : ck1);
                if (l32 == r) win = m;
                if (ck0 == m) ck0 = 0u;
                if (ck1 == m) ck1 = 0u;
            }
            const float ts = pg8::ord2f(win & ~0xFFu); const int flat = 255 - (int)(win & 0xFFu);
            const float mx = __shfl(ts, hh * 32);
            const float e = (l32 < 16) ? __expf(ts - mx) : 0.f;
            const float sum = row16_sum(e);
            gw[i] = e / sum;
            const int e0 = __shfl(ix, hh * 32 + ((flat >> 4) & 15)), e1 = __shfl(ix, hh * 32 + 16 + (flat & 15));
            ex[i] = e0 * 128 + e1;
        }
        float acc[16];
#pragma unroll
        for (int j = 0; j < 16; ++j) acc[j] = 0.f;
#pragma unroll 1
        for (int b = 0; b < 16; ++b) {
            const int i = b >> 2, sl = ((b >> 1) & 1) * 32 + (b & 1) * 8;
            const int exv = i == 0 ? ex[0] : i == 1 ? ex[1] : i == 2 ? ex[2] : ex[3];
            const float gwv = i == 0 ? gw[0] : i == 1 ? gw[1] : i == 2 ? gw[2] : gw[3];
            u32x4 uu[8], vv[8];
#pragma unroll
            for (int q = 0; q < 8; ++q) { const int eid = __builtin_amdgcn_readlane(exv, sl + q); uu[q] = *(const u32x4*)(PU + (size_t)eid * 1024 + 16 * lane); vv[q] = *(const u32x4*)(PVt + (size_t)eid * 1024 + 16 * lane); }
            float d[8];
#pragma unroll
            for (int q = 0; q < 8; ++q) { float s_ = 0.f;
#pragma unroll
                for (int e = 0; e < 4; ++e) { const f32x2v lo = __builtin_amdgcn_cvt_pk_f32_fp8((int)uu[q][e], false), hi2 = __builtin_amdgcn_cvt_pk_f32_fp8((int)uu[q][e], true);
                    s_ += (lo[0] * hf[4 * e] + lo[1] * hf[4 * e + 1]) + (hi2[0] * hf[4 * e + 2] + hi2[1] * hf[4 * e + 3]); }
                d[q] = s_; }
            float z;
            { const bool b0 = lane & 1, b1 = lane & 2, b2 = lane & 4;
              float r4[4], r2[2];
#pragma unroll
              for (int q = 0; q < 4; ++q) { const float keep = b0 ? d[q + 4] : d[q], give = b0 ? d[q] : d[q + 4]; r4[q] = keep + dpp<0xB1>(give); }
#pragma unroll
              for (int q = 0; q < 2; ++q) { const float keep = b1 ? r4[q + 2] : r4[q], give = b1 ? r4[q] : r4[q + 2]; r2[q] = keep + dpp<0x4E>(give); }
              { const float keep = b2 ? r2[1] : r2[0], give = b2 ? r2[0] : r2[1];
                const float up = dpp<0x104>(give), dn = dpp<0x114>(give);
                z = keep + (b2 ? dn : up); }
              z += dpp<0x128>(z);
              auto s16 = __builtin_amdgcn_permlane16_swap(__float_as_uint(z), __float_as_uint(z), false, false); z = __uint_as_float(s16[0]) + __uint_as_float(s16[1]);
              auto s32 = __builtin_amdgcn_permlane32_swap(__float_as_uint(z), __float_as_uint(z), false, false); z = __uint_as_float(s32[0]) + __uint_as_float(s32[1]); }
            const int myq = 4 * (lane & 1) + 2 * ((lane >> 1) & 1) + ((lane >> 2) & 1);
            const float gmine = __shfl(gwv, sl + myq);
            z *= (1.0f / 128.0f);
            const float wl = gmine * 0.5f * z * (1.0f + erff(z * 0.70710678118654752f)) * (1.0f / 128.0f);
#pragma unroll
            for (int q = 0; q < 8; ++q) { const float w = __builtin_bit_cast(float, __builtin_amdgcn_readlane(__builtin_bit_cast(int, wl), ((q >> 2) & 1) | (((q >> 1) & 1) << 1) | ((q & 1) << 2)));
#pragma unroll
                for (int e = 0; e < 4; ++e) { const f32x2v lo = __builtin_amdgcn_cvt_pk_f32_fp8((int)vv[q][e], false), hi2 = __builtin_amdgcn_cvt_pk_f32_fp8((int)vv[q][e], true);
                    acc[4 * e] += w * lo[0]; acc[4 * e + 1] += w * lo[1]; acc[4 * e + 2] += w * hi2[0]; acc[4 * e + 3] += w * hi2[1]; } }
        }
        float s3 = 0.f;
#pragma unroll
        for (int j = 0; j < 4; ++j)
#pragma unroll
            for (int e = 0; e < 4; ++e) { xa[j][e] += acc[4 * j + e]; s3 += xa[j][e] * xa[j][e]; }
        s3 = wsum(s3);
        const float r3 = 1.0f / sqrtf(s3 * (1.0f / D) + 1e-6f);
        float* orow = OUTP + (size_t)tok * D + 16 * lane;
#pragma unroll
        for (int j = 0; j < 4; ++j) { const f32x4 gg = *(const f32x4*)(gO + 16 * lane + 4 * j); *(f32x4*)(orow + 4 * j) = xa[j] * r3 * gg; }
    }
}
}

#define XB_TMO      128
#define XB_XCNT(j)  (256  + 64 * (j))
#define XB_XSUB(j)  (1280 + 64 * (j))
#define XB_XGEN(j)  (2304 + 64 * (j))
#define XB_TOP      3328
#define XB_TOPGEN   3392
#define XCD_BAR_WORDS 3456
#define XB_SPIN_CAP (1u << 18)

__device__ __forceinline__ unsigned xb_ld(unsigned* p)              { return __hip_atomic_load(p, __ATOMIC_RELAXED, __HIP_MEMORY_SCOPE_AGENT); }
__device__ __forceinline__ unsigned xb_add(unsigned* p, unsigned v) { return __hip_atomic_fetch_add(p, v, __ATOMIC_RELAXED, __HIP_MEMORY_SCOPE_AGENT); }
__device__ __forceinline__ unsigned xb_xcc_id() { return (unsigned)__builtin_amdgcn_s_getreg((3 << 11) | 20) & 0xFu; }
#define XB_SPIN(cond, bar) do { unsigned _sp = 0; while (cond) { __builtin_amdgcn_s_sleep(1); \
    if ((++_sp & 255u) == 0u) { if (xb_ld(&(bar)[XB_TMO])) break; if (_sp > XB_SPIN_CAP) { atomicAdd(&(bar)[XB_TMO], 1u); break; } } } } while (0)

struct XcdBarrier {
    unsigned* bar; unsigned x;
    volatile LAS unsigned* st;
};

__device__ __forceinline__ XcdBarrier xcd_barrier_post(unsigned* bar, volatile LAS unsigned* st, int tid) {
    XcdBarrier b; b.bar = bar; b.x = xb_xcc_id(); b.st = st;
    if (tid == 0) (void)xb_add(&bar[XB_XCNT(b.x)], 1u);
    return b;
}
__device__ __forceinline__ void xcd_barrier_complete(unsigned* bar, unsigned x, unsigned& nloc, unsigned& nx) {
    const unsigned G = gridDim.x * gridDim.y * gridDim.z;
    unsigned sum, cnt, mine, sp = 0u;
    for (;;) {
        sum = 0u; cnt = 0u; mine = 0u;
#pragma unroll
        for (unsigned j = 0; j < 16; ++j) { const unsigned c = xb_ld(&bar[XB_XCNT(j)]); sum += c; cnt += (c > 0u) ? 1u : 0u; mine = (j == x) ? c : mine; }
        if (sum == G) break;
        __builtin_amdgcn_s_sleep(1);
        if ((++sp & 255u) == 0u) { if (xb_ld(&bar[XB_TMO])) break; if (sp > XB_SPIN_CAP) { atomicAdd(&bar[XB_TMO], 1u); break; } }
    }
    nloc = mine > 0u ? mine : 1u; nx = cnt > 0u ? cnt : 1u;
}

__device__ __forceinline__ void xcd_barrier(const XcdBarrier& b, int tid) {
    asm volatile("s_waitcnt vmcnt(0)" ::: "memory");
    __syncthreads();
    if (tid == 0) {
        unsigned* bar = b.bar;
        __builtin_amdgcn_s_waitcnt(0);
        unsigned nloc = b.st[0], nx = b.st[1];
        if (nloc == 0u) { xcd_barrier_complete(bar, b.x, nloc, nx); b.st[0] = nloc; b.st[1] = nx; }
        const unsigned old = xb_add(&bar[XB_XSUB(b.x)], 1u);
        const unsigned gen = old / nloc;
        if (old + 1u == (gen + 1u) * nloc) {
            __builtin_amdgcn_fence(__ATOMIC_RELEASE, "agent");
            asm volatile("s_waitcnt vmcnt(0)" ::: "memory");
            const unsigned og = xb_add(&bar[XB_TOP], 1u);
            const unsigned tg = og / nx;
            if (og + 1u == (tg + 1u) * nx) xb_add(&bar[XB_TOPGEN], 1u);
            else XB_SPIN(xb_ld(&bar[XB_TOPGEN]) == tg, bar);
            __builtin_amdgcn_fence(__ATOMIC_ACQUIRE, "agent");
            xb_add(&bar[XB_XGEN(b.x)], 1u);
            asm volatile("s_waitcnt vmcnt(0)" ::: "memory");
        } else {
            XB_SPIN(xb_ld(&bar[XB_XGEN(b.x)]) == gen, bar);
            __builtin_amdgcn_fence(__ATOMIC_ACQUIRE, "agent");
            asm volatile("s_waitcnt vmcnt(0)" ::: "memory");
        }
    }
    __syncthreads();
}

constexpr int LDS_BYTES = 147456, LDS_MISC = 139264;
__global__ void __launch_bounds__(512, 2) mk_fwd(Args a) {
    extern __shared__ __attribute__((aligned(16))) unsigned char lds_raw[];
    LAS unsigned char* lds = (LAS unsigned char*)lds_raw;
    unsigned char* ws = a.ws;
    const int G = gridDim.x, blk = blockIdx.x, wv = __builtin_amdgcn_readfirstlane(threadIdx.x >> 6);
    { const int t0 = opaque_tid(wv); if (t0 < 16) ((volatile LAS unsigned*)(lds + LDS_MISC))[t0] = 0u; }
    __syncthreads();
    XcdBarrier bar = xcd_barrier_post((unsigned*)(ws + WS_CTL), (volatile LAS unsigned*)(lds + LDS_MISC), opaque_tid(wv));
#define IN(k) (a.ph_lo <= (k) && (k) < a.ph_hi)
#define SEAM(k) do { if (IN(k) && IN((k) + 1)) xcd_barrier(bar, opaque_tid(wv)); } while (0)
    if (IN(0)) p0_prologue(wv, a, lds, blk, G);
    SEAM(0);
    if (IN(1)) {
        pg8::Gemm g{(const bf16*)(ws + WS_A0), (const bf16*)(ws + WS_WT_IN), S, NCOLS, D, D, D}; pg8::StaticOrder So; So.init(S, NCOLS, G, blk);
        pg8::EpiProj E{(const float*)(ws + WS_RSTD0), (bf16*)(ws + WS_A1), (bf16*)(ws + WS_A2), (bf16*)(ws + WS_A3), (bf16*)(ws + WS_A4), (bf16*)(ws + WS_A5), (bf16*)(ws + WS_A6), (bf16*)a.out, 0.125f * 1.4426950408889634f, (unsigned*)(ws + WS_KMAX), (PG8_LAS float*)(lds + 131072)};
        pg8::gemm_phase<pg8::EpiProj, pg8::StaticOrder, true, true>(wv, lds, g, So, E);
    }
    SEAM(1);
    if (IN(2)) { conv_phase(wv, a, blk, G);  att::attn_phase(wv, a, lds, blk, G, (bf16*)(ws + WS_A3)); }
    SEAM(2);
    if (IN(3)) {
        pg8::StaticOrder So; So.init(S, D, G, blk);
        { pg8::Gemm g{(const bf16*)(ws + WS_A1), (const bf16*)(ws + WS_WT_CONV), S, D, 2 * D, D, D};
          const pg8::Split sp{16, (long long)WS_A3 - (long long)WS_A1 - 16 * 128, (long long)WS_WT_ATTN - (long long)WS_WT_CONV - 16 * 128};
          pg8::EpiMergeK E{(const bf16*)(ws + WS_A6), (const bf16*)a.out, (bf16*)(ws + WS_A0)};
          pg8::gemm_phase<pg8::EpiMergeK, pg8::StaticOrder, true, true, true>(wv, lds, g, So, E, sp); }
    }
    SEAM(3);
    if (IN(4)) {
        cross_fold(wv, a, blk, G);
        peer_convert(wv, a, blk, G);
        pg8::Gemm g{(const bf16*)(ws + WS_A0), (const bf16*)(ws + WS_WT_MIX), S, D, D, D, D}; pg8::StaticOrder So; So.init(S, D, G, blk);
        pg8::EpiResid E{a.in[I_X], (bf16*)(ws + WS_A2), (float*)(ws + WS_SS1)};
        pg8::gemm_phase<pg8::EpiResid, pg8::StaticOrder, true, true>(wv, lds, g, So, E);
    }
    SEAM(4);
    if (IN(5)) {
        pg8::Gemm g{(const bf16*)(ws + WS_A2), (const bf16*)(ws + WS_WQK), S, D, D, D, D}; pg8::StaticOrder So; So.init(S, D, G, blk);
        pg8::EpiSoftmaxFull E{(const float*)(ws + WS_SS1), (bf16*)(ws + WS_A1), 0.0625f * 1.4426950408889634f};
        pg8::gemm_phase<pg8::EpiSoftmaxFull, pg8::StaticOrder, false, true>(wv, lds, g, So, E);
    }
    SEAM(5);
    if (IN(6)) {
        pg8::Gemm g{(const bf16*)(ws + WS_A1), (const bf16*)(ws + WS_VW), S, D, D, D, D}; pg8::StaticOrder So; So.init(S, D, G, blk);
        pg8::EpiResidB E{(bf16*)(ws + WS_A2), (float*)(ws + WS_SS2)};
        pg8::gemm_phase<pg8::EpiResidB, pg8::StaticOrder, true, true>(wv, lds, g, So, E);
    }
    SEAM(6);
    if (IN(7)) {
        pg8::StaticOrder So; So.init(S, 2048, G, blk);
        unsigned* KS = (unsigned*)(ws + WS_KS) + (size_t)blk * 65536;
        for (int i = 0;; ++i) { pg8::Unit u; if (!So.next(i, u)) break;
            { pg8::Gemm g{(const bf16*)(ws + WS_A2), (const bf16*)(ws + WS_WT_PQ), S, 2048, D, D, D}; pg8::OneUnit S1{u.pm, u.pn};
              pg8::EpiKeys E{(const float*)(ws + WS_SS2), KS};
              pg8::gemm_phase<pg8::EpiKeys, pg8::OneUnit, false, true>(wv, lds, g, S1, E); }
            pg8::topk_from_keys(opaque_tid(wv), KS, (unsigned*)(ws + WS_TOPK), u.pm * 256, u.pn);
            asm volatile("s_waitcnt vmcnt(0)" ::: "memory"); __syncthreads(); }
    }
    SEAM(7);
    if (IN(8)) peer::peer_phase(wv, a, blk, G, a.out);
#undef IN
#undef SEAM
}

extern "C" void kernel_launch(void* const* d_in, const int* in_sizes, int n_in, void* d_out, int out_size, void* d_ws, size_t ws_size, hipStream_t stream) {
    static int grid = 0;
    if (grid == 0) {
        if (ws_size < WS_END || n_in != 25 || out_size != S * D) { fprintf(stderr, "kernel_launch: unexpected ws_size %zu / n_in %d / out_size %d\n", ws_size, n_in, out_size); grid = -1; return; }
        if (hipFuncSetAttribute((const void*)mk_fwd, hipFuncAttributeMaxDynamicSharedMemorySize, LDS_BYTES) != hipSuccess) { fprintf(stderr, "kernel_launch: hipFuncSetAttribute failed\n"); grid = -1; return; }
        int dev = 0, cus = 0, per_cu = 0;
        if (hipGetDevice(&dev) != hipSuccess || hipDeviceGetAttribute(&cus, hipDeviceAttributeMultiprocessorCount, dev) != hipSuccess) { grid = -1; return; }
        if (hipOccupancyMaxActiveBlocksPerMultiprocessor(&per_cu, (const void*)mk_fwd, 512, LDS_BYTES) != hipSuccess || per_cu < 1) { fprintf(stderr, "kernel_launch: occupancy query says %d blocks per CU\n", per_cu); grid = -1; return; }
        grid = cus;
    }
    if (grid < 0) return;
    Args a{};
    for (int i = 0; i < 25; ++i) a.in[i] = (const float*)d_in[i];
    a.out = (float*)d_out; a.ws = (unsigned char*)d_ws; a.ph_lo = 0; a.ph_hi = 9;
    if (hipMemsetAsync(d_ws, 0, 65536, stream) != hipSuccess) { fprintf(stderr, "kernel_launch: hipMemsetAsync failed\n"); return; }
    void* kargs[] = {&a};
    hipError_t e = hipLaunchCooperativeKernel((const void*)mk_fwd, dim3(grid), dim3(512), kargs, LDS_BYTES, stream);
    if (e != hipSuccess) fprintf(stderr, "kernel_launch: cooperative launch failed: %s (grid %d)\n", hipGetErrorString(e), grid);
}
```

```cpp
#include <hip/hip_runtime.h>
#include <math.h>
#include <cstdio>
#include <cstdint>
namespace pg8 {
#define PG8_LAS __attribute__((address_space(3)))
typedef unsigned short bf16_t;
typedef short bf16x8 __attribute__((ext_vector_type(8)));
typedef float f32x4 __attribute__((ext_vector_type(4)));
typedef unsigned u32x4 __attribute__((ext_vector_type(4)));
constexpr int BM = 256, BK = 64, HALF = 128, HTB = HALF * BK * 2  , STAGE_BYTES = 8 * HTB, NXCD = 8, WGM = 8;

__host__ __device__ __forceinline__ int lds_byte(int r, int c) { const int st = (r >> 4) * 2 + (c >> 5), rr = r & 15, cc = c & 31, ob = rr * 64 + cc * 2; return st * 1024 + (ob ^ (((ob >> 9) & 1) << 5)); }
__host__ __device__ __forceinline__ void stage_rc(int b, int& R, int& C) { const int st = b / 1024, sb = b % 1024, swz = sb ^ (((sb >> 9) & 1) << 5); R = (st >> 1) * 16 + swz / 64; C = (st & 1) * 32 + (swz % 64) / 2; }
__host__ __device__ __forceinline__ int perm32(int rho) { const int n = rho >> 4, i = rho & 15; return 8 * (i >> 2) + 4 * n + (i & 3); }

struct Unit { int pm, pn; };
struct Gemm { const bf16_t* A; const bf16_t* Bt; int M, N, K, lda, ldb; };
struct Split { int ksplit; long long dA2, dB2; };

struct StaticOrder {
    int nM, nN, nwg, G, c;
    __host__ __device__ void init(int M, int N, int G_, int c_) { nM = M / BM; nN = N / BM; nwg = nM * nN; G = G_; c = c_; }
    __host__ __device__ bool next(int i, Unit& u) const {
        const long L = (long)i * G + c; if (L >= nwg) return false;
        int wgid = (int)L; { const int q = nwg / NXCD, r = nwg % NXCD, xcd = wgid % NXCD, off = wgid / NXCD; wgid = (xcd < r ? xcd * (q + 1) : r * (q + 1) + (xcd - r) * q) + off; }
        const int nig = WGM * nN, gid = wgid / nig, fm = gid * WGM, gsz = (nM - fm) < WGM ? (nM - fm) : WGM;
        u.pm = fm + ((wgid % nig) % gsz); u.pn = (wgid % nig) / gsz; return true;
    }
    __device__ __forceinline__ void a_ready(const Unit&) const {}
    __device__ __forceinline__ void done(const Unit&) const {}
};

typedef float f32x2 __attribute__((ext_vector_type(2)));
typedef __bf16 bf16x2v __attribute__((ext_vector_type(2)));
__device__ __forceinline__ unsigned cvt_pk_bf16(float lo, float hi) { const f32x2 v = {lo, hi}; const bf16x2v b = __builtin_convertvector(v, bf16x2v); return __builtin_bit_cast(unsigned, b); }
template <class E, class = void> struct HasPrefetch { static constexpr bool value = false; };
template <class E> struct HasPrefetch<E, decltype((void)&E::prefetch)> { static constexpr bool value = true; };
template <class Epi, class Sched, bool ALIGN_EPI = false, bool SP2 = false, bool SPLIT = false>
__device__ __forceinline__ void gemm_phase(int wv, PG8_LAS unsigned char* lds, const Gemm g, const Sched& S, const Epi& E, const Split sp = Split{0, 0, 0}) {
    int tid_; asm volatile("v_mbcnt_lo_u32_b32 %0, -1, 0\n\tv_mbcnt_hi_u32_b32 %0, -1, %0" : "=v"(tid_)); tid_ += wv * 64;
    const int tid = tid_, wid = __builtin_amdgcn_readfirstlane(tid >> 6), lane = tid & 63, wr = wid >> 2, wc = wid & 3, fr = lane & 15, fq = lane >> 4;
    const int K = g.K, nt = K / BK;
    unsigned voffA[2], voffB[2];
#pragma unroll
    for (int i = 0; i < 2; ++i) { int R, C; stage_rc(tid * 16 + i * 8192, R, C); const int Rb = Epi::PERM ? ((R & ~31) + perm32(R & 31)) : R;
        voffA[i] = (unsigned)(R * g.lda + C) * 2u; voffB[i] = (unsigned)(Rb * g.ldb + C) * 2u; }
    const size_t kstep = (size_t)(BK * 2);
    const size_t hstepA = (size_t)HALF * g.lda * 2, hstepB = (size_t)HALF * g.ldb * 2;
    const size_t tstepA = 2 * hstepA, tstepB = 2 * hstepB;
    const unsigned ldsw = (unsigned)wid * 1024u;
    const int aoff = lds_byte(wr * 64 + fr, fq * 8), boff = lds_byte(wc * 32 + fr, fq * 8);
#define PG8_SA(b, h) (((b) * 2 + (h)) * HTB)
#define PG8_SB(b, h) ((4 + (b) * 2 + (h)) * HTB)
#define PG8_STAGE(bufoff, gbase, voff) do { _Pragma("unroll") for (int _i = 0; _i < 2; ++_i) \
        __builtin_amdgcn_global_load_lds((const unsigned*)((const char*)(gbase) + (voff)[_i]), (PG8_LAS unsigned*)(lds + (bufoff) + ldsw + _i * 8192), 16, 0, 0); } while (0)
#define PG8_LDA(dst, b, h) do { _Pragma("unroll") for (int m = 0; m < 4; ++m) _Pragma("unroll") for (int k = 0; k < 2; ++k) dst[m][k] = *(const PG8_LAS bf16x8*)(lds + PG8_SA(b, h) + aoff + m * 2048 + k * 1024); } while (0)
#define PG8_LDB(dst, b, h) do { _Pragma("unroll") for (int n = 0; n < 2; ++n) _Pragma("unroll") for (int k = 0; k < 2; ++k) dst[n][k] = *(const PG8_LAS bf16x8*)(lds + PG8_SB(b, h) + boff + n * 2048 + k * 1024); } while (0)
#define PG8_MMA(ai, bj, At, Bt) do { __builtin_amdgcn_s_setprio(1); _Pragma("unroll") for (int m = 0; m < 4; ++m) _Pragma("unroll") for (int n = 0; n < 2; ++n) _Pragma("unroll") for (int k = 0; k < 2; ++k) \
        acc[ai][bj][m][n] = __builtin_amdgcn_mfma_f32_16x16x32_bf16(Bt[n][k], At[m][k], acc[ai][bj][m][n], 0, 0, 0); __builtin_amdgcn_s_setprio(0); } while (0)
#define PG8_WAIT_V(n) asm volatile("s_waitcnt vmcnt(" #n ")" ::: "memory")
#define PG8_WAIT_L(n) asm volatile("s_waitcnt lgkmcnt(" #n ")" ::: "memory")
#define PG8_BAR __builtin_amdgcn_s_barrier()
#define PG8_SCHED __builtin_amdgcn_sched_barrier(0)
    Unit cur, nxt; int ui = 0;
    if (!S.next(0, cur)) return;
    f32x4 acc[2][2][4][2];
#pragma unroll
    for (int a = 0; a < 2; ++a)
#pragma unroll
        for (int b = 0; b < 2; ++b)
#pragma unroll
            for (int m = 0; m < 4; ++m)
#pragma unroll
                for (int n = 0; n < 2; ++n) acc[a][b][m][n] = (f32x4){0.f, 0.f, 0.f, 0.f};
    bf16x8 At[4][2], B0[2][2], B1[2][2];
    const char* cA = (const char*)g.A + (size_t)cur.pm * tstepA; const char* cB = (const char*)g.Bt + (size_t)cur.pn * tstepB;
    S.a_ready(cur);
    if constexpr (HasPrefetch<Epi>::value) E.prefetch(cur, lds, wid);
    if constexpr (SP2) {
        PG8_STAGE(PG8_SB(0, 0), cB, voffB); PG8_STAGE(PG8_SB(0, 1), cB + hstepB, voffB); PG8_STAGE(PG8_SA(0, 0), cA, voffA); PG8_STAGE(PG8_SA(0, 1), cA + hstepA, voffA);
        if (wr == 1) PG8_BAR;
        PG8_WAIT_V(2); PG8_BAR;
        PG8_STAGE(PG8_SB(1, 0), cB + kstep, voffB); PG8_STAGE(PG8_SA(1, 0), cA + kstep, voffA); PG8_STAGE(PG8_SB(1, 1), cB + hstepB + kstep, voffB);
        PG8_WAIT_V(6); PG8_BAR;
    } else {
        PG8_STAGE(PG8_SB(0, 0), cB, voffB); PG8_STAGE(PG8_SA(0, 0), cA, voffA); PG8_STAGE(PG8_SB(0, 1), cB + hstepB, voffB); PG8_STAGE(PG8_SA(0, 1), cA + hstepA, voffA);
        if (wr == 1) PG8_BAR;
        PG8_WAIT_V(4); PG8_BAR;
        PG8_STAGE(PG8_SB(1, 0), cB + kstep, voffB); PG8_STAGE(PG8_SA(1, 0), cA + kstep, voffA); PG8_STAGE(PG8_SB(1, 1), cB + hstepB + kstep, voffB);
        PG8_WAIT_V(6); PG8_BAR;
    }
    for (;;) {
        const bool has_next = S.next(ui + 1, nxt);
        const char* nA = has_next ? (const char*)g.A + (size_t)nxt.pm * tstepA : cA; const char* nB = has_next ? (const char*)g.Bt + (size_t)nxt.pn * tstepB : cB;
        for (int t = 0; t < nt; t += 2) {
            const bool last = (t == nt - 2);
            long long oa1 = 0, oa2 = 0, ob2 = 0;
            if constexpr (SPLIT) { if (t == sp.ksplit) E.mid(acc, cur, wr, wc, fr, fq);
                if (t >= sp.ksplit) oa1 = sp.dA2; if (t + 2 >= sp.ksplit) { oa2 = sp.dA2; ob2 = sp.dB2; } }
            const char* a1 = cA + (size_t)(t + 1) * kstep + oa1;
            const char* a2 = last ? nA : cA + (size_t)(t + 2) * kstep + oa2; const char* b2 = last ? nB : cB + (size_t)(t + 2) * kstep + ob2;
            const char* a3 = a2 + kstep; const char* b3 = b2 + kstep;
            if (last && has_next) S.a_ready(nxt);
            if constexpr (SP2) {
            PG8_LDB(B0, 0, 0); PG8_LDB(B1, 0, 1); PG8_SCHED; PG8_LDA(At, 0, 0); PG8_STAGE(PG8_SA(1, 1), a1 + hstepA, voffA);
            PG8_WAIT_V(8); PG8_WAIT_L(0); PG8_BAR; PG8_MMA(0, 0, At, B0); PG8_MMA(0, 1, At, B1); PG8_BAR; PG8_SCHED;
            PG8_LDA(At, 0, 1); PG8_STAGE(PG8_SB(0, 0), b2, voffB); PG8_STAGE(PG8_SB(0, 1), b2 + hstepB, voffB); PG8_STAGE(PG8_SA(0, 0), a2, voffA);
            PG8_WAIT_V(8); PG8_WAIT_L(0); PG8_BAR; PG8_MMA(1, 0, At, B0); PG8_MMA(1, 1, At, B1); PG8_BAR; PG8_SCHED;
            PG8_LDB(B0, 1, 0); PG8_LDB(B1, 1, 1); PG8_SCHED; PG8_LDA(At, 1, 0); PG8_STAGE(PG8_SA(0, 1), a2 + hstepA, voffA);
            PG8_WAIT_V(8); PG8_WAIT_L(0); PG8_BAR; PG8_MMA(0, 0, At, B0); PG8_MMA(0, 1, At, B1); PG8_BAR; PG8_SCHED;
            PG8_LDA(At, 1, 1); PG8_STAGE(PG8_SB(1, 0), b3, voffB); PG8_STAGE(PG8_SB(1, 1), b3 + hstepB, voffB); PG8_STAGE(PG8_SA(1, 0), a3, voffA);
            PG8_WAIT_V(8); PG8_WAIT_L(0); PG8_BAR; PG8_MMA(1, 0, At, B0); PG8_MMA(1, 1, At, B1); PG8_BAR; PG8_SCHED;
            } else {
            PG8_LDB(B0, 0, 0); PG8_SCHED; PG8_LDA(At, 0, 0); PG8_STAGE(PG8_SA(1, 1), a1 + hstepA, voffA);
            PG8_WAIT_L(8); PG8_BAR; PG8_WAIT_L(0); PG8_MMA(0, 0, At, B0); PG8_BAR; PG8_SCHED;
            PG8_LDB(B1, 0, 1); PG8_STAGE(PG8_SB(0, 0), b2, voffB);
            PG8_BAR; PG8_WAIT_L(0); PG8_MMA(0, 1, At, B1); PG8_BAR;
            PG8_LDA(At, 0, 1); PG8_STAGE(PG8_SA(0, 0), a2, voffA);
            PG8_BAR; PG8_WAIT_L(0); PG8_MMA(1, 0, At, B0); PG8_BAR; PG8_SCHED;
            PG8_STAGE(PG8_SB(0, 1), b2 + hstepB, voffB);
            PG8_WAIT_V(6); PG8_BAR; PG8_MMA(1, 1, At, B1); PG8_BAR;
            PG8_LDB(B0, 1, 0); PG8_SCHED; PG8_LDA(At, 1, 0); PG8_STAGE(PG8_SA(0, 1), a2 + hstepA, voffA);
            PG8_WAIT_L(8); PG8_BAR; PG8_WAIT_L(0); PG8_MMA(0, 0, At, B0); PG8_BAR; PG8_SCHED;
            PG8_LDB(B1, 1, 1); PG8_STAGE(PG8_SB(1, 0), b3, voffB);
            PG8_BAR; PG8_WAIT_L(0); PG8_MMA(0, 1, At, B1); PG8_BAR;
            PG8_LDA(At, 1, 1); PG8_STAGE(PG8_SA(1, 0), a3, voffA);
            PG8_BAR; PG8_WAIT_L(0); PG8_MMA(1, 0, At, B0); PG8_BAR; PG8_SCHED;
            PG8_STAGE(PG8_SB(1, 1), b3 + hstepB, voffB);
            PG8_WAIT_V(6); PG8_BAR; PG8_MMA(1, 1, At, B1); PG8_BAR;
            }
        }
        if constexpr (ALIGN_EPI) { if (wr == 0) PG8_BAR; }
        if constexpr (!Epi::AFTER_DRAIN) { E(acc, cur, wr, wc, fr, fq); S.done(cur); }
        if (!has_next) break;
#pragma unroll
        for (int a = 0; a < 2; ++a)
#pragma unroll
            for (int b = 0; b < 2; ++b)
#pragma unroll
                for (int m = 0; m < 4; ++m)
#pragma unroll
                    for (int n = 0; n < 2; ++n) acc[a][b][m][n] = (f32x4){0.f, 0.f, 0.f, 0.f};
        cur = nxt; cA = nA; cB = nB; ++ui;
        if constexpr (HasPrefetch<Epi>::value) E.prefetch(cur, lds, wid);
        if constexpr (ALIGN_EPI) { if (wr == 1) PG8_BAR; }
    }
    PG8_WAIT_V(0);
    if constexpr (!ALIGN_EPI) { if (wr == 0) PG8_BAR; }
    PG8_BAR;
    if constexpr (Epi::AFTER_DRAIN) { E.fused(acc, cur, wr, wc, fr, fq, lds, wid, lane); S.done(cur); }
#undef PG8_SA
#undef PG8_SB
#undef PG8_STAGE
#undef PG8_LDA
#undef PG8_LDB
#undef PG8_MMA
#undef PG8_WAIT_V
#undef PG8_WAIT_L
#undef PG8_BAR
#undef PG8_SCHED
}
}


constexpr int S = 16384, D = 1024, NCOLS = 8192, MEMN = 256;
typedef unsigned short bf16;
typedef float f32x4 __attribute__((ext_vector_type(4)));
typedef unsigned u32x4 __attribute__((ext_vector_type(4)));
typedef unsigned u32x2 __attribute__((ext_vector_type(2)));
__device__ __forceinline__ void st16wt(void* p, u32x4 v) { asm volatile("global_store_dwordx4 %0, %1, off sc1\n\ts_nop 1" :: "v"(p), "v"(v) : "memory"); }
#define LAS __attribute__((address_space(3)))

__device__ const unsigned char T5_BUCKET[128] = {0, 1, 2, 3, 4, 5, 6, 7, 8, 9, 10, 11, 12, 13, 14, 15, 16, 16, 16, 17, 17, 18, 18, 18, 19, 19, 19, 20, 20, 20, 20, 21, 21, 21, 21, 22, 22, 22, 22, 22, 23, 23, 23, 23, 23, 23, 24, 24, 24, 24, 24, 24, 25, 25, 25, 25, 25, 25, 25, 26, 26, 26, 26, 26, 26, 26, 26, 27, 27, 27, 27, 27, 27, 27, 27, 27, 27, 28, 28, 28, 28, 28, 28, 28, 28, 28, 28, 29, 29, 29, 29, 29, 29, 29, 29, 29, 29, 29, 29, 30, 30, 30, 30, 30, 30, 30, 30, 30, 30, 30, 30, 30, 30, 31, 31, 31, 31, 31, 31, 31, 31, 31, 31, 31, 31, 31, 31, 31};

constexpr size_t MiB = 1u << 20;
constexpr size_t WS_CTL = 0, WS_KMAX = 32768  , WS_RSTD0 = 512 * 1024;
constexpr size_t WS_WT_IN = 1 * MiB, WS_WT_CONV = 17 * MiB, WS_WT_ATTN = 19 * MiB, WS_WT_MIX = 21 * MiB, WS_WT_CQ = 23 * MiB, WS_WT_CO = 25 * MiB, WS_WT_PQ = 27 * MiB;
constexpr size_t WS_SUBK = 31 * MiB, WS_KV = 32 * MiB, WS_SS1 = 34 * MiB, WS_SS2 = 35 * MiB;
constexpr size_t WS_TOPK = 36 * MiB  , WS_PU = 196 * MiB  , WS_PV = 228 * MiB  ;
constexpr size_t WS_WQK = 23 * MiB  , WS_VW = 212 * MiB  ;
constexpr size_t WS_BTAB = 640 * 1024  ;
constexpr size_t WS_PQS = 52 * MiB  , WS_KS = 132 * MiB  ;
constexpr size_t WS_A0 = 36 * MiB, WS_A1 = 68 * MiB, WS_A2 = 100 * MiB, WS_A3 = 132 * MiB, WS_A4 = 164 * MiB, WS_A5 = 196 * MiB, WS_A6 = 228 * MiB, WS_END = 260 * MiB;

__device__ __forceinline__ float wave_sum(float v) {
#pragma unroll
    for (int o = 1; o < 64; o <<= 1) v += __shfl_xor(v, o);
    return v;
}
__device__ __forceinline__ float wave_max(float v) {
#pragma unroll
    for (int o = 1; o < 64; o <<= 1) v = fmaxf(v, __shfl_xor(v, o));
    return v;
}
__device__ __forceinline__ int opaque_tid(int wv) { int t; asm volatile("v_mbcnt_lo_u32_b32 %0, -1, 0\n\tv_mbcnt_hi_u32_b32 %0, -1, %0" : "=v"(t)); return t + wv * 64; }
__device__ __forceinline__ unsigned f2bf(float f) { unsigned u = __builtin_bit_cast(unsigned, f); return (u + 0x7fffu + ((u >> 16) & 1u)) >> 16; }
__device__ __forceinline__ unsigned pk2(float lo, float hi) { return pg8::cvt_pk_bf16(lo, hi); }
__device__ __forceinline__ float bflo(unsigned w) { return __builtin_bit_cast(float, w << 16); }
__device__ __forceinline__ float bfhi(unsigned w) { return __builtin_bit_cast(float, w & 0xffff0000u); }
__device__ __forceinline__ float sigmoidf_(float x) { return __builtin_amdgcn_rcpf(1.0f + __builtin_amdgcn_exp2f(x * -1.4426950408889634f)); }

struct Args { const float* in[25]; float* out; unsigned char* ws; int ph_lo, ph_hi; };
enum { I_X = 0, I_MEM, I_NORM_MIX_G, I_W_IN, I_CONV_W, I_W_CONV_OUT, I_LQ1, I_LK1, I_LQ2, I_LK2, I_SUBLN_G, I_W_ATTN_OUT, I_W_MIX_OUT, I_REL_BIAS, I_NORM_CROSS_G, I_NORM_MEM_G,
       I_W_CQ, I_W_CKV, I_W_CO, I_NORM_FFN_G, I_W_PQ, I_SUB_KEYS, I_PEER_U, I_PEER_V, I_FINAL_G };

namespace pg8 {
template <int CTRL> __device__ __forceinline__ float dppf(float x) { return __builtin_bit_cast(float, __builtin_amdgcn_mov_dpp(__builtin_bit_cast(int, x), CTRL, 0xf, 0xf, true)); }
__device__ __forceinline__ float row16_max(float v) { v = fmaxf(v, dppf<0xB1>(v)); v = fmaxf(v, dppf<0x4E>(v)); v = fmaxf(v, dppf<0x141>(v)); return fmaxf(v, dppf<0x140>(v)); }
__device__ __forceinline__ float xrow16_max(float x) {
    auto s = __builtin_amdgcn_permlane16_swap(__float_as_uint(x), __float_as_uint(x), false, false); x = fmaxf(__uint_as_float(s[0]), __uint_as_float(s[1]));
    auto t = __builtin_amdgcn_permlane32_swap(__float_as_uint(x), __float_as_uint(x), false, false); return fmaxf(__uint_as_float(t[0]), __uint_as_float(t[1])); }
__device__ __forceinline__ float xrow16_sum(float x) {
    auto s = __builtin_amdgcn_permlane16_swap(__float_as_uint(x), __float_as_uint(x), false, false); x = __uint_as_float(s[0]) + __uint_as_float(s[1]);
    auto t = __builtin_amdgcn_permlane32_swap(__float_as_uint(x), __float_as_uint(x), false, false); return __uint_as_float(t[0]) + __uint_as_float(t[1]); }
__device__ __forceinline__ u32x4 pack8(const f32x4& v0, const f32x4& v1) { u32x4 w; w.x = cvt_pk_bf16(v0[0], v0[1]); w.y = cvt_pk_bf16(v0[2], v0[3]); w.z = cvt_pk_bf16(v1[0], v1[1]); w.w = cvt_pk_bf16(v1[2], v1[3]); return w; }
struct EpiProj {
    static constexpr bool PERM = true, AFTER_DRAIN = false;
    const float* rstd_g; bf16_t *CB, *U, *Q, *K, *V, *SGC, *SGA; float qscale; unsigned* KMAX; PG8_LAS float* rl;
    __device__ __forceinline__ void prefetch(const Unit& u, PG8_LAS unsigned char* lds, int wid) const {
        if (wid == 0) { int ln; asm volatile("v_mbcnt_lo_u32_b32 %0, -1, 0\n\tv_mbcnt_hi_u32_b32 %0, -1, %0" : "=v"(ln));
            __builtin_amdgcn_global_load_lds((const unsigned*)(rstd_g + u.pm * BM + ln * 4), (PG8_LAS unsigned*)rl, 16, 0, 0); }
    }
    __device__ __forceinline__ void operator()(const f32x4 (&acc)[2][2][4][2], const Unit& u, int wr, int wc, int fr0, int fq) const {
        int fr = fr0; asm volatile("" : "+v"(fr));
        const int row0 = u.pm * BM + wr * 64 + fr, pn = u.pn, colw = wc * 32 + 8 * fq;
        const PG8_LAS float* rstd = rl - u.pm * BM;
        if (pn >= 4 && pn < 12) {
            const int col = 128 * (pn - 4) + colw;
#pragma unroll
            for (int ai = 0; ai < 2; ++ai)
#pragma unroll
                for (int m = 0; m < 4; ++m) { const int row = row0 + ai * HALF + m * 16; const float rs = rstd[row], r2 = rs * rs;
                    const f32x4 v0 = acc[ai][0][m][0] * acc[ai][1][m][0] * r2, v1 = acc[ai][0][m][1] * acc[ai][1][m][1] * r2;
                    *(u32x4*)(U + (size_t)row * 1024 + col) = pack8(v0, v1); }
            return;
        }
        bf16_t* base; int cbase; float sc = 1.f; bool gate = false;
        if (pn < 4) { base = CB; cbase = pn * 256; }
        else if (pn < 16) { base = Q; cbase = (pn - 12) * 256; sc = qscale; }
        else if (pn < 20) { base = K; cbase = (pn - 16) * 256; }
        else if (pn < 24) { base = V; cbase = (pn - 20) * 256; }
        else if (pn < 28) { base = SGC; cbase = (pn - 24) * 256; gate = true; }
        else { base = SGA; cbase = (pn - 28) * 256; gate = true; }
#pragma unroll
        for (int ai = 0; ai < 2; ++ai)
#pragma unroll
            for (int m = 0; m < 4; ++m) { const int row = row0 + ai * HALF + m * 16; const float rs = rstd[row] * sc;
#pragma unroll
                for (int bj = 0; bj < 2; ++bj) { f32x4 v0 = acc[ai][bj][m][0] * rs, v1 = acc[ai][bj][m][1] * rs;
                    if (gate) {
#pragma unroll
                        for (int e = 0; e < 4; ++e) { v0[e] = sigmoidf_(v0[e]); v1[e] = sigmoidf_(v1[e]); } }
                    *(u32x4*)(base + (size_t)row * 1024 + cbase + bj * HALF + colw) = pack8(v0, v1); } }
        if (pn >= 16 && pn < 20) {
            float mx[2] = {0.f, 0.f};
#pragma unroll
            for (int ai = 0; ai < 2; ++ai)
#pragma unroll
                for (int m = 0; m < 4; ++m) { const float rs = rstd[row0 + ai * HALF + m * 16];
#pragma unroll
                    for (int bj = 0; bj < 2; ++bj) { const f32x4 v0 = acc[ai][bj][m][0] * rs, v1 = acc[ai][bj][m][1] * rs;
                        const float s = xrow16_sum(((v0[0] * v0[0] + v0[1] * v0[1]) + (v0[2] * v0[2] + v0[3] * v0[3])) + ((v1[0] * v1[0] + v1[1] * v1[1]) + (v1[2] * v1[2] + v1[3] * v1[3])));
                        mx[bj] = fmaxf(mx[bj], s); } }
#pragma unroll
            for (int bj = 0; bj < 2; ++bj) { float v = mx[bj];
                v = row16_max(v);
                if (fr == 0 && fq == 0) atomicMax(KMAX + (((pn - 16) * 2 + bj) * 2 + (wc >> 1)) * 2 + (wc & 1), __float_as_uint(v)); }
        }
    }
};
struct EpiGateT {
    static constexpr bool PERM = true, AFTER_DRAIN = false;
    const bf16_t* SG; float* T;
    __device__ __forceinline__ void operator()(const f32x4 (&acc)[2][2][4][2], const Unit& u, int wr, int wc, int fr0, int fq) const {
        int fr = fr0; asm volatile("" : "+v"(fr));
        const int row0 = u.pm * BM + wr * 64 + fr, col0 = u.pn * BM + wc * 32 + 8 * fq;
#pragma unroll
        for (int ai = 0; ai < 2; ++ai)
#pragma unroll
            for (int m = 0; m < 4; ++m) { const size_t off = (size_t)(row0 + ai * HALF + m * 16) * 1024 + col0;
#pragma unroll
                for (int bj = 0; bj < 2; ++bj) { const u32x4 g = *(const u32x4*)(SG + off + bj * HALF);
                    f32x4 g0 = {bflo(g.x), bfhi(g.x), bflo(g.y), bfhi(g.y)}, g1 = {bflo(g.z), bfhi(g.z), bflo(g.w), bfhi(g.w)};
                    *(f32x4*)(T + off + bj * HALF) = g0 * acc[ai][bj][m][0]; *(f32x4*)(T + off + bj * HALF + 4) = g1 * acc[ai][bj][m][1]; } }
    }
};
struct EpiMerge {
    static constexpr bool PERM = true, AFTER_DRAIN = false;
    const float* T; const bf16_t* SG; bf16_t* O;
    __device__ __forceinline__ void operator()(const f32x4 (&acc)[2][2][4][2], const Unit& u, int wr, int wc, int fr0, int fq) const {
        int fr = fr0; asm volatile("" : "+v"(fr));
        const int row0 = u.pm * BM + wr * 64 + fr, col0 = u.pn * BM + wc * 32 + 8 * fq;
#pragma unroll
        for (int ai = 0; ai < 2; ++ai)
#pragma unroll
            for (int m = 0; m < 4; ++m) { const size_t off = (size_t)(row0 + ai * HALF + m * 16) * 1024 + col0;
#pragma unroll
                for (int bj = 0; bj < 2; ++bj) { const u32x4 g = *(const u32x4*)(SG + off + bj * HALF);
                    f32x4 g0 = {bflo(g.x), bfhi(g.x), bflo(g.y), bfhi(g.y)}, g1 = {bflo(g.z), bfhi(g.z), bflo(g.w), bfhi(g.w)};
                    const f32x4 t0 = *(const f32x4*)(T + off + bj * HALF), t1 = *(const f32x4*)(T + off + bj * HALF + 4);
                    *(u32x4*)(O + off + bj * HALF) = pack8(t0 + g0 * acc[ai][bj][m][0], t1 + g1 * acc[ai][bj][m][1]); } }
    }
};
struct EpiMergeK {
    static constexpr bool PERM = true, AFTER_DRAIN = false;
    const bf16_t* SGc; const bf16_t* SGa; bf16_t* O;
    __device__ __forceinline__ void mid(f32x4 (&acc)[2][2][4][2], const Unit& u, int wr, int wc, int fr0, int fq) const {
        int fr = fr0; asm volatile("" : "+v"(fr));
        const int row0 = u.pm * BM + wr * 64 + fr, col0 = u.pn * BM + wc * 32 + 8 * fq;
#pragma unroll
        for (int ai = 0; ai < 2; ++ai)
#pragma unroll
            for (int m = 0; m < 4; ++m) { const size_t off = (size_t)(row0 + ai * HALF + m * 16) * 1024 + col0;
#pragma unroll
                for (int bj = 0; bj < 2; ++bj) { const u32x4 c = *(const u32x4*)(SGc + off + bj * HALF), g = *(const u32x4*)(SGa + off + bj * HALF);
                    const f32x4 c0 = {bflo(c.x), bfhi(c.x), bflo(c.y), bfhi(c.y)}, c1 = {bflo(c.z), bfhi(c.z), bflo(c.w), bfhi(c.w)};
                    f32x4 g0 = {bflo(g.x), bfhi(g.x), bflo(g.y), bfhi(g.y)}, g1 = {bflo(g.z), bfhi(g.z), bflo(g.w), bfhi(g.w)};
#pragma unroll
                    for (int e = 0; e < 4; ++e) { g0[e] = c0[e] * __builtin_amdgcn_rcpf(fmaxf(g0[e], 1e-20f)); g1[e] = c1[e] * __builtin_amdgcn_rcpf(fmaxf(g1[e], 1e-20f)); }
                    acc[ai][bj][m][0] *= g0; acc[ai][bj][m][1] *= g1; } }
    }
    __device__ __forceinline__ void operator()(const f32x4 (&acc)[2][2][4][2], const Unit& u, int wr, int wc, int fr0, int fq) const {
        int fr = fr0; asm volatile("" : "+v"(fr));
        const int row0 = u.pm * BM + wr * 64 + fr, col0 = u.pn * BM + wc * 32 + 8 * fq;
#pragma unroll
        for (int ai = 0; ai < 2; ++ai)
#pragma unroll
            for (int m = 0; m < 4; ++m) { const size_t off = (size_t)(row0 + ai * HALF + m * 16) * 1024 + col0;
#pragma unroll
                for (int bj = 0; bj < 2; ++bj) { const u32x4 g = *(const u32x4*)(SGa + off + bj * HALF);
                    f32x4 g0 = {bflo(g.x), bfhi(g.x), bflo(g.y), bfhi(g.y)}, g1 = {bflo(g.z), bfhi(g.z), bflo(g.w), bfhi(g.w)};
#pragma unroll
                    for (int e = 0; e < 4; ++e) { g0[e] = fmaxf(g0[e], 1e-20f); g1[e] = fmaxf(g1[e], 1e-20f); }
                    st16wt(O + off + bj * HALF, pack8(g0 * acc[ai][bj][m][0], g1 * acc[ai][bj][m][1])); } }
    }
};
struct EpiResid {
    static constexpr bool PERM = true, AFTER_DRAIN = false;
    const float* R; bf16_t* XB; float* SS;
    __device__ __forceinline__ void operator()(const f32x4 (&acc)[2][2][4][2], const Unit& u, int wr, int wc, int fr0, int fq) const {
        int fr = fr0; asm volatile("" : "+v"(fr));
        const int row0 = u.pm * BM + wr * 64 + fr, col0 = u.pn * BM + wc * 32 + 8 * fq;
#pragma unroll
        for (int ai = 0; ai < 2; ++ai)
#pragma unroll
            for (int m = 0; m < 4; ++m) { const int row = row0 + ai * HALF + m * 16; const size_t off = (size_t)row * 1024 + col0; float ss = 0.f;
#pragma unroll
                for (int bj = 0; bj < 2; ++bj) {
                    const f32x4 x0 = *(const f32x4*)(R + off + bj * HALF) + acc[ai][bj][m][0], x1 = *(const f32x4*)(R + off + bj * HALF + 4) + acc[ai][bj][m][1];
                    st16wt(XB + off + bj * HALF, pack8(x0, x1));
                    ss += (x0[0] * x0[0] + x0[1] * x0[1]) + (x0[2] * x0[2] + x0[3] * x0[3]) + (x1[0] * x1[0] + x1[1] * x1[1]) + (x1[2] * x1[2] + x1[3] * x1[3]); }
                ss = xrow16_sum(ss);
                if (fq == 0) SS[(size_t)row * 16 + u.pn * 4 + wc] = ss; }
    }
};
struct EpiResidB {
    static constexpr bool PERM = true, AFTER_DRAIN = false;
    bf16_t* XB; float* SS;
    __device__ __forceinline__ void operator()(const f32x4 (&acc)[2][2][4][2], const Unit& u, int wr, int wc, int fr0, int fq) const {
        int fr = fr0; asm volatile("" : "+v"(fr));
        const int row0 = u.pm * BM + wr * 64 + fr, col0 = u.pn * BM + wc * 32 + 8 * fq;
#pragma unroll
        for (int ai = 0; ai < 2; ++ai)
#pragma unroll
            for (int m = 0; m < 4; ++m) { const int row = row0 + ai * HALF + m * 16; const size_t off = (size_t)row * 1024 + col0; float ss = 0.f;
#pragma unroll
                for (int bj = 0; bj < 2; ++bj) { const u32x4 g = *(const u32x4*)(XB + off + bj * HALF);
                    const f32x4 r0 = {bflo(g.x), bfhi(g.x), bflo(g.y), bfhi(g.y)}, r1 = {bflo(g.z), bfhi(g.z), bflo(g.w), bfhi(g.w)};
                    const f32x4 x0 = r0 + acc[ai][bj][m][0], x1 = r1 + acc[ai][bj][m][1];
                    st16wt(XB + off + bj * HALF, pack8(x0, x1));
                    ss += (x0[0] * x0[0] + x0[1] * x0[1]) + (x0[2] * x0[2] + x0[3] * x0[3]) + (x1[0] * x1[0] + x1[1] * x1[1]) + (x1[2] * x1[2] + x1[3] * x1[3]); }
                ss = xrow16_sum(ss);
                if (fq == 0) SS[(size_t)row * 16 + u.pn * 4 + wc] = ss; }
    }
};
struct EpiRowScale {
    static constexpr bool PERM = true, AFTER_DRAIN = false;
    const float* SS; bf16_t* O; int ldc; float sc;
    __device__ __forceinline__ void operator()(const f32x4 (&acc)[2][2][4][2], const Unit& u, int wr, int wc, int fr0, int fq) const {
        int fr = fr0; asm volatile("" : "+v"(fr));
        const int row0 = u.pm * BM + wr * 64 + fr, col0 = u.pn * BM + wc * 32 + 8 * fq;
#pragma unroll
        for (int ai = 0; ai < 2; ++ai)
#pragma unroll
            for (int m = 0; m < 4; ++m) { const int row = row0 + ai * HALF + m * 16;
                const f32x4* sp = (const f32x4*)(SS + (size_t)row * 16); const f32x4 s4 = (sp[0] + sp[1]) + (sp[2] + sp[3]);
                const float rs = sc / sqrtf(((s4[0] + s4[1]) + (s4[2] + s4[3])) * (1.0f / 1024.0f) + 1e-6f);
#pragma unroll
                for (int bj = 0; bj < 2; ++bj) *(u32x4*)(O + (size_t)row * ldc + col0 + bj * HALF) = pack8(acc[ai][bj][m][0] * rs, acc[ai][bj][m][1] * rs); }
    }
};

__device__ __forceinline__ unsigned f2ord(float f) { const unsigned u = __builtin_bit_cast(unsigned, f); return u ^ ((unsigned)((int)u >> 31) | 0x80000000u); }
__device__ __forceinline__ float ord2f(unsigned k) { const unsigned u = (k & 0x80000000u) ? (k ^ 0x80000000u) : ~k; return __builtin_bit_cast(float, u); }
#define PG8_CSWAP(a, b) do { const unsigned hi_ = (a) > (b) ? (a) : (b), lo_ = (a) > (b) ? (b) : (a); (a) = hi_; (b) = lo_; } while (0)
__device__ __forceinline__ void sort16_desc(unsigned (&k)[16]) {
#pragma unroll
    for (int sz = 2; sz <= 16; sz <<= 1)
#pragma unroll
        for (int st = sz >> 1; st > 0; st >>= 1)
#pragma unroll
            for (int i = 0; i < 16; ++i) { const int l = i ^ st; if (l > i) { if ((i & sz) == 0) PG8_CSWAP(k[i], k[l]); else PG8_CSWAP(k[l], k[i]); } }
}
__device__ __forceinline__ void merge16_desc(unsigned (&a)[16], const unsigned (&b)[16]) {
#pragma unroll
    for (int i = 0; i < 16; ++i) a[i] = a[i] > b[15 - i] ? a[i] : b[15 - i];
#pragma unroll
    for (int st = 8; st > 0; st >>= 1)
#pragma unroll
        for (int i = 0; i < 16; ++i) { const int l = i ^ st; if (l > i) PG8_CSWAP(a[i], a[l]); }
}
struct EpiKeys {
    static constexpr bool PERM = true, AFTER_DRAIN = false;
    const float* SS; unsigned* KS;
    __device__ __forceinline__ void operator()(const f32x4 (&acc)[2][2][4][2], const Unit& u, int wr, int wc, int fr0, int fq) const {
        int fr = fr0; asm volatile("" : "+v"(fr));
#pragma unroll
        for (int ai = 0; ai < 2; ++ai)
#pragma unroll
            for (int m = 0; m < 4; ++m) { const int row = ai * HALF + wr * 64 + m * 16 + fr;
                const f32x4* sp = (const f32x4*)(SS + (size_t)(u.pm * BM + row) * 16); const f32x4 s4 = (sp[0] + sp[1]) + (sp[2] + sp[3]);
                const float rs = 1.0f / sqrtf(((s4[0] + s4[1]) + (s4[2] + s4[3])) * (1.0f / 1024.0f) + 1e-6f);
#pragma unroll
                for (int bj = 0; bj < 2; ++bj)
#pragma unroll
                    for (int n = 0; n < 2; ++n) { const int cw = wc * 32 + 8 * fq + 4 * n; u32x4 k;
#pragma unroll
                        for (int e = 0; e < 4; ++e) k[e] = (f2ord(acc[ai][bj][m][n][e] * rs) & ~0x7Fu) | (unsigned)(127 - (cw + e));
                        *(u32x4*)(KS + row * 256 + bj * HALF + cw) = k; } }
    }
};
__device__ __forceinline__ void topk_from_keys(int tid, const unsigned* KS, unsigned* TOPK, int tok0, int h) {
#pragma unroll 1
    for (int ai = 0; ai < 2; ++ai) {
        const int j = tid & 1, rl = (tid >> 1) & 127, c = tid >> 8;
        const unsigned* src = KS + (ai * 128 + rl) * 256 + c * 128 + j * 64;
        unsigned best[16], cur[16];
        { const u32x4 a0 = *(const u32x4*)src, a1 = *(const u32x4*)(src + 4), a2 = *(const u32x4*)(src + 8), a3 = *(const u32x4*)(src + 12);
#pragma unroll
          for (int e = 0; e < 4; ++e) { best[e] = a0[e]; best[4 + e] = a1[e]; best[8 + e] = a2[e]; best[12 + e] = a3[e]; } }
        sort16_desc(best);
#pragma unroll 1
        for (int gq = 1; gq < 4; ++gq) {
            const u32x4 a0 = *(const u32x4*)(src + gq * 16), a1 = *(const u32x4*)(src + gq * 16 + 4), a2 = *(const u32x4*)(src + gq * 16 + 8), a3 = *(const u32x4*)(src + gq * 16 + 12);
#pragma unroll
            for (int e = 0; e < 4; ++e) { cur[e] = a0[e]; cur[4 + e] = a1[e]; cur[8 + e] = a2[e]; cur[12 + e] = a3[e]; }
            sort16_desc(cur); merge16_desc(best, cur); }
#pragma unroll
        for (int i = 0; i < 16; ++i) cur[i] = (unsigned)__shfl_xor((int)best[i], 1);
        merge16_desc(best, cur);
        unsigned* dst = TOPK + ((size_t)(tok0 + ai * 128 + rl) * 8 + h) * 32 + c * 16 + j * 8;
        u32x4 w0, w1;
        if (j == 0) { w0 = (u32x4){best[0], best[1], best[2], best[3]}; w1 = (u32x4){best[4], best[5], best[6], best[7]}; }
        else { w0 = (u32x4){best[8], best[9], best[10], best[11]}; w1 = (u32x4){best[12], best[13], best[14], best[15]}; }
        st16wt(dst, w0); st16wt(dst + 4, w1);
    }
}
struct EpiSoftmaxP {
    static constexpr bool PERM = true, AFTER_DRAIN = true;
    bf16_t* P; PG8_LAS float* lrow;
    __device__ __forceinline__ void fused(f32x4 (&acc)[2][2][4][2], const Unit& u, int wr, int wc, int fr0, int fq, PG8_LAS unsigned char* lds, int wid, int lane) const {
        int fr = fr0; asm volatile("" : "+v"(fr));
        PG8_LAS float* MX = (PG8_LAS float*)lds; PG8_LAS float* SM = MX + 1024;
#pragma unroll
        for (int ai = 0; ai < 2; ++ai)
#pragma unroll
            for (int m = 0; m < 4; ++m) { float mx = -INFINITY;
#pragma unroll
                for (int bj = 0; bj < 2; ++bj)
#pragma unroll
                    for (int n = 0; n < 2; ++n)
#pragma unroll
                        for (int e = 0; e < 4; ++e) mx = fmaxf(mx, acc[ai][bj][m][n][e]);
                mx = xrow16_max(mx);
                if (fq == 0) MX[(ai * HALF + wr * 64 + m * 16 + fr) * 4 + wc] = mx; }
        asm volatile("s_waitcnt lgkmcnt(0)\n\ts_barrier" ::: "memory");
#pragma unroll
        for (int ai = 0; ai < 2; ++ai)
#pragma unroll
            for (int m = 0; m < 4; ++m) { const int row = ai * HALF + wr * 64 + m * 16 + fr;
                const f32x4 m4 = *(const PG8_LAS f32x4*)(MX + row * 4); const float rm = fmaxf(fmaxf(m4[0], m4[1]), fmaxf(m4[2], m4[3])); float s = 0.f;
#pragma unroll
                for (int bj = 0; bj < 2; ++bj) { f32x4 p0, p1;
#pragma unroll
                    for (int e = 0; e < 4; ++e) { p0[e] = __builtin_amdgcn_exp2f(acc[ai][bj][m][0][e] - rm); p1[e] = __builtin_amdgcn_exp2f(acc[ai][bj][m][1][e] - rm); }
                    s += ((p0[0] + p0[1]) + (p0[2] + p0[3])) + ((p1[0] + p1[1]) + (p1[2] + p1[3]));
                    *(u32x4*)(P + (size_t)row * 256 + bj * HALF + wc * 32 + 8 * fq) = pack8(p0, p1); }
                s = xrow16_sum(s);
                if (fq == 0) SM[row * 4 + wc] = s; }
        asm volatile("s_waitcnt lgkmcnt(0)\n\ts_barrier" ::: "memory");
        const int tid = wid * 64 + lane;
        if (tid < 256) { const f32x4 s4 = *(const PG8_LAS f32x4*)(SM + tid * 4); lrow[tid] = (s4[0] + s4[1]) + (s4[2] + s4[3]); }
    }
};
struct EpiSoftmaxFull {
    static constexpr bool PERM = true, AFTER_DRAIN = true;
    const float* SS; bf16_t* P; float sc;
    __device__ __forceinline__ void fused(f32x4 (&acc)[2][2][4][2], const Unit& u, int wr, int wc, int fr0, int fq, PG8_LAS unsigned char* lds, int wid, int lane) const {
        int fr = fr0; asm volatile("" : "+v"(fr));
        PG8_LAS float* MX = (PG8_LAS float*)lds; PG8_LAS float* SM = MX + 1024;
#pragma unroll
        for (int ai = 0; ai < 2; ++ai)
#pragma unroll
            for (int m = 0; m < 4; ++m) { const int lr = ai * HALF + wr * 64 + m * 16 + fr, row = u.pm * BM + lr; float mx = -INFINITY;
                const f32x4* sp = (const f32x4*)(SS + (size_t)row * 16); const f32x4 s4 = (sp[0] + sp[1]) + (sp[2] + sp[3]);
                const float rs = sc / sqrtf(((s4[0] + s4[1]) + (s4[2] + s4[3])) * (1.0f / 1024.0f) + 1e-6f);
#pragma unroll
                for (int bj = 0; bj < 2; ++bj)
#pragma unroll
                    for (int n = 0; n < 2; ++n) { acc[ai][bj][m][n] *= rs;
#pragma unroll
                        for (int e = 0; e < 4; ++e) mx = fmaxf(mx, acc[ai][bj][m][n][e]); }
                mx = xrow16_max(mx);
                if (fq == 0) MX[lr * 4 + wc] = mx; }
        asm volatile("s_waitcnt lgkmcnt(0)\n\ts_barrier" ::: "memory");
#pragma unroll
        for (int ai = 0; ai < 2; ++ai)
#pragma unroll
            for (int m = 0; m < 4; ++m) { const int lr = ai * HALF + wr * 64 + m * 16 + fr;
                const f32x4 m4 = *(const PG8_LAS f32x4*)(MX + lr * 4); const float rm = fmaxf(fmaxf(m4[0], m4[1]), fmaxf(m4[2], m4[3])); float s = 0.f;
#pragma unroll
                for (int bj = 0; bj < 2; ++bj)
#pragma unroll
                    for (int n = 0; n < 2; ++n) {
#pragma unroll
                        for (int e = 0; e < 4; ++e) acc[ai][bj][m][n][e] = __builtin_amdgcn_exp2f(acc[ai][bj][m][n][e] - rm);
                        s += (acc[ai][bj][m][n][0] + acc[ai][bj][m][n][1]) + (acc[ai][bj][m][n][2] + acc[ai][bj][m][n][3]); }
                s = xrow16_sum(s);
                if (fq == 0) SM[lr * 4 + wc] = s; }
        asm volatile("s_waitcnt lgkmcnt(0)\n\ts_barrier" ::: "memory");
#pragma unroll
        for (int ai = 0; ai < 2; ++ai)
#pragma unroll
            for (int m = 0; m < 4; ++m) { const int lr = ai * HALF + wr * 64 + m * 16 + fr;
                const f32x4 s4 = *(const PG8_LAS f32x4*)(SM + lr * 4); const float inv = 1.0f / ((s4[0] + s4[1]) + (s4[2] + s4[3]));
#pragma unroll
                for (int bj = 0; bj < 2; ++bj)
                    st16wt(P + (size_t)(u.pm * BM + lr) * 1024 + u.pn * BM + bj * HALF + wc * 32 + 8 * fq, pack8(acc[ai][bj][m][0] * inv, acc[ai][bj][m][1] * inv)); }
    }
};
struct EpiCO {
    static constexpr bool PERM = true, AFTER_DRAIN = false;
    bf16_t* O; const PG8_LAS float* lrow;
    __device__ __forceinline__ void operator()(const f32x4 (&acc)[2][2][4][2], const Unit& u, int wr, int wc, int fr0, int fq) const {
        int fr = fr0; asm volatile("" : "+v"(fr));
#pragma unroll
        for (int ai = 0; ai < 2; ++ai)
#pragma unroll
            for (int m = 0; m < 4; ++m) { const int row = ai * HALF + wr * 64 + m * 16 + fr; const float inv = 1.0f / lrow[row];
#pragma unroll
                for (int bj = 0; bj < 2; ++bj) *(u32x4*)(O + (size_t)row * 1024 + bj * HALF + wc * 32 + 8 * fq) = pack8(acc[ai][bj][m][0] * inv, acc[ai][bj][m][1] * inv); }
    }
};
struct OneUnit {
    int pm, pn;
    __device__ __forceinline__ bool next(int i, Unit& u) const { if (i) return false; u.pm = pm; u.pn = pn; return true; }
    __device__ __forceinline__ void a_ready(const Unit&) const {}
    __device__ __forceinline__ void done(const Unit&) const {}
};
}

__device__ __forceinline__ int win_src_col(int n) {
    if (n < 1024 || n >= 3072) return n;
    const int t = (n - 1024) >> 8, j = (n - 1024) & 255;
    return j < 128 ? 1024 + 128 * t + j : 2048 + 128 * t + (j - 128);
}
__device__ __forceinline__ void p0_prologue(int wv, const Args& a, LAS unsigned char* lds, int blk, int G) {
    const int tid = opaque_tid(wv), lane = tid & 63, wave = tid >> 6;
    unsigned char* ws = a.ws;
    LAS float* tl = (LAS float*)lds;
    {
        f32x4 cur[8], nxt[8]; const float* gcur = nullptr; const float* gnxt = nullptr;
#define P0_DECODE(job, W, ldw, nb, kb, Wt, gain, perm) do { \
            if ((job) < 512) { W = a.in[I_W_IN]; ldw = NCOLS; kb = (job) >> 5; nb = (job) & 31; Wt = (bf16*)(ws + WS_WT_IN); gain = a.in[I_NORM_MIX_G]; perm = true; } \
            else { const int mat = ((job) - 512) >> 6, idx = ((job) - 512) & 63; kb = idx >> 2; nb = idx & 3; ldw = 1024; gain = nullptr; perm = false; \
                if (mat == 0) { W = a.in[I_W_CONV_OUT]; Wt = (bf16*)(ws + WS_WT_CONV); } \
                else if (mat == 1) { W = a.in[I_W_ATTN_OUT]; Wt = (bf16*)(ws + WS_WT_ATTN); } \
                else if (mat == 2) { W = a.in[I_W_MIX_OUT]; Wt = (bf16*)(ws + WS_WT_MIX); } \
                else { W = a.in[I_W_CO]; Wt = (bf16*)(ws + WS_WT_CO); } } } while (0)
#define P0_LOAD(dst, gv, job) do { const float* W; int ldw, nb, kb; bf16* Wt; const float* gain; bool perm; P0_DECODE(job, W, ldw, nb, kb, Wt, gain, perm); (void)Wt; \
            const int k0 = kb * 64, c = tid & 63, nd0 = nb * 256 + 64 * (c >> 4), ns0 = (perm ? win_src_col(nd0) : nd0) + 4 * (c & 15); gv = gain ? gain + k0 : nullptr; \
            _Pragma("unroll") for (int i = 0; i < 8; ++i) dst[i] = *(const f32x4*)(W + (size_t)(k0 + (tid >> 6) + 8 * i) * ldw + ns0); } while (0)
        if (blk < 768) P0_LOAD(cur, gcur, blk);
        for (int job = blk; job < 768; job += G) {
            if (job + G < 768) P0_LOAD(nxt, gnxt, job + G);
#pragma unroll
            for (int i = 0; i < 8; ++i) { const int kk = (tid >> 6) + 8 * i, c = tid & 63; const float gk = gcur ? gcur[kk] : 1.0f; LAS float* d = tl + kk * 257 + 4 * c;
                d[0] = cur[i][0] * gk; d[1] = cur[i][1] * gk; d[2] = cur[i][2] * gk; d[3] = cur[i][3] * gk; }
            __syncthreads();
            { const float* W; int ldw, nb, kb; bf16* Wt; const float* gain; bool perm; P0_DECODE(job, W, ldw, nb, kb, Wt, gain, perm); (void)W; (void)ldw; (void)gain; (void)perm;
#pragma unroll
              for (int r = 0; r < 4; ++r) { const int idx = tid + 512 * r, nn = idx >> 3, kq = idx & 7; const LAS float* s = tl + (kq * 8) * 257 + nn;
                  u32x4 o; o.x = pk2(s[0], s[257]); o.y = pk2(s[2 * 257], s[3 * 257]); o.z = pk2(s[4 * 257], s[5 * 257]); o.w = pk2(s[6 * 257], s[7 * 257]);
                  st16wt(Wt + (size_t)(nb * 256 + nn) * 1024 + kb * 64 + kq * 8, o); } }
            __syncthreads();
#pragma unroll
            for (int i = 0; i < 8; ++i) cur[i] = nxt[i];
            gcur = gnxt;
        }
#undef P0_DECODE
#undef P0_LOAD
    }
    { const float* x = a.in[I_X]; bf16* XB = (bf16*)(ws + WS_A0); float* rstd0 = (float*)(ws + WS_RSTD0);
      f32x4 v[4], w4[4]; int row = blk * 8 + wave;
#define P0_XLOAD(dst, r) do { const f32x4* xr = (const f32x4*)(x + (size_t)(r) * D) + 2 * lane; dst[0] = xr[0]; dst[1] = xr[1]; dst[2] = xr[128]; dst[3] = xr[129]; } while (0)
      if (row < S) P0_XLOAD(v, row);
      for (; row < S; row += G * 8) {
          if (row + G * 8 < S) P0_XLOAD(w4, row + G * 8);
          float s = 0.f;
#pragma unroll
          for (int j = 0; j < 4; ++j) s += (v[j][0] * v[j][0] + v[j][1] * v[j][1]) + (v[j][2] * v[j][2] + v[j][3] * v[j][3]);
          s = wave_sum(s);
          if (lane == 0) rstd0[row] = 1.0f / sqrtf(s * (1.0f / D) + 1e-6f);
          bf16* o = XB + (size_t)row * D + 8 * lane;
#pragma unroll
          for (int j = 0; j < 2; ++j) { u32x4 w; w.x = pk2(v[2 * j][0], v[2 * j][1]); w.y = pk2(v[2 * j][2], v[2 * j][3]); w.z = pk2(v[2 * j + 1][0], v[2 * j + 1][1]); w.w = pk2(v[2 * j + 1][2], v[2 * j + 1][3]);
              st16wt(o + 512 * j, w); }
#pragma unroll
          for (int j = 0; j < 4; ++j) v[j] = w4[j];
      }
#undef P0_XLOAD
    }
    { typedef short bf16x8_t __attribute__((ext_vector_type(8))); typedef float f32x16_t __attribute__((ext_vector_type(16)));
      LAS bf16* mnb = (LAS bf16*)lds;
      LAS float* red = (LAS float*)(lds + 32 * 1032 * 2);
      const float* mem = a.in[I_MEM]; const float* g = a.in[I_NORM_MEM_G]; const float* Wc = a.in[I_W_CKV]; bf16* KC = (bf16*)(ws + WS_KV); bf16* VC = KC + 4 * 256 * 256;
      const int r32 = lane & 31, kg = lane >> 5;
      for (int wb = blk; wb < 256; wb += G) {
          const int m0 = (wb >> 5) * 32, n0 = (wb & 31) * 64;
          __syncthreads();
#pragma unroll
          for (int r = 0; r < 4; ++r) { const int rr = wave * 4 + r; const f32x4* mr = (const f32x4*)(mem + (size_t)(m0 + rr) * D) + lane; f32x4 v[4]; float s = 0.f;
#pragma unroll
              for (int j = 0; j < 4; ++j) { v[j] = mr[64 * j]; s += (v[j][0] * v[j][0] + v[j][1] * v[j][1]) + (v[j][2] * v[j][2] + v[j][3] * v[j][3]); }
              s = wave_sum(s); const float rs = 1.0f / sqrtf(s * (1.0f / D) + 1e-6f);
#pragma unroll
              for (int j = 0; j < 4; ++j) { const f32x4 gg = ((const f32x4*)g)[lane + 64 * j]; const f32x4 y = v[j] * rs * gg; u32x2 w; w.x = pk2(y[0], y[1]); w.y = pk2(y[2], y[3]);
                  *(LAS u32x2*)(mnb + rr * 1032 + 4 * (lane + 64 * j)) = w; } }
          __syncthreads();
          const int it = wave & 1, kq = wave >> 1, ncol = n0 + 32 * it + r32;
          f32x16_t acc;
#pragma unroll
          for (int r = 0; r < 16; ++r) acc[r] = 0.f;
#pragma unroll 1
          for (int half = 0; half < 2; ++half) {
              float wv_[8][8];
#pragma unroll
              for (int s = 0; s < 8; ++s)
#pragma unroll
                  for (int j = 0; j < 8; ++j) wv_[s][j] = Wc[(size_t)(256 * kq + 128 * half + 16 * s + 8 * kg + j) * 2048 + ncol];
#pragma unroll
              for (int s = 0; s < 8; ++s) {
                  u32x4 bw; bw.x = pk2(wv_[s][0], wv_[s][1]); bw.y = pk2(wv_[s][2], wv_[s][3]); bw.z = pk2(wv_[s][4], wv_[s][5]); bw.w = pk2(wv_[s][6], wv_[s][7]);
                  const bf16x8_t af = *(const LAS bf16x8_t*)(mnb + r32 * 1032 + 256 * kq + 128 * half + 16 * s + 8 * kg);
                  acc = __builtin_amdgcn_mfma_f32_32x32x16_bf16(af, __builtin_bit_cast(bf16x8_t, bw), acc, 0, 0, 0); }
          }
#pragma unroll
          for (int r = 0; r < 16; ++r) red[((it * 4 + kq) * 16 + r) * 64 + lane] = acc[r];
          __syncthreads();
          if (kq == 0) {
#pragma unroll
              for (int r = 0; r < 16; ++r) acc[r] = (red[((it * 4 + 0) * 16 + r) * 64 + lane] + red[((it * 4 + 1) * 16 + r) * 64 + lane]) + (red[((it * 4 + 2) * 16 + r) * 64 + lane] + red[((it * 4 + 3) * 16 + r) * 64 + lane]);
              if (ncol < 1024) {
#pragma unroll
                  for (int r = 0; r < 16; ++r) KC[((size_t)(ncol >> 8) * 256 + (m0 + (r & 3) + 8 * (r >> 2) + 4 * kg)) * 256 + (ncol & 255)] = (bf16)f2bf(acc[r]);
              } else {
#pragma unroll
                  for (int r = 0; r < 16; ++r) VC[((size_t)((ncol - 1024) >> 8) * 256 + (m0 + (r & 3) + 8 * (r >> 2) + 4 * kg)) * 256 + (ncol & 255)] = (bf16)f2bf(acc[r]);
              }
          }
      }
      __syncthreads(); }
    { typedef short bf16x8_t __attribute__((ext_vector_type(8))); typedef float f32x16_t __attribute__((ext_vector_type(16)));
      const float* sk = a.in[I_SUB_KEYS]; const float* wpq = a.in[I_W_PQ]; const float* gf = a.in[I_NORM_FFN_G]; bf16* WT = (bf16*)(ws + WS_WT_PQ);
      const int r32 = lane & 31, kg = lane >> 5;
      for (int item = blk * 8 + wave; item < 2048; item += G * 8) {
          const int hc = item >> 7, h = hc >> 1, c = hc & 1, kt = (item >> 2) & 31, nt = item & 3;
          const float* ap = wpq + (size_t)(kt * 32 + r32) * 2048 + hc * 128 + 8 * kg;
          const float* bp = sk + ((size_t)((c * 8 + h) * 128 + nt * 32 + r32)) * 128 + 8 * kg;
          const float gk = gf[kt * 32 + r32];
          f32x4 av[8][2], bv[8][2];
#pragma unroll
          for (int s = 0; s < 8; ++s) { av[s][0] = *(const f32x4*)(ap + 16 * s); av[s][1] = *(const f32x4*)(ap + 16 * s + 4); bv[s][0] = *(const f32x4*)(bp + 16 * s); bv[s][1] = *(const f32x4*)(bp + 16 * s + 4); }
          f32x16_t acc;
#pragma unroll
          for (int r = 0; r < 16; ++r) acc[r] = 0.f;
#pragma unroll
          for (int s = 0; s < 8; ++s) {
              const f32x4 a0 = av[s][0] * gk, a1 = av[s][1] * gk;
              u32x4 aw, bw; aw.x = pk2(a0[0], a0[1]); aw.y = pk2(a0[2], a0[3]); aw.z = pk2(a1[0], a1[1]); aw.w = pk2(a1[2], a1[3]);
              bw.x = pk2(bv[s][0][0], bv[s][0][1]); bw.y = pk2(bv[s][0][2], bv[s][0][3]); bw.z = pk2(bv[s][1][0], bv[s][1][1]); bw.w = pk2(bv[s][1][2], bv[s][1][3]);
              acc = __builtin_amdgcn_mfma_f32_32x32x16_bf16(__builtin_bit_cast(bf16x8_t, aw), __builtin_bit_cast(bf16x8_t, bw), acc, 0, 0, 0); }
          bf16* dst = WT + (size_t)(hc * 128 + nt * 32 + r32) * 1024 + kt * 32 + 4 * kg;
#pragma unroll
          for (int q = 0; q < 4; ++q) { u32x2 w; w.x = pk2(acc[4 * q], acc[4 * q + 1]); w.y = pk2(acc[4 * q + 2], acc[4 * q + 3]); *(u32x2*)(dst + 8 * q) = w; }
      } }
    if (blk == 0) { float* BT = (float*)(ws + WS_BTAB); const float* rb = a.in[I_REL_BIAS];
        for (int i = tid; i < 8 * 132; i += 512) { const int h = i / 132, j = i - h * 132; float v = 0.f;
            if (j < 129) { const int b = j < 128 ? (int)T5_BUCKET[j] : 31; v = (rb[b * 8 + h] - rb[31 * 8 + h]) * 1.4426950408889634f; }
            else if (j == 129) { float m = -INFINITY; for (int b = 0; b < 32; ++b) m = fmaxf(m, rb[b * 8 + h] * 1.4426950408889634f); v = m; }
            else if (j == 130) v = rb[31 * 8 + h] * 1.4426950408889634f;
            BT[i] = v; }
        if (tid == 0) { float s1 = 0.f, s2 = 0.f;
            for (int i = 0; i < 64; ++i) { s1 += a.in[I_LQ1][i] * a.in[I_LK1][i]; s2 += a.in[I_LQ2][i] * a.in[I_LK2][i]; }
            BT[8 * 132] = expf(s1) - expf(s2) + 0.2f; } }
}

__device__ __forceinline__ void cross_fold(int wv, const Args& a, int blk, int G) {
    typedef short bf16x8_t __attribute__((ext_vector_type(8))); typedef float f32x16_t __attribute__((ext_vector_type(16)));
    const int tid = opaque_tid(wv), lane = tid & 63, wave = tid >> 6, r32 = lane & 31, kg = lane >> 5;
    const bf16* KC = (const bf16*)(a.ws + WS_KV); const bf16* VC = KC + 4 * 256 * 256;
    for (int item = blk * 8 + wave; item < 2048; item += G * 8) {
        f32x16_t acc;
#pragma unroll
        for (int r = 0; r < 16; ++r) acc[r] = 0.f;
        bf16* dst;
        if (item < 1024) {
            const int h = item >> 8, kt = (item >> 3) & 31, mt = item & 7;
            const float* ap = a.in[I_W_CQ] + (size_t)(kt * 32 + r32) * 1024 + h * 256 + 8 * kg;
            const bf16* bp = KC + ((size_t)h * 256 + mt * 32 + r32) * 256 + 8 * kg;
            const float gk = a.in[I_NORM_CROSS_G][kt * 32 + r32];
#pragma unroll 1
            for (int half = 0; half < 2; ++half) {
                f32x4 av[8][2]; u32x4 bv[8];
#pragma unroll
                for (int s = 0; s < 8; ++s) { av[s][0] = *(const f32x4*)(ap + 128 * half + 16 * s); av[s][1] = *(const f32x4*)(ap + 128 * half + 16 * s + 4); bv[s] = *(const u32x4*)(bp + 128 * half + 16 * s); }
#pragma unroll
                for (int s = 0; s < 8; ++s) { const f32x4 a0 = av[s][0] * gk, a1 = av[s][1] * gk;
                    u32x4 aw; aw.x = pk2(a0[0], a0[1]); aw.y = pk2(a0[2], a0[3]); aw.z = pk2(a1[0], a1[1]); aw.w = pk2(a1[2], a1[3]);
                    acc = __builtin_amdgcn_mfma_f32_32x32x16_bf16(__builtin_bit_cast(bf16x8_t, aw), __builtin_bit_cast(bf16x8_t, bv[s]), acc, 0, 0, 0); }
            }
            dst = (bf16*)(a.ws + WS_WQK) + (size_t)(h * 256 + mt * 32 + r32) * 1024 + kt * 32 + 4 * kg;
        } else {
            const int it = item - 1024, h = it >> 8, mt = (it >> 5) & 7, nt = it & 31;
            const bf16* ap = VC + ((size_t)h * 256 + mt * 32 + r32) * 256 + 8 * kg;
            const bf16* bp = (const bf16*)(a.ws + WS_WT_CO) + (size_t)(nt * 32 + r32) * 1024 + h * 256 + 8 * kg;
            u32x4 av[16], bv[16];
#pragma unroll
            for (int s = 0; s < 16; ++s) { av[s] = *(const u32x4*)(ap + 16 * s); bv[s] = *(const u32x4*)(bp + 16 * s); }
#pragma unroll
            for (int s = 0; s < 16; ++s) acc = __builtin_amdgcn_mfma_f32_32x32x16_bf16(__builtin_bit_cast(bf16x8_t, av[s]), __builtin_bit_cast(bf16x8_t, bv[s]), acc, 0, 0, 0);
            dst = (bf16*)(a.ws + WS_VW) + (size_t)(nt * 32 + r32) * 1024 + h * 256 + mt * 32 + 4 * kg;
        }
#pragma unroll
        for (int q = 0; q < 4; ++q) { u32x2 w; w.x = pk2(acc[4 * q], acc[4 * q + 1]); w.y = pk2(acc[4 * q + 2], acc[4 * q + 3]); *(u32x2*)(dst + 8 * q) = w; }
    }
}

__device__ __forceinline__ void conv_phase(int wv, const Args& a, int blk, int G) {
    bf16* CB = (bf16*)(a.ws + WS_A1); const bf16* U = (const bf16*)(a.ws + WS_A2); const float* cw = a.in[I_CONV_W];
    const int tid = opaque_tid(wv);
    const int c = (tid & 127) * 8;
    float w0[8], w1[8], w2[8];
#pragma unroll
    for (int e = 0; e < 8; ++e) { w0[e] = cw[c + e]; w1[e] = cw[D + c + e]; w2[e] = cw[2 * D + c + e]; }
    const size_t step = (size_t)G * 512, total = (size_t)S * D / 8;
    for (size_t i0 = (size_t)blk * 512 + tid; i0 < total; i0 += 4 * step) {
        u32x4 cb[4], u2[4], u1[4], u0[4];
#pragma unroll
        for (int q = 0; q < 4; ++q) { const size_t i = i0 + q * step; const int r = (int)(i >> 7);
            cb[q] = u2[q] = u1[q] = u0[q] = (u32x4){0, 0, 0, 0};
            if (i < total) { cb[q] = *(const u32x4*)(CB + i * 8); u2[q] = *(const u32x4*)(U + i * 8);
                if (r >= 1) u1[q] = *(const u32x4*)(U + i * 8 - D);
                if (r >= 2) u0[q] = *(const u32x4*)(U + i * 8 - 2 * D); } }
#pragma unroll
        for (int q = 0; q < 4; ++q) { const size_t i = i0 + q * step;
            u32x4 o;
#pragma unroll
            for (int e = 0; e < 4; ++e) {
                const float lo = bflo(cb[q][e]) * (w0[2 * e] * bflo(u0[q][e]) + w1[2 * e] * bflo(u1[q][e]) + w2[2 * e] * bflo(u2[q][e]));
                const float hi = bfhi(cb[q][e]) * (w0[2 * e + 1] * bfhi(u0[q][e]) + w1[2 * e + 1] * bfhi(u1[q][e]) + w2[2 * e + 1] * bfhi(u2[q][e]));
                o[e] = pk2(lo, hi);
            }
            if (i < total) st16wt(CB + i * 8, o); }
    }
}


namespace att {
typedef short bf16x8 __attribute__((ext_vector_type(8)));
typedef short s16x4 __attribute__((ext_vector_type(4)));
typedef float f32x16 __attribute__((ext_vector_type(16)));
typedef short v4i16_t __attribute__((ext_vector_type(4)));
typedef LAS const char* lds_cptr;
constexpr int SLOT = 16384, LDS_K = 0, LDS_V = 4 * SLOT, LDS_WSF = 8 * SLOT, LDS_BT = LDS_WSF + 2048, LDS_TOTAL = LDS_BT + 1024;
constexpr int LDS_XCH = 0, LDS_OST = 65536;
constexpr float LOG2E = 1.4426950408889634f, THR = 8.0f;
__device__ __forceinline__ int crow(int r, int hi) { return (r & 3) + 8 * (r >> 2) + 4 * hi; }
typedef float f32x2_t __attribute__((ext_vector_type(2))); typedef __bf16 bf16x2_t __attribute__((ext_vector_type(2)));
__device__ __forceinline__ unsigned cvtpk(float lo, float hi) { const f32x2_t v = {lo, hi}; const bf16x2_t b = __builtin_convertvector(v, bf16x2_t); return __builtin_bit_cast(unsigned, b); }
__device__ __forceinline__ void glds16(const void* g, unsigned lds_base) {
    unsigned sv; asm volatile("s_mov_b32 %0, m0\n\ts_mov_b32 m0, %2\n\ts_nop 0\n\tglobal_load_lds_dwordx4 %1, off\n\ts_mov_b32 m0, %0" : "=&s"(sv) : "v"(g), "s"(lds_base) : "memory"); }
template <int IMM> __device__ __forceinline__ void glds16s(unsigned voff, const void* sbase, unsigned lds_base) {
    unsigned sv; asm volatile("s_mov_b32 %0, m0\n\ts_mov_b32 m0, %3\n\ts_nop 0\n\tglobal_load_lds_dwordx4 %1, %2 offset:%c4\n\ts_mov_b32 m0, %0" : "=&s"(sv) : "v"(voff), "s"(sbase), "s"(lds_base), "i"(IMM) : "memory"); }
__device__ __forceinline__ s16x4 vtr(lds_cptr p) { return __builtin_bit_cast(s16x4, __builtin_amdgcn_ds_read_tr16_b64_v4i16((LAS v4i16_t*)p)); }
#define ATT_MX3(a, b, c) __builtin_fmaxf(__builtin_fmaxf((a), (b)), (c))
__device__ __forceinline__ float rowmax(const f32x16& p0, const f32x16& p1) {
    float a = ATT_MX3(p0[0], p0[1], p1[0]), b = ATT_MX3(p0[2], p0[3], p1[1]); a = ATT_MX3(a, p1[2], p1[3]);
#pragma unroll
    for (int r = 4; r < 16; r += 4) { a = ATT_MX3(a, p0[r], p0[r + 1]); b = ATT_MX3(b, p0[r + 2], p0[r + 3]); a = ATT_MX3(a, p1[r], p1[r + 1]); b = ATT_MX3(b, p1[r + 2], p1[r + 3]); }
    float m = __builtin_fmaxf(a, b); auto rr = __builtin_amdgcn_permlane32_swap(__float_as_uint(m), __float_as_uint(m), false, false);
    return __builtin_fmaxf(__uint_as_float(rr[0]), __uint_as_float(rr[1])); }
#define ATT_WAIT_BAR(N) asm volatile("s_waitcnt vmcnt(" #N ") lgkmcnt(0)\n\ts_barrier" ::: "memory")
#define ATT_LBAR() asm volatile("s_waitcnt lgkmcnt(0)\n\ts_barrier" ::: "memory")
#define ATT_MFMA(a, b, c) __builtin_amdgcn_mfma_f32_32x32x16_bf16(a, b, c, 0, 0, 0)

__device__ __forceinline__ void attn_unit_pipe(int wv, int h, int qb, const bf16* Q, const bf16* __restrict__ K, const bf16* __restrict__ V, bf16* O, LAS unsigned char* lds,
                                               float lam, const float* BTAB, const float* subln_g, const unsigned* KMAX) {
    const int tid = opaque_tid(wv), lane = tid & 63, r32 = lane & 31, hi = lane >> 5;
    const int wid = __builtin_amdgcn_readfirstlane(tid >> 6), comp = wid >> 2, rg = wid & 3;
    const int q0 = qb * 128, qw0 = q0 + 32 * rg, NT = 2 * qb + 2;
    const unsigned lds0 = (unsigned)(unsigned long long)lds;
    LAS float* wsf = (LAS float*)(lds + LDS_WSF) + wid * 64;
    LAS float* bt = (LAS float*)(lds + LDS_BT);
    const unsigned kvoff = (unsigned)lane * 2048u + (unsigned)wid * 16u;
    const unsigned vvoff = (unsigned)(16 * (wid & 3) + (lane >> 2)) * 2048u + (unsigned)((wid >> 2) * 32 + (lane & 3) * 8) * 2u;
    const char* kbase = (const char*)(K + h * 128); const char* vbase = (const char*)(V + h * 128);
    const unsigned kdst = lds0 + LDS_K + wid * 1024, vdst = lds0 + LDS_V + wid * 1024;
#define ATT_RFL(x) ((unsigned)__builtin_amdgcn_readfirstlane((int)(x)))
#define DMA_K(t, so) do { const char* b_ = kbase + (size_t)(t) * 131072; glds16s<0>(kvoff, b_, ATT_RFL(kdst + (so))); glds16s<128>(kvoff, b_, ATT_RFL(kdst + (so) + 8192 - 128)); } while (0)
#define DMA_V(t, so) do { const char* b_ = vbase + (size_t)(t) * 131072; glds16s<0>(vvoff, b_, ATT_RFL(vdst + (so))); glds16s<128>(vvoff, b_, ATT_RFL(vdst + (so) + 8192 - 128)); } while (0)
    DMA_K(0, 0); DMA_K(1, SLOT); DMA_V(0, 0); if (NT > 2) DMA_K(2, 2 * SLOT);
    const float* bth = BTAB + h * 132;
    bf16x8 qr[4];
    float cfar;
    { const bf16* Qw = Q + (size_t)(qw0 + r32) * 1024 + h * 128 + comp * 64 + hi * 8;
#pragma unroll
      for (int d0 = 0; d0 < 4; ++d0) qr[d0] = *(const bf16x8*)(Qw + d0 * 16);
      float btv = 0.f; if (tid < 129) btv = bth[tid];
      const float bmax = bth[129], bfar = bth[130];
      const float kmx = sqrtf(__uint_as_float(KMAX[(h * 2 + comp) * 2]) + __uint_as_float(KMAX[(h * 2 + comp) * 2 + 1])) * 1.02f;
      if (tid < 129) bt[tid] = btv;
      float s = 0.f;
#pragma unroll
      for (int d0 = 0; d0 < 4; ++d0)
#pragma unroll
          for (int e2 = 0; e2 < 8; ++e2) { const float f = __builtin_bit_cast(float, (unsigned)(unsigned short)qr[d0][e2] << 16); s += f * f; }
      auto rr = __builtin_amdgcn_permlane32_swap(__float_as_uint(s), __float_as_uint(s), false, false); s = __uint_as_float(rr[0]) + __uint_as_float(rr[1]);
      cfar = bfar - (sqrtf(s) * 1.01f * kmx + bmax); }
    f32x16 cf;
#pragma unroll
    for (int r = 0; r < 16; ++r) cf[r] = cfar;
    asm volatile("" : "+v"(cf));
    const lds_cptr kp0 = (lds_cptr)(lds + LDS_K) + comp * 8192 + hi * 1024 + r32 * 16;
    const lds_cptr vp0 = (lds_cptr)(lds + LDS_V) + ((lane >> 4) & 1) * 32 + (lane & 3) * 8 + (4 * hi + ((lane & 15) >> 2)) * 64;
    float l_reg = 0.f;
    f32x16 o[4];
#pragma unroll
    for (int d0 = 0; d0 < 4; ++d0)
#pragma unroll
        for (int r = 0; r < 16; ++r) o[d0][r] = 0.f;
    bf16x8 kf[8];
    f32x16 pA0, pA1, pB0, pB1;
    u32x4 pw0, pw1, pw2, pw3;
    s16x4 vl0, vh0, vl1, vh1;
#define SBAR() __builtin_amdgcn_sched_barrier(0)
#define PIN(x) asm volatile("" : "+v"(x))
#define PKW(P, B) cvtpk(P[B], P[B + 1])
#define PAF(k) __builtin_bit_cast(bf16x8, pw##k)
#define EX(v) __builtin_amdgcn_exp2f(v)
#define ROT3() do { const int t_ = s0; s0 = s1; s1 = s2; s2 = t_; } while (0)
#define ENDW(t) do { if ((t) + 3 < NT) { ATT_WAIT_BAR(4); } else if ((t) + 1 < NT) { ATT_WAIT_BAR(2); } else { ATT_WAIT_BAR(0); } } while (0)
#define KLD(f, kp_) kf[f] = *(LAS const bf16x8*)((kp_) + ((f) >> 1) * 2048 + ((f) & 1) * 512)
#define BANDFIX(C0, C1, t) do { if (__builtin_expect(64 * (t) + 63 + 128 > qw0, 0)) { const int ln_ = opaque_tid(0);   \
        const int dq = qw0 + (ln_ & 31) - 64 * (t) - 4 * (ln_ >> 5); \
        _Pragma("unroll") for (int r = 0; r < 16; ++r) { const int d0_ = dq - ((r & 3) + 8 * (r >> 2)), d1_ = d0_ - 32; \
            const float b0 = bt[min(max(d0_, 0), 128)], b1 = bt[min(max(d1_, 0), 128)]; \
            C0[r] = d0_ < 0 ? -INFINITY : C0[r] + b0; C1[r] = d1_ < 0 ? -INFINITY : C1[r] + b1; } } } while (0)
#define VRD(j, i, vp_) do { vl##j = vtr((vp_) + ((i) & 3) * 4096 + ((i) >> 2) * 1024); vh##j = vtr((vp_) + ((i) & 3) * 4096 + ((i) >> 2) * 1024 + 512); } while (0)
#define VFR(j) (bf16x8){vl##j[0], vl##j[1], vl##j[2], vl##j[3], vh##j[0], vh##j[1], vh##j[2], vh##j[3]}
#define GAPA(MF, A0, A1, A2, A3, W0, W1, PWX) do { MF; sacc += A0; sacc += A1; sacc += A2; sacc += A3; PIN(sacc); W0; W1; PIN(PWX); SBAR(); } while (0)
#define PHASE_A(C0, C1, P0, P1, vp_) do { float sacc = P0[0] + P0[1]; \
        GAPA(C0 = ATT_MFMA(kf[0], qr[0], cf), P0[2], P0[3], P0[4], P0[5],     pw0[0] = PKW(P0, 0), pw0[1] = PKW(P0, 2), pw0); \
        GAPA(C1 = ATT_MFMA(kf[1], qr[0], cf), P0[6], P0[7], P0[8], P0[9],     pw0[2] = PKW(P0, 4), pw0[3] = PKW(P0, 6), pw0); \
        GAPA(C0 = ATT_MFMA(kf[2], qr[1], C0), P0[10], P0[11], P0[12], P0[13], pw1[0] = PKW(P0, 8), pw1[1] = PKW(P0, 10), pw1); \
        GAPA(C1 = ATT_MFMA(kf[3], qr[1], C1), P0[14], P0[15], P1[0], P1[1],   pw1[2] = PKW(P0, 12), pw1[3] = PKW(P0, 14), pw1); \
        GAPA(C0 = ATT_MFMA(kf[4], qr[2], C0), P1[2], P1[3], P1[4], P1[5],     pw2[0] = PKW(P1, 0), pw2[1] = PKW(P1, 2), pw2); \
        GAPA(C1 = ATT_MFMA(kf[5], qr[2], C1), P1[6], P1[7], P1[8], P1[9],     pw2[2] = PKW(P1, 4), pw2[3] = PKW(P1, 6), pw2); \
        GAPA(C0 = ATT_MFMA(kf[6], qr[3], C0), P1[10], P1[11], P1[12], P1[13], pw3[0] = PKW(P1, 8), pw3[1] = PKW(P1, 10), pw3); \
        VRD(0, 0, vp_); SBAR(); \
        GAPA(C1 = ATT_MFMA(kf[7], qr[3], C1), P1[14], P1[15], 0.f, 0.f,       pw3[2] = PKW(P1, 12), pw3[3] = PKW(P1, 14), pw3); \
        l_reg += sacc; } while (0)
#define GAPB(i, j, jn, X, XB, DOEX, GL, vp_, kp_, N0, N1, DOSP) do { if ((i) + 1 < 16) { VRD(jn, (i) + 1, vp_); } \
        if ((GL) && ((i) & 1)) { KLD((i) >> 1, kp_); } SBAR(); \
        o[(i) & 3] = ATT_MFMA(PAF_SEL((i) >> 2), VFR(j), o[(i) & 3]); \
        if (DOEX) { X[XB] = EX(X[XB]); X[XB + 1] = EX(X[XB + 1]); PIN(X); } \
        SBAR(); } while (0)
#define PAF_SEL(k) ((k) == 0 ? PAF(0) : (k) == 1 ? PAF(1) : (k) == 2 ? PAF(2) : PAF(3))
#define PHASE_B(C0, C1, DOEX, GL, vp_, kp_, N0, N1, DOSP) do { \
        GAPB(0, 0, 1, C0, 0, DOEX, GL, vp_, kp_, N0, N1, DOSP); GAPB(1, 1, 0, C0, 2, DOEX, GL, vp_, kp_, N0, N1, DOSP); GAPB(2, 0, 1, C0, 4, DOEX, GL, vp_, kp_, N0, N1, DOSP); GAPB(3, 1, 0, C0, 6, DOEX, GL, vp_, kp_, N0, N1, DOSP); \
        GAPB(4, 0, 1, C0, 8, DOEX, GL, vp_, kp_, N0, N1, DOSP); GAPB(5, 1, 0, C0, 10, DOEX, GL, vp_, kp_, N0, N1, DOSP); GAPB(6, 0, 1, C0, 12, DOEX, GL, vp_, kp_, N0, N1, DOSP); GAPB(7, 1, 0, C0, 14, DOEX, GL, vp_, kp_, N0, N1, DOSP); \
        GAPB(8, 0, 1, C1, 0, DOEX, GL, vp_, kp_, N0, N1, DOSP); GAPB(9, 1, 0, C1, 2, DOEX, GL, vp_, kp_, N0, N1, DOSP); GAPB(10, 0, 1, C1, 4, DOEX, GL, vp_, kp_, N0, N1, DOSP); GAPB(11, 1, 0, C1, 6, DOEX, GL, vp_, kp_, N0, N1, DOSP); \
        GAPB(12, 0, 1, C1, 8, DOEX, GL, vp_, kp_, N0, N1, DOSP); GAPB(13, 1, 0, C1, 10, DOEX, GL, vp_, kp_, N0, N1, DOSP); GAPB(14, 0, 1, C1, 12, DOEX, GL, vp_, kp_, N0, N1, DOSP); GAPB(15, 1, 0, C1, 14, DOEX, GL, vp_, kp_, N0, N1, DOSP); \
        } while (0)
#define KSL(t) ((((t) & 3)) * SLOT)
#define DMA_GROUP(t) do { if ((t) + 3 < NT) DMA_K((t) + 3, KSL((t) + 3)); if ((t) + 1 < NT) DMA_V((t) + 1, KSL((t) + 1)); } while (0)
#define STEP(C0, C1, P0, P1, t) do { const lds_cptr vpp = vp0 + KSL((t) - 1); const lds_cptr kpn = kp0 + KSL((t) + 1); \
        PHASE_A(C0, C1, P0, P1, vpp); \
        BANDFIX(C0, C1, t); \
        if (comp == 0) { DMA_GROUP(t); } else { ENDW(t); } \
        SBAR(); \
        PHASE_B(C0, C1, true, true, vpp, kpn, P0, P1, true); PIN(P0); PIN(P1); \
        if (comp == 0) { ENDW(t); } else { DMA_GROUP((t) + 1); } } while (0)
#define PACKSUM(P0, P1) do { float sacc = 0.f; _Pragma("unroll") for (int r = 0; r < 16; ++r) sacc += P0[r] + P1[r]; l_reg += sacc; \
        pw0 = (u32x4){PKW(P0, 0), PKW(P0, 2), PKW(P0, 4), PKW(P0, 6)}; pw1 = (u32x4){PKW(P0, 8), PKW(P0, 10), PKW(P0, 12), PKW(P0, 14)}; \
        pw2 = (u32x4){PKW(P1, 0), PKW(P1, 2), PKW(P1, 4), PKW(P1, 6)}; pw3 = (u32x4){PKW(P1, 8), PKW(P1, 10), PKW(P1, 12), PKW(P1, 14)}; } while (0)

    if (NT > 2) { ATT_WAIT_BAR(4); } else { ATT_WAIT_BAR(2); }
    if (comp != 0) { DMA_GROUP(0); }
    {
#pragma unroll
      for (int f = 0; f < 8; ++f) KLD(f, kp0);
      pA0 = ATT_MFMA(kf[0], qr[0], cf); pA1 = ATT_MFMA(kf[1], qr[0], cf);
#pragma unroll
      for (int d0 = 1; d0 < 4; ++d0) { pA0 = ATT_MFMA(kf[2 * d0], qr[d0], pA0); pA1 = ATT_MFMA(kf[2 * d0 + 1], qr[d0], pA1); } }
    SBAR();
    BANDFIX(pA0, pA1, 0);
    if (comp == 0) { DMA_GROUP(0); } else { ENDW(0); }
    {
#pragma unroll
        for (int r = 0; r < 16; ++r) { pA0[r] = EX(pA0[r]); pA1[r] = EX(pA1[r]); }
#pragma unroll
        for (int f = 0; f < 8; ++f) KLD(f, kp0 + KSL(1));
    }
    if (comp == 0) { ENDW(0); } else { DMA_GROUP(1); }
    {
        int t = 1;
        for (; t + 2 < NT; t += 2) { STEP(pB0, pB1, pA0, pA1, t); STEP(pA0, pA1, pB0, pB1, t + 1); }
        STEP(pB0, pB1, pA0, pA1, t);
        PACKSUM(pB0, pB1);
        VRD(0, 0, vp0 + KSL(NT - 1)); SBAR();
        PHASE_B(pA0, pA1, false, false, vp0 + KSL(NT - 1), kp0, pA0, pA1, false);
    }
    float l = l_reg;
    { auto rr = __builtin_amdgcn_permlane32_swap(__float_as_uint(l), __float_as_uint(l), false, false); l = __uint_as_float(rr[0]) + __uint_as_float(rr[1]); }
    if (hi == 0) wsf[32 + r32] = l;
    float rli[16];
#pragma unroll
    for (int r = 0; r < 16; ++r) rli[r] = __builtin_amdgcn_rcpf(wsf[32 + crow(r, hi)]);
    ATT_LBAR();
    LAS float* xch = (LAS float*)(lds + LDS_XCH) + rg * 4096;
    if (comp == 1) {
#pragma unroll
        for (int d0 = 0; d0 < 4; ++d0)
#pragma unroll
            for (int r = 0; r < 16; ++r) xch[(d0 * 16 + r) * 64 + lane] = o[d0][r] * rli[r] * lam;
    }
    ATT_LBAR();
    if (comp == 0) {
        float ss[16];
#pragma unroll
        for (int r = 0; r < 16; ++r) { float s_ = 0.f;
#pragma unroll
            for (int d0 = 0; d0 < 4; ++d0) { const float v = o[d0][r] * rli[r] - xch[(d0 * 16 + r) * 64 + lane]; o[d0][r] = v; s_ += v * v; }
            ss[r] = s_; }
#pragma unroll
        for (int r = 0; r < 16; ++r) {
            float v = ss[r]; v += pg8::dppf<0xB1>(v); v += pg8::dppf<0x4E>(v); v += pg8::dppf<0x141>(v); v += pg8::dppf<0x140>(v);
            auto sw = __builtin_amdgcn_permlane16_swap(__float_as_uint(v), __float_as_uint(v), false, false); ss[r] = __uint_as_float(sw[0]) + __uint_as_float(sw[1]); }
        LAS bf16* stg = (LAS bf16*)(lds + LDS_OST) + rg * 4096;
        float g4[4];
#pragma unroll
        for (int d0 = 0; d0 < 4; ++d0) g4[d0] = subln_g[d0 * 32 + r32];
#pragma unroll
        for (int r = 0; r < 16; ++r) { const float rs = 0.8f * __builtin_amdgcn_rsqf(ss[r] * (1.0f / 128.0f) + 1e-5f); const int orow = crow(r, hi);
#pragma unroll
            for (int d0 = 0; d0 < 4; ++d0) stg[orow * 128 + d0 * 32 + r32] = (bf16)f2bf(o[d0][r] * rs * g4[d0]); }
#pragma unroll
        for (int i = 0; i < 8; ++i) { const int row = i * 4 + (lane >> 4), ch = lane & 15;
            const u32x4 v = *(LAS const u32x4*)(stg + row * 128 + ch * 8);
            st16wt(O + (size_t)(qw0 + row) * 1024 + h * 128 + ch * 8, v); }
    }
    ATT_LBAR();
#undef ATT_RFL
#undef DMA_K
#undef DMA_V
#undef SBAR
#undef PIN
#undef PKW
#undef PAF
#undef EX
#undef ROT3
#undef ENDW
#undef KLD
#undef BANDFIX
#undef VRD
#undef VFR
#undef GAPA
#undef PHASE_A
#undef GAPB
#undef PAF_SEL
#undef PHASE_B
#undef STEP
#undef PACKSUM
#undef KSL
#undef DMA_GROUP
}

__device__ __forceinline__ void attn_phase(int wv, const Args& a, LAS unsigned char* lds, int blk, int G, bf16* Odst) {
    const float* BTAB = (const float*)(a.ws + WS_BTAB);
    const float lam = __builtin_bit_cast(float, __builtin_amdgcn_readfirstlane(__builtin_bit_cast(int, BTAB[8 * 132])));
    const bf16* Q = (const bf16*)(a.ws + WS_A3); const bf16* K = (const bf16*)(a.ws + WS_A4); const bf16* V = (const bf16*)(a.ws + WS_A5);
    const bool snake = (1024 % G) == 0;
    for (int j = 0;; ++j) {
        const int idx = j * G + blk; if (idx >= 1024) break;
        const int rank = (snake && (j & 1)) ? (j * G + (G - 1 - blk)) : idx;
        attn_unit_pipe(wv, rank & 7, 127 - (rank >> 3), Q, K, V, Odst, lds, lam, BTAB, a.in[I_SUBLN_G], (const unsigned*)(a.ws + WS_KMAX));
    }
}
}


__device__ __forceinline__ void peer_convert(int wv, const Args& a, int blk, int G) {
    const int tid = opaque_tid(wv), lane = tid & 63, gw = blk * 8 + (tid >> 6);
    for (int which = 0; which < 2; ++which) {
        const float* src = a.in[which ? I_PEER_V : I_PEER_U]; unsigned* dst = (unsigned*)(a.ws + (which ? WS_PV : WS_PU));
        const size_t nchunk = (size_t)16384 * 1024 / 1024, stride = (size_t)G * 8;
        for (size_t c = gw; c < nchunk; c += 2 * stride) {
            const size_t c1 = c + stride; const bool two = c1 < nchunk;
            f32x4 v[8];
#pragma unroll
            for (int j = 0; j < 4; ++j) v[j] = __builtin_nontemporal_load((const f32x4*)(src + c * 1024 + 256 * j + 4 * lane));
            if (two) {
#pragma unroll
                for (int j = 0; j < 4; ++j) v[4 + j] = __builtin_nontemporal_load((const f32x4*)(src + c1 * 1024 + 256 * j + 4 * lane)); }
#pragma unroll
            for (int j = 0; j < 4; ++j) { const f32x4 x = v[j] * 128.0f; int w = __builtin_amdgcn_cvt_pk_fp8_f32(x[0], x[1], 0, false); w = __builtin_amdgcn_cvt_pk_fp8_f32(x[2], x[3], w, true);
                dst[c * 256 + 64 * j + lane] = (unsigned)w; }
            if (two) {
#pragma unroll
                for (int j = 0; j < 4; ++j) { const f32x4 x = v[4 + j] * 128.0f; int w = __builtin_amdgcn_cvt_pk_fp8_f32(x[0], x[1], 0, false); w = __builtin_amdgcn_cvt_pk_fp8_f32(x[2], x[3], w, true);
                    dst[c1 * 256 + 64 * j + lane] = (unsigned)w; } }
        } }
}
namespace peer {
typedef float f32x2v __attribute__((ext_vector_type(2)));
template <int CTRL> __device__ __forceinline__ float dpp(float x) { return __builtin_bit_cast(float, __builtin_amdgcn_mov_dpp(__builtin_bit_cast(int, x), CTRL, 0xf, 0xf, true)); }
template <int CTRL> __device__ __forceinline__ unsigned dppu(unsigned x) { return (unsigned)__builtin_amdgcn_mov_dpp((int)x, CTRL, 0xf, 0xf, true); }
__device__ __forceinline__ unsigned half32_umax(unsigned m) {
    unsigned t = dppu<0xB1>(m); m = t > m ? t : m; t = dppu<0x4E>(m); m = t > m ? t : m; t = dppu<0x141>(m); m = t > m ? t : m; t = dppu<0x140>(m); m = t > m ? t : m;
    auto s = __builtin_amdgcn_permlane16_swap(m, m, false, false); return s[0] > s[1] ? s[0] : s[1]; }
__device__ __forceinline__ float row16_sum(float x) { x += dpp<0xB1>(x); x += dpp<0x4E>(x); x += dpp<0x141>(x); x += dpp<0x140>(x); return x; }
__device__ __forceinline__ float wsum(float x) {
    x += dpp<0xB1>(x); x += dpp<0x4E>(x); x += dpp<0x141>(x); x += dpp<0x140>(x);
    auto s = __builtin_amdgcn_permlane16_swap(__float_as_uint(x), __float_as_uint(x), false, false); x = __uint_as_float(s[0]) + __uint_as_float(s[1]);
    auto t = __builtin_amdgcn_permlane32_swap(__float_as_uint(x), __float_as_uint(x), false, false); return __uint_as_float(t[0]) + __uint_as_float(t[1]);
}
__device__ __forceinline__ void peer_phase(int wv, const Args& a, int blk, int G, float* OUTP) {
    const int tid = opaque_tid(wv), lane = tid & 63, wave = tid >> 6, hh = lane >> 5, l32 = lane & 31;
    const unsigned* TK = (const unsigned*)(a.ws + WS_TOPK); const unsigned char* PU = (const unsigned char*)(a.ws + WS_PU); const unsigned char* PVt = (const unsigned char*)(a.ws + WS_PV);
    const float* gF = a.in[I_NORM_FFN_G]; const float* gO = a.in[I_FINAL_G];
    int ci0 = 0, cj0 = 0, ci1 = 0, cj1 = 0; bool valid1 = false;
    { int p = 0;
      for (int i = 0; i < 16; ++i) for (int j = 0; j < 16; ++j) if ((i + 1) * (j + 1) <= 16) { if (p == l32) { ci0 = i; cj0 = j; } if (p == l32 + 32) { ci1 = i; cj1 = j; valid1 = true; } ++p; } }
    for (int tok = blk * 8 + wave; tok < S; tok += G * 8) {
        const unsigned short* xrow = (const unsigned short*)(a.ws + WS_A2) + (size_t)tok * D + 16 * lane;
        f32x4 xa[4];
        { const u32x4 r0 = *(const u32x4*)xrow, r1 = *(const u32x4*)(xrow + 8);
          xa[0] = (f32x4){bflo(r0.x), bfhi(r0.x), bflo(r0.y), bfhi(r0.y)}; xa[1] = (f32x4){bflo(r0.z), bfhi(r0.z), bflo(r0.w), bfhi(r0.w)};
          xa[2] = (f32x4){bflo(r1.x), bfhi(r1.x), bflo(r1.y), bfhi(r1.y)}; xa[3] = (f32x4){bflo(r1.z), bfhi(r1.z), bflo(r1.w), bfhi(r1.w)}; }
        unsigned key[4];
#pragma unroll
        for (int i = 0; i < 4; ++i) key[i] = TK[(size_t)tok * 256 + lane + 64 * i];
        float ss = 0.f;
#pragma unroll
        for (int j = 0; j < 4; ++j) ss += (xa[j][0] * xa[j][0] + xa[j][1] * xa[j][1]) + (xa[j][2] * xa[j][2] + xa[j][3] * xa[j][3]);
        ss = wsum(ss);
        const float rstd = 1.0f / sqrtf(ss * (1.0f / D) + 1e-6f);
        float hf[16];
#pragma unroll
        for (int j = 0; j < 4; ++j) { const f32x4 gg = *(const f32x4*)(gF + 16 * lane + 4 * j);
#pragma unroll
            for (int e = 0; e < 4; ++e) hf[4 * j + e] = xa[j][e] * rstd * gg[e]; }
        int ex[4]; float gw[4];
#pragma unroll
        for (int i = 0; i < 4; ++i) {
            const unsigned k = key[i];
            const float v = pg8::ord2f(k & ~0x7Fu); const int ix = 127 - (int)(k & 0x7Fu);
            const float s0 = __shfl(v, hh * 32 + ci0) + __shfl(v, hh * 32 + 16 + cj0);
            const float s1 = __shfl(v, hh * 32 + ci1) + __shfl(v, hh * 32 + 16 + cj1);
            unsigned ck0 = (pg8::f2ord(s0) & ~0xFFu) | (unsigned)(255 - (ci0 * 16 + cj0));
            unsigned ck1 = valid1 ? ((pg8::f2ord(s1) & ~0xFFu) | (unsigned)(255 - (ci1 * 16 + cj1))) : 0u;
            unsigned win = 0u;
#pragma unroll
            for (int r = 0; r < 16; ++r) {
                const unsigned m = half32_umax(ck0 > ck1 ? ck0 : ck1);
                if (l32 == r) win = m;
                if (ck0 == m) ck0 = 0u;
                if (ck1 == m) ck1 = 0u;
            }
            const float ts = pg8::ord2f(win & ~0xFFu); const int flat = 255 - (int)(win & 0xFFu);
            const float mx = __shfl(ts, hh * 32);
            const float e = (l32 < 16) ? __expf(ts - mx) : 0.f;
            const float sum = row16_sum(e);
            gw[i] = e / sum;
            const int e0 = __shfl(ix, hh * 32 + ((flat >> 4) & 15)), e1 = __shfl(ix, hh * 32 + 16 + (flat & 15));
            ex[i] = e0 * 128 + e1;
        }
        float acc[16];
#pragma unroll
        for (int j = 0; j < 16; ++j) acc[j] = 0.f;
#pragma unroll 1
        for (int b = 0; b < 16; ++b) {
            const int i = b >> 2, sl = ((b >> 1) & 1) * 32 + (b & 1) * 8;
            const int exv = i == 0 ? ex[0] : i == 1 ? ex[1] : i == 2 ? ex[2] : ex[3];
            const float gwv = i == 0 ? gw[0] : i == 1 ? gw[1] : i == 2 ? gw[2] : gw[3];
            u32x4 uu[8], vv[8];
#pragma unroll
            for (int q = 0; q < 8; ++q) { const int eid = __builtin_amdgcn_readlane(exv, sl + q); uu[q] = *(const u32x4*)(PU + (size_t)eid * 1024 + 16 * lane); vv[q] = *(const u32x4*)(PVt + (size_t)eid * 1024 + 16 * lane); }
            float d[8];
#pragma unroll
            for (int q = 0; q < 8; ++q) { float s_ = 0.f;
#pragma unroll
                for (int e = 0; e < 4; ++e) { const f32x2v lo = __builtin_amdgcn_cvt_pk_f32_fp8((int)uu[q][e], false), hi2 = __builtin_amdgcn_cvt_pk_f32_fp8((int)uu[q][e], true);
                    s_ += (lo[0] * hf[4 * e] + lo[1] * hf[4 * e + 1]) + (hi2[0] * hf[4 * e + 2] + hi2[1] * hf[4 * e + 3]); }
                d[q] = s_; }
            float z;
            { const bool b0 = lane & 1, b1 = lane & 2, b2 = lane & 4;
              float r4[4], r2[2];
#pragma unroll
              for (int q = 0; q < 4; ++q) { const float keep = b0 ? d[q + 4] : d[q], give = b0 ? d[q] : d[q + 4]; r4[q] = keep + dpp<0xB1>(give); }
#pragma unroll
              for (int q = 0; q < 2; ++q) { const float keep = b1 ? r4[q + 2] : r4[q], give = b1 ? r4[q] : r4[q + 2]; r2[q] = keep + dpp<0x4E>(give); }
              { const float keep = b2 ? r2[1] : r2[0], give = b2 ? r2[0] : r2[1];
                const float up = dpp<0x104>(give), dn = dpp<0x114>(give);
                z = keep + (b2 ? dn : up); }
              z += dpp<0x128>(z);
              auto s16 = __builtin_amdgcn_permlane16_swap(__float_as_uint(z), __float_as_uint(z), false, false); z = __uint_as_float(s16[0]) + __uint_as_float(s16[1]);
              auto s32 = __builtin_amdgcn_permlane32_swap(__float_as_uint(z), __float_as_uint(z), false, false); z = __uint_as_float(s32[0]) + __uint_as_float(s32[1]); }
            const int myq = 4 * (lane & 1) + 2 * ((lane >> 1) & 1) + ((lane >> 2) & 1);
            const float gmine = __shfl(gwv, sl + myq);
            z *= (1.0f / 128.0f);
            const float wl = gmine * 0.5f * z * (1.0f + erff(z * 0.70710678118654752f)) * (1.0f / 128.0f);
#pragma unroll
            for (int q = 0; q < 8; ++q) { const float w = __builtin_bit_cast(float, __builtin_amdgcn_readlane(__builtin_bit_cast(int, wl), ((q >> 2) & 1) | (((q >> 1) & 1) << 1) | ((q & 1) << 2)));
#pragma unroll
                for (int e = 0; e < 4; ++e) { const f32x2v lo = __builtin_amdgcn_cvt_pk_f32_fp8((int)vv[q][e], false), hi2 = __builtin_amdgcn_cvt_pk_f32_fp8((int)vv[q][e], true);
                    acc[4 * e] += w * lo[0]; acc[4 * e + 1] += w * lo[1]; acc[4 * e + 2] += w * hi2[0]; acc[4 * e + 3] += w * hi2[1]; } }
        }
        float s3 = 0.f;
#pragma unroll
        for (int j = 0; j < 4; ++j)
#pragma unroll
            for (int e = 0; e < 4; ++e) { xa[j][e] += acc[4 * j + e]; s3 += xa[j][e] * xa[j][e]; }
        s3 = wsum(s3);
        const float r3 = 1.0f / sqrtf(s3 * (1.0f / D) + 1e-6f);
        float* orow = OUTP + (size_t)tok * D + 16 * lane;
#pragma unroll
        for (int j = 0; j < 4; ++j) { const f32x4 gg = *(const f32x4*)(gO + 16 * lane + 4 * j); *(f32x4*)(orow + 4 * j) = xa[j] * r3 * gg; }
    }
}
}

#define XB_TMO      128
#define XB_XCNT(j)  (256  + 64 * (j))
#define XB_XSUB(j)  (1280 + 64 * (j))
#define XB_XGEN(j)  (2304 + 64 * (j))
#define XB_TOP      3328
#define XB_TOPGEN   3392
#define XCD_BAR_WORDS 3456
#define XB_SPIN_CAP (1u << 18)

__device__ __forceinline__ unsigned xb_ld(unsigned* p)              { return __hip_atomic_load(p, __ATOMIC_RELAXED, __HIP_MEMORY_SCOPE_AGENT); }
__device__ __forceinline__ unsigned xb_add(unsigned* p, unsigned v) { return __hip_atomic_fetch_add(p, v, __ATOMIC_RELAXED, __HIP_MEMORY_SCOPE_AGENT); }
__device__ __forceinline__ unsigned xb_xcc_id() { return (unsigned)__builtin_amdgcn_s_getreg((3 << 11) | 20) & 0xFu; }
#define XB_SPIN(cond, bar) do { unsigned _sp = 0; while (cond) { __builtin_amdgcn_s_sleep(1); \
    if ((++_sp & 255u) == 0u) { if (xb_ld(&(bar)[XB_TMO])) break; if (_sp > XB_SPIN_CAP) { atomicAdd(&(bar)[XB_TMO], 1u); break; } } } } while (0)

struct XcdBarrier {
    unsigned* bar; unsigned x;
    volatile LAS unsigned* st;
};

__device__ __forceinline__ XcdBarrier xcd_barrier_post(unsigned* bar, volatile LAS unsigned* st, int tid) {
    XcdBarrier b; b.bar = bar; b.x = xb_xcc_id(); b.st = st;
    if (tid == 0) (void)xb_add(&bar[XB_XCNT(b.x)], 1u);
    return b;
}
__device__ __forceinline__ void xcd_barrier_complete(unsigned* bar, unsigned x, unsigned& nloc, unsigned& nx) {
    const unsigned G = gridDim.x * gridDim.y * gridDim.z;
    unsigned sum, cnt, mine, sp = 0u;
    for (;;) {
        sum = 0u; cnt = 0u; mine = 0u;
#pragma unroll
        for (unsigned j = 0; j < 16; ++j) { const unsigned c = xb_ld(&bar[XB_XCNT(j)]); sum += c; cnt += (c > 0u) ? 1u : 0u; mine = (j == x) ? c : mine; }
        if (sum == G) break;
        __builtin_amdgcn_s_sleep(1);
        if ((++sp & 255u) == 0u) { if (xb_ld(&bar[XB_TMO])) break; if (sp > XB_SPIN_CAP) { atomicAdd(&bar[XB_TMO], 1u); break; } }
    }
    nloc = mine > 0u ? mine : 1u; nx = cnt > 0u ? cnt : 1u;
}

__device__ __forceinline__ void xcd_barrier(const XcdBarrier& b, int tid) {
    asm volatile("s_waitcnt vmcnt(0)" ::: "memory");
    __syncthreads();
    if (tid == 0) {
        unsigned* bar = b.bar;
        __builtin_amdgcn_s_waitcnt(0);
        unsigned nloc = b.st[0], nx = b.st[1];
        if (nloc == 0u) { xcd_barrier_complete(bar, b.x, nloc, nx); b.st[0] = nloc; b.st[1] = nx; }
        const unsigned old = xb_add(&bar[XB_XSUB(b.x)], 1u);
        const unsigned gen = old / nloc;
        if (old + 1u == (gen + 1u) * nloc) {
            __builtin_amdgcn_fence(__ATOMIC_RELEASE, "agent");
            asm volatile("s_waitcnt vmcnt(0)" ::: "memory");
            const unsigned og = xb_add(&bar[XB_TOP], 1u);
            const unsigned tg = og / nx;
            if (og + 1u == (tg + 1u) * nx) xb_add(&bar[XB_TOPGEN], 1u);
            else XB_SPIN(xb_ld(&bar[XB_TOPGEN]) == tg, bar);
            __builtin_amdgcn_fence(__ATOMIC_ACQUIRE, "agent");
            xb_add(&bar[XB_XGEN(b.x)], 1u);
            asm volatile("s_waitcnt vmcnt(0)" ::: "memory");
        } else {
            XB_SPIN(xb_ld(&bar[XB_XGEN(b.x)]) == gen, bar);
            __builtin_amdgcn_fence(__ATOMIC_ACQUIRE, "agent");
            asm volatile("s_waitcnt vmcnt(0)" ::: "memory");
        }
    }
    __syncthreads();
}

constexpr int LDS_BYTES = 147456, LDS_MISC = 139264;
__global__ void __launch_bounds__(512, 2) mk_fwd(Args a) {
    extern __shared__ __attribute__((aligned(16))) unsigned char lds_raw[];
    LAS unsigned char* lds = (LAS unsigned char*)lds_raw;
    unsigned char* ws = a.ws;
    const int G = gridDim.x, blk = blockIdx.x, wv = __builtin_amdgcn_readfirstlane(threadIdx.x >> 6);
    { const int t0 = opaque_tid(wv); if (t0 < 16) ((volatile LAS unsigned*)(lds + LDS_MISC))[t0] = 0u; }
    __syncthreads();
    XcdBarrier bar = xcd_barrier_post((unsigned*)(ws + WS_CTL), (volatile LAS unsigned*)(lds + LDS_MISC), opaque_tid(wv));
#define IN(k) (a.ph_lo <= (k) && (k) < a.ph_hi)
#define SEAM(k) do { if (IN(k) && IN((k) + 1)) xcd_barrier(bar, opaque_tid(wv)); } while (0)
    if (IN(0)) p0_prologue(wv, a, lds, blk, G);
    SEAM(0);
    if (IN(1)) {
        pg8::Gemm g{(const bf16*)(ws + WS_A0), (const bf16*)(ws + WS_WT_IN), S, NCOLS, D, D, D}; pg8::StaticOrder So; So.init(S, NCOLS, G, blk);
        pg8::EpiProj E{(const float*)(ws + WS_RSTD0), (bf16*)(ws + WS_A1), (bf16*)(ws + WS_A2), (bf16*)(ws + WS_A3), (bf16*)(ws + WS_A4), (bf16*)(ws + WS_A5), (bf16*)(ws + WS_A6), (bf16*)a.out, 0.125f * 1.4426950408889634f, (unsigned*)(ws + WS_KMAX), (PG8_LAS float*)(lds + 131072)};
        pg8::gemm_phase<pg8::EpiProj, pg8::StaticOrder, true, true>(wv, lds, g, So, E);
    }
    SEAM(1);
    if (IN(2)) { conv_phase(wv, a, blk, G);  att::attn_phase(wv, a, lds, blk, G, (bf16*)(ws + WS_A3)); }
    SEAM(2);
    if (IN(3)) {
        pg8::StaticOrder So; So.init(S, D, G, blk);
        { pg8::Gemm g{(const bf16*)(ws + WS_A1), (const bf16*)(ws + WS_WT_CONV), S, D, 2 * D, D, D};
          const pg8::Split sp{16, (long long)WS_A3 - (long long)WS_A1 - 16 * 128, (long long)WS_WT_ATTN - (long long)WS_WT_CONV - 16 * 128};
          pg8::EpiMergeK E{(const bf16*)(ws + WS_A6), (const bf16*)a.out, (bf16*)(ws + WS_A0)};
          pg8::gemm_phase<pg8::EpiMergeK, pg8::StaticOrder, true, true, true>(wv, lds, g, So, E, sp); }
    }
    SEAM(3);
    if (IN(4)) {
        cross_fold(wv, a, blk, G);
        peer_convert(wv, a, blk, G);
        pg8::Gemm g{(const bf16*)(ws + WS_A0), (const bf16*)(ws + WS_WT_MIX), S, D, D, D, D}; pg8::StaticOrder So; So.init(S, D, G, blk);
        pg8::EpiResid E{a.in[I_X], (bf16*)(ws + WS_A2), (float*)(ws + WS_SS1)};
        pg8::gemm_phase<pg8::EpiResid, pg8::StaticOrder, true, true>(wv, lds, g, So, E);
    }
    SEAM(4);
    if (IN(5)) {
        pg8::Gemm g{(const bf16*)(ws + WS_A2), (const bf16*)(ws + WS_WQK), S, D, D, D, D}; pg8::StaticOrder So; So.init(S, D, G, blk);
        pg8::EpiSoftmaxFull E{(const float*)(ws + WS_SS1), (bf16*)(ws + WS_A1), 0.0625f * 1.4426950408889634f};
        pg8::gemm_phase<pg8::EpiSoftmaxFull, pg8::StaticOrder, false, true>(wv, lds, g, So, E);
    }
    SEAM(5);
    if (IN(6)) {
        pg8::Gemm g{(const bf16*)(ws + WS_A1), (const bf16*)(ws + WS_VW), S, D, D, D, D}; pg8::StaticOrder So; So.init(S, D, G, blk);
        pg8::EpiResidB E{(bf16*)(ws + WS_A2), (float*)(ws + WS_SS2)};
        pg8::gemm_phase<pg8::EpiResidB, pg8::StaticOrder, true, true>(wv, lds, g, So, E);
    }
    SEAM(6);
    if (IN(7)) {
        pg8::StaticOrder So; So.init(S, 2048, G, blk);
        unsigned* KS = (unsigned*)(ws + WS_KS) + (size_t)blk * 65536;
        for (int i = 0;; ++i) { pg8::Unit u; if (!So.next(i, u)) break;
            { pg8::Gemm g{(const bf16*)(ws + WS_A2), (const bf16*)(ws + WS_WT_PQ), S, 2048, D, D, D}; pg8::OneUnit S1{u.pm, u.pn};
              pg8::EpiKeys E{(const float*)(ws + WS_SS2), KS};
              pg8::gemm_phase<pg8::EpiKeys, pg8::OneUnit, false, true>(wv, lds, g, S1, E); }
            pg8::topk_from_keys(opaque_tid(wv), KS, (unsigned*)(ws + WS_TOPK), u.pm * 256, u.pn);
            asm volatile("s_waitcnt vmcnt(0)" ::: "memory"); __syncthreads(); }
    }
    SEAM(7);
    if (IN(8)) peer::peer_phase(wv, a, blk, G, a.out);
#undef IN
#undef SEAM
}

extern "C" void kernel_launch(void* const* d_in, const int* in_sizes, int n_in, void* d_out, int out_size, void* d_ws, size_t ws_size, hipStream_t stream) {
    static int grid = 0;
    if (grid == 0) {
        if (ws_size < WS_END || n_in != 25 || out_size != S * D) { fprintf(stderr, "kernel_launch: unexpected ws_size %zu / n_in %d / out_size %d\n", ws_size, n_in, out_size); grid = -1; return; }
        if (hipFuncSetAttribute((const void*)mk_fwd, hipFuncAttributeMaxDynamicSharedMemorySize, LDS_BYTES) != hipSuccess) { fprintf(stderr, "kernel_launch: hipFuncSetAttribute failed\n"); grid = -1; return; }
        int dev = 0, cus = 0, per_cu = 0;
        if (hipGetDevice(&dev) != hipSuccess || hipDeviceGetAttribute(&cus, hipDeviceAttributeMultiprocessorCount, dev) != hipSuccess) { grid = -1; return; }
        if (hipOccupancyMaxActiveBlocksPerMultiprocessor(&per_cu, (const void*)mk_fwd, 512, LDS_BYTES) != hipSuccess || per_cu < 1) { fprintf(stderr, "kernel_launch: occupancy query says %d blocks per CU\n", per_cu); grid = -1; return; }
        grid = cus;
    }
    if (grid < 0) return;
    Args a{};
    for (int i = 0; i < 25; ++i) a.in[i] = (const float*)d_in[i];
    a.out = (float*)d_out; a.ws = (unsigned char*)d_ws; a.ph_lo = 0; a.ph_hi = 9;
    if (hipMemsetAsync(d_ws, 0, 65536, stream) != hipSuccess) { fprintf(stderr, "kernel_launch: hipMemsetAsync failed\n"); return; }
    void* kargs[] = {&a};
    hipError_t e = hipLaunchCooperativeKernel((const void*)mk_fwd, dim3(grid), dim3(512), kargs, LDS_BYTES, stream);
    if (e != hipSuccess) fprintf(stderr, "kernel_launch: cooperative launch failed: %s (grid %d)\n", hipGetErrorString(e), grid);
}
```

```cpp
#include <hip/hip_runtime.h>
#include <math.h>
#include <cstdio>
#include <cstdint>
namespace pg8 {
#define PG8_LAS __attribute__((address_space(3)))
typedef unsigned short bf16_t;
typedef short bf16x8 __attribute__((ext_vector_type(8)));
typedef float f32x4 __attribute__((ext_vector_type(4)));
typedef unsigned u32x4 __attribute__((ext_vector_type(4)));
constexpr int BM = 256, BK = 64, HALF = 128, HTB = HALF * BK * 2  , STAGE_BYTES = 8 * HTB, NXCD = 8, WGM = 8;

__host__ __device__ __forceinline__ int lds_byte(int r, int c) { const int st = (r >> 4) * 2 + (c >> 5), rr = r & 15, cc = c & 31, ob = rr * 64 + cc * 2; return st * 1024 + (ob ^ (((ob >> 9) & 1) << 5)); }
__host__ __device__ __forceinline__ void stage_rc(int b, int& R, int& C) { const int st = b / 1024, sb = b % 1024, swz = sb ^ (((sb >> 9) & 1) << 5); R = (st >> 1) * 16 + swz / 64; C = (st & 1) * 32 + (swz % 64) / 2; }
__host__ __device__ __forceinline__ int perm32(int rho) { const int n = rho >> 4, i = rho & 15; return 8 * (i >> 2) + 4 * n + (i & 3); }

struct Unit { int pm, pn; };
struct Gemm { const bf16_t* A; const bf16_t* Bt; int M, N, K, lda, ldb; };
struct Split { int ksplit; long long dA2, dB2; };

struct StaticOrder {
    int nM, nN, nwg, G, c;
    __host__ __device__ void init(int M, int N, int G_, int c_) { nM = M / BM; nN = N / BM; nwg = nM * nN; G = G_; c = c_; }
    __host__ __device__ bool next(int i, Unit& u) const {
        const long L = (long)i * G + c; if (L >= nwg) return false;
        int wgid = (int)L; { const int q = nwg / NXCD, r = nwg % NXCD, xcd = wgid % NXCD, off = wgid / NXCD; wgid = (xcd < r ? xcd * (q + 1) : r * (q + 1) + (xcd - r) * q) + off; }
        const int nig = WGM * nN, gid = wgid / nig, fm = gid * WGM, gsz = (nM - fm) < WGM ? (nM - fm) : WGM;
        u.pm = fm + ((wgid % nig) % gsz); u.pn = (wgid % nig) / gsz; return true;
    }
    __device__ __forceinline__ void a_ready(const Unit&) const {}
    __device__ __forceinline__ void done(const Unit&) const {}
};

typedef float f32x2 __attribute__((ext_vector_type(2)));
typedef __bf16 bf16x2v __attribute__((ext_vector_type(2)));
__device__ __forceinline__ unsigned cvt_pk_bf16(float lo, float hi) { const f32x2 v = {lo, hi}; const bf16x2v b = __builtin_convertvector(v, bf16x2v); return __builtin_bit_cast(unsigned, b); }
template <class E, class = void> struct HasPrefetch { static constexpr bool value = false; };
template <class E> struct HasPrefetch<E, decltype((void)&E::prefetch)> { static constexpr bool value = true; };
template <class Epi, class Sched, bool ALIGN_EPI = false, bool SP2 = false, bool SPLIT = false>
__device__ __forceinline__ void gemm_phase(int wv, PG8_LAS unsigned char* lds, const Gemm g, const Sched& S, const Epi& E, const Split sp = Split{0, 0, 0}) {
    int tid_; asm volatile("v_mbcnt_lo_u32_b32 %0, -1, 0\n\tv_mbcnt_hi_u32_b32 %0, -1, %0" : "=v"(tid_)); tid_ += wv * 64;
    const int tid = tid_, wid = __builtin_amdgcn_readfirstlane(tid >> 6), lane = tid & 63, wr = wid >> 2, wc = wid & 3, fr = lane & 15, fq = lane >> 4;
    const int K = g.K, nt = K / BK;
    unsigned voffA[2], voffB[2];
#pragma unroll
    for (int i = 0; i < 2; ++i) { int R, C; stage_rc(tid * 16 + i * 8192, R, C); const int Rb = Epi::PERM ? ((R & ~31) + perm32(R & 31)) : R;
        voffA[i] = (unsigned)(R * g.lda + C) * 2u; voffB[i] = (unsigned)(Rb * g.ldb + C) * 2u; }
    const size_t kstep = (size_t)(BK * 2);
    const size_t hstepA = (size_t)HALF * g.lda * 2, hstepB = (size_t)HALF * g.ldb * 2;
    const size_t tstepA = 2 * hstepA, tstepB = 2 * hstepB;
    const unsigned ldsw = (unsigned)wid * 1024u;
    const int aoff = lds_byte(wr * 64 + fr, fq * 8), boff = lds_byte(wc * 32 + fr, fq * 8);
#define PG8_SA(b, h) (((b) * 2 + (h)) * HTB)
#define PG8_SB(b, h) ((4 + (b) * 2 + (h)) * HTB)
#define PG8_STAGE(bufoff, gbase, voff) do { _Pragma("unroll") for (int _i = 0; _i < 2; ++_i) \
        __builtin_amdgcn_global_load_lds((const unsigned*)((const char*)(gbase) + (voff)[_i]), (PG8_LAS unsigned*)(lds + (bufoff) + ldsw + _i * 8192), 16, 0, 0); } while (0)
#define PG8_LDA(dst, b, h) do { _Pragma("unroll") for (int m = 0; m < 4; ++m) _Pragma("unroll") for (int k = 0; k < 2; ++k) dst[m][k] = *(const PG8_LAS bf16x8*)(lds + PG8_SA(b, h) + aoff + m * 2048 + k * 1024); } while (0)
#define PG8_LDB(dst, b, h) do { _Pragma("unroll") for (int n = 0; n < 2; ++n) _Pragma("unroll") for (int k = 0; k < 2; ++k) dst[n][k] = *(const PG8_LAS bf16x8*)(lds + PG8_SB(b, h) + boff + n * 2048 + k * 1024); } while (0)
#define PG8_MMA(ai, bj, At, Bt) do { __builtin_amdgcn_s_setprio(1); _Pragma("unroll") for (int m = 0; m < 4; ++m) _Pragma("unroll") for (int n = 0; n < 2; ++n) _Pragma("unroll") for (int k = 0; k < 2; ++k) \
        acc[ai][bj][m][n] = __builtin_amdgcn_mfma_f32_16x16x32_bf16(Bt[n][k], At[m][k], acc[ai][bj][m][n], 0, 0, 0); __builtin_amdgcn_s_setprio(0); } while (0)
#define PG8_WAIT_V(n) asm volatile("s_waitcnt vmcnt(" #n ")" ::: "memory")
#define PG8_WAIT_L(n) asm volatile("s_waitcnt lgkmcnt(" #n ")" ::: "memory")
#define PG8_BAR __builtin_amdgcn_s_barrier()
#define PG8_SCHED __builtin_amdgcn_sched_barrier(0)
    Unit cur, nxt; int ui = 0;
    if (!S.next(0, cur)) return;
    f32x4 acc[2][2][4][2];
#pragma unroll
    for (int a = 0; a < 2; ++a)
#pragma unroll
        for (int b = 0; b < 2; ++b)
#pragma unroll
            for (int m = 0; m < 4; ++m)
#pragma unroll
                for (int n = 0; n < 2; ++n) acc[a][b][m][n] = (f32x4){0.f, 0.f, 0.f, 0.f};
    bf16x8 At[4][2], B0[2][2], B1[2][2];
    const char* cA = (const char*)g.A + (size_t)cur.pm * tstepA; const char* cB = (const char*)g.Bt + (size_t)cur.pn * tstepB;
    S.a_ready(cur);
    if constexpr (HasPrefetch<Epi>::value) E.prefetch(cur, lds, wid);
    if constexpr (SP2) {
        PG8_STAGE(PG8_SB(0, 0), cB, voffB); PG8_STAGE(PG8_SB(0, 1), cB + hstepB, voffB); PG8_STAGE(PG8_SA(0, 0), cA, voffA); PG8_STAGE(PG8_SA(0, 1), cA + hstepA, voffA);
        if (wr == 1) PG8_BAR;
        PG8_WAIT_V(2); PG8_BAR;
        PG8_STAGE(PG8_SB(1, 0), cB + kstep, voffB); PG8_STAGE(PG8_SA(1, 0), cA + kstep, voffA); PG8_STAGE(PG8_SB(1, 1), cB + hstepB + kstep, voffB);
        PG8_WAIT_V(6); PG8_BAR;
    } else {
        PG8_STAGE(PG8_SB(0, 0), cB, voffB); PG8_STAGE(PG8_SA(0, 0), cA, voffA); PG8_STAGE(PG8_SB(0, 1), cB + hstepB, voffB); PG8_STAGE(PG8_SA(0, 1), cA + hstepA, voffA);
        if (wr == 1) PG8_BAR;
        PG8_WAIT_V(4); PG8_BAR;
        PG8_STAGE(PG8_SB(1, 0), cB + kstep, voffB); PG8_STAGE(PG8_SA(1, 0), cA + kstep, voffA); PG8_STAGE(PG8_SB(1, 1), cB + hstepB + kstep, voffB);
        PG8_WAIT_V(6); PG8_BAR;
    }
    for (;;) {
        const bool has_next = S.next(ui + 1, nxt);
        const char* nA = has_next ? (const char*)g.A + (size_t)nxt.pm * tstepA : cA; const char* nB = has_next ? (const char*)g.Bt + (size_t)nxt.pn * tstepB : cB;
        for (int t = 0; t < nt; t += 2) {
            const bool last = (t == nt - 2);
            long long oa1 = 0, oa2 = 0, ob2 = 0;
            if constexpr (SPLIT) { if (t == sp.ksplit) E.mid(acc, cur, wr, wc, fr, fq);
                if (t >= sp.ksplit) oa1 = sp.dA2; if (t + 2 >= sp.ksplit) { oa2 = sp.dA2; ob2 = sp.dB2; } }
            const char* a1 = cA + (size_t)(t + 1) * kstep + oa1;
            const char* a2 = last ? nA : cA + (size_t)(t + 2) * kstep + oa2; const char* b2 = last ? nB : cB + (size_t)(t + 2) * kstep + ob2;
            const char* a3 = a2 + kstep; const char* b3 = b2 + kstep;
            if (last && has_next) S.a_ready(nxt);
            if constexpr (SP2) {
            PG8_LDB(B0, 0, 0); PG8_LDB(B1, 0, 1); PG8_SCHED; PG8_LDA(At, 0, 0); PG8_STAGE(PG8_SA(1, 1), a1 + hstepA, voffA);
            PG8_WAIT_V(8); PG8_WAIT_L(0); PG8_BAR; PG8_MMA(0, 0, At, B0); PG8_MMA(0, 1, At, B1); PG8_BAR; PG8_SCHED;
            PG8_LDA(At, 0, 1); PG8_STAGE(PG8_SB(0, 0), b2, voffB); PG8_STAGE(PG8_SB(0, 1), b2 + hstepB, voffB); PG8_STAGE(PG8_SA(0, 0), a2, voffA);
            PG8_WAIT_V(8); PG8_WAIT_L(0); PG8_BAR; PG8_MMA(1, 0, At, B0); PG8_MMA(1, 1, At, B1); PG8_BAR; PG8_SCHED;
            PG8_LDB(B0, 1, 0); PG8_LDB(B1, 1, 1); PG8_SCHED; PG8_LDA(At, 1, 0); PG8_STAGE(PG8_SA(0, 1), a2 + hstepA, voffA);
            PG8_WAIT_V(8); PG8_WAIT_L(0); PG8_BAR; PG8_MMA(0, 0, At, B0); PG8_MMA(0, 1, At, B1); PG8_BAR; PG8_SCHED;
            PG8_LDA(At, 1, 1); PG8_STAGE(PG8_SB(1, 0), b3, voffB); PG8_STAGE(PG8_SB(1, 1), b3 + hstepB, voffB); PG8_STAGE(PG8_SA(1, 0), a3, voffA);
            PG8_WAIT_V(8); PG8_WAIT_L(0); PG8_BAR; PG8_MMA(1, 0, At, B0); PG8_MMA(1, 1, At, B1); PG8_BAR; PG8_SCHED;
            } else {
            PG8_LDB(B0, 0, 0); PG8_SCHED; PG8_LDA(At, 0, 0); PG8_STAGE(PG8_SA(1, 1), a1 + hstepA, voffA);
            PG8_WAIT_L(8); PG8_BAR; PG8_WAIT_L(0); PG8_MMA(0, 0, At, B0); PG8_BAR; PG8_SCHED;
            PG8_LDB(B1, 0, 1); PG8_STAGE(PG8_SB(0, 0), b2, voffB);
            PG8_BAR; PG8_WAIT_L(0); PG8_MMA(0, 1, At, B1); PG8_BAR;
            PG8_LDA(At, 0, 1); PG8_STAGE(PG8_SA(0, 0), a2, voffA);
            PG8_BAR; PG8_WAIT_L(0); PG8_MMA(1, 0, At, B0); PG8_BAR; PG8_SCHED;
            PG8_STAGE(PG8_SB(0, 1), b2 + hstepB, voffB);
            PG8_WAIT_V(6); PG8_BAR; PG8_MMA(1, 1, At, B1); PG8_BAR;
            PG8_LDB(B0, 1, 0); PG8_SCHED; PG8_LDA(At, 1, 0); PG8_STAGE(PG8_SA(0, 1), a2 + hstepA, voffA);
            PG8_WAIT_L(8); PG8_BAR; PG8_WAIT_L(0); PG8_MMA(0, 0, At, B0); PG8_BAR; PG8_SCHED;
            PG8_LDB(B1, 1, 1); PG8_STAGE(PG8_SB(1, 0), b3, voffB);
            PG8_BAR; PG8_WAIT_L(0); PG8_MMA(0, 1, At, B1); PG8_BAR;
            PG8_LDA(At, 1, 1); PG8_STAGE(PG8_SA(1, 0), a3, voffA);
            PG8_BAR; PG8_WAIT_L(0); PG8_MMA(1, 0, At, B0); PG8_BAR; PG8_SCHED;
            PG8_STAGE(PG8_SB(1, 1), b3 + hstepB, voffB);
            PG8_WAIT_V(6); PG8_BAR; PG8_MMA(1, 1, At, B1); PG8_BAR;
            }
        }
        if constexpr (ALIGN_EPI) { if (wr == 0) PG8_BAR; }
        if constexpr (!Epi::AFTER_DRAIN) { E(acc, cur, wr, wc, fr, fq); S.done(cur); }
        if (!has_next) break;
#pragma unroll
        for (int a = 0; a < 2; ++a)
#pragma unroll
            for (int b = 0; b < 2; ++b)
#pragma unroll
                for (int m = 0; m < 4; ++m)
#pragma unroll
                    for (int n = 0; n < 2; ++n) acc[a][b][m][n] = (f32x4){0.f, 0.f, 0.f, 0.f};
        cur = nxt; cA = nA; cB = nB; ++ui;
        if constexpr (HasPrefetch<Epi>::value) E.prefetch(cur, lds, wid);
        if constexpr (ALIGN_EPI) { if (wr == 1) PG8_BAR; }
    }
    PG8_WAIT_V(0);
    if constexpr (!ALIGN_EPI) { if (wr == 0) PG8_BAR; }
    PG8_BAR;
    if constexpr (Epi::AFTER_DRAIN) { E.fused(acc, cur, wr, wc, fr, fq, lds, wid, lane); S.done(cur); }
#undef PG8_SA
#undef PG8_SB
#undef PG8_STAGE
#undef PG8_LDA
#undef PG8_LDB
#undef PG8_MMA
#undef PG8_WAIT_V
#undef PG8_WAIT_L
#undef PG8_BAR
#undef PG8_SCHED
}
}


constexpr int S = 16384, D = 1024, NCOLS = 8192, MEMN = 256;
typedef unsigned short bf16;
typedef float f32x4 __attribute__((ext_vector_type(4)));
typedef unsigned u32x4 __attribute__((ext_vector_type(4)));
typedef unsigned u32x2 __attribute__((ext_vector_type(2)));
__device__ __forceinline__ void st16wt(void* p, u32x4 v) { asm volatile("global_store_dwordx4 %0, %1, off sc1\n\ts_nop 1" :: "v"(p), "v"(v) : "memory"); }
#define LAS __attribute__((address_space(3)))

__device__ const unsigned char T5_BUCKET[128] = {0, 1, 2, 3, 4, 5, 6, 7, 8, 9, 10, 11, 12, 13, 14, 15, 16, 16, 16, 17, 17, 18, 18, 18, 19, 19, 19, 20, 20, 20, 20, 21, 21, 21, 21, 22, 22, 22, 22, 22, 23, 23, 23, 23, 23, 23, 24, 24, 24, 24, 24, 24, 25, 25, 25, 25, 25, 25, 25, 26, 26, 26, 26, 26, 26, 26, 26, 27, 27, 27, 27, 27, 27, 27, 27, 27, 27, 28, 28, 28, 28, 28, 28, 28, 28, 28, 28, 29, 29, 29, 29, 29, 29, 29, 29, 29, 29, 29, 29, 30, 30, 30, 30, 30, 30, 30, 30, 30, 30, 30, 30, 30, 30, 31, 31, 31, 31, 31, 31, 31, 31, 31, 31, 31, 31, 31, 31, 31};

constexpr size_t MiB = 1u << 20;
constexpr size_t WS_CTL = 0, WS_KMAX = 32768  , WS_RSTD0 = 512 * 1024;
constexpr size_t WS_WT_IN = 1 * MiB, WS_WT_CONV = 17 * MiB, WS_WT_ATTN = 19 * MiB, WS_WT_MIX = 21 * MiB, WS_WT_CQ = 23 * MiB, WS_WT_CO = 25 * MiB, WS_WT_PQ = 27 * MiB;
constexpr size_t WS_SUBK = 31 * MiB, WS_KV = 32 * MiB, WS_SS1 = 34 * MiB, WS_SS2 = 35 * MiB;
constexpr size_t WS_TOPK = 36 * MiB  , WS_PU = 196 * MiB  , WS_PV = 228 * MiB  ;
constexpr size_t WS_WQK = 23 * MiB  , WS_VW = 212 * MiB  ;
constexpr size_t WS_BTAB = 640 * 1024  ;
constexpr size_t WS_PQS = 52 * MiB  , WS_KS = 132 * MiB  ;
constexpr size_t WS_A0 = 36 * MiB, WS_A1 = 68 * MiB, WS_A2 = 100 * MiB, WS_A3 = 132 * MiB, WS_A4 = 164 * MiB, WS_A5 = 196 * MiB, WS_A6 = 228 * MiB, WS_END = 260 * MiB;

__device__ __forceinline__ float wave_sum(float v) {
#pragma unroll
    for (int o = 1; o < 64; o <<= 1) v += __shfl_xor(v, o);
    return v;
}
__device__ __forceinline__ float wave_max(float v) {
#pragma unroll
    for (int o = 1; o < 64; o <<= 1) v = fmaxf(v, __shfl_xor(v, o));
    return v;
}
__device__ __forceinline__ int opaque_tid(int wv) { int t; asm volatile("v_mbcnt_lo_u32_b32 %0, -1, 0\n\tv_mbcnt_hi_u32_b32 %0, -1, %0" : "=v"(t)); return t + wv * 64; }
__device__ __forceinline__ unsigned f2bf(float f) { unsigned u = __builtin_bit_cast(unsigned, f); return (u + 0x7fffu + ((u >> 16) & 1u)) >> 16; }
__device__ __forceinline__ unsigned pk2(float lo, float hi) { return pg8::cvt_pk_bf16(lo, hi); }
__device__ __forceinline__ float bflo(unsigned w) { return __builtin_bit_cast(float, w << 16); }
__device__ __forceinline__ float bfhi(unsigned w) { return __builtin_bit_cast(float, w & 0xffff0000u); }
__device__ __forceinline__ float sigmoidf_(float x) { return __builtin_amdgcn_rcpf(1.0f + __builtin_amdgcn_exp2f(x * -1.4426950408889634f)); }

struct Args { const float* in[25]; float* out; unsigned char* ws; int ph_lo, ph_hi; };
enum { I_X = 0, I_MEM, I_NORM_MIX_G, I_W_IN, I_CONV_W, I_W_CONV_OUT, I_LQ1, I_LK1, I_LQ2, I_LK2, I_SUBLN_G, I_W_ATTN_OUT, I_W_MIX_OUT, I_REL_BIAS, I_NORM_CROSS_G, I_NORM_MEM_G,
       I_W_CQ, I_W_CKV, I_W_CO, I_NORM_FFN_G, I_W_PQ, I_SUB_KEYS, I_PEER_U, I_PEER_V, I_FINAL_G };

namespace pg8 {
template <int CTRL> __device__ __forceinline__ float dppf(float x) { return __builtin_bit_cast(float, __builtin_amdgcn_mov_dpp(__builtin_bit_cast(int, x), CTRL, 0xf, 0xf, true)); }
__device__ __forceinline__ float row16_max(float v) { v = fmaxf(v, dppf<0xB1>(v)); v = fmaxf(v, dppf<0x4E>(v)); v = fmaxf(v, dppf<0x141>(v)); return fmaxf(v, dppf<0x140>(v)); }
__device__ __forceinline__ float xrow16_max(float x) {
    auto s = __builtin_amdgcn_permlane16_swap(__float_as_uint(x), __float_as_uint(x), false, false); x = fmaxf(__uint_as_float(s[0]), __uint_as_float(s[1]));
    auto t = __builtin_amdgcn_permlane32_swap(__float_as_uint(x), __float_as_uint(x), false, false); return fmaxf(__uint_as_float(t[0]), __uint_as_float(t[1])); }
__device__ __forceinline__ float xrow16_sum(float x) {
    auto s = __builtin_amdgcn_permlane16_swap(__float_as_uint(x), __float_as_uint(x), false, false); x = __uint_as_float(s[0]) + __uint_as_float(s[1]);
    auto t = __builtin_amdgcn_permlane32_swap(__float_as_uint(x), __float_as_uint(x), false, false); return __uint_as_float(t[0]) + __uint_as_float(t[1]); }
__device__ __forceinline__ u32x4 pack8(const f32x4& v0, const f32x4& v1) { u32x4 w; w.x = cvt_pk_bf16(v0[0], v0[1]); w.y = cvt_pk_bf16(v0[2], v0[3]); w.z = cvt_pk_bf16(v1[0], v1[1]); w.w = cvt_pk_bf16(v1[2], v1[3]); return w; }
struct EpiProj {
    static constexpr bool PERM = true, AFTER_DRAIN = false;
    const float* rstd_g; bf16_t *CB, *U, *Q, *K, *V, *SGC, *SGA; float qscale; unsigned* KMAX; PG8_LAS float* rl;
    __device__ __forceinline__ void prefetch(const Unit& u, PG8_LAS unsigned char* lds, int wid) const {
        if (wid == 0) { int ln; asm volatile("v_mbcnt_lo_u32_b32 %0, -1, 0\n\tv_mbcnt_hi_u32_b32 %0, -1, %0" : "=v"(ln));
            __builtin_amdgcn_global_load_lds((const unsigned*)(rstd_g + u.pm * BM + ln * 4), (PG8_LAS unsigned*)rl, 16, 0, 0); }
    }
    __device__ __forceinline__ void operator()(const f32x4 (&acc)[2][2][4][2], const Unit& u, int wr, int wc, int fr0, int fq) const {
        int fr = fr0; asm volatile("" : "+v"(fr));
        const int row0 = u.pm * BM + wr * 64 + fr, pn = u.pn, colw = wc * 32 + 8 * fq;
        const PG8_LAS float* rstd = rl - u.pm * BM;
        if (pn >= 4 && pn < 12) {
            const int col = 128 * (pn - 4) + colw;
#pragma unroll
            for (int ai = 0; ai < 2; ++ai)
#pragma unroll
                for (int m = 0; m < 4; ++m) { const int row = row0 + ai * HALF + m * 16; const float rs = rstd[row], r2 = rs * rs;
                    const f32x4 v0 = acc[ai][0][m][0] * acc[ai][1][m][0] * r2, v1 = acc[ai][0][m][1] * acc[ai][1][m][1] * r2;
                    *(u32x4*)(U + (size_t)row * 1024 + col) = pack8(v0, v1); }
            return;
        }
        bf16_t* base; int cbase; float sc = 1.f; bool gate = false;
        if (pn < 4) { base = CB; cbase = pn * 256; }
        else if (pn < 16) { base = Q; cbase = (pn - 12) * 256; sc = qscale; }
        else if (pn < 20) { base = K; cbase = (pn - 16) * 256; }
        else if (pn < 24) { base = V; cbase = (pn - 20) * 256; }
        else if (pn < 28) { base = SGC; cbase = (pn - 24) * 256; gate = true; }
        else { base = SGA; cbase = (pn - 28) * 256; gate = true; }
#pragma unroll
        for (int ai = 0; ai < 2; ++ai)
#pragma unroll
            for (int m = 0; m < 4; ++m) { const int row = row0 + ai * HALF + m * 16; const float rs = rstd[row] * sc;
#pragma unroll
                for (int bj = 0; bj < 2; ++bj) { f32x4 v0 = acc[ai][bj][m][0] * rs, v1 = acc[ai][bj][m][1] * rs;
                    if (gate) {
#pragma unroll
                        for (int e = 0; e < 4; ++e) { v0[e] = sigmoidf_(v0[e]); v1[e] = sigmoidf_(v1[e]); } }
                    *(u32x4*)(base + (size_t)row * 1024 + cbase + bj * HALF + colw) = pack8(v0, v1); } }
        if (pn >= 16 && pn < 20) {
            float mx[2] = {0.f, 0.f};
#pragma unroll
            for (int ai = 0; ai < 2; ++ai)
#pragma unroll
                for (int m = 0; m < 4; ++m) { const float rs = rstd[row0 + ai * HALF + m * 16];
#pragma unroll
                    for (int bj = 0; bj < 2; ++bj) { const f32x4 v0 = acc[ai][bj][m][0] * rs, v1 = acc[ai][bj][m][1] * rs;
                        const float s = xrow16_sum(((v0[0] * v0[0] + v0[1] * v0[1]) + (v0[2] * v0[2] + v0[3] * v0[3])) + ((v1[0] * v1[0] + v1[1] * v1[1]) + (v1[2] * v1[2] + v1[3] * v1[3])));
                        mx[bj] = fmaxf(mx[bj], s); } }
#pragma unroll
            for (int bj = 0; bj < 2; ++bj) { float v = mx[bj];
                v = row16_max(v);
                if (fr == 0 && fq == 0) atomicMax(KMAX + (((pn - 16) * 2 + bj) * 2 + (wc >> 1)) * 2 + (wc & 1), __float_as_uint(v)); }
        }
    }
};
struct EpiGateT {
    static constexpr bool PERM = true, AFTER_DRAIN = false;
    const bf16_t* SG; float* T;
    __device__ __forceinline__ void operator()(const f32x4 (&acc)[2][2][4][2], const Unit& u, int wr, int wc, int fr0, int fq) const {
        int fr = fr0; asm volatile("" : "+v"(fr));
        const int row0 = u.pm * BM + wr * 64 + fr, col0 = u.pn * BM + wc * 32 + 8 * fq;
#pragma unroll
        for (int ai = 0; ai < 2; ++ai)
#pragma unroll
            for (int m = 0; m < 4; ++m) { const size_t off = (size_t)(row0 + ai * HALF + m * 16) * 1024 + col0;
#pragma unroll
                for (int bj = 0; bj < 2; ++bj) { const u32x4 g = *(const u32x4*)(SG + off + bj * HALF);
                    f32x4 g0 = {bflo(g.x), bfhi(g.x), bflo(g.y), bfhi(g.y)}, g1 = {bflo(g.z), bfhi(g.z), bflo(g.w), bfhi(g.w)};
                    *(f32x4*)(T + off + bj * HALF) = g0 * acc[ai][bj][m][0]; *(f32x4*)(T + off + bj * HALF + 4) = g1 * acc[ai][bj][m][1]; } }
    }
};
struct EpiMerge {
    static constexpr bool PERM = true, AFTER_DRAIN = false;
    const float* T; const bf16_t* SG; bf16_t* O;
    __device__ __forceinline__ void operator()(const f32x4 (&acc)[2][2][4][2], const Unit& u, int wr, int wc, int fr0, int fq) const {
        int fr = fr0; asm volatile("" : "+v"(fr));
        const int row0 = u.pm * BM + wr * 64 + fr, col0 = u.pn * BM + wc * 32 + 8 * fq;
#pragma unroll
        for (int ai = 0; ai < 2; ++ai)
#pragma unroll
            for (int m = 0; m < 4; ++m) { const size_t off = (size_t)(row0 + ai * HALF + m * 16) * 1024 + col0;
#pragma unroll
                for (int bj = 0; bj < 2; ++bj) { const u32x4 g = *(const u32x4*)(SG + off + bj * HALF);
                    f32x4 g0 = {bflo(g.x), bfhi(g.x), bflo(g.y), bfhi(g.y)}, g1 = {bflo(g.z), bfhi(g.z), bflo(g.w), bfhi(g.w)};
                    const f32x4 t0 = *(const f32x4*)(T + off + bj * HALF), t1 = *(const f32x4*)(T + off + bj * HALF + 4);
                    *(u32x4*)(O + off + bj * HALF) = pack8(t0 + g0 * acc[ai][bj][m][0], t1 + g1 * acc[ai][bj][m][1]); } }
    }
};
struct EpiMergeK {
    static constexpr bool PERM = true, AFTER_DRAIN = false;
    const bf16_t* SGc; const bf16_t* SGa; bf16_t* O;
    __device__ __forceinline__ void mid(f32x4 (&acc)[2][2][4][2], const Unit& u, int wr, int wc, int fr0, int fq) const {
        int fr = fr0; asm volatile("" : "+v"(fr));
        const int row0 = u.pm * BM + wr * 64 + fr, col0 = u.pn * BM + wc * 32 + 8 * fq;
#pragma unroll
        for (int ai = 0; ai < 2; ++ai)
#pragma unroll
            for (int m = 0; m < 4; ++m) { const size_t off = (size_t)(row0 + ai * HALF + m * 16) * 1024 + col0;
#pragma unroll
                for (int bj = 0; bj < 2; ++bj) { const u32x4 c = *(const u32x4*)(SGc + off + bj * HALF), g = *(const u32x4*)(SGa + off + bj * HALF);
                    const f32x4 c0 = {bflo(c.x), bfhi(c.x), bflo(c.y), bfhi(c.y)}, c1 = {bflo(c.z), bfhi(c.z), bflo(c.w), bfhi(c.w)};
                    f32x4 g0 = {bflo(g.x), bfhi(g.x), bflo(g.y), bfhi(g.y)}, g1 = {bflo(g.z), bfhi(g.z), bflo(g.w), bfhi(g.w)};
#pragma unroll
                    for (int e = 0; e < 4; ++e) { g0[e] = c0[e] * __builtin_amdgcn_rcpf(fmaxf(g0[e], 1e-20f)); g1[e] = c1[e] * __builtin_amdgcn_rcpf(fmaxf(g1[e], 1e-20f)); }
                    acc[ai][bj][m][0] *= g0; acc[ai][bj][m][1] *= g1; } }
    }
    __device__ __forceinline__ void operator()(const f32x4 (&acc)[2][2][4][2], const Unit& u, int wr, int wc, int fr0, int fq) const {
        int fr = fr0; asm volatile("" : "+v"(fr));
        const int row0 = u.pm * BM + wr * 64 + fr, col0 = u.pn * BM + wc * 32 + 8 * fq;
#pragma unroll
        for (int ai = 0; ai < 2; ++ai)
#pragma unroll
            for (int m = 0; m < 4; ++m) { const size_t off = (size_t)(row0 + ai * HALF + m * 16) * 1024 + col0;
#pragma unroll
                for (int bj = 0; bj < 2; ++bj) { const u32x4 g = *(const u32x4*)(SGa + off + bj * HALF);
                    f32x4 g0 = {bflo(g.x), bfhi(g.x), bflo(g.y), bfhi(g.y)}, g1 = {bflo(g.z), bfhi(g.z), bflo(g.w), bfhi(g.w)};
#pragma unroll
                    for (int e = 0; e < 4; ++e) { g0[e] = fmaxf(g0[e], 1e-20f); g1[e] = fmaxf(g1[e], 1e-20f); }
                    st16wt(O + off + bj * HALF, pack8(g0 * acc[ai][bj][m][0], g1 * acc[ai][bj][m][1])); } }
    }
};
struct EpiResid {
    static constexpr bool PERM = true, AFTER_DRAIN = false;
    const float* R; bf16_t* XB; float* SS;
    __device__ __forceinline__ void operator()(const f32x4 (&acc)[2][2][4][2], const Unit& u, int wr, int wc, int fr0, int fq) const {
        int fr = fr0; asm volatile("" : "+v"(fr));
        const int row0 = u.pm * BM + wr * 64 + fr, col0 = u.pn * BM + wc * 32 + 8 * fq;
#pragma unroll
        for (int ai = 0; ai < 2; ++ai)
#pragma unroll
            for (int m = 0; m < 4; ++m) { const int row = row0 + ai * HALF + m * 16; const size_t off = (size_t)row * 1024 + col0; float ss = 0.f;
#pragma unroll
                for (int bj = 0; bj < 2; ++bj) {
                    const f32x4 x0 = *(const f32x4*)(R + off + bj * HALF) + acc[ai][bj][m][0], x1 = *(const f32x4*)(R + off + bj * HALF + 4) + acc[ai][bj][m][1];
                    st16wt(XB + off + bj * HALF, pack8(x0, x1));
                    ss += (x0[0] * x0[0] + x0[1] * x0[1]) + (x0[2] * x0[2] + x0[3] * x0[3]) + (x1[0] * x1[0] + x1[1] * x1[1]) + (x1[2] * x1[2] + x1[3] * x1[3]); }
                ss = xrow16_sum(ss);
                if (fq == 0) SS[(size_t)row * 16 + u.pn * 4 + wc] = ss; }
    }
};
struct EpiResidB {
    static constexpr bool PERM = true, AFTER_DRAIN = false;
    bf16_t* XB; float* SS;
    __device__ __forceinline__ void operator()(const f32x4 (&acc)[2][2][4][2], const Unit& u, int wr, int wc, int fr0, int fq) const {
        int fr = fr0; asm volatile("" : "+v"(fr));
        const int row0 = u.pm * BM + wr * 64 + fr, col0 = u.pn * BM + wc * 32 + 8 * fq;
#pragma unroll
        for (int ai = 0; ai < 2; ++ai)
#pragma unroll
            for (int m = 0; m < 4; ++m) { const int row = row0 + ai * HALF + m * 16; const size_t off = (size_t)row * 1024 + col0; float ss = 0.f;
#pragma unroll
                for (int bj = 0; bj < 2; ++bj) { const u32x4 g = *(const u32x4*)(XB + off + bj * HALF);
                    const f32x4 r0 = {bflo(g.x), bfhi(g.x), bflo(g.y), bfhi(g.y)}, r1 = {bflo(g.z), bfhi(g.z), bflo(g.w), bfhi(g.w)};
                    const f32x4 x0 = r0 + acc[ai][bj][m][0], x1 = r1 + acc[ai][bj][m][1];
                    st16wt(XB + off + bj * HALF, pack8(x0, x1));
                    ss += (x0[0] * x0[0] + x0[1] * x0[1]) + (x0[2] * x0[2] + x0[3] * x0[3]) + (x1[0] * x1[0] + x1[1] * x1[1]) + (x1[2] * x1[2] + x1[3] * x1[3]); }
                ss = xrow16_sum(ss);
                if (fq == 0) SS[(size_t)row * 16 + u.pn * 4 + wc] = ss; }
    }
};
struct EpiRowScale {
    static constexpr bool PERM = true, AFTER_DRAIN = false;
    const float* SS; bf16_t* O; int ldc; float sc;
    __device__ __forceinline__ void operator()(const f32x4 (&acc)[2][2][4][2], const Unit& u, int wr, int wc, int fr0, int fq) const {
        int fr = fr0; asm volatile("" : "+v"(fr));
        const int row0 = u.pm * BM + wr * 64 + fr, col0 = u.pn * BM + wc * 32 + 8 * fq;
#pragma unroll
        for (int ai = 0; ai < 2; ++ai)
#pragma unroll
            for (int m = 0; m < 4; ++m) { const int row = row0 + ai * HALF + m * 16;
                const f32x4* sp = (const f32x4*)(SS + (size_t)row * 16); const f32x4 s4 = (sp[0] + sp[1]) + (sp[2] + sp[3]);
                const float rs = sc / sqrtf(((s4[0] + s4[1]) + (s4[2] + s4[3])) * (1.0f / 1024.0f) + 1e-6f);
#pragma unroll
                for (int bj = 0; bj < 2; ++bj) *(u32x4*)(O + (size_t)row * ldc + col0 + bj * HALF) = pack8(acc[ai][bj][m][0] * rs, acc[ai][bj][m][1] * rs); }
    }
};

__device__ __forceinline__ unsigned f2ord(float f) { const unsigned u = __builtin_bit_cast(unsigned, f); return u ^ ((unsigned)((int)u >> 31) | 0x80000000u); }
__device__ __forceinline__ float ord2f(unsigned k) { const unsigned u = (k & 0x80000000u) ? (k ^ 0x80000000u) : ~k; return __builtin_bit_cast(float, u); }
#define PG8_CSWAP(a, b) do { const unsigned hi_ = (a) > (b) ? (a) : (b), lo_ = (a) > (b) ? (b) : (a); (a) = hi_; (b) = lo_; } while (0)
__device__ __forceinline__ void sort16_desc(unsigned (&k)[16]) {
#pragma unroll
    for (int sz = 2; sz <= 16; sz <<= 1)
#pragma unroll
        for (int st = sz >> 1; st > 0; st >>= 1)
#pragma unroll
            for (int i = 0; i < 16; ++i) { const int l = i ^ st; if (l > i) { if ((i & sz) == 0) PG8_CSWAP(k[i], k[l]); else PG8_CSWAP(k[l], k[i]); } }
}
__device__ __forceinline__ void merge16_desc(unsigned (&a)[16], const unsigned (&b)[16]) {
#pragma unroll
    for (int i = 0; i < 16; ++i) a[i] = a[i] > b[15 - i] ? a[i] : b[15 - i];
#pragma unroll
    for (int st = 8; st > 0; st >>= 1)
#pragma unroll
        for (int i = 0; i < 16; ++i) { const int l = i ^ st; if (l > i) PG8_CSWAP(a[i], a[l]); }
}
struct EpiKeys {
    static constexpr bool PERM = true, AFTER_DRAIN = false;
    const float* SS; unsigned* KS;
    __device__ __forceinline__ void operator()(const f32x4 (&acc)[2][2][4][2], const Unit& u, int wr, int wc, int fr0, int fq) const {
        int fr = fr0; asm volatile("" : "+v"(fr));
#pragma unroll
        for (int ai = 0; ai < 2; ++ai)
#pragma unroll
            for (int m = 0; m < 4; ++m) { const int row = ai * HALF + wr * 64 + m * 16 + fr;
                const f32x4* sp = (const f32x4*)(SS + (size_t)(u.pm * BM + row) * 16); const f32x4 s4 = (sp[0] + sp[1]) + (sp[2] + sp[3]);
                const float rs = 1.0f / sqrtf(((s4[0] + s4[1]) + (s4[2] + s4[3])) * (1.0f / 1024.0f) + 1e-6f);
#pragma unroll
                for (int bj = 0; bj < 2; ++bj)
#pragma unroll
                    for (int n = 0; n < 2; ++n) { const int cw = wc * 32 + 8 * fq + 4 * n; u32x4 k;
#pragma unroll
                        for (int e = 0; e < 4; ++e) k[e] = (f2ord(acc[ai][bj][m][n][e] * rs) & ~0x7Fu) | (unsigned)(127 - (cw + e));
                        *(u32x4*)(KS + row * 256 + bj * HALF + cw) = k; } }
    }
};
__device__ __forceinline__ void topk_from_keys(int tid, const unsigned* KS, unsigned* TOPK, int tok0, int h) {
#pragma unroll 1
    for (int ai = 0; ai < 2; ++ai) {
        const int j = tid & 1, rl = (tid >> 1) & 127, c = tid >> 8;
        const unsigned* src = KS + (ai * 128 + rl) * 256 + c * 128 + j * 64;
        unsigned best[16], cur[16];
        { const u32x4 a0 = *(const u32x4*)src, a1 = *(const u32x4*)(src + 4), a2 = *(const u32x4*)(src + 8), a3 = *(const u32x4*)(src + 12);
#pragma unroll
          for (int e = 0; e < 4; ++e) { best[e] = a0[e]; best[4 + e] = a1[e]; best[8 + e] = a2[e]; best[12 + e] = a3[e]; } }
        sort16_desc(best);
#pragma unroll 1
        for (int gq = 1; gq < 4; ++gq) {
            const u32x4 a0 = *(const u32x4*)(src + gq * 16), a1 = *(const u32x4*)(src + gq * 16 + 4), a2 = *(const u32x4*)(src + gq * 16 + 8), a3 = *(const u32x4*)(src + gq * 16 + 12);
#pragma unroll
            for (int e = 0; e < 4; ++e) { cur[e] = a0[e]; cur[4 + e] = a1[e]; cur[8 + e] = a2[e]; cur[12 + e] = a3[e]; }
            sort16_desc(cur); merge16_desc(best, cur); }
#pragma unroll
        for (int i = 0; i < 16; ++i) cur[i] = (unsigned)__shfl_xor((int)best[i], 1);
        merge16_desc(best, cur);
        unsigned* dst = TOPK + ((size_t)(tok0 + ai * 128 + rl) * 8 + h) * 32 + c * 16 + j * 8;
        u32x4 w0, w1;
        if (j == 0) { w0 = (u32x4){best[0], best[1], best[2], best[3]}; w1 = (u32x4){best[4], best[5], best[6], best[7]}; }
        else { w0 = (u32x4){best[8], best[9], best[10], best[11]}; w1 = (u32x4){best[12], best[13], best[14], best[15]}; }
        st16wt(dst, w0); st16wt(dst + 4, w1);
    }
}
struct EpiKeysTopk {
    static constexpr bool PERM = true, AFTER_DRAIN = true;
    const float* SS; unsigned* TOPK;
    __device__ __forceinline__ void fused(f32x4 (&acc)[2][2][4][2], const Unit& u, int wr, int wc, int fr0, int fq, PG8_LAS unsigned char* lds, int wid, int lane) const {
        int fr = fr0; asm volatile("" : "+v"(fr));
        const int tid = wid * 64 + lane;
#pragma unroll
        for (int ai = 0; ai < 2; ++ai) {
#pragma unroll
            for (int m = 0; m < 4; ++m) { const int lr = wr * 64 + m * 16 + fr;
                const f32x4* sp = (const f32x4*)(SS + (size_t)(u.pm * BM + ai * HALF + lr) * 16); const f32x4 s4 = (sp[0] + sp[1]) + (sp[2] + sp[3]);
                const float rs = 1.0f / sqrtf(((s4[0] + s4[1]) + (s4[2] + s4[3])) * (1.0f / 1024.0f) + 1e-6f);
#pragma unroll
                for (int bj = 0; bj < 2; ++bj)
#pragma unroll
                    for (int n = 0; n < 2; ++n) { const int cw = wc * 32 + 8 * fq + 4 * n, col = bj * HALF + cw; u32x4 k;
#pragma unroll
                        for (int e = 0; e < 4; ++e) k[e] = (f2ord(acc[ai][bj][m][n][e] * rs) & ~0x7Fu) | (unsigned)(127 - (cw + e));
                        *(PG8_LAS u32x4*)(lds + lr * 1024 + (((col >> 2) ^ ((2 * lr + ((col >> 6) & 1)) & 15)) << 4)) = k; } }
            asm volatile("s_waitcnt lgkmcnt(0)\n\ts_barrier" ::: "memory");
            { const int j = tid & 1, rl = (tid >> 1) & 127, c = tid >> 8, sw = (2 * rl + j) & 15;
              const PG8_LAS unsigned char* src = lds + rl * 1024 + (2 * c + j) * 256;
              unsigned best[16], cur[16];
              u32x4 kk[16];
#pragma unroll
              for (int q = 0; q < 16; ++q) kk[q] = *(const PG8_LAS u32x4*)(src + ((q ^ sw) << 4));
#pragma unroll
              for (int e = 0; e < 4; ++e) { best[e] = kk[0][e]; best[4 + e] = kk[1][e]; best[8 + e] = kk[2][e]; best[12 + e] = kk[3][e]; }
              sort16_desc(best);
#pragma unroll
              for (int gq = 1; gq < 4; ++gq) {
#pragma unroll
                  for (int e = 0; e < 4; ++e) { cur[e] = kk[4 * gq][e]; cur[4 + e] = kk[4 * gq + 1][e]; cur[8 + e] = kk[4 * gq + 2][e]; cur[12 + e] = kk[4 * gq + 3][e]; }
                  sort16_desc(cur); merge16_desc(best, cur); }
#pragma unroll
              for (int i = 0; i < 16; ++i) cur[i] = (unsigned)__shfl_xor((int)best[i], 1);
              merge16_desc(best, cur);
              unsigned* dst = TOPK + ((size_t)(u.pm * BM + ai * HALF + rl) * 8 + u.pn) * 32 + c * 16 + j * 8;
              u32x4 w0, w1;
              if (j == 0) { w0 = (u32x4){best[0], best[1], best[2], best[3]}; w1 = (u32x4){best[4], best[5], best[6], best[7]}; }
              else { w0 = (u32x4){best[8], best[9], best[10], best[11]}; w1 = (u32x4){best[12], best[13], best[14], best[15]}; }
              st16wt(dst, w0); st16wt(dst + 4, w1); }
            asm volatile("s_waitcnt lgkmcnt(0)\n\ts_barrier" ::: "memory");
        }
    }
};
struct EpiSoftmaxP {
    static constexpr bool PERM = true, AFTER_DRAIN = true;
    bf16_t* P; PG8_LAS float* lrow;
    __device__ __forceinline__ void fused(f32x4 (&acc)[2][2][4][2], const Unit& u, int wr, int wc, int fr0, int fq, PG8_LAS unsigned char* lds, int wid, int lane) const {
        int fr = fr0; asm volatile("" : "+v"(fr));
        PG8_LAS float* MX = (PG8_LAS float*)lds; PG8_LAS float* SM = MX + 1024;
#pragma unroll
        for (int ai = 0; ai < 2; ++ai)
#pragma unroll
            for (int m = 0; m < 4; ++m) { float mx = -INFINITY;
#pragma unroll
                for (int bj = 0; bj < 2; ++bj)
#pragma unroll
                    for (int n = 0; n < 2; ++n)
#pragma unroll
                        for (int e = 0; e < 4; ++e) mx = fmaxf(mx, acc[ai][bj][m][n][e]);
                mx = xrow16_max(mx);
                if (fq == 0) MX[(ai * HALF + wr * 64 + m * 16 + fr) * 4 + wc] = mx; }
        asm volatile("s_waitcnt lgkmcnt(0)\n\ts_barrier" ::: "memory");
#pragma unroll
        for (int ai = 0; ai < 2; ++ai)
#pragma unroll
            for (int m = 0; m < 4; ++m) { const int row = ai * HALF + wr * 64 + m * 16 + fr;
                const f32x4 m4 = *(const PG8_LAS f32x4*)(MX + row * 4); const float rm = fmaxf(fmaxf(m4[0], m4[1]), fmaxf(m4[2], m4[3])); float s = 0.f;
#pragma unroll
                for (int bj = 0; bj < 2; ++bj) { f32x4 p0, p1;
#pragma unroll
                    for (int e = 0; e < 4; ++e) { p0[e] = __builtin_amdgcn_exp2f(acc[ai][bj][m][0][e] - rm); p1[e] = __builtin_amdgcn_exp2f(acc[ai][bj][m][1][e] - rm); }
                    s += ((p0[0] + p0[1]) + (p0[2] + p0[3])) + ((p1[0] + p1[1]) + (p1[2] + p1[3]));
                    *(u32x4*)(P + (size_t)row * 256 + bj * HALF + wc * 32 + 8 * fq) = pack8(p0, p1); }
                s = xrow16_sum(s);
                if (fq == 0) SM[row * 4 + wc] = s; }
        asm volatile("s_waitcnt lgkmcnt(0)\n\ts_barrier" ::: "memory");
        const int tid = wid * 64 + lane;
        if (tid < 256) { const f32x4 s4 = *(const PG8_LAS f32x4*)(SM + tid * 4); lrow[tid] = (s4[0] + s4[1]) + (s4[2] + s4[3]); }
    }
};
struct EpiSoftmaxFull {
    static constexpr bool PERM = true, AFTER_DRAIN = true;
    const float* SS; bf16_t* P; float sc;
    __device__ __forceinline__ void fused(f32x4 (&acc)[2][2][4][2], const Unit& u, int wr, int wc, int fr0, int fq, PG8_LAS unsigned char* lds, int wid, int lane) const {
        int fr = fr0; asm volatile("" : "+v"(fr));
        PG8_LAS float* MX = (PG8_LAS float*)lds; PG8_LAS float* SM = MX + 1024;
#pragma unroll
        for (int ai = 0; ai < 2; ++ai)
#pragma unroll
            for (int m = 0; m < 4; ++m) { const int lr = ai * HALF + wr * 64 + m * 16 + fr, row = u.pm * BM + lr; float mx = -INFINITY;
                const f32x4* sp = (const f32x4*)(SS + (size_t)row * 16); const f32x4 s4 = (sp[0] + sp[1]) + (sp[2] + sp[3]);
                const float rs = sc / sqrtf(((s4[0] + s4[1]) + (s4[2] + s4[3])) * (1.0f / 1024.0f) + 1e-6f);
#pragma unroll
                for (int bj = 0; bj < 2; ++bj)
#pragma unroll
                    for (int n = 0; n < 2; ++n) { acc[ai][bj][m][n] *= rs;
#pragma unroll
                        for (int e = 0; e < 4; ++e) mx = fmaxf(mx, acc[ai][bj][m][n][e]); }
                mx = xrow16_max(mx);
                if (fq == 0) MX[lr * 4 + wc] = mx; }
        asm volatile("s_waitcnt lgkmcnt(0)\n\ts_barrier" ::: "memory");
#pragma unroll
        for (int ai = 0; ai < 2; ++ai)
#pragma unroll
            for (int m = 0; m < 4; ++m) { const int lr = ai * HALF + wr * 64 + m * 16 + fr;
                const f32x4 m4 = *(const PG8_LAS f32x4*)(MX + lr * 4); const float rm = fmaxf(fmaxf(m4[0], m4[1]), fmaxf(m4[2], m4[3])); float s = 0.f;
#pragma unroll
                for (int bj = 0; bj < 2; ++bj)
#pragma unroll
                    for (int n = 0; n < 2; ++n) {
#pragma unroll
                        for (int e = 0; e < 4; ++e) acc[ai][bj][m][n][e] = __builtin_amdgcn_exp2f(acc[ai][bj][m][n][e] - rm);
                        s += (acc[ai][bj][m][n][0] + acc[ai][bj][m][n][1]) + (acc[ai][bj][m][n][2] + acc[ai][bj][m][n][3]); }
                s = xrow16_sum(s);
                if (fq == 0) SM[lr * 4 + wc] = s; }
        asm volatile("s_waitcnt lgkmcnt(0)\n\ts_barrier" ::: "memory");
#pragma unroll
        for (int ai = 0; ai < 2; ++ai)
#pragma unroll
            for (int m = 0; m < 4; ++m) { const int lr = ai * HALF + wr * 64 + m * 16 + fr;
                const f32x4 s4 = *(const PG8_LAS f32x4*)(SM + lr * 4); const float inv = 1.0f / ((s4[0] + s4[1]) + (s4[2] + s4[3]));
#pragma unroll
                for (int bj = 0; bj < 2; ++bj)
                    st16wt(P + (size_t)(u.pm * BM + lr) * 1024 + u.pn * BM + bj * HALF + wc * 32 + 8 * fq, pack8(acc[ai][bj][m][0] * inv, acc[ai][bj][m][1] * inv)); }
    }
};
struct EpiCO {
    static constexpr bool PERM = true, AFTER_DRAIN = false;
    bf16_t* O; const PG8_LAS float* lrow;
    __device__ __forceinline__ void operator()(const f32x4 (&acc)[2][2][4][2], const Unit& u, int wr, int wc, int fr0, int fq) const {
        int fr = fr0; asm volatile("" : "+v"(fr));
#pragma unroll
        for (int ai = 0; ai < 2; ++ai)
#pragma unroll
            for (int m = 0; m < 4; ++m) { const int row = ai * HALF + wr * 64 + m * 16 + fr; const float inv = 1.0f / lrow[row];
#pragma unroll
                for (int bj = 0; bj < 2; ++bj) *(u32x4*)(O + (size_t)row * 1024 + bj * HALF + wc * 32 + 8 * fq) = pack8(acc[ai][bj][m][0] * inv, acc[ai][bj][m][1] * inv); }
    }
};
struct OneUnit {
    int pm, pn;
    __device__ __forceinline__ bool next(int i, Unit& u) const { if (i) return false; u.pm = pm; u.pn = pn; return true; }
    __device__ __forceinline__ void a_ready(const Unit&) const {}
    __device__ __forceinline__ void done(const Unit&) const {}
};
}

__device__ __forceinline__ int win_src_col(int n) {
    if (n < 1024 || n >= 3072) return n;
    const int t = (n - 1024) >> 8, j = (n - 1024) & 255;
    return j < 128 ? 1024 + 128 * t + j : 2048 + 128 * t + (j - 128);
}
__device__ __forceinline__ void p0_prologue(int wv, const Args& a, LAS unsigned char* lds, int blk, int G) {
    const int tid = opaque_tid(wv), lane = tid & 63, wave = tid >> 6;
    unsigned char* ws = a.ws;
    LAS float* tl = (LAS float*)lds;
    {
        f32x4 cur[8], nxt[8]; const float* gcur = nullptr; const float* gnxt = nullptr;
#define P0_DECODE(job, W, ldw, nb, kb, Wt, gain, perm) do { \
            if ((job) < 512) { W = a.in[I_W_IN]; ldw = NCOLS; kb = (job) >> 5; nb = (job) & 31; Wt = (bf16*)(ws + WS_WT_IN); gain = a.in[I_NORM_MIX_G]; perm = true; } \
            else { const int mat = ((job) - 512) >> 6, idx = ((job) - 512) & 63; kb = idx >> 2; nb = idx & 3; ldw = 1024; gain = nullptr; perm = false; \
                if (mat == 0) { W = a.in[I_W_CONV_OUT]; Wt = (bf16*)(ws + WS_WT_CONV); } \
                else if (mat == 1) { W = a.in[I_W_ATTN_OUT]; Wt = (bf16*)(ws + WS_WT_ATTN); } \
                else if (mat == 2) { W = a.in[I_W_MIX_OUT]; Wt = (bf16*)(ws + WS_WT_MIX); } \
                else { W = a.in[I_W_CO]; Wt = (bf16*)(ws + WS_WT_CO); } } } while (0)
#define P0_LOAD(dst, gv, job) do { const float* W; int ldw, nb, kb; bf16* Wt; const float* gain; bool perm; P0_DECODE(job, W, ldw, nb, kb, Wt, gain, perm); (void)Wt; \
            const int k0 = kb * 64, c = tid & 63, nd0 = nb * 256 + 64 * (c >> 4), ns0 = (perm ? win_src_col(nd0) : nd0) + 4 * (c & 15); gv = gain ? gain + k0 : nullptr; \
            _Pragma("unroll") for (int i = 0; i < 8; ++i) dst[i] = *(const f32x4*)(W + (size_t)(k0 + (tid >> 6) + 8 * i) * ldw + ns0); } while (0)
        if (blk < 768) P0_LOAD(cur, gcur, blk);
        for (int job = blk; job < 768; job += G) {
            if (job + G < 768) P0_LOAD(nxt, gnxt, job + G);
#pragma unroll
            for (int i = 0; i < 8; ++i) { const int kk = (tid >> 6) + 8 * i, c = tid & 63; const float gk = gcur ? gcur[kk] : 1.0f; LAS float* d = tl + kk * 257 + 4 * c;
                d[0] = cur[i][0] * gk; d[1] = cur[i][1] * gk; d[2] = cur[i][2] * gk; d[3] = cur[i][3] * gk; }
            __syncthreads();
            { const float* W; int ldw, nb, kb; bf16* Wt; const float* gain; bool perm; P0_DECODE(job, W, ldw, nb, kb, Wt, gain, perm); (void)W; (void)ldw; (void)gain; (void)perm;
#pragma unroll
              for (int r = 0; r < 4; ++r) { const int idx = tid + 512 * r, nn = idx >> 3, kq = idx & 7; const LAS float* s = tl + (kq * 8) * 257 + nn;
                  u32x4 o; o.x = pk2(s[0], s[257]); o.y = pk2(s[2 * 257], s[3 * 257]); o.z = pk2(s[4 * 257], s[5 * 257]); o.w = pk2(s[6 * 257], s[7 * 257]);
                  st16wt(Wt + (size_t)(nb * 256 + nn) * 1024 + kb * 64 + kq * 8, o); } }
            __syncthreads();
#pragma unroll
            for (int i = 0; i < 8; ++i) cur[i] = nxt[i];
            gcur = gnxt;
        }
#undef P0_DECODE
#undef P0_LOAD
    }
    { const float* x = a.in[I_X]; bf16* XB = (bf16*)(ws + WS_A0); float* rstd0 = (float*)(ws + WS_RSTD0);
      f32x4 v[4], w4[4]; int row = blk * 8 + wave;
#define P0_XLOAD(dst, r) do { const f32x4* xr = (const f32x4*)(x + (size_t)(r) * D) + 2 * lane; dst[0] = xr[0]; dst[1] = xr[1]; dst[2] = xr[128]; dst[3] = xr[129]; } while (0)
      if (row < S) P0_XLOAD(v, row);
      for (; row < S; row += G * 8) {
          if (row + G * 8 < S) P0_XLOAD(w4, row + G * 8);
          float s = 0.f;
#pragma unroll
          for (int j = 0; j < 4; ++j) s += (v[j][0] * v[j][0] + v[j][1] * v[j][1]) + (v[j][2] * v[j][2] + v[j][3] * v[j][3]);
          s = wave_sum(s);
          if (lane == 0) rstd0[row] = 1.0f / sqrtf(s * (1.0f / D) + 1e-6f);
          bf16* o = XB + (size_t)row * D + 8 * lane;
#pragma unroll
          for (int j = 0; j < 2; ++j) { u32x4 w; w.x = pk2(v[2 * j][0], v[2 * j][1]); w.y = pk2(v[2 * j][2], v[2 * j][3]); w.z = pk2(v[2 * j + 1][0], v[2 * j + 1][1]); w.w = pk2(v[2 * j + 1][2], v[2 * j + 1][3]);
              st16wt(o + 512 * j, w); }
#pragma unroll
          for (int j = 0; j < 4; ++j) v[j] = w4[j];
      }
#undef P0_XLOAD
    }
    { typedef short bf16x8_t __attribute__((ext_vector_type(8))); typedef float f32x16_t __attribute__((ext_vector_type(16)));
      LAS bf16* mnb = (LAS bf16*)lds;
      LAS float* red = (LAS float*)(lds + 32 * 1032 * 2);
      const float* mem = a.in[I_MEM]; const float* g = a.in[I_NORM_MEM_G]; const float* Wc = a.in[I_W_CKV]; bf16* KC = (bf16*)(ws + WS_KV); bf16* VC = KC + 4 * 256 * 256;
      const int r32 = lane & 31, kg = lane >> 5;
      for (int wb = blk; wb < 256; wb += G) {
          const int m0 = (wb >> 5) * 32, n0 = (wb & 31) * 64;
          __syncthreads();
#pragma unroll
          for (int r = 0; r < 4; ++r) { const int rr = wave * 4 + r; const f32x4* mr = (const f32x4*)(mem + (size_t)(m0 + rr) * D) + lane; f32x4 v[4]; float s = 0.f;
#pragma unroll
              for (int j = 0; j < 4; ++j) { v[j] = mr[64 * j]; s += (v[j][0] * v[j][0] + v[j][1] * v[j][1]) + (v[j][2] * v[j][2] + v[j][3] * v[j][3]); }
              s = wave_sum(s); const float rs = 1.0f / sqrtf(s * (1.0f / D) + 1e-6f);
#pragma unroll
              for (int j = 0; j < 4; ++j) { const f32x4 gg = ((const f32x4*)g)[lane + 64 * j]; const f32x4 y = v[j] * rs * gg; u32x2 w; w.x = pk2(y[0], y[1]); w.y = pk2(y[2], y[3]);
                  *(LAS u32x2*)(mnb + rr * 1032 + 4 * (lane + 64 * j)) = w; } }
          __syncthreads();
          const int it = wave & 1, kq = wave >> 1, ncol = n0 + 32 * it + r32;
          f32x16_t acc;
#pragma unroll
          for (int r = 0; r < 16; ++r) acc[r] = 0.f;
#pragma unroll 1
          for (int half = 0; half < 2; ++half) {
              float wv_[8][8];
#pragma unroll
              for (int s = 0; s < 8; ++s)
#pragma unroll
                  for (int j = 0; j < 8; ++j) wv_[s][j] = Wc[(size_t)(256 * kq + 128 * half + 16 * s + 8 * kg + j) * 2048 + ncol];
#pragma unroll
              for (int s = 0; s < 8; ++s) {
                  u32x4 bw; bw.x = pk2(wv_[s][0], wv_[s][1]); bw.y = pk2(wv_[s][2], wv_[s][3]); bw.z = pk2(wv_[s][4], wv_[s][5]); bw.w = pk2(wv_[s][6], wv_[s][7]);
                  const bf16x8_t af = *(const LAS bf16x8_t*)(mnb + r32 * 1032 + 256 * kq + 128 * half + 16 * s + 8 * kg);
                  acc = __builtin_amdgcn_mfma_f32_32x32x16_bf16(af, __builtin_bit_cast(bf16x8_t, bw), acc, 0, 0, 0); }
          }
#pragma unroll
          for (int r = 0; r < 16; ++r) red[((it * 4 + kq) * 16 + r) * 64 + lane] = acc[r];
          __syncthreads();
          if (kq == 0) {
#pragma unroll
              for (int r = 0; r < 16; ++r) acc[r] = (red[((it * 4 + 0) * 16 + r) * 64 + lane] + red[((it * 4 + 1) * 16 + r) * 64 + lane]) + (red[((it * 4 + 2) * 16 + r) * 64 + lane] + red[((it * 4 + 3) * 16 + r) * 64 + lane]);
              if (ncol < 1024) {
#pragma unroll
                  for (int r = 0; r < 16; ++r) KC[((size_t)(ncol >> 8) * 256 + (m0 + (r & 3) + 8 * (r >> 2) + 4 * kg)) * 256 + (ncol & 255)] = (bf16)f2bf(acc[r]);
              } else {
#pragma unroll
                  for (int r = 0; r < 16; ++r) VC[((size_t)((ncol - 1024) >> 8) * 256 + (m0 + (r & 3) + 8 * (r >> 2) + 4 * kg)) * 256 + (ncol & 255)] = (bf16)f2bf(acc[r]);
              }
          }
      }
      __syncthreads(); }
    { typedef short bf16x8_t __attribute__((ext_vector_type(8))); typedef float f32x16_t __attribute__((ext_vector_type(16)));
      const float* sk = a.in[I_SUB_KEYS]; const float* wpq = a.in[I_W_PQ]; const float* gf = a.in[I_NORM_FFN_G]; bf16* WT = (bf16*)(ws + WS_WT_PQ);
      const int r32 = lane & 31, kg = lane >> 5;
      for (int item = blk * 8 + wave; item < 2048; item += G * 8) {
          const int hc = item >> 7, h = hc >> 1, c = hc & 1, kt = (item >> 2) & 31, nt = item & 3;
          const float* ap = wpq + (size_t)(kt * 32 + r32) * 2048 + hc * 128 + 8 * kg;
          const float* bp = sk + ((size_t)((c * 8 + h) * 128 + nt * 32 + r32)) * 128 + 8 * kg;
          const float gk = gf[kt * 32 + r32];
          f32x4 av[8][2], bv[8][2];
#pragma unroll
          for (int s = 0; s < 8; ++s) { av[s][0] = *(const f32x4*)(ap + 16 * s); av[s][1] = *(const f32x4*)(ap + 16 * s + 4); bv[s][0] = *(const f32x4*)(bp + 16 * s); bv[s][1] = *(const f32x4*)(bp + 16 * s + 4); }
          f32x16_t acc;
#pragma unroll
          for (int r = 0; r < 16; ++r) acc[r] = 0.f;
#pragma unroll
          for (int s = 0; s < 8; ++s) {
              const f32x4 a0 = av[s][0] * gk, a1 = av[s][1] * gk;
              u32x4 aw, bw; aw.x = pk2(a0[0], a0[1]); aw.y = pk2(a0[2], a0[3]); aw.z = pk2(a1[0], a1[1]); aw.w = pk2(a1[2], a1[3]);
              bw.x = pk2(bv[s][0][0], bv[s][0][1]); bw.y = pk2(bv[s][0][2], bv[s][0][3]); bw.z = pk2(bv[s][1][0], bv[s][1][1]); bw.w = pk2(bv[s][1][2], bv[s][1][3]);
              acc = __builtin_amdgcn_mfma_f32_32x32x16_bf16(__builtin_bit_cast(bf16x8_t, aw), __builtin_bit_cast(bf16x8_t, bw), acc, 0, 0, 0); }
          bf16* dst = WT + (size_t)(hc * 128 + nt * 32 + r32) * 1024 + kt * 32 + 4 * kg;
#pragma unroll
          for (int q = 0; q < 4; ++q) { u32x2 w; w.x = pk2(acc[4 * q], acc[4 * q + 1]); w.y = pk2(acc[4 * q + 2], acc[4 * q + 3]); *(u32x2*)(dst + 8 * q) = w; }
      } }
    if (blk == 0) { float* BT = (float*)(ws + WS_BTAB); const float* rb = a.in[I_REL_BIAS];
        for (int i = tid; i < 8 * 132; i += 512) { const int h = i / 132, j = i - h * 132; float v = 0.f;
            if (j < 129) { const int b = j < 128 ? (int)T5_BUCKET[j] : 31; v = (rb[b * 8 + h] - rb[31 * 8 + h]) * 1.4426950408889634f; }
            else if (j == 129) { float m = -INFINITY; for (int b = 0; b < 32; ++b) m = fmaxf(m, rb[b * 8 + h] * 1.4426950408889634f); v = m; }
            else if (j == 130) v = rb[31 * 8 + h] * 1.4426950408889634f;
            BT[i] = v; }
        if (tid == 0) { float s1 = 0.f, s2 = 0.f;
            for (int i = 0; i < 64; ++i) { s1 += a.in[I_LQ1][i] * a.in[I_LK1][i]; s2 += a.in[I_LQ2][i] * a.in[I_LK2][i]; }
            BT[8 * 132] = expf(s1) - expf(s2) + 0.2f; } }
}

__device__ __forceinline__ void cross_fold(int wv, const Args& a, int blk, int G) {
    typedef short bf16x8_t __attribute__((ext_vector_type(8))); typedef float f32x16_t __attribute__((ext_vector_type(16)));
    const int tid = opaque_tid(wv), lane = tid & 63, wave = tid >> 6, r32 = lane & 31, kg = lane >> 5;
    const bf16* KC = (const bf16*)(a.ws + WS_KV); const bf16* VC = KC + 4 * 256 * 256;
    for (int item = blk * 8 + wave; item < 2048; item += G * 8) {
        f32x16_t acc;
#pragma unroll
        for (int r = 0; r < 16; ++r) acc[r] = 0.f;
        bf16* dst;
        if (item < 1024) {
            const int h = item >> 8, kt = (item >> 3) & 31, mt = item & 7;
            const float* ap = a.in[I_W_CQ] + (size_t)(kt * 32 + r32) * 1024 + h * 256 + 8 * kg;
            const bf16* bp = KC + ((size_t)h * 256 + mt * 32 + r32) * 256 + 8 * kg;
            const float gk = a.in[I_NORM_CROSS_G][kt * 32 + r32];
#pragma unroll 1
            for (int half = 0; half < 2; ++half) {
                f32x4 av[8][2]; u32x4 bv[8];
#pragma unroll
                for (int s = 0; s < 8; ++s) { av[s][0] = *(const f32x4*)(ap + 128 * half + 16 * s); av[s][1] = *(const f32x4*)(ap + 128 * half + 16 * s + 4); bv[s] = *(const u32x4*)(bp + 128 * half + 16 * s); }
#pragma unroll
                for (int s = 0; s < 8; ++s) { const f32x4 a0 = av[s][0] * gk, a1 = av[s][1] * gk;
                    u32x4 aw; aw.x = pk2(a0[0], a0[1]); aw.y = pk2(a0[2], a0[3]); aw.z = pk2(a1[0], a1[1]); aw.w = pk2(a1[2], a1[3]);
                    acc = __builtin_amdgcn_mfma_f32_32x32x16_bf16(__builtin_bit_cast(bf16x8_t, aw), __builtin_bit_cast(bf16x8_t, bv[s]), acc, 0, 0, 0); }
            }
            dst = (bf16*)(a.ws + WS_WQK) + (size_t)(h * 256 + mt * 32 + r32) * 1024 + kt * 32 + 4 * kg;
        } else {
            const int it = item - 1024, h = it >> 8, mt = (it >> 5) & 7, nt = it & 31;
            const bf16* ap = VC + ((size_t)h * 256 + mt * 32 + r32) * 256 + 8 * kg;
            const bf16* bp = (const bf16*)(a.ws + WS_WT_CO) + (size_t)(nt * 32 + r32) * 1024 + h * 256 + 8 * kg;
            u32x4 av[16], bv[16];
#pragma unroll
            for (int s = 0; s < 16; ++s) { av[s] = *(const u32x4*)(ap + 16 * s); bv[s] = *(const u32x4*)(bp + 16 * s); }
#pragma unroll
            for (int s = 0; s < 16; ++s) acc = __builtin_amdgcn_mfma_f32_32x32x16_bf16(__builtin_bit_cast(bf16x8_t, av[s]), __builtin_bit_cast(bf16x8_t, bv[s]), acc, 0, 0, 0);
            dst = (bf16*)(a.ws + WS_VW) + (size_t)(nt * 32 + r32) * 1024 + h * 256 + mt * 32 + 4 * kg;
        }
#pragma unroll
        for (int q = 0; q < 4; ++q) { u32x2 w; w.x = pk2(acc[4 * q], acc[4 * q + 1]); w.y = pk2(acc[4 * q + 2], acc[4 * q + 3]); *(u32x2*)(dst + 8 * q) = w; }
    }
}

__device__ __forceinline__ void conv_phase(int wv, const Args& a, int blk, int G) {
    bf16* CB = (bf16*)(a.ws + WS_A1); const bf16* U = (const bf16*)(a.ws + WS_A2); const float* cw = a.in[I_CONV_W];
    const int tid = opaque_tid(wv);
    const int c = (tid & 127) * 8;
    float w0[8], w1[8], w2[8];
#pragma unroll
    for (int e = 0; e < 8; ++e) { w0[e] = cw[c + e]; w1[e] = cw[D + c + e]; w2[e] = cw[2 * D + c + e]; }
    const size_t step = (size_t)G * 512, total = (size_t)S * D / 8;
    for (size_t i0 = (size_t)blk * 512 + tid; i0 < total; i0 += 4 * step) {
        u32x4 cb[4], u2[4], u1[4], u0[4];
#pragma unroll
        for (int q = 0; q < 4; ++q) { const size_t i = i0 + q * step; const int r = (int)(i >> 7);
            cb[q] = u2[q] = u1[q] = u0[q] = (u32x4){0, 0, 0, 0};
            if (i < total) { cb[q] = *(const u32x4*)(CB + i * 8); u2[q] = *(const u32x4*)(U + i * 8);
                if (r >= 1) u1[q] = *(const u32x4*)(U + i * 8 - D);
                if (r >= 2) u0[q] = *(const u32x4*)(U + i * 8 - 2 * D); } }
#pragma unroll
        for (int q = 0; q < 4; ++q) { const size_t i = i0 + q * step;
            u32x4 o;
#pragma unroll
            for (int e = 0; e < 4; ++e) {
                const float lo = bflo(cb[q][e]) * (w0[2 * e] * bflo(u0[q][e]) + w1[2 * e] * bflo(u1[q][e]) + w2[2 * e] * bflo(u2[q][e]));
                const float hi = bfhi(cb[q][e]) * (w0[2 * e + 1] * bfhi(u0[q][e]) + w1[2 * e + 1] * bfhi(u1[q][e]) + w2[2 * e + 1] * bfhi(u2[q][e]));
                o[e] = pk2(lo, hi);
            }
            if (i < total) st16wt(CB + i * 8, o); }
    }
}


namespace att {
typedef short bf16x8 __attribute__((ext_vector_type(8)));
typedef short s16x4 __attribute__((ext_vector_type(4)));
typedef float f32x16 __attribute__((ext_vector_type(16)));
typedef short v4i16_t __attribute__((ext_vector_type(4)));
typedef LAS const char* lds_cptr;
constexpr int SLOT = 16384, LDS_K = 0, LDS_V = 4 * SLOT, LDS_WSF = 8 * SLOT, LDS_BT = LDS_WSF + 2048, LDS_TOTAL = LDS_BT + 1024;
constexpr int LDS_XCH = 0, LDS_OST = 65536;
constexpr float LOG2E = 1.4426950408889634f, THR = 8.0f;
__device__ __forceinline__ int crow(int r, int hi) { return (r & 3) + 8 * (r >> 2) + 4 * hi; }
typedef float f32x2_t __attribute__((ext_vector_type(2))); typedef __bf16 bf16x2_t __attribute__((ext_vector_type(2)));
__device__ __forceinline__ unsigned cvtpk(float lo, float hi) { const f32x2_t v = {lo, hi}; const bf16x2_t b = __builtin_convertvector(v, bf16x2_t); return __builtin_bit_cast(unsigned, b); }
__device__ __forceinline__ void glds16(const void* g, unsigned lds_base) {
    unsigned sv; asm volatile("s_mov_b32 %0, m0\n\ts_mov_b32 m0, %2\n\ts_nop 0\n\tglobal_load_lds_dwordx4 %1, off\n\ts_mov_b32 m0, %0" : "=&s"(sv) : "v"(g), "s"(lds_base) : "memory"); }
template <int IMM> __device__ __forceinline__ void glds16s(unsigned voff, const void* sbase, unsigned lds_base) {
    unsigned sv; asm volatile("s_mov_b32 %0, m0\n\ts_mov_b32 m0, %3\n\ts_nop 0\n\tglobal_load_lds_dwordx4 %1, %2 offset:%c4\n\ts_mov_b32 m0, %0" : "=&s"(sv) : "v"(voff), "s"(sbase), "s"(lds_base), "i"(IMM) : "memory"); }
__device__ __forceinline__ s16x4 vtr(lds_cptr p) { return __builtin_bit_cast(s16x4, __builtin_amdgcn_ds_read_tr16_b64_v4i16((LAS v4i16_t*)p)); }
#define ATT_MX3(a, b, c) __builtin_fmaxf(__builtin_fmaxf((a), (b)), (c))
__device__ __forceinline__ float rowmax(const f32x16& p0, const f32x16& p1) {
    float a = ATT_MX3(p0[0], p0[1], p1[0]), b = ATT_MX3(p0[2], p0[3], p1[1]); a = ATT_MX3(a, p1[2], p1[3]);
#pragma unroll
    for (int r = 4; r < 16; r += 4) { a = ATT_MX3(a, p0[r], p0[r + 1]); b = ATT_MX3(b, p0[r + 2], p0[r + 3]); a = ATT_MX3(a, p1[r], p1[r + 1]); b = ATT_MX3(b, p1[r + 2], p1[r + 3]); }
    float m = __builtin_fmaxf(a, b); auto rr = __builtin_amdgcn_permlane32_swap(__float_as_uint(m), __float_as_uint(m), false, false);
    return __builtin_fmaxf(__uint_as_float(rr[0]), __uint_as_float(rr[1])); }
#define ATT_WAIT_BAR(N) asm volatile("s_waitcnt vmcnt(" #N ") lgkmcnt(0)\n\ts_barrier" ::: "memory")
#define ATT_LBAR() asm volatile("s_waitcnt lgkmcnt(0)\n\ts_barrier" ::: "memory")
#define ATT_MFMA(a, b, c) __builtin_amdgcn_mfma_f32_32x32x16_bf16(a, b, c, 0, 0, 0)

__device__ __forceinline__ void attn_unit_pipe(int wv, int h, int qb, const bf16* Q, const bf16* __restrict__ K, const bf16* __restrict__ V, bf16* O, LAS unsigned char* lds,
                                               float lam, const float* BTAB, const float* subln_g, const unsigned* KMAX) {
    const int tid = opaque_tid(wv), lane = tid & 63, r32 = lane & 31, hi = lane >> 5;
    const int wid = __builtin_amdgcn_readfirstlane(tid >> 6), comp = wid >> 2, rg = wid & 3;
    const int q0 = qb * 128, qw0 = q0 + 32 * rg, NT = 2 * qb + 2;
    const unsigned lds0 = (unsigned)(unsigned long long)lds;
    LAS float* wsf = (LAS float*)(lds + LDS_WSF) + wid * 64;
    LAS float* bt = (LAS float*)(lds + LDS_BT);
    const unsigned kvoff = (unsigned)lane * 2048u + (unsigned)wid * 16u;
    const unsigned vvoff = (unsigned)(16 * (wid & 3) + (lane >> 2)) * 2048u + (unsigned)((wid >> 2) * 32 + (lane & 3) * 8) * 2u;
    const char* kbase = (const char*)(K + h * 128); const char* vbase = (const char*)(V + h * 128);
    const unsigned kdst = lds0 + LDS_K + wid * 1024, vdst = lds0 + LDS_V + wid * 1024;
#define ATT_RFL(x) ((unsigned)__builtin_amdgcn_readfirstlane((int)(x)))
#define DMA_K(t, so) do { const char* b_ = kbase + (size_t)(t) * 131072; glds16s<0>(kvoff, b_, ATT_RFL(kdst + (so))); glds16s<128>(kvoff, b_, ATT_RFL(kdst + (so) + 8192 - 128)); } while (0)
#define DMA_V(t, so) do { const char* b_ = vbase + (size_t)(t) * 131072; glds16s<0>(vvoff, b_, ATT_RFL(vdst + (so))); glds16s<128>(vvoff, b_, ATT_RFL(vdst + (so) + 8192 - 128)); } while (0)
    DMA_K(0, 0); DMA_K(1, SLOT); DMA_V(0, 0); if (NT > 2) DMA_K(2, 2 * SLOT);
    const float* bth = BTAB + h * 132;
    bf16x8 qr[4];
    float cfar;
    { const bf16* Qw = Q + (size_t)(qw0 + r32) * 1024 + h * 128 + comp * 64 + hi * 8;
#pragma unroll
      for (int d0 = 0; d0 < 4; ++d0) qr[d0] = *(const bf16x8*)(Qw + d0 * 16);
      float btv = 0.f; if (tid < 129) btv = bth[tid];
      const float bmax = bth[129], bfar = bth[130];
      const float kmx = sqrtf(__uint_as_float(KMAX[(h * 2 + comp) * 2]) + __uint_as_float(KMAX[(h * 2 + comp) * 2 + 1])) * 1.02f;
      if (tid < 129) bt[tid] = btv;
      float s = 0.f;
#pragma unroll
      for (int d0 = 0; d0 < 4; ++d0)
#pragma unroll
          for (int e2 = 0; e2 < 8; ++e2) { const float f = __builtin_bit_cast(float, (unsigned)(unsigned short)qr[d0][e2] << 16); s += f * f; }
      auto rr = __builtin_amdgcn_permlane32_swap(__float_as_uint(s), __float_as_uint(s), false, false); s = __uint_as_float(rr[0]) + __uint_as_float(rr[1]);
      cfar = bfar - (sqrtf(s) * 1.01f * kmx + bmax); }
    f32x16 cf;
#pragma unroll
    for (int r = 0; r < 16; ++r) cf[r] = cfar;
    asm volatile("" : "+v"(cf));
    const lds_cptr kp0 = (lds_cptr)(lds + LDS_K) + comp * 8192 + hi * 1024 + r32 * 16;
    const lds_cptr vp0 = (lds_cptr)(lds + LDS_V) + ((lane >> 4) & 1) * 32 + (lane & 3) * 8 + (4 * hi + ((lane & 15) >> 2)) * 64;
    float l_reg = 0.f;
    f32x16 o[4];
#pragma unroll
    for (int d0 = 0; d0 < 4; ++d0)
#pragma unroll
        for (int r = 0; r < 16; ++r) o[d0][r] = 0.f;
    bf16x8 kf[8];
    f32x16 pA0, pA1, pB0, pB1;
    u32x4 pw0, pw1, pw2, pw3;
    s16x4 vl0, vh0, vl1, vh1;
#define SBAR() __builtin_amdgcn_sched_barrier(0)
#define PIN(x) asm volatile("" : "+v"(x))
#define PKW(P, B) cvtpk(P[B], P[B + 1])
#define PAF(k) __builtin_bit_cast(bf16x8, pw##k)
#define EX(v) __builtin_amdgcn_exp2f(v)
#define ROT3() do { const int t_ = s0; s0 = s1; s1 = s2; s2 = t_; } while (0)
#define ENDW(t) do { if ((t) + 3 < NT) { ATT_WAIT_BAR(4); } else if ((t) + 1 < NT) { ATT_WAIT_BAR(2); } else { ATT_WAIT_BAR(0); } } while (0)
#define KLD(f, kp_) kf[f] = *(LAS const bf16x8*)((kp_) + ((f) >> 1) * 2048 + ((f) & 1) * 512)
#define BANDFIX(C0, C1, t) do { if (__builtin_expect(64 * (t) + 63 + 128 > qw0, 0)) { const int ln_ = opaque_tid(0);   \
        const int dq = qw0 + (ln_ & 31) - 64 * (t) - 4 * (ln_ >> 5); \
        _Pragma("unroll") for (int r = 0; r < 16; ++r) { const int d0_ = dq - ((r & 3) + 8 * (r >> 2)), d1_ = d0_ - 32; \
            const float b0 = bt[min(max(d0_, 0), 128)], b1 = bt[min(max(d1_, 0), 128)]; \
            C0[r] = d0_ < 0 ? -INFINITY : C0[r] + b0; C1[r] = d1_ < 0 ? -INFINITY : C1[r] + b1; } } } while (0)
#define VRD(j, i, vp_) do { vl##j = vtr((vp_) + ((i) & 3) * 4096 + ((i) >> 2) * 1024); vh##j = vtr((vp_) + ((i) & 3) * 4096 + ((i) >> 2) * 1024 + 512); } while (0)
#define VFR(j) (bf16x8){vl##j[0], vl##j[1], vl##j[2], vl##j[3], vh##j[0], vh##j[1], vh##j[2], vh##j[3]}
#define GAPA(MF, A0, A1, A2, A3, W0, W1, PWX) do { MF; sacc += A0; sacc += A1; sacc += A2; sacc += A3; PIN(sacc); W0; W1; PIN(PWX); SBAR(); } while (0)
#define PHASE_A(C0, C1, P0, P1, vp_) do { float sacc = P0[0] + P0[1]; \
        GAPA(C0 = ATT_MFMA(kf[0], qr[0], cf), P0[2], P0[3], P0[4], P0[5],     pw0[0] = PKW(P0, 0), pw0[1] = PKW(P0, 2), pw0); \
        GAPA(C1 = ATT_MFMA(kf[1], qr[0], cf), P0[6], P0[7], P0[8], P0[9],     pw0[2] = PKW(P0, 4), pw0[3] = PKW(P0, 6), pw0); \
        GAPA(C0 = ATT_MFMA(kf[2], qr[1], C0), P0[10], P0[11], P0[12], P0[13], pw1[0] = PKW(P0, 8), pw1[1] = PKW(P0, 10), pw1); \
        GAPA(C1 = ATT_MFMA(kf[3], qr[1], C1), P0[14], P0[15], P1[0], P1[1],   pw1[2] = PKW(P0, 12), pw1[3] = PKW(P0, 14), pw1); \
        GAPA(C0 = ATT_MFMA(kf[4], qr[2], C0), P1[2], P1[3], P1[4], P1[5],     pw2[0] = PKW(P1, 0), pw2[1] = PKW(P1, 2), pw2); \
        GAPA(C1 = ATT_MFMA(kf[5], qr[2], C1), P1[6], P1[7], P1[8], P1[9],     pw2[2] = PKW(P1, 4), pw2[3] = PKW(P1, 6), pw2); \
        GAPA(C0 = ATT_MFMA(kf[6], qr[3], C0), P1[10], P1[11], P1[12], P1[13], pw3[0] = PKW(P1, 8), pw3[1] = PKW(P1, 10), pw3); \
        VRD(0, 0, vp_); SBAR(); \
        GAPA(C1 = ATT_MFMA(kf[7], qr[3], C1), P1[14], P1[15], 0.f, 0.f,       pw3[2] = PKW(P1, 12), pw3[3] = PKW(P1, 14), pw3); \
        l_reg += sacc; } while (0)
#define GAPB(i, j, jn, X, XB, DOEX, GL, vp_, kp_, N0, N1, DOSP) do { if ((i) + 1 < 16) { VRD(jn, (i) + 1, vp_); } \
        if ((GL) && ((i) & 1)) { KLD((i) >> 1, kp_); } SBAR(); \
        o[(i) & 3] = ATT_MFMA(PAF_SEL((i) >> 2), VFR(j), o[(i) & 3]); \
        if (DOEX) { X[XB] = EX(X[XB]); X[XB + 1] = EX(X[XB + 1]); PIN(X); } \
        SBAR(); } while (0)
#define PAF_SEL(k) ((k) == 0 ? PAF(0) : (k) == 1 ? PAF(1) : (k) == 2 ? PAF(2) : PAF(3))
#define PHASE_B(C0, C1, DOEX, GL, vp_, kp_, N0, N1, DOSP) do { \
        GAPB(0, 0, 1, C0, 0, DOEX, GL, vp_, kp_, N0, N1, DOSP); GAPB(1, 1, 0, C0, 2, DOEX, GL, vp_, kp_, N0, N1, DOSP); GAPB(2, 0, 1, C0, 4, DOEX, GL, vp_, kp_, N0, N1, DOSP); GAPB(3, 1, 0, C0, 6, DOEX, GL, vp_, kp_, N0, N1, DOSP); \
        GAPB(4, 0, 1, C0, 8, DOEX, GL, vp_, kp_, N0, N1, DOSP); GAPB(5, 1, 0, C0, 10, DOEX, GL, vp_, kp_, N0, N1, DOSP); GAPB(6, 0, 1, C0, 12, DOEX, GL, vp_, kp_, N0, N1, DOSP); GAPB(7, 1, 0, C0, 14, DOEX, GL, vp_, kp_, N0, N1, DOSP); \
        GAPB(8, 0, 1, C1, 0, DOEX, GL, vp_, kp_, N0, N1, DOSP); GAPB(9, 1, 0, C1, 2, DOEX, GL, vp_, kp_, N0, N1, DOSP); GAPB(10, 0, 1, C1, 4, DOEX, GL, vp_, kp_, N0, N1, DOSP); GAPB(11, 1, 0, C1, 6, DOEX, GL, vp_, kp_, N0, N1, DOSP); \
        GAPB(12, 0, 1, C1, 8, DOEX, GL, vp_, kp_, N0, N1, DOSP); GAPB(13, 1, 0, C1, 10, DOEX, GL, vp_, kp_, N0, N1, DOSP); GAPB(14, 0, 1, C1, 12, DOEX, GL, vp_, kp_, N0, N1, DOSP); GAPB(15, 1, 0, C1, 14, DOEX, GL, vp_, kp_, N0, N1, DOSP); \
        } while (0)
#define KSL(t) ((((t) & 3)) * SLOT)
#define DMA_GROUP(t) do { if ((t) + 3 < NT) DMA_K((t) + 3, KSL((t) + 3)); if ((t) + 1 < NT) DMA_V((t) + 1, KSL((t) + 1)); } while (0)
#define STEP(C0, C1, P0, P1, t) do { const lds_cptr vpp = vp0 + KSL((t) - 1); const lds_cptr kpn = kp0 + KSL((t) + 1); \
        PHASE_A(C0, C1, P0, P1, vpp); \
        BANDFIX(C0, C1, t); \
        if (comp == 0) { DMA_GROUP(t); } else { ENDW(t); } \
        SBAR(); \
        PHASE_B(C0, C1, true, true, vpp, kpn, P0, P1, true); PIN(P0); PIN(P1); \
        if (comp == 0) { ENDW(t); } else { DMA_GROUP((t) + 1); } } while (0)
#define PACKSUM(P0, P1) do { float sacc = 0.f; _Pragma("unroll") for (int r = 0; r < 16; ++r) sacc += P0[r] + P1[r]; l_reg += sacc; \
        pw0 = (u32x4){PKW(P0, 0), PKW(P0, 2), PKW(P0, 4), PKW(P0, 6)}; pw1 = (u32x4){PKW(P0, 8), PKW(P0, 10), PKW(P0, 12), PKW(P0, 14)}; \
        pw2 = (u32x4){PKW(P1, 0), PKW(P1, 2), PKW(P1, 4), PKW(P1, 6)}; pw3 = (u32x4){PKW(P1, 8), PKW(P1, 10), PKW(P1, 12), PKW(P1, 14)}; } while (0)

    if (NT > 2) { ATT_WAIT_BAR(4); } else { ATT_WAIT_BAR(2); }
    if (comp != 0) { DMA_GROUP(0); }
    {
#pragma unroll
      for (int f = 0; f < 8; ++f) KLD(f, kp0);
      pA0 = ATT_MFMA(kf[0], qr[0], cf); pA1 = ATT_MFMA(kf[1], qr[0], cf);
#pragma unroll
      for (int d0 = 1; d0 < 4; ++d0) { pA0 = ATT_MFMA(kf[2 * d0], qr[d0], pA0); pA1 = ATT_MFMA(kf[2 * d0 + 1], qr[d0], pA1); } }
    SBAR();
    BANDFIX(pA0, pA1, 0);
    if (comp == 0) { DMA_GROUP(0); } else { ENDW(0); }
    {
#pragma unroll
        for (int r = 0; r < 16; ++r) { pA0[r] = EX(pA0[r]); pA1[r] = EX(pA1[r]); }
#pragma unroll
        for (int f = 0; f < 8; ++f) KLD(f, kp0 + KSL(1));
    }
    if (comp == 0) { ENDW(0); } else { DMA_GROUP(1); }
    {
        int t = 1;
        for (; t + 2 < NT; t += 2) { STEP(pB0, pB1, pA0, pA1, t); STEP(pA0, pA1, pB0, pB1, t + 1); }
        STEP(pB0, pB1, pA0, pA1, t);
        PACKSUM(pB0, pB1);
        VRD(0, 0, vp0 + KSL(NT - 1)); SBAR();
        PHASE_B(pA0, pA1, false, false, vp0 + KSL(NT - 1), kp0, pA0, pA1, false);
    }
    float l = l_reg;
    { auto rr = __builtin_amdgcn_permlane32_swap(__float_as_uint(l), __float_as_uint(l), false, false); l = __uint_as_float(rr[0]) + __uint_as_float(rr[1]); }
    if (hi == 0) wsf[32 + r32] = l;
    float rli[16];
#pragma unroll
    for (int r = 0; r < 16; ++r) rli[r] = __builtin_amdgcn_rcpf(wsf[32 + crow(r, hi)]);
    ATT_LBAR();
    LAS float* xch = (LAS float*)(lds + LDS_XCH) + rg * 4096;
    if (comp == 1) {
#pragma unroll
        for (int d0 = 0; d0 < 4; ++d0)
#pragma unroll
            for (int r = 0; r < 16; ++r) xch[(d0 * 16 + r) * 64 + lane] = o[d0][r] * rli[r] * lam;
    }
    ATT_LBAR();
    if (comp == 0) {
        float ss[16];
#pragma unroll
        for (int r = 0; r < 16; ++r) { float s_ = 0.f;
#pragma unroll
            for (int d0 = 0; d0 < 4; ++d0) { const float v = o[d0][r] * rli[r] - xch[(d0 * 16 + r) * 64 + lane]; o[d0][r] = v; s_ += v * v; }
            ss[r] = s_; }
#pragma unroll
        for (int r = 0; r < 16; ++r) {
            float v = ss[r]; v += pg8::dppf<0xB1>(v); v += pg8::dppf<0x4E>(v); v += pg8::dppf<0x141>(v); v += pg8::dppf<0x140>(v);
            auto sw = __builtin_amdgcn_permlane16_swap(__float_as_uint(v), __float_as_uint(v), false, false); ss[r] = __uint_as_float(sw[0]) + __uint_as_float(sw[1]); }
        LAS bf16* stg = (LAS bf16*)(lds + LDS_OST) + rg * 4096;
        float g4[4];
#pragma unroll
        for (int d0 = 0; d0 < 4; ++d0) g4[d0] = subln_g[d0 * 32 + r32];
#pragma unroll
        for (int r = 0; r < 16; ++r) { const float rs = 0.8f * __builtin_amdgcn_rsqf(ss[r] * (1.0f / 128.0f) + 1e-5f); const int orow = crow(r, hi);
#pragma unroll
            for (int d0 = 0; d0 < 4; ++d0) stg[orow * 128 + d0 * 32 + r32] = (bf16)f2bf(o[d0][r] * rs * g4[d0]); }
#pragma unroll
        for (int i = 0; i < 8; ++i) { const int row = i * 4 + (lane >> 4), ch = lane & 15;
            const u32x4 v = *(LAS const u32x4*)(stg + row * 128 + ch * 8);
            st16wt(O + (size_t)(qw0 + row) * 1024 + h * 128 + ch * 8, v); }
    }
    ATT_LBAR();
#undef ATT_RFL
#undef DMA_K
#undef DMA_V
#undef SBAR
#undef PIN
#undef PKW
#undef PAF
#undef EX
#undef ROT3
#undef ENDW
#undef KLD
#undef BANDFIX
#undef VRD
#undef VFR
#undef GAPA
#undef PHASE_A
#undef GAPB
#undef PAF_SEL
#undef PHASE_B
#undef STEP
#undef PACKSUM
#undef KSL
#undef DMA_GROUP
}

__device__ __forceinline__ void attn_phase(int wv, const Args& a, LAS unsigned char* lds, int blk, int G, bf16* Odst) {
    const float* BTAB = (const float*)(a.ws + WS_BTAB);
    const float lam = __builtin_bit_cast(float, __builtin_amdgcn_readfirstlane(__builtin_bit_cast(int, BTAB[8 * 132])));
    const bf16* Q = (const bf16*)(a.ws + WS_A3); const bf16* K = (const bf16*)(a.ws + WS_A4); const bf16* V = (const bf16*)(a.ws + WS_A5);
    const bool snake = (1024 % G) == 0;
    for (int j = 0;; ++j) {
        const int idx = j * G + blk; if (idx >= 1024) break;
        const int rank = (snake && (j & 1)) ? (j * G + (G - 1 - blk)) : idx;
        attn_unit_pipe(wv, rank & 7, 127 - (rank >> 3), Q, K, V, Odst, lds, lam, BTAB, a.in[I_SUBLN_G], (const unsigned*)(a.ws + WS_KMAX));
    }
}
}


__device__ __forceinline__ void peer_convert(int wv, const Args& a, int blk, int G) {
    const int tid = opaque_tid(wv), lane = tid & 63, gw = blk * 8 + (tid >> 6);
    for (int which = 0; which < 2; ++which) {
        const float* src = a.in[which ? I_PEER_V : I_PEER_U]; unsigned* dst = (unsigned*)(a.ws + (which ? WS_PV : WS_PU));
        const size_t nchunk = (size_t)16384 * 1024 / 1024, stride = (size_t)G * 8;
        for (size_t c = gw; c < nchunk; c += 2 * stride) {
            const size_t c1 = c + stride; const bool two = c1 < nchunk;
            f32x4 v[8];
#pragma unroll
            for (int j = 0; j < 4; ++j) v[j] = __builtin_nontemporal_load((const f32x4*)(src + c * 1024 + 256 * j + 4 * lane));
            if (two) {
#pragma unroll
                for (int j = 0; j < 4; ++j) v[4 + j] = __builtin_nontemporal_load((const f32x4*)(src + c1 * 1024 + 256 * j + 4 * lane)); }
#pragma unroll
            for (int j = 0; j < 4; ++j) { const f32x4 x = v[j] * 128.0f; int w = __builtin_amdgcn_cvt_pk_fp8_f32(x[0], x[1], 0, false); w = __builtin_amdgcn_cvt_pk_fp8_f32(x[2], x[3], w, true);
                dst[c * 256 + 64 * j + lane] = (unsigned)w; }
            if (two) {
#pragma unroll
                for (int j = 0; j < 4; ++j) { const f32x4 x = v[4 + j] * 128.0f; int w = __builtin_amdgcn_cvt_pk_fp8_f32(x[0], x[1], 0, false); w = __builtin_amdgcn_cvt_pk_fp8_f32(x[2], x[3], w, true);
                    dst[c1 * 256 + 64 * j + lane] = (unsigned)w; } }
        } }
}
namespace peer {
typedef float f32x2v __attribute__((ext_vector_type(2)));
template <int CTRL> __device__ __forceinline__ float dpp(float x) { return __builtin_bit_cast(float, __builtin_amdgcn_mov_dpp(__builtin_bit_cast(int, x), CTRL, 0xf, 0xf, true)); }
template <int CTRL> __device__ __forceinline__ unsigned dppu(unsigned x) { return (unsigned)__builtin_amdgcn_mov_dpp((int)x, CTRL, 0xf, 0xf, true); }
__device__ __forceinline__ unsigned half32_umax(unsigned m) {
    unsigned t = dppu<0xB1>(m); m = t > m ? t : m; t = dppu<0x4E>(m); m = t > m ? t : m; t = dppu<0x141>(m); m = t > m ? t : m; t = dppu<0x140>(m); m = t > m ? t : m;
    auto s = __builtin_amdgcn_permlane16_swap(m, m, false, false); return s[0] > s[1] ? s[0] : s[1]; }
__device__ __forceinline__ float row16_sum(float x) { x += dpp<0xB1>(x); x += dpp<0x4E>(x); x += dpp<0x141>(x); x += dpp<0x140>(x); return x; }
__device__ __forceinline__ float wsum(float x) {
    x += dpp<0xB1>(x); x += dpp<0x4E>(x); x += dpp<0x141>(x); x += dpp<0x140>(x);
    auto s = __builtin_amdgcn_permlane16_swap(__float_as_uint(x), __float_as_uint(x), false, false); x = __uint_as_float(s[0]) + __uint_as_float(s[1]);
    auto t = __builtin_amdgcn_permlane32_swap(__float_as_uint(x), __float_as_uint(x), false, false); return __uint_as_float(t[0]) + __uint_as_float(t[1]);
}
__device__ __forceinline__ void peer_phase(int wv, const Args& a, int blk, int G, float* OUTP) {
    const int tid = opaque_tid(wv), lane = tid & 63, wave = tid >> 6, hh = lane >> 5, l32 = lane & 31;
    const unsigned* TK = (const unsigned*)(a.ws + WS_TOPK); const unsigned char* PU = (const unsigned char*)(a.ws + WS_PU); const unsigned char* PVt = (const unsigned char*)(a.ws + WS_PV);
    const float* gF = a.in[I_NORM_FFN_G]; const float* gO = a.in[I_FINAL_G];
    int ci0 = 0, cj0 = 0, ci1 = 0, cj1 = 0; bool valid1 = false;
    { int p = 0;
      for (int i = 0; i < 16; ++i) for (int j = 0; j < 16; ++j) if ((i + 1) * (j + 1) <= 16) { if (p == l32) { ci0 = i; cj0 = j; } if (p == l32 + 32) { ci1 = i; cj1 = j; valid1 = true; } ++p; } }
    for (int tok = blk * 8 + wave; tok < S; tok += G * 8) {
        const unsigned short* xrow = (const unsigned short*)(a.ws + WS_A2) + (size_t)tok * D + 16 * lane;
        f32x4 xa[4];
        { const u32x4 r0 = *(const u32x4*)xrow, r1 = *(const u32x4*)(xrow + 8);
          xa[0] = (f32x4){bflo(r0.x), bfhi(r0.x), bflo(r0.y), bfhi(r0.y)}; xa[1] = (f32x4){bflo(r0.z), bfhi(r0.z), bflo(r0.w), bfhi(r0.w)};
          xa[2] = (f32x4){bflo(r1.x), bfhi(r1.x), bflo(r1.y), bfhi(r1.y)}; xa[3] = (f32x4){bflo(r1.z), bfhi(r1.z), bflo(r1.w), bfhi(r1.w)}; }
        unsigned key[4];
#pragma unroll
        for (int i = 0; i < 4; ++i) key[i] = TK[(size_t)tok * 256 + lane + 64 * i];
        float ss = 0.f;
#pragma unroll
        for (int j = 0; j < 4; ++j) ss += (xa[j][0] * xa[j][0] + xa[j][1] * xa[j][1]) + (xa[j][2] * xa[j][2] + xa[j][3] * xa[j][3]);
        ss = wsum(ss);
        const float rstd = 1.0f / sqrtf(ss * (1.0f / D) + 1e-6f);
        float hf[16];
#pragma unroll
        for (int j = 0; j < 4; ++j) { const f32x4 gg = *(const f32x4*)(gF + 16 * lane + 4 * j);
#pragma unroll
            for (int e = 0; e < 4; ++e) hf[4 * j + e] = xa[j][e] * rstd * gg[e]; }
        int ex[4]; float gw[4];
#pragma unroll
        for (int i = 0; i < 4; ++i) {
            const unsigned k = key[i];
            const float v = pg8::ord2f(k & ~0x7Fu); const int ix = 127 - (int)(k & 0x7Fu);
            const float s0 = __shfl(v, hh * 32 + ci0) + __shfl(v, hh * 32 + 16 + cj0);
            const float s1 = __shfl(v, hh * 32 + ci1) + __shfl(v, hh * 32 + 16 + cj1);
            unsigned ck0 = (pg8::f2ord(s0) & ~0xFFu) | (unsigned)(255 - (ci0 * 16 + cj0));
            unsigned ck1 = valid1 ? ((pg8::f2ord(s1) & ~0xFFu) | (unsigned)(255 - (ci1 * 16 + cj1))) : 0u;
            unsigned win = 0u;
#pragma unroll
            for (int r = 0; r < 16; ++r) {
                const unsigned m = half32_umax(ck0 > ck1 ? ck0 : ck1);
                if (l32 == r) win = m;
                if (ck0 == m) ck0 = 0u;
                if (ck1 == m) ck1 = 0u;
            }
            const float ts = pg8::ord2f(win & ~0xFFu); const int flat = 255 - (int)(win & 0xFFu);
            const float mx = __shfl(ts, hh * 32);
            const float e = (l32 < 16) ? __expf(ts - mx) : 0.f;
            const float sum = row16_sum(e);
            gw[i] = e / sum;
            const int e0 = __shfl(ix, hh * 32 + ((flat >> 4) & 15)), e1 = __shfl(ix, hh * 32 + 16 + (flat & 15));
            ex[i] = e0 * 128 + e1;
        }
        float acc[16];
#pragma unroll
        for (int j = 0; j < 16; ++j) acc[j] = 0.f;
#pragma unroll 1
        for (int b = 0; b < 16; ++b) {
            const int i = b >> 2, sl = ((b >> 1) & 1) * 32 + (b & 1) * 8;
            const int exv = i == 0 ? ex[0] : i == 1 ? ex[1] : i == 2 ? ex[2] : ex[3];
            const float gwv = i == 0 ? gw[0] : i == 1 ? gw[1] : i == 2 ? gw[2] : gw[3];
            u32x4 uu[8], vv[8];
#pragma unroll
            for (int q = 0; q < 8; ++q) { const int eid = __builtin_amdgcn_readlane(exv, sl + q); uu[q] = *(const u32x4*)(PU + (size_t)eid * 1024 + 16 * lane); vv[q] = *(const u32x4*)(PVt + (size_t)eid * 1024 + 16 * lane); }
            float d[8];
#pragma unroll
            for (int q = 0; q < 8; ++q) { float s_ = 0.f;
#pragma unroll
                for (int e = 0; e < 4; ++e) { const f32x2v lo = __builtin_amdgcn_cvt_pk_f32_fp8((int)uu[q][e], false), hi2 = __builtin_amdgcn_cvt_pk_f32_fp8((int)uu[q][e], true);
                    s_ += (lo[0] * hf[4 * e] + lo[1] * hf[4 * e + 1]) + (hi2[0] * hf[4 * e + 2] + hi2[1] * hf[4 * e + 3]); }
                d[q] = s_; }
            float z;
            { const bool b0 = lane & 1, b1 = lane & 2, b2 = lane & 4;
              float r4[4], r2[2];
#pragma unroll
              for (int q = 0; q < 4; ++q) { const float keep = b0 ? d[q + 4] : d[q], give = b0 ? d[q] : d[q + 4]; r4[q] = keep + dpp<0xB1>(give); }
#pragma unroll
              for (int q = 0; q < 2; ++q) { const float keep = b1 ? r4[q + 2] : r4[q], give = b1 ? r4[q] : r4[q + 2]; r2[q] = keep + dpp<0x4E>(give); }
              { const float keep = b2 ? r2[1] : r2[0], give = b2 ? r2[0] : r2[1];
                const float up = dpp<0x104>(give), dn = dpp<0x114>(give);
                z = keep + (b2 ? dn : up); }
              z += dpp<0x128>(z);
              auto s16 = __builtin_amdgcn_permlane16_swap(__float_as_uint(z), __float_as_uint(z), false, false); z = __uint_as_float(s16[0]) + __uint_as_float(s16[1]);
              auto s32 = __builtin_amdgcn_permlane32_swap(__float_as_uint(z), __float_as_uint(z), false, false); z = __uint_as_float(s32[0]) + __uint_as_float(s32[1]); }
            const int myq = 4 * (lane & 1) + 2 * ((lane >> 1) & 1) + ((lane >> 2) & 1);
            const float gmine = __shfl(gwv, sl + myq);
            z *= (1.0f / 128.0f);
            const float wl = gmine * 0.5f * z * (1.0f + erff(z * 0.70710678118654752f)) * (1.0f / 128.0f);
#pragma unroll
            for (int q = 0; q < 8; ++q) { const float w = __builtin_bit_cast(float, __builtin_amdgcn_readlane(__builtin_bit_cast(int, wl), ((q >> 2) & 1) | (((q >> 1) & 1) << 1) | ((q & 1) << 2)));
#pragma unroll
                for (int e = 0; e < 4; ++e) { const f32x2v lo = __builtin_amdgcn_cvt_pk_f32_fp8((int)vv[q][e], false), hi2 = __builtin_amdgcn_cvt_pk_f32_fp8((int)vv[q][e], true);
                    acc[4 * e] += w * lo[0]; acc[4 * e + 1] += w * lo[1]; acc[4 * e + 2] += w * hi2[0]; acc[4 * e + 3] += w * hi2[1]; } }
        }
        float s3 = 0.f;
#pragma unroll
        for (int j = 0; j < 4; ++j)
#pragma unroll
            for (int e = 0; e < 4; ++e) { xa[j][e] += acc[4 * j + e]; s3 += xa[j][e] * xa[j][e]; }
        s3 = wsum(s3);
        const float r3 = 1.0f / sqrtf(s3 * (1.0f / D) + 1e-6f);
        float* orow = OUTP + (size_t)tok * D + 16 * lane;
#pragma unroll
        for (int j = 0; j < 4; ++j) { const f32x4 gg = *(const f32x4*)(gO + 16 * lane + 4 * j); *(f32x4*)(orow + 4 * j) = xa[j] * r3 * gg; }
    }
}
}

#define XB_TMO      128
#define XB_XCNT(j)  (256  + 64 * (j))
#define XB_XSUB(j)  (1280 + 64 * (j))
#define XB_XGEN(j)  (2304 + 64 * (j))
#define XB_TOP      3328
#define XB_TOPGEN   3392
#define XCD_BAR_WORDS 3456
#define XB_SPIN_CAP (1u << 18)

__device__ __forceinline__ unsigned xb_ld(unsigned* p)              { return __hip_atomic_load(p, __ATOMIC_RELAXED, __HIP_MEMORY_SCOPE_AGENT); }
__device__ __forceinline__ unsigned xb_add(unsigned* p, unsigned v) { return __hip_atomic_fetch_add(p, v, __ATOMIC_RELAXED, __HIP_MEMORY_SCOPE_AGENT); }
__device__ __forceinline__ unsigned xb_xcc_id() { return (unsigned)__builtin_amdgcn_s_getreg((3 << 11) | 20) & 0xFu; }
#define XB_SPIN(cond, bar) do { unsigned _sp = 0; while (cond) { __builtin_amdgcn_s_sleep(1); \
    if ((++_sp & 255u) == 0u) { if (xb_ld(&(bar)[XB_TMO])) break; if (_sp > XB_SPIN_CAP) { atomicAdd(&(bar)[XB_TMO], 1u); break; } } } } while (0)

struct XcdBarrier {
    unsigned* bar; unsigned x;
    volatile LAS unsigned* st;
};

__device__ __forceinline__ XcdBarrier xcd_barrier_post(unsigned* bar, volatile LAS unsigned* st, int tid) {
    XcdBarrier b; b.bar = bar; b.x = xb_xcc_id(); b.st = st;
    if (tid == 0) (void)xb_add(&bar[XB_XCNT(b.x)], 1u);
    return b;
}
__device__ __forceinline__ void xcd_barrier_complete(unsigned* bar, unsigned x, unsigned& nloc, unsigned& nx) {
    const unsigned G = gridDim.x * gridDim.y * gridDim.z;
    unsigned sum, cnt, mine, sp = 0u;
    for (;;) {
        sum = 0u; cnt = 0u; mine = 0u;
#pragma unroll
        for (unsigned j = 0; j < 16; ++j) { const unsigned c = xb_ld(&bar[XB_XCNT(j)]); sum += c; cnt += (c > 0u) ? 1u : 0u; mine = (j == x) ? c : mine; }
        if (sum == G) break;
        __builtin_amdgcn_s_sleep(1);
        if ((++sp & 255u) == 0u) { if (xb_ld(&bar[XB_TMO])) break; if (sp > XB_SPIN_CAP) { atomicAdd(&bar[XB_TMO], 1u); break; } }
    }
    nloc = mine > 0u ? mine : 1u; nx = cnt > 0u ? cnt : 1u;
}

__device__ __forceinline__ void xcd_barrier(const XcdBarrier& b, int tid) {
    asm volatile("s_waitcnt vmcnt(0)" ::: "memory");
    __syncthreads();
    if (tid == 0) {
        unsigned* bar = b.bar;
        __builtin_amdgcn_s_waitcnt(0);
        unsigned nloc = b.st[0], nx = b.st[1];
        if (nloc == 0u) { xcd_barrier_complete(bar, b.x, nloc, nx); b.st[0] = nloc; b.st[1] = nx; }
        const unsigned old = xb_add(&bar[XB_XSUB(b.x)], 1u);
        const unsigned gen = old / nloc;
        if (old + 1u == (gen + 1u) * nloc) {
            __builtin_amdgcn_fence(__ATOMIC_RELEASE, "agent");
            asm volatile("s_waitcnt vmcnt(0)" ::: "memory");
            const unsigned og = xb_add(&bar[XB_TOP], 1u);
            const unsigned tg = og / nx;
            if (og + 1u == (tg + 1u) * nx) xb_add(&bar[XB_TOPGEN], 1u);
            else XB_SPIN(xb_ld(&bar[XB_TOPGEN]) == tg, bar);
            __builtin_amdgcn_fence(__ATOMIC_ACQUIRE, "agent");
            xb_add(&bar[XB_XGEN(b.x)], 1u);
            asm volatile("s_waitcnt vmcnt(0)" ::: "memory");
        } else {
            XB_SPIN(xb_ld(&bar[XB_XGEN(b.x)]) == gen, bar);
            __builtin_amdgcn_fence(__ATOMIC_ACQUIRE, "agent");
            asm volatile("s_waitcnt vmcnt(0)" ::: "memory");
        }
    }
    __syncthreads();
}

constexpr int LDS_BYTES = 147456, LDS_MISC = 139264;
__global__ void __launch_bounds__(512, 2) mk_fwd(Args a) {
    extern __shared__ __attribute__((aligned(16))) unsigned char lds_raw[];
    LAS unsigned char* lds = (LAS unsigned char*)lds_raw;
    unsigned char* ws = a.ws;
    const int G = gridDim.x, blk = blockIdx.x, wv = __builtin_amdgcn_readfirstlane(threadIdx.x >> 6);
    { const int t0 = opaque_tid(wv); if (t0 < 16) ((volatile LAS unsigned*)(lds + LDS_MISC))[t0] = 0u; }
    __syncthreads();
    XcdBarrier bar = xcd_barrier_post((unsigned*)(ws + WS_CTL), (volatile LAS unsigned*)(lds + LDS_MISC), opaque_tid(wv));
#define IN(k) (a.ph_lo <= (k) && (k) < a.ph_hi)
#define SEAM(k) do { if (IN(k) && IN((k) + 1)) xcd_barrier(bar, opaque_tid(wv)); } while (0)
    if (IN(0)) p0_prologue(wv, a, lds, blk, G);
    SEAM(0);
    if (IN(1)) {
        pg8::Gemm g{(const bf16*)(ws + WS_A0), (const bf16*)(ws + WS_WT_IN), S, NCOLS, D, D, D}; pg8::StaticOrder So; So.init(S, NCOLS, G, blk);
        pg8::EpiProj E{(const float*)(ws + WS_RSTD0), (bf16*)(ws + WS_A1), (bf16*)(ws + WS_A2), (bf16*)(ws + WS_A3), (bf16*)(ws + WS_A4), (bf16*)(ws + WS_A5), (bf16*)(ws + WS_A6), (bf16*)a.out, 0.125f * 1.4426950408889634f, (unsigned*)(ws + WS_KMAX), (PG8_LAS float*)(lds + 131072)};
        pg8::gemm_phase<pg8::EpiProj, pg8::StaticOrder, true, true>(wv, lds, g, So, E);
    }
    SEAM(1);
    if (IN(2)) { conv_phase(wv, a, blk, G);  att::attn_phase(wv, a, lds, blk, G, (bf16*)(ws + WS_A3)); }
    SEAM(2);
    if (IN(3)) {
        pg8::StaticOrder So; So.init(S, D, G, blk);
        { pg8::Gemm g{(const bf16*)(ws + WS_A1), (const bf16*)(ws + WS_WT_CONV), S, D, 2 * D, D, D};
          const pg8::Split sp{16, (long long)WS_A3 - (long long)WS_A1 - 16 * 128, (long long)WS_WT_ATTN - (long long)WS_WT_CONV - 16 * 128};
          pg8::EpiMergeK E{(const bf16*)(ws + WS_A6), (const bf16*)a.out, (bf16*)(ws + WS_A0)};
          pg8::gemm_phase<pg8::EpiMergeK, pg8::StaticOrder, true, true, true>(wv, lds, g, So, E, sp); }
    }
    SEAM(3);
    if (IN(4)) {
        cross_fold(wv, a, blk, G);
        peer_convert(wv, a, blk, G);
        pg8::Gemm g{(const bf16*)(ws + WS_A0), (const bf16*)(ws + WS_WT_MIX), S, D, D, D, D}; pg8::StaticOrder So; So.init(S, D, G, blk);
        pg8::EpiResid E{a.in[I_X], (bf16*)(ws + WS_A2), (float*)(ws + WS_SS1)};
        pg8::gemm_phase<pg8::EpiResid, pg8::StaticOrder, true, true>(wv, lds, g, So, E);
    }
    SEAM(4);
    if (IN(5)) {
        pg8::Gemm g{(const bf16*)(ws + WS_A2), (const bf16*)(ws + WS_WQK), S, D, D, D, D}; pg8::StaticOrder So; So.init(S, D, G, blk);
        pg8::EpiSoftmaxFull E{(const float*)(ws + WS_SS1), (bf16*)(ws + WS_A1), 0.0625f * 1.4426950408889634f};
        pg8::gemm_phase<pg8::EpiSoftmaxFull, pg8::StaticOrder, false, true>(wv, lds, g, So, E);
    }
    SEAM(5);
    if (IN(6)) {
        pg8::Gemm g{(const bf16*)(ws + WS_A1), (const bf16*)(ws + WS_VW), S, D, D, D, D}; pg8::StaticOrder So; So.init(S, D, G, blk);
        pg8::EpiResidB E{(bf16*)(ws + WS_A2), (float*)(ws + WS_SS2)};
        pg8::gemm_phase<pg8::EpiResidB, pg8::StaticOrder, true, true>(wv, lds, g, So, E);
    }
    SEAM(6);
    if (IN(7)) {
        pg8::StaticOrder So; So.init(S, 2048, G, blk);
        for (int i = 0;; ++i) { pg8::Unit u; if (!So.next(i, u)) break;
            { pg8::Gemm g{(const bf16*)(ws + WS_A2), (const bf16*)(ws + WS_WT_PQ), S, 2048, D, D, D}; pg8::OneUnit S1{u.pm, u.pn};
              pg8::EpiKeysTopk E{(const float*)(ws + WS_SS2), (unsigned*)(ws + WS_TOPK)};
              pg8::gemm_phase<pg8::EpiKeysTopk, pg8::OneUnit, false, true>(wv, lds, g, S1, E); }
            __syncthreads(); }
    }
    SEAM(7);
    if (IN(8)) peer::peer_phase(wv, a, blk, G, a.out);
#undef IN
#undef SEAM
}

extern "C" void kernel_launch(void* const* d_in, const int* in_sizes, int n_in, void* d_out, int out_size, void* d_ws, size_t ws_size, hipStream_t stream) {
    static int grid = 0;
    if (grid == 0) {
        if (ws_size < WS_END || n_in != 25 || out_size != S * D) { fprintf(stderr, "kernel_launch: unexpected ws_size %zu / n_in %d / out_size %d\n", ws_size, n_in, out_size); grid = -1; return; }
        if (hipFuncSetAttribute((const void*)mk_fwd, hipFuncAttributeMaxDynamicSharedMemorySize, LDS_BYTES) != hipSuccess) { fprintf(stderr, "kernel_launch: hipFuncSetAttribute failed\n"); grid = -1; return; }
        int dev = 0, cus = 0, per_cu = 0;
        if (hipGetDevice(&dev) != hipSuccess || hipDeviceGetAttribute(&cus, hipDeviceAttributeMultiprocessorCount, dev) != hipSuccess) { grid = -1; return; }
        if (hipOccupancyMaxActiveBlocksPerMultiprocessor(&per_cu, (const void*)mk_fwd, 512, LDS_BYTES) != hipSuccess || per_cu < 1) { fprintf(stderr, "kernel_launch: occupancy query says %d blocks per CU\n", per_cu); grid = -1; return; }
        grid = cus;
    }
    if (grid < 0) return;
    Args a{};
    for (int i = 0; i < 25; ++i) a.in[i] = (const float*)d_in[i];
    a.out = (float*)d_out; a.ws = (unsigned char*)d_ws; a.ph_lo = 0; a.ph_hi = 9;
    if (hipMemsetAsync(d_ws, 0, 65536, stream) != hipSuccess) { fprintf(stderr, "kernel_launch: hipMemsetAsync failed\n"); return; }
    void* kargs[] = {&a};
    hipError_t e = hipLaunchCooperativeKernel((const void*)mk_fwd, dim3(grid), dim3(512), kargs, LDS_BYTES, stream);
    if (e != hipSuccess) fprintf(stderr, "kernel_launch: cooperative launch failed: %s (grid %d)\n", hipGetErrorString(e), grid);
}
```

```cpp
#include <hip/hip_runtime.h>
#include <math.h>
#include <cstdio>
#include <cstdint>
namespace pg8 {
#define PG8_LAS __attribute__((address_space(3)))
typedef unsigned short bf16_t;
typedef short bf16x8 __attribute__((ext_vector_type(8)));
typedef float f32x4 __attribute__((ext_vector_type(4)));
typedef unsigned u32x4 __attribute__((ext_vector_type(4)));
constexpr int BM = 256, BK = 64, HALF = 128, HTB = HALF * BK * 2  , STAGE_BYTES = 8 * HTB, NXCD = 8, WGM = 8;

__host__ __device__ __forceinline__ int lds_byte(int r, int c) { const int st = (r >> 4) * 2 + (c >> 5), rr = r & 15, cc = c & 31, ob = rr * 64 + cc * 2; return st * 1024 + (ob ^ (((ob >> 9) & 1) << 5)); }
__host__ __device__ __forceinline__ void stage_rc(int b, int& R, int& C) { const int st = b / 1024, sb = b % 1024, swz = sb ^ (((sb >> 9) & 1) << 5); R = (st >> 1) * 16 + swz / 64; C = (st & 1) * 32 + (swz % 64) / 2; }
__host__ __device__ __forceinline__ int perm32(int rho) { const int n = rho >> 4, i = rho & 15; return 8 * (i >> 2) + 4 * n + (i & 3); }

struct Unit { int pm, pn; };
struct Gemm { const bf16_t* A; const bf16_t* Bt; int M, N, K, lda, ldb; };
struct Split { int ksplit; long long dA2, dB2; };

struct StaticOrder {
    int nM, nN, nwg, G, c;
    __host__ __device__ void init(int M, int N, int G_, int c_) { nM = M / BM; nN = N / BM; nwg = nM * nN; G = G_; c = c_; }
    __host__ __device__ bool next(int i, Unit& u) const {
        const long L = (long)i * G + c; if (L >= nwg) return false;
        int wgid = (int)L; { const int q = nwg / NXCD, r = nwg % NXCD, xcd = wgid % NXCD, off = wgid / NXCD; wgid = (xcd < r ? xcd * (q + 1) : r * (q + 1) + (xcd - r) * q) + off; }
        const int nig = WGM * nN, gid = wgid / nig, fm = gid * WGM, gsz = (nM - fm) < WGM ? (nM - fm) : WGM;
        u.pm = fm + ((wgid % nig) % gsz); u.pn = (wgid % nig) / gsz; return true;
    }
    __device__ __forceinline__ void a_ready(const Unit&) const {}
    __device__ __forceinline__ void done(const Unit&) const {}
};

typedef float f32x2 __attribute__((ext_vector_type(2)));
typedef __bf16 bf16x2v __attribute__((ext_vector_type(2)));
__device__ __forceinline__ unsigned cvt_pk_bf16(float lo, float hi) { const f32x2 v = {lo, hi}; const bf16x2v b = __builtin_convertvector(v, bf16x2v); return __builtin_bit_cast(unsigned, b); }
template <class E, class = void> struct HasPrefetch { static constexpr bool value = false; };
template <class E> struct HasPrefetch<E, decltype((void)&E::prefetch)> { static constexpr bool value = true; };
template <class Epi, class Sched, bool ALIGN_EPI = false, bool SP2 = false, bool SPLIT = false>
__device__ __forceinline__ void gemm_phase(int wv, PG8_LAS unsigned char* lds, const Gemm g, const Sched& S, const Epi& E, const Split sp = Split{0, 0, 0}) {
    int tid_; asm volatile("v_mbcnt_lo_u32_b32 %0, -1, 0\n\tv_mbcnt_hi_u32_b32 %0, -1, %0" : "=v"(tid_)); tid_ += wv * 64;
    const int tid = tid_, wid = __builtin_amdgcn_readfirstlane(tid >> 6), lane = tid & 63, wr = wid >> 2, wc = wid & 3, fr = lane & 15, fq = lane >> 4;
    const int K = g.K, nt = K / BK;
    unsigned voffA[2], voffB[2];
#pragma unroll
    for (int i = 0; i < 2; ++i) { int R, C; stage_rc(tid * 16 + i * 8192, R, C); const int Rb = Epi::PERM ? ((R & ~31) + perm32(R & 31)) : R;
        voffA[i] = (unsigned)(R * g.lda + C) * 2u; voffB[i] = (unsigned)(Rb * g.ldb + C) * 2u; }
    const size_t kstep = (size_t)(BK * 2);
    const size_t hstepA = (size_t)HALF * g.lda * 2, hstepB = (size_t)HALF * g.ldb * 2;
    const size_t tstepA = 2 * hstepA, tstepB = 2 * hstepB;
    const unsigned ldsw = (unsigned)wid * 1024u;
    const int aoff = lds_byte(wr * 64 + fr, fq * 8), boff = lds_byte(wc * 32 + fr, fq * 8);
#define PG8_SA(b, h) (((b) * 2 + (h)) * HTB)
#define PG8_SB(b, h) ((4 + (b) * 2 + (h)) * HTB)
#define PG8_STAGE(bufoff, gbase, voff) do { _Pragma("unroll") for (int _i = 0; _i < 2; ++_i) \
        __builtin_amdgcn_global_load_lds((const unsigned*)((const char*)(gbase) + (voff)[_i]), (PG8_LAS unsigned*)(lds + (bufoff) + ldsw + _i * 8192), 16, 0, 0); } while (0)
#define PG8_LDA(dst, b, h) do { _Pragma("unroll") for (int m = 0; m < 4; ++m) _Pragma("unroll") for (int k = 0; k < 2; ++k) dst[m][k] = *(const PG8_LAS bf16x8*)(lds + PG8_SA(b, h) + aoff + m * 2048 + k * 1024); } while (0)
#define PG8_LDB(dst, b, h) do { _Pragma("unroll") for (int n = 0; n < 2; ++n) _Pragma("unroll") for (int k = 0; k < 2; ++k) dst[n][k] = *(const PG8_LAS bf16x8*)(lds + PG8_SB(b, h) + boff + n * 2048 + k * 1024); } while (0)
#define PG8_MMA(ai, bj, At, Bt) do { __builtin_amdgcn_s_setprio(1); _Pragma("unroll") for (int m = 0; m < 4; ++m) _Pragma("unroll") for (int n = 0; n < 2; ++n) _Pragma("unroll") for (int k = 0; k < 2; ++k) \
        acc[ai][bj][m][n] = __builtin_amdgcn_mfma_f32_16x16x32_bf16(Bt[n][k], At[m][k], acc[ai][bj][m][n], 0, 0, 0); __builtin_amdgcn_s_setprio(0); } while (0)
#define PG8_WAIT_V(n) asm volatile("s_waitcnt vmcnt(" #n ")" ::: "memory")
#define PG8_WAIT_L(n) asm volatile("s_waitcnt lgkmcnt(" #n ")" ::: "memory")
#define PG8_BAR __builtin_amdgcn_s_barrier()
#define PG8_SCHED __builtin_amdgcn_sched_barrier(0)
    Unit cur, nxt; int ui = 0;
    if (!S.next(0, cur)) return;
    f32x4 acc[2][2][4][2];
#pragma unroll
    for (int a = 0; a < 2; ++a)
#pragma unroll
        for (int b = 0; b < 2; ++b)
#pragma unroll
            for (int m = 0; m < 4; ++m)
#pragma unroll
                for (int n = 0; n < 2; ++n) acc[a][b][m][n] = (f32x4){0.f, 0.f, 0.f, 0.f};
    bf16x8 At[4][2], B0[2][2], B1[2][2];
    const char* cA = (const char*)g.A + (size_t)cur.pm * tstepA; const char* cB = (const char*)g.Bt + (size_t)cur.pn * tstepB;
    S.a_ready(cur);
    if constexpr (HasPrefetch<Epi>::value) E.prefetch(cur, lds, wid);
    if constexpr (SP2) {
        PG8_STAGE(PG8_SB(0, 0), cB, voffB); PG8_STAGE(PG8_SB(0, 1), cB + hstepB, voffB); PG8_STAGE(PG8_SA(0, 0), cA, voffA); PG8_STAGE(PG8_SA(0, 1), cA + hstepA, voffA);
        if (wr == 1) PG8_BAR;
        PG8_WAIT_V(2); PG8_BAR;
        PG8_STAGE(PG8_SB(1, 0), cB + kstep, voffB); PG8_STAGE(PG8_SA(1, 0), cA + kstep, voffA); PG8_STAGE(PG8_SB(1, 1), cB + hstepB + kstep, voffB);
        PG8_WAIT_V(6); PG8_BAR;
    } else {
        PG8_STAGE(PG8_SB(0, 0), cB, voffB); PG8_STAGE(PG8_SA(0, 0), cA, voffA); PG8_STAGE(PG8_SB(0, 1), cB + hstepB, voffB); PG8_STAGE(PG8_SA(0, 1), cA + hstepA, voffA);
        if (wr == 1) PG8_BAR;
        PG8_WAIT_V(4); PG8_BAR;
        PG8_STAGE(PG8_SB(1, 0), cB + kstep, voffB); PG8_STAGE(PG8_SA(1, 0), cA + kstep, voffA); PG8_STAGE(PG8_SB(1, 1), cB + hstepB + kstep, voffB);
        PG8_WAIT_V(6); PG8_BAR;
    }
    for (;;) {
        const bool has_next = S.next(ui + 1, nxt);
        const char* nA = has_next ? (const char*)g.A + (size_t)nxt.pm * tstepA : cA; const char* nB = has_next ? (const char*)g.Bt + (size_t)nxt.pn * tstepB : cB;
        for (int t = 0; t < nt; t += 2) {
            const bool last = (t == nt - 2);
            long long oa1 = 0, oa2 = 0, ob2 = 0;
            if constexpr (SPLIT) { if (t == sp.ksplit) E.mid(acc, cur, wr, wc, fr, fq);
                if (t >= sp.ksplit) oa1 = sp.dA2; if (t + 2 >= sp.ksplit) { oa2 = sp.dA2; ob2 = sp.dB2; } }
            const char* a1 = cA + (size_t)(t + 1) * kstep + oa1;
            const char* a2 = last ? nA : cA + (size_t)(t + 2) * kstep + oa2; const char* b2 = last ? nB : cB + (size_t)(t + 2) * kstep + ob2;
            const char* a3 = a2 + kstep; const char* b3 = b2 + kstep;
            if (last && has_next) S.a_ready(nxt);
            if constexpr (SP2) {
            PG8_LDB(B0, 0, 0); PG8_LDB(B1, 0, 1); PG8_SCHED; PG8_LDA(At, 0, 0); PG8_STAGE(PG8_SA(1, 1), a1 + hstepA, voffA);
            PG8_WAIT_V(8); PG8_WAIT_L(0); PG8_BAR; PG8_MMA(0, 0, At, B0); PG8_MMA(0, 1, At, B1); PG8_BAR; PG8_SCHED;
            PG8_LDA(At, 0, 1); PG8_STAGE(PG8_SB(0, 0), b2, voffB); PG8_STAGE(PG8_SB(0, 1), b2 + hstepB, voffB); PG8_STAGE(PG8_SA(0, 0), a2, voffA);
            PG8_WAIT_V(8); PG8_WAIT_L(0); PG8_BAR; PG8_MMA(1, 0, At, B0); PG8_MMA(1, 1, At, B1); PG8_BAR; PG8_SCHED;
            PG8_LDB(B0, 1, 0); PG8_LDB(B1, 1, 1); PG8_SCHED; PG8_LDA(At, 1, 0); PG8_STAGE(PG8_SA(0, 1), a2 + hstepA, voffA);
            PG8_WAIT_V(8); PG8_WAIT_L(0); PG8_BAR; PG8_MMA(0, 0, At, B0); PG8_MMA(0, 1, At, B1); PG8_BAR; PG8_SCHED;
            PG8_LDA(At, 1, 1); PG8_STAGE(PG8_SB(1, 0), b3, voffB); PG8_STAGE(PG8_SB(1, 1), b3 + hstepB, voffB); PG8_STAGE(PG8_SA(1, 0), a3, voffA);
            PG8_WAIT_V(8); PG8_WAIT_L(0); PG8_BAR; PG8_MMA(1, 0, At, B0); PG8_MMA(1, 1, At, B1); PG8_BAR; PG8_SCHED;
            } else {
            PG8_LDB(B0, 0, 0); PG8_SCHED; PG8_LDA(At, 0, 0); PG8_STAGE(PG8_SA(1, 1), a1 + hstepA, voffA);
            PG8_WAIT_L(8); PG8_BAR; PG8_WAIT_L(0); PG8_MMA(0, 0, At, B0); PG8_BAR; PG8_SCHED;
            PG8_LDB(B1, 0, 1); PG8_STAGE(PG8_SB(0, 0), b2, voffB);
            PG8_BAR; PG8_WAIT_L(0); PG8_MMA(0, 1, At, B1); PG8_BAR;
            PG8_LDA(At, 0, 1); PG8_STAGE(PG8_SA(0, 0), a2, voffA);
            PG8_BAR; PG8_WAIT_L(0); PG8_MMA(1, 0, At, B0); PG8_BAR; PG8_SCHED;
            PG8_STAGE(PG8_SB(0, 1), b2 + hstepB, voffB);
            PG8_WAIT_V(6); PG8_BAR; PG8_MMA(1, 1, At, B1); PG8_BAR;
            PG8_LDB(B0, 1, 0); PG8_SCHED; PG8_LDA(At, 1, 0); PG8_STAGE(PG8_SA(0, 1), a2 + hstepA, voffA);
            PG8_WAIT_L(8); PG8_BAR; PG8_WAIT_L(0); PG8_MMA(0, 0, At, B0); PG8_BAR; PG8_SCHED;
            PG8_LDB(B1, 1, 1); PG8_STAGE(PG8_SB(1, 0), b3, voffB);
            PG8_BAR; PG8_WAIT_L(0); PG8_MMA(0, 1, At, B1); PG8_BAR;
            PG8_LDA(At, 1, 1); PG8_STAGE(PG8_SA(1, 0), a3, voffA);
            PG8_BAR; PG8_WAIT_L(0); PG8_MMA(1, 0, At, B0); PG8_BAR; PG8_SCHED;
            PG8_STAGE(PG8_SB(1, 1), b3 + hstepB, voffB);
            PG8_WAIT_V(6); PG8_BAR; PG8_MMA(1, 1, At, B1); PG8_BAR;
            }
        }
        if constexpr (ALIGN_EPI) { if (wr == 0) PG8_BAR; }
        if constexpr (!Epi::AFTER_DRAIN) { E(acc, cur, wr, wc, fr, fq); S.done(cur); }
        if (!has_next) break;
#pragma unroll
        for (int a = 0; a < 2; ++a)
#pragma unroll
            for (int b = 0; b < 2; ++b)
#pragma unroll
                for (int m = 0; m < 4; ++m)
#pragma unroll
                    for (int n = 0; n < 2; ++n) acc[a][b][m][n] = (f32x4){0.f, 0.f, 0.f, 0.f};
        cur = nxt; cA = nA; cB = nB; ++ui;
        if constexpr (HasPrefetch<Epi>::value) E.prefetch(cur, lds, wid);
        if constexpr (ALIGN_EPI) { if (wr == 1) PG8_BAR; }
    }
    PG8_WAIT_V(0);
    if constexpr (!ALIGN_EPI) { if (wr == 0) PG8_BAR; }
    PG8_BAR;
    if constexpr (Epi::AFTER_DRAIN) { E.fused(acc, cur, wr, wc, fr, fq, lds, wid, lane); S.done(cur); }
#undef PG8_SA
#undef PG8_SB
#undef PG8_STAGE
#undef PG8_LDA
#undef PG8_LDB
#undef PG8_MMA
#undef PG8_WAIT_V
#undef PG8_WAIT_L
#undef PG8_BAR
#undef PG8_SCHED
}
}


constexpr int S = 16384, D = 1024, NCOLS = 8192, MEMN = 256;
typedef unsigned short bf16;
typedef float f32x4 __attribute__((ext_vector_type(4)));
typedef unsigned u32x4 __attribute__((ext_vector_type(4)));
typedef unsigned u32x2 __attribute__((ext_vector_type(2)));
__device__ __forceinline__ void st16wt(void* p, u32x4 v) { asm volatile("global_store_dwordx4 %0, %1, off sc1\n\ts_nop 1" :: "v"(p), "v"(v) : "memory"); }
#define LAS __attribute__((address_space(3)))

__device__ const unsigned char T5_BUCKET[128] = {0, 1, 2, 3, 4, 5, 6, 7, 8, 9, 10, 11, 12, 13, 14, 15, 16, 16, 16, 17, 17, 18, 18, 18, 19, 19, 19, 20, 20, 20, 20, 21, 21, 21, 21, 22, 22, 22, 22, 22, 23, 23, 23, 23, 23, 23, 24, 24, 24, 24, 24, 24, 25, 25, 25, 25, 25, 25, 25, 26, 26, 26, 26, 26, 26, 26, 26, 27, 27, 27, 27, 27, 27, 27, 27, 27, 27, 28, 28, 28, 28, 28, 28, 28, 28, 28, 28, 29, 29, 29, 29, 29, 29, 29, 29, 29, 29, 29, 29, 30, 30, 30, 30, 30, 30, 30, 30, 30, 30, 30, 30, 30, 30, 31, 31, 31, 31, 31, 31, 31, 31, 31, 31, 31, 31, 31, 31, 31};

constexpr size_t MiB = 1u << 20;
constexpr size_t WS_CTL = 0, WS_KMAX = 32768  , WS_RSTD0 = 512 * 1024;
constexpr size_t WS_WT_IN = 1 * MiB, WS_WT_CONV = 17 * MiB, WS_WT_ATTN = 19 * MiB, WS_WT_MIX = 21 * MiB, WS_WT_CQ = 23 * MiB, WS_WT_CO = 25 * MiB, WS_WT_PQ = 27 * MiB;
constexpr size_t WS_SUBK = 31 * MiB, WS_KV = 32 * MiB, WS_SS1 = 34 * MiB, WS_SS2 = 35 * MiB;
constexpr size_t WS_TOPK = 36 * MiB  , WS_PU = 196 * MiB  , WS_PV = 228 * MiB  ;
constexpr size_t WS_WQK = 23 * MiB  , WS_VW = 212 * MiB  ;
constexpr size_t WS_BTAB = 640 * 1024  ;
constexpr size_t WS_PQS = 52 * MiB  , WS_KS = 132 * MiB  ;
constexpr size_t WS_A0 = 36 * MiB, WS_A1 = 68 * MiB, WS_A2 = 100 * MiB, WS_A3 = 132 * MiB, WS_A4 = 164 * MiB, WS_A5 = 196 * MiB, WS_A6 = 228 * MiB, WS_END = 260 * MiB;

__device__ __forceinline__ float wave_sum(float v) {
#pragma unroll
    for (int o = 1; o < 64; o <<= 1) v += __shfl_xor(v, o);
    return v;
}
__device__ __forceinline__ float wave_max(float v) {
#pragma unroll
    for (int o = 1; o < 64; o <<= 1) v = fmaxf(v, __shfl_xor(v, o));
    return v;
}
__device__ __forceinline__ int opaque_tid(int wv) { int t; asm volatile("v_mbcnt_lo_u32_b32 %0, -1, 0\n\tv_mbcnt_hi_u32_b32 %0, -1, %0" : "=v"(t)); return t + wv * 64; }
__device__ __forceinline__ unsigned f2bf(float f) { unsigned u = __builtin_bit_cast(unsigned, f); return (u + 0x7fffu + ((u >> 16) & 1u)) >> 16; }
__device__ __forceinline__ unsigned pk2(float lo, float hi) { return pg8::cvt_pk_bf16(lo, hi); }
__device__ __forceinline__ float bflo(unsigned w) { return __builtin_bit_cast(float, w << 16); }
__device__ __forceinline__ float bfhi(unsigned w) { return __builtin_bit_cast(float, w & 0xffff0000u); }
__device__ __forceinline__ float sigmoidf_(float x) { return __builtin_amdgcn_rcpf(1.0f + __builtin_amdgcn_exp2f(x * -1.4426950408889634f)); }

struct Args { const float* in[25]; float* out; unsigned char* ws; int ph_lo, ph_hi; };
enum { I_X = 0, I_MEM, I_NORM_MIX_G, I_W_IN, I_CONV_W, I_W_CONV_OUT, I_LQ1, I_LK1, I_LQ2, I_LK2, I_SUBLN_G, I_W_ATTN_OUT, I_W_MIX_OUT, I_REL_BIAS, I_NORM_CROSS_G, I_NORM_MEM_G,
       I_W_CQ, I_W_CKV, I_W_CO, I_NORM_FFN_G, I_W_PQ, I_SUB_KEYS, I_PEER_U, I_PEER_V, I_FINAL_G };

namespace pg8 {
template <int CTRL> __device__ __forceinline__ float dppf(float x) { return __builtin_bit_cast(float, __builtin_amdgcn_mov_dpp(__builtin_bit_cast(int, x), CTRL, 0xf, 0xf, true)); }
__device__ __forceinline__ float row16_max(float v) { v = fmaxf(v, dppf<0xB1>(v)); v = fmaxf(v, dppf<0x4E>(v)); v = fmaxf(v, dppf<0x141>(v)); return fmaxf(v, dppf<0x140>(v)); }
__device__ __forceinline__ float xrow16_max(float x) {
    auto s = __builtin_amdgcn_permlane16_swap(__float_as_uint(x), __float_as_uint(x), false, false); x = fmaxf(__uint_as_float(s[0]), __uint_as_float(s[1]));
    auto t = __builtin_amdgcn_permlane32_swap(__float_as_uint(x), __float_as_uint(x), false, false); return fmaxf(__uint_as_float(t[0]), __uint_as_float(t[1])); }
__device__ __forceinline__ float xrow16_sum(float x) {
    auto s = __builtin_amdgcn_permlane16_swap(__float_as_uint(x), __float_as_uint(x), false, false); x = __uint_as_float(s[0]) + __uint_as_float(s[1]);
    auto t = __builtin_amdgcn_permlane32_swap(__float_as_uint(x), __float_as_uint(x), false, false); return __uint_as_float(t[0]) + __uint_as_float(t[1]); }
__device__ __forceinline__ u32x4 pack8(const f32x4& v0, const f32x4& v1) { u32x4 w; w.x = cvt_pk_bf16(v0[0], v0[1]); w.y = cvt_pk_bf16(v0[2], v0[3]); w.z = cvt_pk_bf16(v1[0], v1[1]); w.w = cvt_pk_bf16(v1[2], v1[3]); return w; }
struct EpiProj {
    static constexpr bool PERM = true, AFTER_DRAIN = false;
    const float* rstd_g; bf16_t *CB, *U, *Q, *K, *V, *SGC, *SGA; float qscale; unsigned* KMAX; PG8_LAS float* rl;
    __device__ __forceinline__ void prefetch(const Unit& u, PG8_LAS unsigned char* lds, int wid) const {
        if (wid == 0) { int ln; asm volatile("v_mbcnt_lo_u32_b32 %0, -1, 0\n\tv_mbcnt_hi_u32_b32 %0, -1, %0" : "=v"(ln));
            __builtin_amdgcn_global_load_lds((const unsigned*)(rstd_g + u.pm * BM + ln * 4), (PG8_LAS unsigned*)rl, 16, 0, 0); }
    }
    __device__ __forceinline__ void operator()(const f32x4 (&acc)[2][2][4][2], const Unit& u, int wr, int wc, int fr0, int fq) const {
        int fr = fr0; asm volatile("" : "+v"(fr));
        const int row0 = u.pm * BM + wr * 64 + fr, pn = u.pn, colw = wc * 32 + 8 * fq;
        const PG8_LAS float* rstd = rl - u.pm * BM;
        if (pn >= 4 && pn < 12) {
            const int col = 128 * (pn - 4) + colw;
#pragma unroll
            for (int ai = 0; ai < 2; ++ai)
#pragma unroll
                for (int m = 0; m < 4; ++m) { const int row = row0 + ai * HALF + m * 16; const float rs = rstd[row], r2 = rs * rs;
                    const f32x4 v0 = acc[ai][0][m][0] * acc[ai][1][m][0] * r2, v1 = acc[ai][0][m][1] * acc[ai][1][m][1] * r2;
                    *(u32x4*)(U + (size_t)row * 1024 + col) = pack8(v0, v1); }
            return;
        }
        bf16_t* base; int cbase; float sc = 1.f; bool gate = false;
        if (pn < 4) { base = CB; cbase = pn * 256; }
        else if (pn < 16) { base = Q; cbase = (pn - 12) * 256; sc = qscale; }
        else if (pn < 20) { base = K; cbase = (pn - 16) * 256; }
        else if (pn < 24) { base = V; cbase = (pn - 20) * 256; }
        else if (pn < 28) { base = SGC; cbase = (pn - 24) * 256; gate = true; }
        else { base = SGA; cbase = (pn - 28) * 256; gate = true; }
#pragma unroll
        for (int ai = 0; ai < 2; ++ai)
#pragma unroll
            for (int m = 0; m < 4; ++m) { const int row = row0 + ai * HALF + m * 16; const float rs = rstd[row] * sc;
#pragma unroll
                for (int bj = 0; bj < 2; ++bj) { f32x4 v0 = acc[ai][bj][m][0] * rs, v1 = acc[ai][bj][m][1] * rs;
                    if (gate) {
#pragma unroll
                        for (int e = 0; e < 4; ++e) { v0[e] = sigmoidf_(v0[e]); v1[e] = sigmoidf_(v1[e]); } }
                    *(u32x4*)(base + (size_t)row * 1024 + cbase + bj * HALF + colw) = pack8(v0, v1); } }
        if (pn >= 16 && pn < 20) {
            float mx[2] = {0.f, 0.f};
#pragma unroll
            for (int ai = 0; ai < 2; ++ai)
#pragma unroll
                for (int m = 0; m < 4; ++m) { const float rs = rstd[row0 + ai * HALF + m * 16];
#pragma unroll
                    for (int bj = 0; bj < 2; ++bj) { const f32x4 v0 = acc[ai][bj][m][0] * rs, v1 = acc[ai][bj][m][1] * rs;
                        const float s = xrow16_sum(((v0[0] * v0[0] + v0[1] * v0[1]) + (v0[2] * v0[2] + v0[3] * v0[3])) + ((v1[0] * v1[0] + v1[1] * v1[1]) + (v1[2] * v1[2] + v1[3] * v1[3])));
                        mx[bj] = fmaxf(mx[bj], s); } }
#pragma unroll
            for (int bj = 0; bj < 2; ++bj) { float v = mx[bj];
                v = row16_max(v);
                if (fr == 0 && fq == 0) atomicMax(KMAX + (((pn - 16) * 2 + bj) * 2 + (wc >> 1)) * 2 + (wc & 1), __float_as_uint(v)); }
        }
    }
};
struct EpiGateT {
    static constexpr bool PERM = true, AFTER_DRAIN = false;
    const bf16_t* SG; float* T;
    __device__ __forceinline__ void operator()(const f32x4 (&acc)[2][2][4][2], const Unit& u, int wr, int wc, int fr0, int fq) const {
        int fr = fr0; asm volatile("" : "+v"(fr));
        const int row0 = u.pm * BM + wr * 64 + fr, col0 = u.pn * BM + wc * 32 + 8 * fq;
#pragma unroll
        for (int ai = 0; ai < 2; ++ai)
#pragma unroll
            for (int m = 0; m < 4; ++m) { const size_t off = (size_t)(row0 + ai * HALF + m * 16) * 1024 + col0;
#pragma unroll
                for (int bj = 0; bj < 2; ++bj) { const u32x4 g = *(const u32x4*)(SG + off + bj * HALF);
                    f32x4 g0 = {bflo(g.x), bfhi(g.x), bflo(g.y), bfhi(g.y)}, g1 = {bflo(g.z), bfhi(g.z), bflo(g.w), bfhi(g.w)};
                    *(f32x4*)(T + off + bj * HALF) = g0 * acc[ai][bj][m][0]; *(f32x4*)(T + off + bj * HALF + 4) = g1 * acc[ai][bj][m][1]; } }
    }
};
struct EpiMerge {
    static constexpr bool PERM = true, AFTER_DRAIN = false;
    const float* T; const bf16_t* SG; bf16_t* O;
    __device__ __forceinline__ void operator()(const f32x4 (&acc)[2][2][4][2], const Unit& u, int wr, int wc, int fr0, int fq) const {
        int fr = fr0; asm volatile("" : "+v"(fr));
        const int row0 = u.pm * BM + wr * 64 + fr, col0 = u.pn * BM + wc * 32 + 8 * fq;
#pragma unroll
        for (int ai = 0; ai < 2; ++ai)
#pragma unroll
            for (int m = 0; m < 4; ++m) { const size_t off = (size_t)(row0 + ai * HALF + m * 16) * 1024 + col0;
#pragma unroll
                for (int bj = 0; bj < 2; ++bj) { const u32x4 g = *(const u32x4*)(SG + off + bj * HALF);
                    f32x4 g0 = {bflo(g.x), bfhi(g.x), bflo(g.y), bfhi(g.y)}, g1 = {bflo(g.z), bfhi(g.z), bflo(g.w), bfhi(g.w)};
                    const f32x4 t0 = *(const f32x4*)(T + off + bj * HALF), t1 = *(const f32x4*)(T + off + bj * HALF + 4);
                    *(u32x4*)(O + off + bj * HALF) = pack8(t0 + g0 * acc[ai][bj][m][0], t1 + g1 * acc[ai][bj][m][1]); } }
    }
};
struct EpiMergeK {
    static constexpr bool PERM = true, AFTER_DRAIN = false;
    const bf16_t* SGc; const bf16_t* SGa; bf16_t* O;
    __device__ __forceinline__ void mid(f32x4 (&acc)[2][2][4][2], const Unit& u, int wr, int wc, int fr0, int fq) const {
        int fr = fr0; asm volatile("" : "+v"(fr));
        const int row0 = u.pm * BM + wr * 64 + fr, col0 = u.pn * BM + wc * 32 + 8 * fq;
#pragma unroll
        for (int ai = 0; ai < 2; ++ai)
#pragma unroll
            for (int m = 0; m < 4; ++m) { const size_t off = (size_t)(row0 + ai * HALF + m * 16) * 1024 + col0;
#pragma unroll
                for (int bj = 0; bj < 2; ++bj) { const u32x4 c = *(const u32x4*)(SGc + off + bj * HALF), g = *(const u32x4*)(SGa + off + bj * HALF);
                    const f32x4 c0 = {bflo(c.x), bfhi(c.x), bflo(c.y), bfhi(c.y)}, c1 = {bflo(c.z), bfhi(c.z), bflo(c.w), bfhi(c.w)};
                    f32x4 g0 = {bflo(g.x), bfhi(g.x), bflo(g.y), bfhi(g.y)}, g1 = {bflo(g.z), bfhi(g.z), bflo(g.w), bfhi(g.w)};
#pragma unroll
                    for (int e = 0; e < 4; ++e) { g0[e] = c0[e] * __builtin_amdgcn_rcpf(fmaxf(g0[e], 1e-20f)); g1[e] = c1[e] * __builtin_amdgcn_rcpf(fmaxf(g1[e], 1e-20f)); }
                    acc[ai][bj][m][0] *= g0; acc[ai][bj][m][1] *= g1; } }
    }
    __device__ __forceinline__ void operator()(const f32x4 (&acc)[2][2][4][2], const Unit& u, int wr, int wc, int fr0, int fq) const {
        int fr = fr0; asm volatile("" : "+v"(fr));
        const int row0 = u.pm * BM + wr * 64 + fr, col0 = u.pn * BM + wc * 32 + 8 * fq;
#pragma unroll
        for (int ai = 0; ai < 2; ++ai)
#pragma unroll
            for (int m = 0; m < 4; ++m) { const size_t off = (size_t)(row0 + ai * HALF + m * 16) * 1024 + col0;
#pragma unroll
                for (int bj = 0; bj < 2; ++bj) { const u32x4 g = *(const u32x4*)(SGa + off + bj * HALF);
                    f32x4 g0 = {bflo(g.x), bfhi(g.x), bflo(g.y), bfhi(g.y)}, g1 = {bflo(g.z), bfhi(g.z), bflo(g.w), bfhi(g.w)};
#pragma unroll
                    for (int e = 0; e < 4; ++e) { g0[e] = fmaxf(g0[e], 1e-20f); g1[e] = fmaxf(g1[e], 1e-20f); }
                    st16wt(O + off + bj * HALF, pack8(g0 * acc[ai][bj][m][0], g1 * acc[ai][bj][m][1])); } }
    }
};
struct EpiResid {
    static constexpr bool PERM = true, AFTER_DRAIN = false;
    const float* R; bf16_t* XB; float* SS;
    __device__ __forceinline__ void operator()(const f32x4 (&acc)[2][2][4][2], const Unit& u, int wr, int wc, int fr0, int fq) const {
        int fr = fr0; asm volatile("" : "+v"(fr));
        const int row0 = u.pm * BM + wr * 64 + fr, col0 = u.pn * BM + wc * 32 + 8 * fq;
#pragma unroll
        for (int ai = 0; ai < 2; ++ai)
#pragma unroll
            for (int m = 0; m < 4; ++m) { const int row = row0 + ai * HALF + m * 16; const size_t off = (size_t)row * 1024 + col0; float ss = 0.f;
#pragma unroll
                for (int bj = 0; bj < 2; ++bj) {
                    const f32x4 x0 = *(const f32x4*)(R + off + bj * HALF) + acc[ai][bj][m][0], x1 = *(const f32x4*)(R + off + bj * HALF + 4) + acc[ai][bj][m][1];
                    st16wt(XB + off + bj * HALF, pack8(x0, x1));
                    ss += (x0[0] * x0[0] + x0[1] * x0[1]) + (x0[2] * x0[2] + x0[3] * x0[3]) + (x1[0] * x1[0] + x1[1] * x1[1]) + (x1[2] * x1[2] + x1[3] * x1[3]); }
                ss = xrow16_sum(ss);
                if (fq == 0) SS[(size_t)row * 16 + u.pn * 4 + wc] = ss; }
    }
};
struct EpiResidB {
    static constexpr bool PERM = true, AFTER_DRAIN = false;
    bf16_t* XB; float* SS;
    __device__ __forceinline__ void operator()(const f32x4 (&acc)[2][2][4][2], const Unit& u, int wr, int wc, int fr0, int fq) const {
        int fr = fr0; asm volatile("" : "+v"(fr));
        const int row0 = u.pm * BM + wr * 64 + fr, col0 = u.pn * BM + wc * 32 + 8 * fq;
#pragma unroll
        for (int ai = 0; ai < 2; ++ai)
#pragma unroll
            for (int m = 0; m < 4; ++m) { const int row = row0 + ai * HALF + m * 16; const size_t off = (size_t)row * 1024 + col0; float ss = 0.f;
#pragma unroll
                for (int bj = 0; bj < 2; ++bj) { const u32x4 g = *(const u32x4*)(XB + off + bj * HALF);
                    const f32x4 r0 = {bflo(g.x), bfhi(g.x), bflo(g.y), bfhi(g.y)}, r1 = {bflo(g.z), bfhi(g.z), bflo(g.w), bfhi(g.w)};
                    const f32x4 x0 = r0 + acc[ai][bj][m][0], x1 = r1 + acc[ai][bj][m][1];
                    st16wt(XB + off + bj * HALF, pack8(x0, x1));
                    ss += (x0[0] * x0[0] + x0[1] * x0[1]) + (x0[2] * x0[2] + x0[3] * x0[3]) + (x1[0] * x1[0] + x1[1] * x1[1]) + (x1[2] * x1[2] + x1[3] * x1[3]); }
                ss = xrow16_sum(ss);
                if (fq == 0) SS[(size_t)row * 16 + u.pn * 4 + wc] = ss; }
    }
};
struct EpiRowScale {
    static constexpr bool PERM = true, AFTER_DRAIN = false;
    const float* SS; bf16_t* O; int ldc; float sc;
    __device__ __forceinline__ void operator()(const f32x4 (&acc)[2][2][4][2], const Unit& u, int wr, int wc, int fr0, int fq) const {
        int fr = fr0; asm volatile("" : "+v"(fr));
        const int row0 = u.pm * BM + wr * 64 + fr, col0 = u.pn * BM + wc * 32 + 8 * fq;
#pragma unroll
        for (int ai = 0; ai < 2; ++ai)
#pragma unroll
            for (int m = 0; m < 4; ++m) { const int row = row0 + ai * HALF + m * 16;
                const f32x4* sp = (const f32x4*)(SS + (size_t)row * 16); const f32x4 s4 = (sp[0] + sp[1]) + (sp[2] + sp[3]);
                const float rs = sc / sqrtf(((s4[0] + s4[1]) + (s4[2] + s4[3])) * (1.0f / 1024.0f) + 1e-6f);
#pragma unroll
                for (int bj = 0; bj < 2; ++bj) *(u32x4*)(O + (size_t)row * ldc + col0 + bj * HALF) = pack8(acc[ai][bj][m][0] * rs, acc[ai][bj][m][1] * rs); }
    }
};

__device__ __forceinline__ unsigned f2ord(float f) { const unsigned u = __builtin_bit_cast(unsigned, f); return u ^ ((unsigned)((int)u >> 31) | 0x80000000u); }
__device__ __forceinline__ float ord2f(unsigned k) { const unsigned u = (k & 0x80000000u) ? (k ^ 0x80000000u) : ~k; return __builtin_bit_cast(float, u); }
#define PG8_CSWAP(a, b) do { const unsigned hi_ = (a) > (b) ? (a) : (b), lo_ = (a) > (b) ? (b) : (a); (a) = hi_; (b) = lo_; } while (0)
__device__ __forceinline__ void sort16_desc(unsigned (&k)[16]) {
#pragma unroll
    for (int sz = 2; sz <= 16; sz <<= 1)
#pragma unroll
        for (int st = sz >> 1; st > 0; st >>= 1)
#pragma unroll
            for (int i = 0; i < 16; ++i) { const int l = i ^ st; if (l > i) { if ((i & sz) == 0) PG8_CSWAP(k[i], k[l]); else PG8_CSWAP(k[l], k[i]); } }
}
__device__ __forceinline__ void merge16_desc(unsigned (&a)[16], const unsigned (&b)[16]) {
#pragma unroll
    for (int i = 0; i < 16; ++i) a[i] = a[i] > b[15 - i] ? a[i] : b[15 - i];
#pragma unroll
    for (int st = 8; st > 0; st >>= 1)
#pragma unroll
        for (int i = 0; i < 16; ++i) { const int l = i ^ st; if (l > i) PG8_CSWAP(a[i], a[l]); }
}
struct EpiKeys {
    static constexpr bool PERM = true, AFTER_DRAIN = false;
    const float* SS; unsigned* KS;
    __device__ __forceinline__ void operator()(const f32x4 (&acc)[2][2][4][2], const Unit& u, int wr, int wc, int fr0, int fq) const {
        int fr = fr0; asm volatile("" : "+v"(fr));
#pragma unroll
        for (int ai = 0; ai < 2; ++ai)
#pragma unroll
            for (int m = 0; m < 4; ++m) { const int row = ai * HALF + wr * 64 + m * 16 + fr;
                const f32x4* sp = (const f32x4*)(SS + (size_t)(u.pm * BM + row) * 16); const f32x4 s4 = (sp[0] + sp[1]) + (sp[2] + sp[3]);
                const float rs = 1.0f / sqrtf(((s4[0] + s4[1]) + (s4[2] + s4[3])) * (1.0f / 1024.0f) + 1e-6f);
#pragma unroll
                for (int bj = 0; bj < 2; ++bj)
#pragma unroll
                    for (int n = 0; n < 2; ++n) { const int cw = wc * 32 + 8 * fq + 4 * n; u32x4 k;
#pragma unroll
                        for (int e = 0; e < 4; ++e) k[e] = (f2ord(acc[ai][bj][m][n][e] * rs) & ~0x7Fu) | (unsigned)(127 - (cw + e));
                        *(u32x4*)(KS + row * 256 + bj * HALF + cw) = k; } }
    }
};
__device__ __forceinline__ void topk_from_keys(int tid, const unsigned* KS, unsigned* TOPK, int tok0, int h) {
#pragma unroll 1
    for (int ai = 0; ai < 2; ++ai) {
        const int j = tid & 1, rl = (tid >> 1) & 127, c = tid >> 8;
        const unsigned* src = KS + (ai * 128 + rl) * 256 + c * 128 + j * 64;
        unsigned best[16], cur[16];
        { const u32x4 a0 = *(const u32x4*)src, a1 = *(const u32x4*)(src + 4), a2 = *(const u32x4*)(src + 8), a3 = *(const u32x4*)(src + 12);
#pragma unroll
          for (int e = 0; e < 4; ++e) { best[e] = a0[e]; best[4 + e] = a1[e]; best[8 + e] = a2[e]; best[12 + e] = a3[e]; } }
        sort16_desc(best);
#pragma unroll 1
        for (int gq = 1; gq < 4; ++gq) {
            const u32x4 a0 = *(const u32x4*)(src + gq * 16), a1 = *(const u32x4*)(src + gq * 16 + 4), a2 = *(const u32x4*)(src + gq * 16 + 8), a3 = *(const u32x4*)(src + gq * 16 + 12);
#pragma unroll
            for (int e = 0; e < 4; ++e) { cur[e] = a0[e]; cur[4 + e] = a1[e]; cur[8 + e] = a2[e]; cur[12 + e] = a3[e]; }
            sort16_desc(cur); merge16_desc(best, cur); }
#pragma unroll
        for (int i = 0; i < 16; ++i) cur[i] = (unsigned)__shfl_xor((int)best[i], 1);
        merge16_desc(best, cur);
        unsigned* dst = TOPK + ((size_t)(tok0 + ai * 128 + rl) * 8 + h) * 32 + c * 16 + j * 8;
        u32x4 w0, w1;
        if (j == 0) { w0 = (u32x4){best[0], best[1], best[2], best[3]}; w1 = (u32x4){best[4], best[5], best[6], best[7]}; }
        else { w0 = (u32x4){best[8], best[9], best[10], best[11]}; w1 = (u32x4){best[12], best[13], best[14], best[15]}; }
        st16wt(dst, w0); st16wt(dst + 4, w1);
    }
}
struct EpiKeysTopk {
    static constexpr bool PERM = true, AFTER_DRAIN = true;
    const float* SS; unsigned* TOPK;
    __device__ __forceinline__ void fused(f32x4 (&acc)[2][2][4][2], const Unit& u, int wr, int wc, int fr0, int fq, PG8_LAS unsigned char* lds, int wid, int lane) const {
        int fr = fr0; asm volatile("" : "+v"(fr));
        const int tid = wid * 64 + lane;
#pragma unroll
        for (int ai = 0; ai < 2; ++ai) {
#pragma unroll
            for (int m = 0; m < 4; ++m) { const int lr = wr * 64 + m * 16 + fr;
                const f32x4* sp = (const f32x4*)(SS + (size_t)(u.pm * BM + ai * HALF + lr) * 16); const f32x4 s4 = (sp[0] + sp[1]) + (sp[2] + sp[3]);
                const float rs = 1.0f / sqrtf(((s4[0] + s4[1]) + (s4[2] + s4[3])) * (1.0f / 1024.0f) + 1e-6f);
#pragma unroll
                for (int bj = 0; bj < 2; ++bj)
#pragma unroll
                    for (int n = 0; n < 2; ++n) { const int cw = wc * 32 + 8 * fq + 4 * n, col = bj * HALF + cw; u32x4 k;
#pragma unroll
                        for (int e = 0; e < 4; ++e) k[e] = (f2ord(acc[ai][bj][m][n][e] * rs) & ~0x7Fu) | (unsigned)(127 - (cw + e));
                        *(PG8_LAS u32x4*)(lds + lr * 1024 + (((col >> 2) ^ ((2 * lr + ((col >> 6) & 1)) & 15)) << 4)) = k; } }
            asm volatile("s_waitcnt lgkmcnt(0)\n\ts_barrier" ::: "memory");
            { const int j = tid & 1, rl = (tid >> 1) & 127, c = tid >> 8, sw = (2 * rl + j) & 15;
              const PG8_LAS unsigned char* src = lds + rl * 1024 + (2 * c + j) * 256;
              unsigned best[16], cur[16];
              u32x4 kk[16];
#pragma unroll
              for (int q = 0; q < 16; ++q) kk[q] = *(const PG8_LAS u32x4*)(src + ((q ^ sw) << 4));
#pragma unroll
              for (int e = 0; e < 4; ++e) { best[e] = kk[0][e]; best[4 + e] = kk[1][e]; best[8 + e] = kk[2][e]; best[12 + e] = kk[3][e]; }
              sort16_desc(best);
#pragma unroll
              for (int gq = 1; gq < 4; ++gq) {
#pragma unroll
                  for (int e = 0; e < 4; ++e) { cur[e] = kk[4 * gq][e]; cur[4 + e] = kk[4 * gq + 1][e]; cur[8 + e] = kk[4 * gq + 2][e]; cur[12 + e] = kk[4 * gq + 3][e]; }
                  sort16_desc(cur); merge16_desc(best, cur); }
#pragma unroll
              for (int i = 0; i < 16; ++i) cur[i] = (unsigned)__shfl_xor((int)best[i], 1);
              merge16_desc(best, cur);
              unsigned* dst = TOPK + ((size_t)(u.pm * BM + ai * HALF + rl) * 8 + u.pn) * 32 + c * 16 + j * 8;
              u32x4 w0, w1;
              if (j == 0) { w0 = (u32x4){best[0], best[1], best[2], best[3]}; w1 = (u32x4){best[4], best[5], best[6], best[7]}; }
              else { w0 = (u32x4){best[8], best[9], best[10], best[11]}; w1 = (u32x4){best[12], best[13], best[14], best[15]}; }
              st16wt(dst, w0); st16wt(dst + 4, w1); }
            asm volatile("s_waitcnt lgkmcnt(0)\n\ts_barrier" ::: "memory");
        }
    }
};
struct EpiSoftmaxP {
    static constexpr bool PERM = true, AFTER_DRAIN = true;
    bf16_t* P; PG8_LAS float* lrow;
    __device__ __forceinline__ void fused(f32x4 (&acc)[2][2][4][2], const Unit& u, int wr, int wc, int fr0, int fq, PG8_LAS unsigned char* lds, int wid, int lane) const {
        int fr = fr0; asm volatile("" : "+v"(fr));
        PG8_LAS float* MX = (PG8_LAS float*)lds; PG8_LAS float* SM = MX + 1024;
#pragma unroll
        for (int ai = 0; ai < 2; ++ai)
#pragma unroll
            for (int m = 0; m < 4; ++m) { float mx = -INFINITY;
#pragma unroll
                for (int bj = 0; bj < 2; ++bj)
#pragma unroll
                    for (int n = 0; n < 2; ++n)
#pragma unroll
                        for (int e = 0; e < 4; ++e) mx = fmaxf(mx, acc[ai][bj][m][n][e]);
                mx = xrow16_max(mx);
                if (fq == 0) MX[(ai * HALF + wr * 64 + m * 16 + fr) * 4 + wc] = mx; }
        asm volatile("s_waitcnt lgkmcnt(0)\n\ts_barrier" ::: "memory");
#pragma unroll
        for (int ai = 0; ai < 2; ++ai)
#pragma unroll
            for (int m = 0; m < 4; ++m) { const int row = ai * HALF + wr * 64 + m * 16 + fr;
                const f32x4 m4 = *(const PG8_LAS f32x4*)(MX + row * 4); const float rm = fmaxf(fmaxf(m4[0], m4[1]), fmaxf(m4[2], m4[3])); float s = 0.f;
#pragma unroll
                for (int bj = 0; bj < 2; ++bj) { f32x4 p0, p1;
#pragma unroll
                    for (int e = 0; e < 4; ++e) { p0[e] = __builtin_amdgcn_exp2f(acc[ai][bj][m][0][e] - rm); p1[e] = __builtin_amdgcn_exp2f(acc[ai][bj][m][1][e] - rm); }
                    s += ((p0[0] + p0[1]) + (p0[2] + p0[3])) + ((p1[0] + p1[1]) + (p1[2] + p1[3]));
                    *(u32x4*)(P + (size_t)row * 256 + bj * HALF + wc * 32 + 8 * fq) = pack8(p0, p1); }
                s = xrow16_sum(s);
                if (fq == 0) SM[row * 4 + wc] = s; }
        asm volatile("s_waitcnt lgkmcnt(0)\n\ts_barrier" ::: "memory");
        const int tid = wid * 64 + lane;
        if (tid < 256) { const f32x4 s4 = *(const PG8_LAS f32x4*)(SM + tid * 4); lrow[tid] = (s4[0] + s4[1]) + (s4[2] + s4[3]); }
    }
};
struct EpiSoftmaxFull {
    static constexpr bool PERM = true, AFTER_DRAIN = true;
    const float* SS; bf16_t* P; float sc;
    __device__ __forceinline__ void fused(f32x4 (&acc)[2][2][4][2], const Unit& u, int wr, int wc, int fr0, int fq, PG8_LAS unsigned char* lds, int wid, int lane) const {
        int fr = fr0; asm volatile("" : "+v"(fr));
        PG8_LAS float* MX = (PG8_LAS float*)lds; PG8_LAS float* SM = MX + 1024;
#pragma unroll
        for (int ai = 0; ai < 2; ++ai)
#pragma unroll
            for (int m = 0; m < 4; ++m) { const int lr = ai * HALF + wr * 64 + m * 16 + fr, row = u.pm * BM + lr; float mx = -INFINITY;
                const f32x4* sp = (const f32x4*)(SS + (size_t)row * 16); const f32x4 s4 = (sp[0] + sp[1]) + (sp[2] + sp[3]);
                const float rs = sc / sqrtf(((s4[0] + s4[1]) + (s4[2] + s4[3])) * (1.0f / 1024.0f) + 1e-6f);
#pragma unroll
                for (int bj = 0; bj < 2; ++bj)
#pragma unroll
                    for (int n = 0; n < 2; ++n) { acc[ai][bj][m][n] *= rs;
#pragma unroll
                        for (int e = 0; e < 4; ++e) mx = fmaxf(mx, acc[ai][bj][m][n][e]); }
                mx = xrow16_max(mx);
                if (fq == 0) MX[lr * 4 + wc] = mx; }
        asm volatile("s_waitcnt lgkmcnt(0)\n\ts_barrier" ::: "memory");
#pragma unroll
        for (int ai = 0; ai < 2; ++ai)
#pragma unroll
            for (int m = 0; m < 4; ++m) { const int lr = ai * HALF + wr * 64 + m * 16 + fr;
                const f32x4 m4 = *(const PG8_LAS f32x4*)(MX + lr * 4); const float rm = fmaxf(fmaxf(m4[0], m4[1]), fmaxf(m4[2], m4[3])); float s = 0.f;
#pragma unroll
                for (int bj = 0; bj < 2; ++bj)
#pragma unroll
                    for (int n = 0; n < 2; ++n) {
#pragma unroll
                        for (int e = 0; e < 4; ++e) acc[ai][bj][m][n][e] = __builtin_amdgcn_exp2f(acc[ai][bj][m][n][e] - rm);
                        s += (acc[ai][bj][m][n][0] + acc[ai][bj][m][n][1]) + (acc[ai][bj][m][n][2] + acc[ai][bj][m][n][3]); }
                s = xrow16_sum(s);
                if (fq == 0) SM[lr * 4 + wc] = s; }
        asm volatile("s_waitcnt lgkmcnt(0)\n\ts_barrier" ::: "memory");
#pragma unroll
        for (int ai = 0; ai < 2; ++ai)
#pragma unroll
            for (int m = 0; m < 4; ++m) { const int lr = ai * HALF + wr * 64 + m * 16 + fr;
                const f32x4 s4 = *(const PG8_LAS f32x4*)(SM + lr * 4); const float inv = 1.0f / ((s4[0] + s4[1]) + (s4[2] + s4[3]));
#pragma unroll
                for (int bj = 0; bj < 2; ++bj)
                    st16wt(P + (size_t)(u.pm * BM + lr) * 1024 + u.pn * BM + bj * HALF + wc * 32 + 8 * fq, pack8(acc[ai][bj][m][0] * inv, acc[ai][bj][m][1] * inv)); }
    }
};
struct EpiCO {
    static constexpr bool PERM = true, AFTER_DRAIN = false;
    bf16_t* O; const PG8_LAS float* lrow;
    __device__ __forceinline__ void operator()(const f32x4 (&acc)[2][2][4][2], const Unit& u, int wr, int wc, int fr0, int fq) const {
        int fr = fr0; asm volatile("" : "+v"(fr));
#pragma unroll
        for (int ai = 0; ai < 2; ++ai)
#pragma unroll
            for (int m = 0; m < 4; ++m) { const int row = ai * HALF + wr * 64 + m * 16 + fr; const float inv = 1.0f / lrow[row];
#pragma unroll
                for (int bj = 0; bj < 2; ++bj) *(u32x4*)(O + (size_t)row * 1024 + bj * HALF + wc * 32 + 8 * fq) = pack8(acc[ai][bj][m][0] * inv, acc[ai][bj][m][1] * inv); }
    }
};
struct OneUnit {
    int pm, pn;
    __device__ __forceinline__ bool next(int i, Unit& u) const { if (i) return false; u.pm = pm; u.pn = pn; return true; }
    __device__ __forceinline__ void a_ready(const Unit&) const {}
    __device__ __forceinline__ void done(const Unit&) const {}
};
}

__device__ __forceinline__ int win_src_col(int n) {
    if (n < 1024 || n >= 3072) return n;
    const int t = (n - 1024) >> 8, j = (n - 1024) & 255;
    return j < 128 ? 1024 + 128 * t + j : 2048 + 128 * t + (j - 128);
}
__device__ __forceinline__ void p0_prologue(int wv, const Args& a, LAS unsigned char* lds, int blk, int G) {
    const int tid = opaque_tid(wv), lane = tid & 63, wave = tid >> 6;
    unsigned char* ws = a.ws;
    LAS float* tl = (LAS float*)lds;
    {
        f32x4 cur[8], nxt[8]; const float* gcur = nullptr; const float* gnxt = nullptr;
#define P0_DECODE(job, W, ldw, nb, kb, Wt, gain, perm) do { \
            if ((job) < 512) { W = a.in[I_W_IN]; ldw = NCOLS; kb = (job) >> 5; nb = (job) & 31; Wt = (bf16*)(ws + WS_WT_IN); gain = a.in[I_NORM_MIX_G]; perm = true; } \
            else { const int mat = ((job) - 512) >> 6, idx = ((job) - 512) & 63; kb = idx >> 2; nb = idx & 3; ldw = 1024; gain = nullptr; perm = false; \
                if (mat == 0) { W = a.in[I_W_CONV_OUT]; Wt = (bf16*)(ws + WS_WT_CONV); } \
                else if (mat == 1) { W = a.in[I_W_ATTN_OUT]; Wt = (bf16*)(ws + WS_WT_ATTN); } \
                else if (mat == 2) { W = a.in[I_W_MIX_OUT]; Wt = (bf16*)(ws + WS_WT_MIX); } \
                else { W = a.in[I_W_CO]; Wt = (bf16*)(ws + WS_WT_CO); } } } while (0)
#define P0_LOAD(dst, gv, job) do { const float* W; int ldw, nb, kb; bf16* Wt; const float* gain; bool perm; P0_DECODE(job, W, ldw, nb, kb, Wt, gain, perm); (void)Wt; \
            const int k0 = kb * 64, c = tid & 63, nd0 = nb * 256 + 64 * (c >> 4), ns0 = (perm ? win_src_col(nd0) : nd0) + 4 * (c & 15); gv = gain ? gain + k0 : nullptr; \
            _Pragma("unroll") for (int i = 0; i < 8; ++i) dst[i] = *(const f32x4*)(W + (size_t)(k0 + (tid >> 6) + 8 * i) * ldw + ns0); } while (0)
        if (blk < 768) P0_LOAD(cur, gcur, blk);
        for (int job = blk; job < 768; job += G) {
            if (job + G < 768) P0_LOAD(nxt, gnxt, job + G);
#pragma unroll
            for (int i = 0; i < 8; ++i) { const int kk = (tid >> 6) + 8 * i, c = tid & 63; const float gk = gcur ? gcur[kk] : 1.0f; LAS float* d = tl + kk * 257 + 4 * c;
                d[0] = cur[i][0] * gk; d[1] = cur[i][1] * gk; d[2] = cur[i][2] * gk; d[3] = cur[i][3] * gk; }
            __syncthreads();
            { const float* W; int ldw, nb, kb; bf16* Wt; const float* gain; bool perm; P0_DECODE(job, W, ldw, nb, kb, Wt, gain, perm); (void)W; (void)ldw; (void)gain; (void)perm;
#pragma unroll
              for (int r = 0; r < 4; ++r) { const int idx = tid + 512 * r, nn = idx >> 3, kq = idx & 7; const LAS float* s = tl + (kq * 8) * 257 + nn;
                  u32x4 o; o.x = pk2(s[0], s[257]); o.y = pk2(s[2 * 257], s[3 * 257]); o.z = pk2(s[4 * 257], s[5 * 257]); o.w = pk2(s[6 * 257], s[7 * 257]);
                  st16wt(Wt + (size_t)(nb * 256 + nn) * 1024 + kb * 64 + kq * 8, o); } }
            __syncthreads();
#pragma unroll
            for (int i = 0; i < 8; ++i) cur[i] = nxt[i];
            gcur = gnxt;
        }
#undef P0_DECODE
#undef P0_LOAD
    }
    { const float* x = a.in[I_X]; bf16* XB = (bf16*)(ws + WS_A0); float* rstd0 = (float*)(ws + WS_RSTD0);
      f32x4 v[4], w4[4]; int row = blk * 8 + wave;
#define P0_XLOAD(dst, r) do { const f32x4* xr = (const f32x4*)(x + (size_t)(r) * D) + 2 * lane; dst[0] = xr[0]; dst[1] = xr[1]; dst[2] = xr[128]; dst[3] = xr[129]; } while (0)
      if (row < S) P0_XLOAD(v, row);
      for (; row < S; row += G * 8) {
          if (row + G * 8 < S) P0_XLOAD(w4, row + G * 8);
          float s = 0.f;
#pragma unroll
          for (int j = 0; j < 4; ++j) s += (v[j][0] * v[j][0] + v[j][1] * v[j][1]) + (v[j][2] * v[j][2] + v[j][3] * v[j][3]);
          s = wave_sum(s);
          if (lane == 0) rstd0[row] = 1.0f / sqrtf(s * (1.0f / D) + 1e-6f);
          bf16* o = XB + (size_t)row * D + 8 * lane;
#pragma unroll
          for (int j = 0; j < 2; ++j) { u32x4 w; w.x = pk2(v[2 * j][0], v[2 * j][1]); w.y = pk2(v[2 * j][2], v[2 * j][3]); w.z = pk2(v[2 * j + 1][0], v[2 * j + 1][1]); w.w = pk2(v[2 * j + 1][2], v[2 * j + 1][3]);
              st16wt(o + 512 * j, w); }
#pragma unroll
          for (int j = 0; j < 4; ++j) v[j] = w4[j];
      }
#undef P0_XLOAD
    }
    { typedef short bf16x8_t __attribute__((ext_vector_type(8))); typedef float f32x16_t __attribute__((ext_vector_type(16)));
      LAS bf16* mnb = (LAS bf16*)lds;
      LAS float* red = (LAS float*)(lds + 32 * 1032 * 2);
      const float* mem = a.in[I_MEM]; const float* g = a.in[I_NORM_MEM_G]; const float* Wc = a.in[I_W_CKV]; bf16* KC = (bf16*)(ws + WS_KV); bf16* VC = KC + 4 * 256 * 256;
      const int r32 = lane & 31, kg = lane >> 5;
      for (int wb = blk; wb < 256; wb += G) {
          const int m0 = (wb >> 5) * 32, n0 = (wb & 31) * 64;
          __syncthreads();
#pragma unroll
          for (int r = 0; r < 4; ++r) { const int rr = wave * 4 + r; const f32x4* mr = (const f32x4*)(mem + (size_t)(m0 + rr) * D) + lane; f32x4 v[4]; float s = 0.f;
#pragma unroll
              for (int j = 0; j < 4; ++j) { v[j] = mr[64 * j]; s += (v[j][0] * v[j][0] + v[j][1] * v[j][1]) + (v[j][2] * v[j][2] + v[j][3] * v[j][3]); }
              s = wave_sum(s); const float rs = 1.0f / sqrtf(s * (1.0f / D) + 1e-6f);
#pragma unroll
              for (int j = 0; j < 4; ++j) { const f32x4 gg = ((const f32x4*)g)[lane + 64 * j]; const f32x4 y = v[j] * rs * gg; u32x2 w; w.x = pk2(y[0], y[1]); w.y = pk2(y[2], y[3]);
                  *(LAS u32x2*)(mnb + rr * 1032 + 4 * (lane + 64 * j)) = w; } }
          __syncthreads();
          const int it = wave & 1, kq = wave >> 1, ncol = n0 + 32 * it + r32;
          f32x16_t acc;
#pragma unroll
          for (int r = 0; r < 16; ++r) acc[r] = 0.f;
#pragma unroll 1
          for (int half = 0; half < 2; ++half) {
              float wv_[8][8];
#pragma unroll
              for (int s = 0; s < 8; ++s)
#pragma unroll
                  for (int j = 0; j < 8; ++j) wv_[s][j] = Wc[(size_t)(256 * kq + 128 * half + 16 * s + 8 * kg + j) * 2048 + ncol];
#pragma unroll
              for (int s = 0; s < 8; ++s) {
                  u32x4 bw; bw.x = pk2(wv_[s][0], wv_[s][1]); bw.y = pk2(wv_[s][2], wv_[s][3]); bw.z = pk2(wv_[s][4], wv_[s][5]); bw.w = pk2(wv_[s][6], wv_[s][7]);
                  const bf16x8_t af = *(const LAS bf16x8_t*)(mnb + r32 * 1032 + 256 * kq + 128 * half + 16 * s + 8 * kg);
                  acc = __builtin_amdgcn_mfma_f32_32x32x16_bf16(af, __builtin_bit_cast(bf16x8_t, bw), acc, 0, 0, 0); }
          }
#pragma unroll
          for (int r = 0; r < 16; ++r) red[((it * 4 + kq) * 16 + r) * 64 + lane] = acc[r];
          __syncthreads();
          if (kq == 0) {
#pragma unroll
              for (int r = 0; r < 16; ++r) acc[r] = (red[((it * 4 + 0) * 16 + r) * 64 + lane] + red[((it * 4 + 1) * 16 + r) * 64 + lane]) + (red[((it * 4 + 2) * 16 + r) * 64 + lane] + red[((it * 4 + 3) * 16 + r) * 64 + lane]);
              if (ncol < 1024) {
#pragma unroll
                  for (int r = 0; r < 16; ++r) KC[((size_t)(ncol >> 8) * 256 + (m0 + (r & 3) + 8 * (r >> 2) + 4 * kg)) * 256 + (ncol & 255)] = (bf16)f2bf(acc[r]);
              } else {
#pragma unroll
                  for (int r = 0; r < 16; ++r) VC[((size_t)((ncol - 1024) >> 8) * 256 + (m0 + (r & 3) + 8 * (r >> 2) + 4 * kg)) * 256 + (ncol & 255)] = (bf16)f2bf(acc[r]);
              }
          }
      }
      __syncthreads(); }
    { typedef short bf16x8_t __attribute__((ext_vector_type(8))); typedef float f32x16_t __attribute__((ext_vector_type(16)));
      const float* sk = a.in[I_SUB_KEYS]; const float* wpq = a.in[I_W_PQ]; const float* gf = a.in[I_NORM_FFN_G]; bf16* WT = (bf16*)(ws + WS_WT_PQ);
      const int r32 = lane & 31, kg = lane >> 5;
      for (int item = blk * 8 + wave; item < 2048; item += G * 8) {
          const int hc = item >> 7, h = hc >> 1, c = hc & 1, kt = (item >> 2) & 31, nt = item & 3;
          const float* ap = wpq + (size_t)(kt * 32 + r32) * 2048 + hc * 128 + 8 * kg;
          const float* bp = sk + ((size_t)((c * 8 + h) * 128 + nt * 32 + r32)) * 128 + 8 * kg;
          const float gk = gf[kt * 32 + r32];
          f32x4 av[8][2], bv[8][2];
#pragma unroll
          for (int s = 0; s < 8; ++s) { av[s][0] = *(const f32x4*)(ap + 16 * s); av[s][1] = *(const f32x4*)(ap + 16 * s + 4); bv[s][0] = *(const f32x4*)(bp + 16 * s); bv[s][1] = *(const f32x4*)(bp + 16 * s + 4); }
          f32x16_t acc;
#pragma unroll
          for (int r = 0; r < 16; ++r) acc[r] = 0.f;
#pragma unroll
          for (int s = 0; s < 8; ++s) {
              const f32x4 a0 = av[s][0] * gk, a1 = av[s][1] * gk;
              u32x4 aw, bw; aw.x = pk2(a0[0], a0[1]); aw.y = pk2(a0[2], a0[3]); aw.z = pk2(a1[0], a1[1]); aw.w = pk2(a1[2], a1[3]);
              bw.x = pk2(bv[s][0][0], bv[s][0][1]); bw.y = pk2(bv[s][0][2], bv[s][0][3]); bw.z = pk2(bv[s][1][0], bv[s][1][1]); bw.w = pk2(bv[s][1][2], bv[s][1][3]);
              acc = __builtin_amdgcn_mfma_f32_32x32x16_bf16(__builtin_bit_cast(bf16x8_t, aw), __builtin_bit_cast(bf16x8_t, bw), acc, 0, 0, 0); }
          bf16* dst = WT + (size_t)(hc * 128 + nt * 32 + r32) * 1024 + kt * 32 + 4 * kg;
#pragma unroll
          for (int q = 0; q < 4; ++q) { u32x2 w; w.x = pk2(acc[4 * q], acc[4 * q + 1]); w.y = pk2(acc[4 * q + 2], acc[4 * q + 3]); *(u32x2*)(dst + 8 * q) = w; }
      } }
    if (blk == 0) { float* BT = (float*)(ws + WS_BTAB); const float* rb = a.in[I_REL_BIAS];
        for (int i = tid; i < 8 * 132; i += 512) { const int h = i / 132, j = i - h * 132; float v = 0.f;
            if (j < 129) { const int b = j < 128 ? (int)T5_BUCKET[j] : 31; v = (rb[b * 8 + h] - rb[31 * 8 + h]) * 1.4426950408889634f; }
            else if (j == 129) { float m = -INFINITY; for (int b = 0; b < 32; ++b) m = fmaxf(m, rb[b * 8 + h] * 1.4426950408889634f); v = m; }
            else if (j == 130) v = rb[31 * 8 + h] * 1.4426950408889634f;
            BT[i] = v; }
        if (tid == 0) { float s1 = 0.f, s2 = 0.f;
            for (int i = 0; i < 64; ++i) { s1 += a.in[I_LQ1][i] * a.in[I_LK1][i]; s2 += a.in[I_LQ2][i] * a.in[I_LK2][i]; }
            BT[8 * 132] = expf(s1) - expf(s2) + 0.2f; } }
}

__device__ __forceinline__ void cross_fold(int wv, const Args& a, int blk, int G) {
    typedef short bf16x8_t __attribute__((ext_vector_type(8))); typedef float f32x16_t __attribute__((ext_vector_type(16)));
    const int tid = opaque_tid(wv), lane = tid & 63, wave = tid >> 6, r32 = lane & 31, kg = lane >> 5;
    const bf16* KC = (const bf16*)(a.ws + WS_KV); const bf16* VC = KC + 4 * 256 * 256;
    for (int item = blk * 8 + wave; item < 2048; item += G * 8) {
        f32x16_t acc;
#pragma unroll
        for (int r = 0; r < 16; ++r) acc[r] = 0.f;
        bf16* dst;
        if (item < 1024) {
            const int h = item >> 8, kt = (item >> 3) & 31, mt = item & 7;
            const float* ap = a.in[I_W_CQ] + (size_t)(kt * 32 + r32) * 1024 + h * 256 + 8 * kg;
            const bf16* bp = KC + ((size_t)h * 256 + mt * 32 + r32) * 256 + 8 * kg;
            const float gk = a.in[I_NORM_CROSS_G][kt * 32 + r32];
#pragma unroll 1
            for (int half = 0; half < 2; ++half) {
                f32x4 av[8][2]; u32x4 bv[8];
#pragma unroll
                for (int s = 0; s < 8; ++s) { av[s][0] = *(const f32x4*)(ap + 128 * half + 16 * s); av[s][1] = *(const f32x4*)(ap + 128 * half + 16 * s + 4); bv[s] = *(const u32x4*)(bp + 128 * half + 16 * s); }
#pragma unroll
                for (int s = 0; s < 8; ++s) { const f32x4 a0 = av[s][0] * gk, a1 = av[s][1] * gk;
                    u32x4 aw; aw.x = pk2(a0[0], a0[1]); aw.y = pk2(a0[2], a0[3]); aw.z = pk2(a1[0], a1[1]); aw.w = pk2(a1[2], a1[3]);
                    acc = __builtin_amdgcn_mfma_f32_32x32x16_bf16(__builtin_bit_cast(bf16x8_t, aw), __builtin_bit_cast(bf16x8_t, bv[s]), acc, 0, 0, 0); }
            }
            dst = (bf16*)(a.ws + WS_WQK) + (size_t)(h * 256 + mt * 32 + r32) * 1024 + kt * 32 + 4 * kg;
        } else {
            const int it = item - 1024, h = it >> 8, mt = (it >> 5) & 7, nt = it & 31;
            const bf16* ap = VC + ((size_t)h * 256 + mt * 32 + r32) * 256 + 8 * kg;
            const bf16* bp = (const bf16*)(a.ws + WS_WT_CO) + (size_t)(nt * 32 + r32) * 1024 + h * 256 + 8 * kg;
            u32x4 av[16], bv[16];
#pragma unroll
            for (int s = 0; s < 16; ++s) { av[s] = *(const u32x4*)(ap + 16 * s); bv[s] = *(const u32x4*)(bp + 16 * s); }
#pragma unroll
            for (int s = 0; s < 16; ++s) acc = __builtin_amdgcn_mfma_f32_32x32x16_bf16(__builtin_bit_cast(bf16x8_t, av[s]), __builtin_bit_cast(bf16x8_t, bv[s]), acc, 0, 0, 0);
            dst = (bf16*)(a.ws + WS_VW) + (size_t)(nt * 32 + r32) * 1024 + h * 256 + mt * 32 + 4 * kg;
        }
#pragma unroll
        for (int q = 0; q < 4; ++q) { u32x2 w; w.x = pk2(acc[4 * q], acc[4 * q + 1]); w.y = pk2(acc[4 * q + 2], acc[4 * q + 3]); *(u32x2*)(dst + 8 * q) = w; }
    }
}

__device__ __forceinline__ void conv_phase(int wv, const Args& a, int blk, int G) {
    bf16* CB = (bf16*)(a.ws + WS_A1); const bf16* U = (const bf16*)(a.ws + WS_A2); const float* cw = a.in[I_CONV_W];
    const int tid = opaque_tid(wv);
    const int c = (tid & 127) * 8;
    float w0[8], w1[8], w2[8];
#pragma unroll
    for (int e = 0; e < 8; ++e) { w0[e] = cw[c + e]; w1[e] = cw[D + c + e]; w2[e] = cw[2 * D + c + e]; }
    const size_t step = (size_t)G * 512, total = (size_t)S * D / 8;
    for (size_t i0 = (size_t)blk * 512 + tid; i0 < total; i0 += 4 * step) {
        u32x4 cb[4], u2[4], u1[4], u0[4];
#pragma unroll
        for (int q = 0; q < 4; ++q) { const size_t i = i0 + q * step; const int r = (int)(i >> 7);
            cb[q] = u2[q] = u1[q] = u0[q] = (u32x4){0, 0, 0, 0};
            if (i < total) { cb[q] = *(const u32x4*)(CB + i * 8); u2[q] = *(const u32x4*)(U + i * 8);
                if (r >= 1) u1[q] = *(const u32x4*)(U + i * 8 - D);
                if (r >= 2) u0[q] = *(const u32x4*)(U + i * 8 - 2 * D); } }
#pragma unroll
        for (int q = 0; q < 4; ++q) { const size_t i = i0 + q * step;
            u32x4 o;
#pragma unroll
            for (int e = 0; e < 4; ++e) {
                const float lo = bflo(cb[q][e]) * (w0[2 * e] * bflo(u0[q][e]) + w1[2 * e] * bflo(u1[q][e]) + w2[2 * e] * bflo(u2[q][e]));
                const float hi = bfhi(cb[q][e]) * (w0[2 * e + 1] * bfhi(u0[q][e]) + w1[2 * e + 1] * bfhi(u1[q][e]) + w2[2 * e + 1] * bfhi(u2[q][e]));
                o[e] = pk2(lo, hi);
            }
            if (i < total) st16wt(CB + i * 8, o); }
    }
}


namespace att {
typedef short bf16x8 __attribute__((ext_vector_type(8)));
typedef short s16x4 __attribute__((ext_vector_type(4)));
typedef float f32x16 __attribute__((ext_vector_type(16)));
typedef short v4i16_t __attribute__((ext_vector_type(4)));
typedef LAS const char* lds_cptr;
constexpr int SLOT = 16384, LDS_K = 0, LDS_V = 4 * SLOT, LDS_WSF = 8 * SLOT, LDS_BT = LDS_WSF + 2048, LDS_TOTAL = LDS_BT + 1024;
constexpr int LDS_XCH = 0, LDS_OST = 65536;
constexpr float LOG2E = 1.4426950408889634f, THR = 8.0f;
__device__ __forceinline__ int crow(int r, int hi) { return (r & 3) + 8 * (r >> 2) + 4 * hi; }
typedef float f32x2_t __attribute__((ext_vector_type(2))); typedef __bf16 bf16x2_t __attribute__((ext_vector_type(2)));
__device__ __forceinline__ unsigned cvtpk(float lo, float hi) { const f32x2_t v = {lo, hi}; const bf16x2_t b = __builtin_convertvector(v, bf16x2_t); return __builtin_bit_cast(unsigned, b); }
__device__ __forceinline__ void glds16(const void* g, unsigned lds_base) {
    unsigned sv; asm volatile("s_mov_b32 %0, m0\n\ts_mov_b32 m0, %2\n\ts_nop 0\n\tglobal_load_lds_dwordx4 %1, off\n\ts_mov_b32 m0, %0" : "=&s"(sv) : "v"(g), "s"(lds_base) : "memory"); }
template <int IMM> __device__ __forceinline__ void glds16s(unsigned voff, const void* sbase, unsigned lds_base) {
    unsigned sv; asm volatile("s_mov_b32 %0, m0\n\ts_mov_b32 m0, %3\n\ts_nop 0\n\tglobal_load_lds_dwordx4 %1, %2 offset:%c4\n\ts_mov_b32 m0, %0" : "=&s"(sv) : "v"(voff), "s"(sbase), "s"(lds_base), "i"(IMM) : "memory"); }
__device__ __forceinline__ s16x4 vtr(lds_cptr p) { return __builtin_bit_cast(s16x4, __builtin_amdgcn_ds_read_tr16_b64_v4i16((LAS v4i16_t*)p)); }
#define ATT_MX3(a, b, c) __builtin_fmaxf(__builtin_fmaxf((a), (b)), (c))
__device__ __forceinline__ float rowmax(const f32x16& p0, const f32x16& p1) {
    float a = ATT_MX3(p0[0], p0[1], p1[0]), b = ATT_MX3(p0[2], p0[3], p1[1]); a = ATT_MX3(a, p1[2], p1[3]);
#pragma unroll
    for (int r = 4; r < 16; r += 4) { a = ATT_MX3(a, p0[r], p0[r + 1]); b = ATT_MX3(b, p0[r + 2], p0[r + 3]); a = ATT_MX3(a, p1[r], p1[r + 1]); b = ATT_MX3(b, p1[r + 2], p1[r + 3]); }
    float m = __builtin_fmaxf(a, b); auto rr = __builtin_amdgcn_permlane32_swap(__float_as_uint(m), __float_as_uint(m), false, false);
    return __builtin_fmaxf(__uint_as_float(rr[0]), __uint_as_float(rr[1])); }
#define ATT_WAIT_BAR(N) asm volatile("s_waitcnt vmcnt(" #N ") lgkmcnt(0)\n\ts_barrier" ::: "memory")
#define ATT_LBAR() asm volatile("s_waitcnt lgkmcnt(0)\n\ts_barrier" ::: "memory")
#define ATT_MFMA(a, b, c) __builtin_amdgcn_mfma_f32_32x32x16_bf16(a, b, c, 0, 0, 0)

__device__ __forceinline__ void attn_unit_pipe(int wv, int h, int qb, const bf16* Q, const bf16* __restrict__ K, const bf16* __restrict__ V, bf16* O, LAS unsigned char* lds,
                                               float lam, const float* BTAB, const float* subln_g, const unsigned* KMAX) {
    const int tid = opaque_tid(wv), lane = tid & 63, r32 = lane & 31, hi = lane >> 5;
    const int wid = __builtin_amdgcn_readfirstlane(tid >> 6), comp = wid >> 2, rg = wid & 3;
    const int q0 = qb * 128, qw0 = q0 + 32 * rg, NT = 2 * qb + 2;
    const unsigned lds0 = (unsigned)(unsigned long long)lds;
    LAS float* wsf = (LAS float*)(lds + LDS_WSF) + wid * 64;
    LAS float* bt = (LAS float*)(lds + LDS_BT);
    const unsigned kvoff = (unsigned)lane * 2048u + (unsigned)wid * 16u;
    const unsigned vvoff = (unsigned)(16 * (wid & 3) + (lane >> 2)) * 2048u + (unsigned)((wid >> 2) * 32 + (lane & 3) * 8) * 2u;
    const char* kbase = (const char*)(K + h * 128); const char* vbase = (const char*)(V + h * 128);
    const unsigned kdst = lds0 + LDS_K + wid * 1024, vdst = lds0 + LDS_V + wid * 1024;
#define ATT_RFL(x) ((unsigned)__builtin_amdgcn_readfirstlane((int)(x)))
#define DMA_K(t, so) do { const char* b_ = kbase + (size_t)(t) * 131072; glds16s<0>(kvoff, b_, ATT_RFL(kdst + (so))); glds16s<128>(kvoff, b_, ATT_RFL(kdst + (so) + 8192 - 128)); } while (0)
#define DMA_V(t, so) do { const char* b_ = vbase + (size_t)(t) * 131072; glds16s<0>(vvoff, b_, ATT_RFL(vdst + (so))); glds16s<128>(vvoff, b_, ATT_RFL(vdst + (so) + 8192 - 128)); } while (0)
#define DMA_K0(t, so) do { const char* b_ = kbase + (size_t)(t) * 131072; glds16s<0>(kvoff, b_, ATT_RFL(kdst + (so))); } while (0)
#define DMA_K1(t, so) do { const char* b_ = kbase + (size_t)(t) * 131072; glds16s<128>(kvoff, b_, ATT_RFL(kdst + (so) + 8192 - 128)); } while (0)
#define DMA_V0(t, so) do { const char* b_ = vbase + (size_t)(t) * 131072; glds16s<0>(vvoff, b_, ATT_RFL(vdst + (so))); } while (0)
#define DMA_V1(t, so) do { const char* b_ = vbase + (size_t)(t) * 131072; glds16s<128>(vvoff, b_, ATT_RFL(vdst + (so) + 8192 - 128)); } while (0)
    DMA_K(0, 0); DMA_K(1, SLOT); DMA_V(0, 0); if (NT > 2) DMA_K(2, 2 * SLOT);
    const float* bth = BTAB + h * 132;
    bf16x8 qr[4];
    float cfar;
    { const bf16* Qw = Q + (size_t)(qw0 + r32) * 1024 + h * 128 + comp * 64 + hi * 8;
#pragma unroll
      for (int d0 = 0; d0 < 4; ++d0) qr[d0] = *(const bf16x8*)(Qw + d0 * 16);
      float btv = 0.f; if (tid < 129) btv = bth[tid];
      const float bmax = bth[129], bfar = bth[130];
      const float kmx = sqrtf(__uint_as_float(KMAX[(h * 2 + comp) * 2]) + __uint_as_float(KMAX[(h * 2 + comp) * 2 + 1])) * 1.02f;
      if (tid < 129) bt[tid] = btv;
      float s = 0.f;
#pragma unroll
      for (int d0 = 0; d0 < 4; ++d0)
#pragma unroll
          for (int e2 = 0; e2 < 8; ++e2) { const float f = __builtin_bit_cast(float, (unsigned)(unsigned short)qr[d0][e2] << 16); s += f * f; }
      auto rr = __builtin_amdgcn_permlane32_swap(__float_as_uint(s), __float_as_uint(s), false, false); s = __uint_as_float(rr[0]) + __uint_as_float(rr[1]);
      cfar = bfar - (sqrtf(s) * 1.01f * kmx + bmax); }
    f32x16 cf;
#pragma unroll
    for (int r = 0; r < 16; ++r) cf[r] = cfar;
    asm volatile("" : "+v"(cf));
    const lds_cptr kp0 = (lds_cptr)(lds + LDS_K) + comp * 8192 + hi * 1024 + r32 * 16;
    const lds_cptr vp0 = (lds_cptr)(lds + LDS_V) + ((lane >> 4) & 1) * 32 + (lane & 3) * 8 + (4 * hi + ((lane & 15) >> 2)) * 64;
    float l_reg = 0.f;
    f32x16 o[4];
#pragma unroll
    for (int d0 = 0; d0 < 4; ++d0)
#pragma unroll
        for (int r = 0; r < 16; ++r) o[d0][r] = 0.f;
    bf16x8 kf[8];
    f32x16 pA0, pA1, pB0, pB1;
    u32x4 pw0, pw1, pw2, pw3;
    s16x4 vl0, vh0, vl1, vh1;
#define SBAR() __builtin_amdgcn_sched_barrier(0)
#define PIN(x) asm volatile("" : "+v"(x))
#define PKW(P, B) cvtpk(P[B], P[B + 1])
#define PAF(k) __builtin_bit_cast(bf16x8, pw##k)
#define EX(v) __builtin_amdgcn_exp2f(v)
#define ROT3() do { const int t_ = s0; s0 = s1; s1 = s2; s2 = t_; } while (0)
#define ENDW(t) do { if ((t) + 3 < NT) { ATT_WAIT_BAR(4); } else if ((t) + 1 < NT) { ATT_WAIT_BAR(2); } else { ATT_WAIT_BAR(0); } } while (0)
#define KLD(f, kp_) kf[f] = *(LAS const bf16x8*)((kp_) + ((f) >> 1) * 2048 + ((f) & 1) * 512)
#define BANDFIX(C0, C1, t) do { if (__builtin_expect(64 * (t) + 63 + 128 > qw0, 0)) { const int ln_ = opaque_tid(0);   \
        const int dq = qw0 + (ln_ & 31) - 64 * (t) - 4 * (ln_ >> 5); \
        _Pragma("unroll") for (int r = 0; r < 16; ++r) { const int d0_ = dq - ((r & 3) + 8 * (r >> 2)), d1_ = d0_ - 32; \
            const float b0 = bt[min(max(d0_, 0), 128)], b1 = bt[min(max(d1_, 0), 128)]; \
            C0[r] = d0_ < 0 ? -INFINITY : C0[r] + b0; C1[r] = d1_ < 0 ? -INFINITY : C1[r] + b1; } } } while (0)
#define VRD(j, i, vp_) do { vl##j = vtr((vp_) + ((i) & 3) * 4096 + ((i) >> 2) * 1024); vh##j = vtr((vp_) + ((i) & 3) * 4096 + ((i) >> 2) * 1024 + 512); } while (0)
#define VFR(j) (bf16x8){vl##j[0], vl##j[1], vl##j[2], vl##j[3], vh##j[0], vh##j[1], vh##j[2], vh##j[3]}
#define KSL(t) ((((t) & 3)) * SLOT)
#define GAPA(MF, A0, A1, A2, A3, W0, W1, PWX) do { MF; sacc += A0; sacc += A1; sacc += A2; sacc += A3; PIN(sacc); W0; W1; PIN(PWX); SBAR(); } while (0)
#define PHASE_A(C0, C1, P0, P1, vp_, t) do { float sacc = P0[0] + P0[1]; \
        GAPA(C0 = ATT_MFMA(kf[0], qr[0], cf), P0[2], P0[3], P0[4], P0[5],     pw0[0] = PKW(P0, 0), pw0[1] = PKW(P0, 2), pw0); \
        GAPA(C1 = ATT_MFMA(kf[1], qr[0], cf), P0[6], P0[7], P0[8], P0[9],     pw0[2] = PKW(P0, 4), pw0[3] = PKW(P0, 6), pw0); \
        if ((t) + 3 < NT) DMA_K0((t) + 3, KSL((t) + 3)); SBAR(); \
        GAPA(C0 = ATT_MFMA(kf[2], qr[1], C0), P0[10], P0[11], P0[12], P0[13], pw1[0] = PKW(P0, 8), pw1[1] = PKW(P0, 10), pw1); \
        GAPA(C1 = ATT_MFMA(kf[3], qr[1], C1), P0[14], P0[15], P1[0], P1[1],   pw1[2] = PKW(P0, 12), pw1[3] = PKW(P0, 14), pw1); \
        if ((t) + 3 < NT) DMA_K1((t) + 3, KSL((t) + 3)); SBAR(); \
        GAPA(C0 = ATT_MFMA(kf[4], qr[2], C0), P1[2], P1[3], P1[4], P1[5],     pw2[0] = PKW(P1, 0), pw2[1] = PKW(P1, 2), pw2); \
        GAPA(C1 = ATT_MFMA(kf[5], qr[2], C1), P1[6], P1[7], P1[8], P1[9],     pw2[2] = PKW(P1, 4), pw2[3] = PKW(P1, 6), pw2); \
        if ((t) + 1 < NT) DMA_V0((t) + 1, KSL((t) + 1)); SBAR(); \
        GAPA(C0 = ATT_MFMA(kf[6], qr[3], C0), P1[10], P1[11], P1[12], P1[13], pw3[0] = PKW(P1, 8), pw3[1] = PKW(P1, 10), pw3); \
        VRD(0, 0, vp_); SBAR(); \
        GAPA(C1 = ATT_MFMA(kf[7], qr[3], C1), P1[14], P1[15], 0.f, 0.f,       pw3[2] = PKW(P1, 12), pw3[3] = PKW(P1, 14), pw3); \
        if ((t) + 1 < NT) DMA_V1((t) + 1, KSL((t) + 1)); SBAR(); \
        l_reg += sacc; } while (0)
#define GAPB(i, j, jn, X, XB, DOEX, GL, vp_, kp_, N0, N1, DOSP) do { if ((i) + 1 < 16) { VRD(jn, (i) + 1, vp_); } \
        if ((GL) && ((i) & 1)) { KLD((i) >> 1, kp_); } SBAR(); \
        o[(i) & 3] = ATT_MFMA(PAF_SEL((i) >> 2), VFR(j), o[(i) & 3]); \
        if (DOEX) { X[XB] = EX(X[XB]); X[XB + 1] = EX(X[XB + 1]); PIN(X); } \
        SBAR(); } while (0)
#define PAF_SEL(k) ((k) == 0 ? PAF(0) : (k) == 1 ? PAF(1) : (k) == 2 ? PAF(2) : PAF(3))
#define PHASE_B(C0, C1, DOEX, GL, vp_, kp_, N0, N1, DOSP) do { \
        GAPB(0, 0, 1, C0, 0, DOEX, GL, vp_, kp_, N0, N1, DOSP); GAPB(1, 1, 0, C0, 2, DOEX, GL, vp_, kp_, N0, N1, DOSP); GAPB(2, 0, 1, C0, 4, DOEX, GL, vp_, kp_, N0, N1, DOSP); GAPB(3, 1, 0, C0, 6, DOEX, GL, vp_, kp_, N0, N1, DOSP); \
        GAPB(4, 0, 1, C0, 8, DOEX, GL, vp_, kp_, N0, N1, DOSP); GAPB(5, 1, 0, C0, 10, DOEX, GL, vp_, kp_, N0, N1, DOSP); GAPB(6, 0, 1, C0, 12, DOEX, GL, vp_, kp_, N0, N1, DOSP); GAPB(7, 1, 0, C0, 14, DOEX, GL, vp_, kp_, N0, N1, DOSP); \
        GAPB(8, 0, 1, C1, 0, DOEX, GL, vp_, kp_, N0, N1, DOSP); GAPB(9, 1, 0, C1, 2, DOEX, GL, vp_, kp_, N0, N1, DOSP); GAPB(10, 0, 1, C1, 4, DOEX, GL, vp_, kp_, N0, N1, DOSP); GAPB(11, 1, 0, C1, 6, DOEX, GL, vp_, kp_, N0, N1, DOSP); \
        GAPB(12, 0, 1, C1, 8, DOEX, GL, vp_, kp_, N0, N1, DOSP); GAPB(13, 1, 0, C1, 10, DOEX, GL, vp_, kp_, N0, N1, DOSP); GAPB(14, 0, 1, C1, 12, DOEX, GL, vp_, kp_, N0, N1, DOSP); GAPB(15, 1, 0, C1, 14, DOEX, GL, vp_, kp_, N0, N1, DOSP); \
        } while (0)
#define DMA_GROUP(t) do { if ((t) + 3 < NT) DMA_K((t) + 3, KSL((t) + 3)); if ((t) + 1 < NT) DMA_V((t) + 1, KSL((t) + 1)); } while (0)
#define STEP(C0, C1, P0, P1, t) do { const lds_cptr vpp = vp0 + KSL((t) - 1); const lds_cptr kpn = kp0 + KSL((t) + 1); \
        PHASE_A(C0, C1, P0, P1, vpp, t); \
        BANDFIX(C0, C1, t); \
        if (comp != 0) { ENDW(t); } \
        SBAR(); \
        PHASE_B(C0, C1, true, true, vpp, kpn, P0, P1, true); PIN(P0); PIN(P1); \
        if (comp == 0) { ENDW(t); } } while (0)
#define PACKSUM(P0, P1) do { float sacc = 0.f; _Pragma("unroll") for (int r = 0; r < 16; ++r) sacc += P0[r] + P1[r]; l_reg += sacc; \
        pw0 = (u32x4){PKW(P0, 0), PKW(P0, 2), PKW(P0, 4), PKW(P0, 6)}; pw1 = (u32x4){PKW(P0, 8), PKW(P0, 10), PKW(P0, 12), PKW(P0, 14)}; \
        pw2 = (u32x4){PKW(P1, 0), PKW(P1, 2), PKW(P1, 4), PKW(P1, 6)}; pw3 = (u32x4){PKW(P1, 8), PKW(P1, 10), PKW(P1, 12), PKW(P1, 14)}; } while (0)

    if (NT > 2) { ATT_WAIT_BAR(4); } else { ATT_WAIT_BAR(2); }
    if (comp != 0) { DMA_GROUP(0); }
    {
#pragma unroll
      for (int f = 0; f < 8; ++f) KLD(f, kp0);
      pA0 = ATT_MFMA(kf[0], qr[0], cf); pA1 = ATT_MFMA(kf[1], qr[0], cf);
#pragma unroll
      for (int d0 = 1; d0 < 4; ++d0) { pA0 = ATT_MFMA(kf[2 * d0], qr[d0], pA0); pA1 = ATT_MFMA(kf[2 * d0 + 1], qr[d0], pA1); } }
    SBAR();
    BANDFIX(pA0, pA1, 0);
    if (comp == 0) { DMA_GROUP(0); } else { ENDW(0); }
    {
#pragma unroll
        for (int r = 0; r < 16; ++r) { pA0[r] = EX(pA0[r]); pA1[r] = EX(pA1[r]); }
#pragma unroll
        for (int f = 0; f < 8; ++f) KLD(f, kp0 + KSL(1));
    }
    if (comp == 0) { ENDW(0); }
    {
        int t = 1;
        for (; t + 2 < NT; t += 2) { STEP(pB0, pB1, pA0, pA1, t); STEP(pA0, pA1, pB0, pB1, t + 1); }
        STEP(pB0, pB1, pA0, pA1, t);
        PACKSUM(pB0, pB1);
        VRD(0, 0, vp0 + KSL(NT - 1)); SBAR();
        PHASE_B(pA0, pA1, false, false, vp0 + KSL(NT - 1), kp0, pA0, pA1, false);
    }
    float l = l_reg;
    { auto rr = __builtin_amdgcn_permlane32_swap(__float_as_uint(l), __float_as_uint(l), false, false); l = __uint_as_float(rr[0]) + __uint_as_float(rr[1]); }
    if (hi == 0) wsf[32 + r32] = l;
    float rli[16];
#pragma unroll
    for (int r = 0; r < 16; ++r) rli[r] = __builtin_amdgcn_rcpf(wsf[32 + crow(r, hi)]);
    ATT_LBAR();
    LAS float* xch = (LAS float*)(lds + LDS_XCH) + rg * 4096;
    if (comp == 1) {
#pragma unroll
        for (int d0 = 0; d0 < 4; ++d0)
#pragma unroll
            for (int r = 0; r < 16; ++r) xch[(d0 * 16 + r) * 64 + lane] = o[d0][r] * rli[r] * lam;
    }
    ATT_LBAR();
    if (comp == 0) {
        float ss[16];
#pragma unroll
        for (int r = 0; r < 16; ++r) { float s_ = 0.f;
#pragma unroll
            for (int d0 = 0; d0 < 4; ++d0) { const float v = o[d0][r] * rli[r] - xch[(d0 * 16 + r) * 64 + lane]; o[d0][r] = v; s_ += v * v; }
            ss[r] = s_; }
#pragma unroll
        for (int r = 0; r < 16; ++r) {
            float v = ss[r]; v += pg8::dppf<0xB1>(v); v += pg8::dppf<0x4E>(v); v += pg8::dppf<0x141>(v); v += pg8::dppf<0x140>(v);
            auto sw = __builtin_amdgcn_permlane16_swap(__float_as_uint(v), __float_as_uint(v), false, false); ss[r] = __uint_as_float(sw[0]) + __uint_as_float(sw[1]); }
        LAS bf16* stg = (LAS bf16*)(lds + LDS_OST) + rg * 4096;
        float g4[4];
#pragma unroll
        for (int d0 = 0; d0 < 4; ++d0) g4[d0] = subln_g[d0 * 32 + r32];
#pragma unroll
        for (int r = 0; r < 16; ++r) { const float rs = 0.8f * __builtin_amdgcn_rsqf(ss[r] * (1.0f / 128.0f) + 1e-5f); const int orow = crow(r, hi);
#pragma unroll
            for (int d0 = 0; d0 < 4; ++d0) stg[orow * 128 + d0 * 32 + r32] = (bf16)f2bf(o[d0][r] * rs * g4[d0]); }
#pragma unroll
        for (int i = 0; i < 8; ++i) { const int row = i * 4 + (lane >> 4), ch = lane & 15;
            const u32x4 v = *(LAS const u32x4*)(stg + row * 128 + ch * 8);
            st16wt(O + (size_t)(qw0 + row) * 1024 + h * 128 + ch * 8, v); }
    }
    ATT_LBAR();
#undef ATT_RFL
#undef DMA_K
#undef DMA_V
#undef SBAR
#undef PIN
#undef PKW
#undef PAF
#undef EX
#undef ROT3
#undef ENDW
#undef KLD
#undef BANDFIX
#undef VRD
#undef VFR
#undef GAPA
#undef PHASE_A
#undef GAPB
#undef PAF_SEL
#undef PHASE_B
#undef STEP
#undef PACKSUM
#undef KSL
#undef DMA_GROUP
}

__device__ __forceinline__ void attn_phase(int wv, const Args& a, LAS unsigned char* lds, int blk, int G, bf16* Odst) {
    const float* BTAB = (const float*)(a.ws + WS_BTAB);
    const float lam = __builtin_bit_cast(float, __builtin_amdgcn_readfirstlane(__builtin_bit_cast(int, BTAB[8 * 132])));
    const bf16* Q = (const bf16*)(a.ws + WS_A3); const bf16* K = (const bf16*)(a.ws + WS_A4); const bf16* V = (const bf16*)(a.ws + WS_A5);
    const bool snake = (1024 % G) == 0;
    for (int j = 0;; ++j) {
        const int idx = j * G + blk; if (idx >= 1024) break;
        const int rank = (snake && (j & 1)) ? (j * G + (G - 1 - blk)) : idx;
        attn_unit_pipe(wv, rank & 7, 127 - (rank >> 3), Q, K, V, Odst, lds, lam, BTAB, a.in[I_SUBLN_G], (const unsigned*)(a.ws + WS_KMAX));
    }
}
}


__device__ __forceinline__ void peer_convert(int wv, const Args& a, int blk, int G) {
    const int tid = opaque_tid(wv), lane = tid & 63, gw = blk * 8 + (tid >> 6);
    for (int which = 0; which < 2; ++which) {
        const float* src = a.in[which ? I_PEER_V : I_PEER_U]; unsigned* dst = (unsigned*)(a.ws + (which ? WS_PV : WS_PU));
        const size_t nchunk = (size_t)16384 * 1024 / 1024, stride = (size_t)G * 8;
        for (size_t c = gw; c < nchunk; c += 2 * stride) {
            const size_t c1 = c + stride; const bool two = c1 < nchunk;
            f32x4 v[8];
#pragma unroll
            for (int j = 0; j < 4; ++j) v[j] = __builtin_nontemporal_load((const f32x4*)(src + c * 1024 + 256 * j + 4 * lane));
            if (two) {
#pragma unroll
                for (int j = 0; j < 4; ++j) v[4 + j] = __builtin_nontemporal_load((const f32x4*)(src + c1 * 1024 + 256 * j + 4 * lane)); }
#pragma unroll
            for (int j = 0; j < 4; ++j) { const f32x4 x = v[j] * 128.0f; int w = __builtin_amdgcn_cvt_pk_fp8_f32(x[0], x[1], 0, false); w = __builtin_amdgcn_cvt_pk_fp8_f32(x[2], x[3], w, true);
                dst[c * 256 + 64 * j + lane] = (unsigned)w; }
            if (two) {
#pragma unroll
                for (int j = 0; j < 4; ++j) { const f32x4 x = v[4 + j] * 128.0f; int w = __builtin_amdgcn_cvt_pk_fp8_f32(x[0], x[1], 0, false); w = __builtin_amdgcn_cvt_pk_fp8_f32(x[2], x[3], w, true);
                    dst[c1 * 256 + 64 * j + lane] = (unsigned)w; } }
        } }
}
namespace peer {
typedef float f32x2v __attribute__((ext_vector_type(2)));
template <int CTRL> __device__ __forceinline__ float dpp(float x) { return __builtin_bit_cast(float, __builtin_amdgcn_mov_dpp(__builtin_bit_cast(int, x), CTRL, 0xf, 0xf, true)); }
template <int CTRL> __device__ __forceinline__ unsigned dppu(unsigned x) { return (unsigned)__builtin_amdgcn_mov_dpp((int)x, CTRL, 0xf, 0xf, true); }
__device__ __forceinline__ unsigned half32_umax(unsigned m) {
    unsigned t = dppu<0xB1>(m); m = t > m ? t : m; t = dppu<0x4E>(m); m = t > m ? t : m; t = dppu<0x141>(m); m = t > m ? t : m; t = dppu<0x140>(m); m = t > m ? t : m;
    auto s = __builtin_amdgcn_permlane16_swap(m, m, false, false); return s[0] > s[1] ? s[0] : s[1]; }
__device__ __forceinline__ float row16_sum(float x) { x += dpp<0xB1>(x); x += dpp<0x4E>(x); x += dpp<0x141>(x); x += dpp<0x140>(x); return x; }
__device__ __forceinline__ float wsum(float x) {
    x += dpp<0xB1>(x); x += dpp<0x4E>(x); x += dpp<0x141>(x); x += dpp<0x140>(x);
    auto s = __builtin_amdgcn_permlane16_swap(__float_as_uint(x), __float_as_uint(x), false, false); x = __uint_as_float(s[0]) + __uint_as_float(s[1]);
    auto t = __builtin_amdgcn_permlane32_swap(__float_as_uint(x), __float_as_uint(x), false, false); return __uint_as_float(t[0]) + __uint_as_float(t[1]);
}
__device__ __forceinline__ void peer_phase(int wv, const Args& a, int blk, int G, float* OUTP) {
    const int tid = opaque_tid(wv), lane = tid & 63, wave = tid >> 6, hh = lane >> 5, l32 = lane & 31;
    const unsigned* TK = (const unsigned*)(a.ws + WS_TOPK); const unsigned char* PU = (const unsigned char*)(a.ws + WS_PU); const unsigned char* PVt = (const unsigned char*)(a.ws + WS_PV);
    const float* gF = a.in[I_NORM_FFN_G]; const float* gO = a.in[I_FINAL_G];
    int ci0 = 0, cj0 = 0, ci1 = 0, cj1 = 0; bool valid1 = false;
    { int p = 0;
      for (int i = 0; i < 16; ++i) for (int j = 0; j < 16; ++j) if ((i + 1) * (j + 1) <= 16) { if (p == l32) { ci0 = i; cj0 = j; } if (p == l32 + 32) { ci1 = i; cj1 = j; valid1 = true; } ++p; } }
    for (int tok = blk * 8 + wave; tok < S; tok += G * 8) {
        const unsigned short* xrow = (const unsigned short*)(a.ws + WS_A2) + (size_t)tok * D + 16 * lane;
        f32x4 xa[4];
        { const u32x4 r0 = *(const u32x4*)xrow, r1 = *(const u32x4*)(xrow + 8);
          xa[0] = (f32x4){bflo(r0.x), bfhi(r0.x), bflo(r0.y), bfhi(r0.y)}; xa[1] = (f32x4){bflo(r0.z), bfhi(r0.z), bflo(r0.w), bfhi(r0.w)};
          xa[2] = (f32x4){bflo(r1.x), bfhi(r1.x), bflo(r1.y), bfhi(r1.y)}; xa[3] = (f32x4){bflo(r1.z), bfhi(r1.z), bflo(r1.w), bfhi(r1.w)}; }
        unsigned key[4];
#pragma unroll
        for (int i = 0; i < 4; ++i) key[i] = TK[(size_t)tok * 256 + lane + 64 * i];
        float ss = 0.f;
#pragma unroll
        for (int j = 0; j < 4; ++j) ss += (xa[j][0] * xa[j][0] + xa[j][1] * xa[j][1]) + (xa[j][2] * xa[j][2] + xa[j][3] * xa[j][3]);
        ss = wsum(ss);
        const float rstd = 1.0f / sqrtf(ss * (1.0f / D) + 1e-6f);
        float hf[16];
#pragma unroll
        for (int j = 0; j < 4; ++j) { const f32x4 gg = *(const f32x4*)(gF + 16 * lane + 4 * j);
#pragma unroll
            for (int e = 0; e < 4; ++e) hf[4 * j + e] = xa[j][e] * rstd * gg[e]; }
        int ex[4]; float gw[4];
#pragma unroll
        for (int i = 0; i < 4; ++i) {
            const unsigned k = key[i];
            const float v = pg8::ord2f(k & ~0x7Fu); const int ix = 127 - (int)(k & 0x7Fu);
            const float s0 = __shfl(v, hh * 32 + ci0) + __shfl(v, hh * 32 + 16 + cj0);
            const float s1 = __shfl(v, hh * 32 + ci1) + __shfl(v, hh * 32 + 16 + cj1);
            unsigned ck0 = (pg8::f2ord(s0) & ~0xFFu) | (unsigned)(255 - (ci0 * 16 + cj0));
            unsigned ck1 = valid1 ? ((pg8::f2ord(s1) & ~0xFFu) | (unsigned)(255 - (ci1 * 16 + cj1))) : 0u;
            unsigned win = 0u;
#pragma unroll
            for (int r = 0; r < 16; ++r) {
                const unsigned m = half32_umax(ck0 > ck1 ? ck0 : ck1);
                if (l32 == r) win = m;
                if (ck0 == m) ck0 = 0u;
                if (ck1 == m) ck1 = 0u;
            }
            const float ts = pg8::ord2f(win & ~0xFFu); const int flat = 255 - (int)(win & 0xFFu);
            const float mx = __shfl(ts, hh * 32);
            const float e = (l32 < 16) ? __expf(ts - mx) : 0.f;
            const float sum = row16_sum(e);
            gw[i] = e / sum;
            const int e0 = __shfl(ix, hh * 32 + ((flat >> 4) & 15)), e1 = __shfl(ix, hh * 32 + 16 + (flat & 15));
            ex[i] = e0 * 128 + e1;
        }
        float acc[16];
#pragma unroll
        for (int j = 0; j < 16; ++j) acc[j] = 0.f;
#pragma unroll 1
        for (int b = 0; b < 16; ++b) {
            const int i = b >> 2, sl = ((b >> 1) & 1) * 32 + (b & 1) * 8;
            const int exv = i == 0 ? ex[0] : i == 1 ? ex[1] : i == 2 ? ex[2] : ex[3];
            const float gwv = i == 0 ? gw[0] : i == 1 ? gw[1] : i == 2 ? gw[2] : gw[3];
            u32x4 uu[8], vv[8];
#pragma unroll
            for (int q = 0; q < 8; ++q) { const int eid = __builtin_amdgcn_readlane(exv, sl + q); uu[q] = *(const u32x4*)(PU + (size_t)eid * 1024 + 16 * lane); vv[q] = *(const u32x4*)(PVt + (size_t)eid * 1024 + 16 * lane); }
            float d[8];
#pragma unroll
            for (int q = 0; q < 8; ++q) { float s_ = 0.f;
#pragma unroll
                for (int e = 0; e < 4; ++e) { const f32x2v lo = __builtin_amdgcn_cvt_pk_f32_fp8((int)uu[q][e], false), hi2 = __builtin_amdgcn_cvt_pk_f32_fp8((int)uu[q][e], true);
                    s_ += (lo[0] * hf[4 * e] + lo[1] * hf[4 * e + 1]) + (hi2[0] * hf[4 * e + 2] + hi2[1] * hf[4 * e + 3]); }
                d[q] = s_; }
            float z;
            { const bool b0 = lane & 1, b1 = lane & 2, b2 = lane & 4;
              float r4[4], r2[2];
#pragma unroll
              for (int q = 0; q < 4; ++q) { const float keep = b0 ? d[q + 4] : d[q], give = b0 ? d[q] : d[q + 4]; r4[q] = keep + dpp<0xB1>(give); }
#pragma unroll
              for (int q = 0; q < 2; ++q) { const float keep = b1 ? r4[q + 2] : r4[q], give = b1 ? r4[q] : r4[q + 2]; r2[q] = keep + dpp<0x4E>(give); }
              { const float keep = b2 ? r2[1] : r2[0], give = b2 ? r2[0] : r2[1];
                const float up = dpp<0x104>(give), dn = dpp<0x114>(give);
                z = keep + (b2 ? dn : up); }
              z += dpp<0x128>(z);
              auto s16 = __builtin_amdgcn_permlane16_swap(__float_as_uint(z), __float_as_uint(z), false, false); z = __uint_as_float(s16[0]) + __uint_as_float(s16[1]);
              auto s32 = __builtin_amdgcn_permlane32_swap(__float_as_uint(z), __float_as_uint(z), false, false); z = __uint_as_float(s32[0]) + __uint_as_float(s32[1]); }
            const int myq = 4 * (lane & 1) + 2 * ((lane >> 1) & 1) + ((lane >> 2) & 1);
            const float gmine = __shfl(gwv, sl + myq);
            z *= (1.0f / 128.0f);
            const float wl = gmine * 0.5f * z * (1.0f + erff(z * 0.70710678118654752f)) * (1.0f / 128.0f);
#pragma unroll
            for (int q = 0; q < 8; ++q) { const float w = __builtin_bit_cast(float, __builtin_amdgcn_readlane(__builtin_bit_cast(int, wl), ((q >> 2) & 1) | (((q >> 1) & 1) << 1) | ((q & 1) << 2)));
#pragma unroll
                for (int e = 0; e < 4; ++e) { const f32x2v lo = __builtin_amdgcn_cvt_pk_f32_fp8((int)vv[q][e], false), hi2 = __builtin_amdgcn_cvt_pk_f32_fp8((int)vv[q][e], true);
                    acc[4 * e] += w * lo[0]; acc[4 * e + 1] += w * lo[1]; acc[4 * e + 2] += w * hi2[0]; acc[4 * e + 3] += w * hi2[1]; } }
        }
        float s3 = 0.f;
#pragma unroll
        for (int j = 0; j < 4; ++j)
#pragma unroll
            for (int e = 0; e < 4; ++e) { xa[j][e] += acc[4 * j + e]; s3 += xa[j][e] * xa[j][e]; }
        s3 = wsum(s3);
        const float r3 = 1.0f / sqrtf(s3 * (1.0f / D) + 1e-6f);
        float* orow = OUTP + (size_t)tok * D + 16 * lane;
#pragma unroll
        for (int j = 0; j < 4; ++j) { const f32x4 gg = *(const f32x4*)(gO + 16 * lane + 4 * j); *(f32x4*)(orow + 4 * j) = xa[j] * r3 * gg; }
    }
}
}

#define XB_TMO      128
#define XB_XCNT(j)  (256  + 64 * (j))
#define XB_XSUB(j)  (1280 + 64 * (j))
#define XB_XGEN(j)  (2304 + 64 * (j))
#define XB_TOP      3328
#define XB_TOPGEN   3392
#define XCD_BAR_WORDS 3456
#define XB_SPIN_CAP (1u << 18)

__device__ __forceinline__ unsigned xb_ld(unsigned* p)              { return __hip_atomic_load(p, __ATOMIC_RELAXED, __HIP_MEMORY_SCOPE_AGENT); }
__device__ __forceinline__ unsigned xb_add(unsigned* p, unsigned v) { return __hip_atomic_fetch_add(p, v, __ATOMIC_RELAXED, __HIP_MEMORY_SCOPE_AGENT); }
__device__ __forceinline__ unsigned xb_xcc_id() { return (unsigned)__builtin_amdgcn_s_getreg((3 << 11) | 20) & 0xFu; }
#define XB_SPIN(cond, bar) do { unsigned _sp = 0; while (cond) { __builtin_amdgcn_s_sleep(1); \
    if ((++_sp & 255u) == 0u) { if (xb_ld(&(bar)[XB_TMO])) break; if (_sp > XB_SPIN_CAP) { atomicAdd(&(bar)[XB_TMO], 1u); break; } } } } while (0)

struct XcdBarrier {
    unsigned* bar; unsigned x;
    volatile LAS unsigned* st;
};

__device__ __forceinline__ XcdBarrier xcd_barrier_post(unsigned* bar, volatile LAS unsigned* st, int tid) {
    XcdBarrier b; b.bar = bar; b.x = xb_xcc_id(); b.st = st;
    if (tid == 0) (void)xb_add(&bar[XB_XCNT(b.x)], 1u);
    return b;
}
__device__ __forceinline__ void xcd_barrier_complete(unsigned* bar, unsigned x, unsigned& nloc, unsigned& nx) {
    const unsigned G = gridDim.x * gridDim.y * gridDim.z;
    unsigned sum, cnt, mine, sp = 0u;
    for (;;) {
        sum = 0u; cnt = 0u; mine = 0u;
#pragma unroll
        for (unsigned j = 0; j < 16; ++j) { const unsigned c = xb_ld(&bar[XB_XCNT(j)]); sum += c; cnt += (c > 0u) ? 1u : 0u; mine = (j == x) ? c : mine; }
        if (sum == G) break;
        __builtin_amdgcn_s_sleep(1);
        if ((++sp & 255u) == 0u) { if (xb_ld(&bar[XB_TMO])) break; if (sp > XB_SPIN_CAP) { atomicAdd(&bar[XB_TMO], 1u); break; } }
    }
    nloc = mine > 0u ? mine : 1u; nx = cnt > 0u ? cnt : 1u;
}

__device__ __forceinline__ void xcd_barrier(const XcdBarrier& b, int tid) {
    asm volatile("s_waitcnt vmcnt(0)" ::: "memory");
    __syncthreads();
    if (tid == 0) {
        unsigned* bar = b.bar;
        __builtin_amdgcn_s_waitcnt(0);
        unsigned nloc = b.st[0], nx = b.st[1];
        if (nloc == 0u) { xcd_barrier_complete(bar, b.x, nloc, nx); b.st[0] = nloc; b.st[1] = nx; }
        const unsigned old = xb_add(&bar[XB_XSUB(b.x)], 1u);
        const unsigned gen = old / nloc;
        if (old + 1u == (gen + 1u) * nloc) {
            __builtin_amdgcn_fence(__ATOMIC_RELEASE, "agent");
            asm volatile("s_waitcnt vmcnt(0)" ::: "memory");
            const unsigned og = xb_add(&bar[XB_TOP], 1u);
            const unsigned tg = og / nx;
            if (og + 1u == (tg + 1u) * nx) xb_add(&bar[XB_TOPGEN], 1u);
            else XB_SPIN(xb_ld(&bar[XB_TOPGEN]) == tg, bar);
            __builtin_amdgcn_fence(__ATOMIC_ACQUIRE, "agent");
            xb_add(&bar[XB_XGEN(b.x)], 1u);
            asm volatile("s_waitcnt vmcnt(0)" ::: "memory");
        } else {
            XB_SPIN(xb_ld(&bar[XB_XGEN(b.x)]) == gen, bar);
            __builtin_amdgcn_fence(__ATOMIC_ACQUIRE, "agent");
            asm volatile("s_waitcnt vmcnt(0)" ::: "memory");
        }
    }
    __syncthreads();
}

constexpr int LDS_BYTES = 147456, LDS_MISC = 139264;
__global__ void __launch_bounds__(512, 2) mk_fwd(Args a) {
    extern __shared__ __attribute__((aligned(16))) unsigned char lds_raw[];
    LAS unsigned char* lds = (LAS unsigned char*)lds_raw;
    unsigned char* ws = a.ws;
    const int G = gridDim.x, blk = blockIdx.x, wv = __builtin_amdgcn_readfirstlane(threadIdx.x >> 6);
    { const int t0 = opaque_tid(wv); if (t0 < 16) ((volatile LAS unsigned*)(lds + LDS_MISC))[t0] = 0u; }
    __syncthreads();
    XcdBarrier bar = xcd_barrier_post((unsigned*)(ws + WS_CTL), (volatile LAS unsigned*)(lds + LDS_MISC), opaque_tid(wv));
#define IN(k) (a.ph_lo <= (k) && (k) < a.ph_hi)
#define SEAM(k) do { if (IN(k) && IN((k) + 1)) xcd_barrier(bar, opaque_tid(wv)); } while (0)
    if (IN(0)) p0_prologue(wv, a, lds, blk, G);
    SEAM(0);
    if (IN(1)) {
        pg8::Gemm g{(const bf16*)(ws + WS_A0), (const bf16*)(ws + WS_WT_IN), S, NCOLS, D, D, D}; pg8::StaticOrder So; So.init(S, NCOLS, G, blk);
        pg8::EpiProj E{(const float*)(ws + WS_RSTD0), (bf16*)(ws + WS_A1), (bf16*)(ws + WS_A2), (bf16*)(ws + WS_A3), (bf16*)(ws + WS_A4), (bf16*)(ws + WS_A5), (bf16*)(ws + WS_A6), (bf16*)a.out, 0.125f * 1.4426950408889634f, (unsigned*)(ws + WS_KMAX), (PG8_LAS float*)(lds + 131072)};
        pg8::gemm_phase<pg8::EpiProj, pg8::StaticOrder, true, true>(wv, lds, g, So, E);
    }
    SEAM(1);
    if (IN(2)) { conv_phase(wv, a, blk, G);  att::attn_phase(wv, a, lds, blk, G, (bf16*)(ws + WS_A3)); }
    SEAM(2);
    if (IN(3)) {
        pg8::StaticOrder So; So.init(S, D, G, blk);
        { pg8::Gemm g{(const bf16*)(ws + WS_A1), (const bf16*)(ws + WS_WT_CONV), S, D, 2 * D, D, D};
          const pg8::Split sp{16, (long long)WS_A3 - (long long)WS_A1 - 16 * 128, (long long)WS_WT_ATTN - (long long)WS_WT_CONV - 16 * 128};
          pg8::EpiMergeK E{(const bf16*)(ws + WS_A6), (const bf16*)a.out, (bf16*)(ws + WS_A0)};
          pg8::gemm_phase<pg8::EpiMergeK, pg8::StaticOrder, true, true, true>(wv, lds, g, So, E, sp); }
    }
    SEAM(3);
    if (IN(4)) {
        cross_fold(wv, a, blk, G);
        peer_convert(wv, a, blk, G);
        pg8::Gemm g{(const bf16*)(ws + WS_A0), (const bf16*)(ws + WS_WT_MIX), S, D, D, D, D}; pg8::StaticOrder So; So.init(S, D, G, blk);
        pg8::EpiResid E{a.in[I_X], (bf16*)(ws + WS_A2), (float*)(ws + WS_SS1)};
        pg8::gemm_phase<pg8::EpiResid, pg8::StaticOrder, true, true>(wv, lds, g, So, E);
    }
    SEAM(4);
    if (IN(5)) {
        pg8::Gemm g{(const bf16*)(ws + WS_A2), (const bf16*)(ws + WS_WQK), S, D, D, D, D}; pg8::StaticOrder So; So.init(S, D, G, blk);
        pg8::EpiSoftmaxFull E{(const float*)(ws + WS_SS1), (bf16*)(ws + WS_A1), 0.0625f * 1.4426950408889634f};
        pg8::gemm_phase<pg8::EpiSoftmaxFull, pg8::StaticOrder, false, true>(wv, lds, g, So, E);
    }
    SEAM(5);
    if (IN(6)) {
        pg8::Gemm g{(const bf16*)(ws + WS_A1), (const bf16*)(ws + WS_VW), S, D, D, D, D}; pg8::StaticOrder So; So.init(S, D, G, blk);
        pg8::EpiResidB E{(bf16*)(ws + WS_A2), (float*)(ws + WS_SS2)};
        pg8::gemm_phase<pg8::EpiResidB, pg8::StaticOrder, true, true>(wv, lds, g, So, E);
    }
    SEAM(6);
    if (IN(7)) {
        pg8::StaticOrder So; So.init(S, 2048, G, blk);
        for (int i = 0;; ++i) { pg8::Unit u; if (!So.next(i, u)) break;
            { pg8::Gemm g{(const bf16*)(ws + WS_A2), (const bf16*)(ws + WS_WT_PQ), S, 2048, D, D, D}; pg8::OneUnit S1{u.pm, u.pn};
              pg8::EpiKeysTopk E{(const float*)(ws + WS_SS2), (unsigned*)(ws + WS_TOPK)};
              pg8::gemm_phase<pg8::EpiKeysTopk, pg8::OneUnit, false, true>(wv, lds, g, S1, E); }
            __syncthreads(); }
    }
    SEAM(7);
    if (IN(8)) peer::peer_phase(wv, a, blk, G, a.out);
#undef IN
#undef SEAM
}

extern "C" void kernel_launch(void* const* d_in, const int* in_sizes, int n_in, void* d_out, int out_size, void* d_ws, size_t ws_size, hipStream_t stream) {
    static int grid = 0;
    if (grid == 0) {
        if (ws_size < WS_END || n_in != 25 || out_size != S * D) { fprintf(stderr, "kernel_launch: unexpected ws_size %zu / n_in %d / out_size %d\n", ws_size, n_in, out_size); grid = -1; return; }
        if (hipFuncSetAttribute((const void*)mk_fwd, hipFuncAttributeMaxDynamicSharedMemorySize, LDS_BYTES) != hipSuccess) { fprintf(stderr, "kernel_launch: hipFuncSetAttribute failed\n"); grid = -1; return; }
        int dev = 0, cus = 0, per_cu = 0;
        if (hipGetDevice(&dev) != hipSuccess || hipDeviceGetAttribute(&cus, hipDeviceAttributeMultiprocessorCount, dev) != hipSuccess) { grid = -1; return; }
        if (hipOccupancyMaxActiveBlocksPerMultiprocessor(&per_cu, (const void*)mk_fwd, 512, LDS_BYTES) != hipSuccess || per_cu < 1) { fprintf(stderr, "kernel_launch: occupancy query says %d blocks per CU\n", per_cu); grid = -1; return; }
        grid = cus;
    }
    if (grid < 0) return;
    Args a{};
    for (int i = 0; i < 25; ++i) a.in[i] = (const float*)d_in[i];
    a.out = (float*)d_out; a.ws = (unsigned char*)d_ws; a.ph_lo = 0; a.ph_hi = 9;
    if (hipMemsetAsync(d_ws, 0, 65536, stream) != hipSuccess) { fprintf(stderr, "kernel_launch: hipMemsetAsync failed\n"); return; }
    void* kargs[] = {&a};
    hipError_t e = hipLaunchCooperativeKernel((const void*)mk_fwd, dim3(grid), dim3(512), kargs, LDS_BYTES, stream);
    if (e != hipSuccess) fprintf(stderr, "kernel_launch: cooperative launch failed: %s (grid %d)\n", hipGetErrorString(e), grid);
}
```

```cpp
#include <hip/hip_runtime.h>
#include <math.h>
#include <cstdio>
#include <cstdint>
namespace pg8 {
#define PG8_LAS __attribute__((address_space(3)))
typedef unsigned short bf16_t;
typedef short bf16x8 __attribute__((ext_vector_type(8)));
typedef float f32x4 __attribute__((ext_vector_type(4)));
typedef unsigned u32x4 __attribute__((ext_vector_type(4)));
constexpr int BM = 256, BK = 64, HALF = 128, HTB = HALF * BK * 2  , STAGE_BYTES = 8 * HTB, NXCD = 8, WGM = 8;

__host__ __device__ __forceinline__ int lds_byte(int r, int c) { const int st = (r >> 4) * 2 + (c >> 5), rr = r & 15, cc = c & 31, ob = rr * 64 + cc * 2; return st * 1024 + (ob ^ (((ob >> 9) & 1) << 5)); }
__host__ __device__ __forceinline__ void stage_rc(int b, int& R, int& C) { const int st = b / 1024, sb = b % 1024, swz = sb ^ (((sb >> 9) & 1) << 5); R = (st >> 1) * 16 + swz / 64; C = (st & 1) * 32 + (swz % 64) / 2; }
__host__ __device__ __forceinline__ int perm32(int rho) { const int n = rho >> 4, i = rho & 15; return 8 * (i >> 2) + 4 * n + (i & 3); }

struct Unit { int pm, pn; };
struct Gemm { const bf16_t* A; const bf16_t* Bt; int M, N, K, lda, ldb; };
struct Split { int ksplit; long long dA2, dB2; };

struct StaticOrder {
    int nM, nN, nwg, G, c;
    __host__ __device__ void init(int M, int N, int G_, int c_) { nM = M / BM; nN = N / BM; nwg = nM * nN; G = G_; c = c_; }
    __host__ __device__ bool next(int i, Unit& u) const {
        const long L = (long)i * G + c; if (L >= nwg) return false;
        int wgid = (int)L; { const int q = nwg / NXCD, r = nwg % NXCD, xcd = wgid % NXCD, off = wgid / NXCD; wgid = (xcd < r ? xcd * (q + 1) : r * (q + 1) + (xcd - r) * q) + off; }
        const int nig = WGM * nN, gid = wgid / nig, fm = gid * WGM, gsz = (nM - fm) < WGM ? (nM - fm) : WGM;
        u.pm = fm + ((wgid % nig) % gsz); u.pn = (wgid % nig) / gsz; return true;
    }
    __device__ __forceinline__ void a_ready(const Unit&) const {}
    __device__ __forceinline__ void done(const Unit&) const {}
};

typedef float f32x2 __attribute__((ext_vector_type(2)));
typedef __bf16 bf16x2v __attribute__((ext_vector_type(2)));
__device__ __forceinline__ unsigned cvt_pk_bf16(float lo, float hi) { const f32x2 v = {lo, hi}; const bf16x2v b = __builtin_convertvector(v, bf16x2v); return __builtin_bit_cast(unsigned, b); }
template <class E, class = void> struct HasPrefetch { static constexpr bool value = false; };
template <class E> struct HasPrefetch<E, decltype((void)&E::prefetch)> { static constexpr bool value = true; };
template <class Epi, class Sched, bool ALIGN_EPI = false, bool SP2 = false, bool SPLIT = false>
__device__ __forceinline__ void gemm_phase(int wv, PG8_LAS unsigned char* lds, const Gemm g, const Sched& S, const Epi& E, const Split sp = Split{0, 0, 0}) {
    int tid_; asm volatile("v_mbcnt_lo_u32_b32 %0, -1, 0\n\tv_mbcnt_hi_u32_b32 %0, -1, %0" : "=v"(tid_)); tid_ += wv * 64;
    const int tid = tid_, wid = __builtin_amdgcn_readfirstlane(tid >> 6), lane = tid & 63, wr = wid >> 2, wc = wid & 3, fr = lane & 15, fq = lane >> 4;
    const int K = g.K, nt = K / BK;
    unsigned voffA[2], voffB[2];
#pragma unroll
    for (int i = 0; i < 2; ++i) { int R, C; stage_rc(tid * 16 + i * 8192, R, C); const int Rb = Epi::PERM ? ((R & ~31) + perm32(R & 31)) : R;
        voffA[i] = (unsigned)(R * g.lda + C) * 2u; voffB[i] = (unsigned)(Rb * g.ldb + C) * 2u; }
    const size_t kstep = (size_t)(BK * 2);
    const size_t hstepA = (size_t)HALF * g.lda * 2, hstepB = (size_t)HALF * g.ldb * 2;
    const size_t tstepA = 2 * hstepA, tstepB = 2 * hstepB;
    const unsigned ldsw = (unsigned)wid * 1024u;
    const int aoff = lds_byte(wr * 64 + fr, fq * 8), boff = lds_byte(wc * 32 + fr, fq * 8);
#define PG8_SA(b, h) (((b) * 2 + (h)) * HTB)
#define PG8_SB(b, h) ((4 + (b) * 2 + (h)) * HTB)
#define PG8_STAGE(bufoff, gbase, voff) do { _Pragma("unroll") for (int _i = 0; _i < 2; ++_i) \
        __builtin_amdgcn_global_load_lds((const unsigned*)((const char*)(gbase) + (voff)[_i]), (PG8_LAS unsigned*)(lds + (bufoff) + ldsw + _i * 8192), 16, 0, 0); } while (0)
#define PG8_LDA(dst, b, h) do { _Pragma("unroll") for (int m = 0; m < 4; ++m) _Pragma("unroll") for (int k = 0; k < 2; ++k) dst[m][k] = *(const PG8_LAS bf16x8*)(lds + PG8_SA(b, h) + aoff + m * 2048 + k * 1024); } while (0)
#define PG8_LDB(dst, b, h) do { _Pragma("unroll") for (int n = 0; n < 2; ++n) _Pragma("unroll") for (int k = 0; k < 2; ++k) dst[n][k] = *(const PG8_LAS bf16x8*)(lds + PG8_SB(b, h) + boff + n * 2048 + k * 1024); } while (0)
#define PG8_MMA(ai, bj, At, Bt) do { __builtin_amdgcn_s_setprio(1); _Pragma("unroll") for (int m = 0; m < 4; ++m) _Pragma("unroll") for (int n = 0; n < 2; ++n) _Pragma("unroll") for (int k = 0; k < 2; ++k) \
        acc[ai][bj][m][n] = __builtin_amdgcn_mfma_f32_16x16x32_bf16(Bt[n][k], At[m][k], acc[ai][bj][m][n], 0, 0, 0); __builtin_amdgcn_s_setprio(0); } while (0)
#define PG8_WAIT_V(n) asm volatile("s_waitcnt vmcnt(" #n ")" ::: "memory")
#define PG8_WAIT_L(n) asm volatile("s_waitcnt lgkmcnt(" #n ")" ::: "memory")
#define PG8_BAR __builtin_amdgcn_s_barrier()
#define PG8_SCHED __builtin_amdgcn_sched_barrier(0)
    Unit cur, nxt; int ui = 0;
    if (!S.next(0, cur)) return;
    f32x4 acc[2][2][4][2];
#pragma unroll
    for (int a = 0; a < 2; ++a)
#pragma unroll
        for (int b = 0; b < 2; ++b)
#pragma unroll
            for (int m = 0; m < 4; ++m)
#pragma unroll
                for (int n = 0; n < 2; ++n) acc[a][b][m][n] = (f32x4){0.f, 0.f, 0.f, 0.f};
    bf16x8 At[4][2], B0[2][2], B1[2][2];
    const char* cA = (const char*)g.A + (size_t)cur.pm * tstepA; const char* cB = (const char*)g.Bt + (size_t)cur.pn * tstepB;
    S.a_ready(cur);
    if constexpr (HasPrefetch<Epi>::value) E.prefetch(cur, lds, wid);
    if constexpr (SP2) {
        PG8_STAGE(PG8_SB(0, 0), cB, voffB); PG8_STAGE(PG8_SB(0, 1), cB + hstepB, voffB); PG8_STAGE(PG8_SA(0, 0), cA, voffA); PG8_STAGE(PG8_SA(0, 1), cA + hstepA, voffA);
        if (wr == 1) PG8_BAR;
        PG8_WAIT_V(2); PG8_BAR;
        PG8_STAGE(PG8_SB(1, 0), cB + kstep, voffB); PG8_STAGE(PG8_SA(1, 0), cA + kstep, voffA); PG8_STAGE(PG8_SB(1, 1), cB + hstepB + kstep, voffB);
        PG8_WAIT_V(6); PG8_BAR;
    } else {
        PG8_STAGE(PG8_SB(0, 0), cB, voffB); PG8_STAGE(PG8_SA(0, 0), cA, voffA); PG8_STAGE(PG8_SB(0, 1), cB + hstepB, voffB); PG8_STAGE(PG8_SA(0, 1), cA + hstepA, voffA);
        if (wr == 1) PG8_BAR;
        PG8_WAIT_V(4); PG8_BAR;
        PG8_STAGE(PG8_SB(1, 0), cB + kstep, voffB); PG8_STAGE(PG8_SA(1, 0), cA + kstep, voffA); PG8_STAGE(PG8_SB(1, 1), cB + hstepB + kstep, voffB);
        PG8_WAIT_V(6); PG8_BAR;
    }
    for (;;) {
        const bool has_next = S.next(ui + 1, nxt);
        const char* nA = has_next ? (const char*)g.A + (size_t)nxt.pm * tstepA : cA; const char* nB = has_next ? (const char*)g.Bt + (size_t)nxt.pn * tstepB : cB;
        for (int t = 0; t < nt; t += 2) {
            const bool last = (t == nt - 2);
            long long oa1 = 0, oa2 = 0, ob2 = 0;
            if constexpr (SPLIT) { if (t == sp.ksplit) E.mid(acc, cur, wr, wc, fr, fq);
                if (t >= sp.ksplit) oa1 = sp.dA2; if (t + 2 >= sp.ksplit) { oa2 = sp.dA2; ob2 = sp.dB2; } }
            const char* a1 = cA + (size_t)(t + 1) * kstep + oa1;
            const char* a2 = last ? nA : cA + (size_t)(t + 2) * kstep + oa2; const char* b2 = last ? nB : cB + (size_t)(t + 2) * kstep + ob2;
            const char* a3 = a2 + kstep; const char* b3 = b2 + kstep;
            if (last && has_next) S.a_ready(nxt);
            if constexpr (SP2) {
            PG8_LDB(B0, 0, 0); PG8_LDB(B1, 0, 1); PG8_SCHED; PG8_LDA(At, 0, 0); PG8_STAGE(PG8_SA(1, 1), a1 + hstepA, voffA);
            PG8_WAIT_V(8); PG8_WAIT_L(0); PG8_BAR; PG8_MMA(0, 0, At, B0); PG8_MMA(0, 1, At, B1); PG8_BAR; PG8_SCHED;
            PG8_LDA(At, 0, 1); PG8_STAGE(PG8_SB(0, 0), b2, voffB); PG8_STAGE(PG8_SB(0, 1), b2 + hstepB, voffB); PG8_STAGE(PG8_SA(0, 0), a2, voffA);
            PG8_WAIT_V(8); PG8_WAIT_L(0); PG8_BAR; PG8_MMA(1, 0, At, B0); PG8_MMA(1, 1, At, B1); PG8_BAR; PG8_SCHED;
            PG8_LDB(B0, 1, 0); PG8_LDB(B1, 1, 1); PG8_SCHED; PG8_LDA(At, 1, 0); PG8_STAGE(PG8_SA(0, 1), a2 + hstepA, voffA);
            PG8_WAIT_V(8); PG8_WAIT_L(0); PG8_BAR; PG8_MMA(0, 0, At, B0); PG8_MMA(0, 1, At, B1); PG8_BAR; PG8_SCHED;
            PG8_LDA(At, 1, 1); PG8_STAGE(PG8_SB(1, 0), b3, voffB); PG8_STAGE(PG8_SB(1, 1), b3 + hstepB, voffB); PG8_STAGE(PG8_SA(1, 0), a3, voffA);
            PG8_WAIT_V(8); PG8_WAIT_L(0); PG8_BAR; PG8_MMA(1, 0, At, B0); PG8_MMA(1, 1, At, B1); PG8_BAR; PG8_SCHED;
            } else {
            PG8_LDB(B0, 0, 0); PG8_SCHED; PG8_LDA(At, 0, 0); PG8_STAGE(PG8_SA(1, 1), a1 + hstepA, voffA);
            PG8_WAIT_L(8); PG8_BAR; PG8_WAIT_L(0); PG8_MMA(0, 0, At, B0); PG8_BAR; PG8_SCHED;
            PG8_LDB(B1, 0, 1); PG8_STAGE(PG8_SB(0, 0), b2, voffB);
            PG8_BAR; PG8_WAIT_L(0); PG8_MMA(0, 1, At, B1); PG8_BAR;
            PG8_LDA(At, 0, 1); PG8_STAGE(PG8_SA(0, 0), a2, voffA);
            PG8_BAR; PG8_WAIT_L(0); PG8_MMA(1, 0, At, B0); PG8_BAR; PG8_SCHED;
            PG8_STAGE(PG8_SB(0, 1), b2 + hstepB, voffB);
            PG8_WAIT_V(6); PG8_BAR; PG8_MMA(1, 1, At, B1); PG8_BAR;
            PG8_LDB(B0, 1, 0); PG8_SCHED; PG8_LDA(At, 1, 0); PG8_STAGE(PG8_SA(0, 1), a2 + hstepA, voffA);
            PG8_WAIT_L(8); PG8_BAR; PG8_WAIT_L(0); PG8_MMA(0, 0, At, B0); PG8_BAR; PG8_SCHED;
            PG8_LDB(B1, 1, 1); PG8_STAGE(PG8_SB(1, 0), b3, voffB);
            PG8_BAR; PG8_WAIT_L(0); PG8_MMA(0, 1, At, B1); PG8_BAR;
            PG8_LDA(At, 1, 1); PG8_STAGE(PG8_SA(1, 0), a3, voffA);
            PG8_BAR; PG8_WAIT_L(0); PG8_MMA(1, 0, At, B0); PG8_BAR; PG8_SCHED;
            PG8_STAGE(PG8_SB(1, 1), b3 + hstepB, voffB);
            PG8_WAIT_V(6); PG8_BAR; PG8_MMA(1, 1, At, B1); PG8_BAR;
            }
        }
        if constexpr (ALIGN_EPI) { if (wr == 0) PG8_BAR; }
        if constexpr (!Epi::AFTER_DRAIN) { E(acc, cur, wr, wc, fr, fq); S.done(cur); }
        if (!has_next) break;
#pragma unroll
        for (int a = 0; a < 2; ++a)
#pragma unroll
            for (int b = 0; b < 2; ++b)
#pragma unroll
                for (int m = 0; m < 4; ++m)
#pragma unroll
                    for (int n = 0; n < 2; ++n) acc[a][b][m][n] = (f32x4){0.f, 0.f, 0.f, 0.f};
        cur = nxt; cA = nA; cB = nB; ++ui;
        if constexpr (HasPrefetch<Epi>::value) E.prefetch(cur, lds, wid);
        if constexpr (ALIGN_EPI) { if (wr == 1) PG8_BAR; }
    }
    PG8_WAIT_V(0);
    if constexpr (!ALIGN_EPI) { if (wr == 0) PG8_BAR; }
    PG8_BAR;
    if constexpr (Epi::AFTER_DRAIN) { E.fused(acc, cur, wr, wc, fr, fq, lds, wid, lane); S.done(cur); }
#undef PG8_SA
#undef PG8_SB
#undef PG8_STAGE
#undef PG8_LDA
#undef PG8_LDB
#undef PG8_MMA
#undef PG8_WAIT_V
#undef PG8_WAIT_L
#undef PG8_BAR
#undef PG8_SCHED
}
}


constexpr int S = 16384, D = 1024, NCOLS = 8192, MEMN = 256;
typedef unsigned short bf16;
typedef float f32x4 __attribute__((ext_vector_type(4)));
typedef unsigned u32x4 __attribute__((ext_vector_type(4)));
typedef unsigned u32x2 __attribute__((ext_vector_type(2)));
__device__ __forceinline__ void st16wt(void* p, u32x4 v) { asm volatile("global_store_dwordx4 %0, %1, off sc1\n\ts_nop 1" :: "v"(p), "v"(v) : "memory"); }
#define LAS __attribute__((address_space(3)))

__device__ const unsigned char T5_BUCKET[128] = {0, 1, 2, 3, 4, 5, 6, 7, 8, 9, 10, 11, 12, 13, 14, 15, 16, 16, 16, 17, 17, 18, 18, 18, 19, 19, 19, 20, 20, 20, 20, 21, 21, 21, 21, 22, 22, 22, 22, 22, 23, 23, 23, 23, 23, 23, 24, 24, 24, 24, 24, 24, 25, 25, 25, 25, 25, 25, 25, 26, 26, 26, 26, 26, 26, 26, 26, 27, 27, 27, 27, 27, 27, 27, 27, 27, 27, 28, 28, 28, 28, 28, 28, 28, 28, 28, 28, 29, 29, 29, 29, 29, 29, 29, 29, 29, 29, 29, 29, 30, 30, 30, 30, 30, 30, 30, 30, 30, 30, 30, 30, 30, 30, 31, 31, 31, 31, 31, 31, 31, 31, 31, 31, 31, 31, 31, 31, 31};

constexpr size_t MiB = 1u << 20;
constexpr size_t WS_CTL = 0, WS_KMAX = 32768  , WS_RSTD0 = 512 * 1024;
constexpr size_t WS_WT_IN = 1 * MiB, WS_WT_CONV = 17 * MiB, WS_WT_ATTN = 19 * MiB, WS_WT_MIX = 21 * MiB, WS_WT_CQ = 23 * MiB, WS_WT_CO = 25 * MiB, WS_WT_PQ = 27 * MiB;
constexpr size_t WS_SUBK = 31 * MiB, WS_KV = 32 * MiB, WS_SS1 = 34 * MiB, WS_SS2 = 35 * MiB;
constexpr size_t WS_TOPK = 36 * MiB  , WS_PU = 196 * MiB  , WS_PV = 228 * MiB  ;
constexpr size_t WS_WQK = 23 * MiB  , WS_VW = 212 * MiB  ;
constexpr size_t WS_IDG = 52 * MiB  , WS_GW = 60 * MiB  , WS_WW = 68 * MiB  , WS_SSP = 76 * MiB  , WS_RS = 77 * MiB  , WS_PART = 132 * MiB  ;
constexpr size_t OUT_VW = 48 * MiB  ;
constexpr size_t WS_BTAB = 640 * 1024  ;
constexpr size_t WS_PQS = 52 * MiB  , WS_KS = 132 * MiB  ;
constexpr size_t WS_A0 = 36 * MiB, WS_A1 = 68 * MiB, WS_A2 = 100 * MiB, WS_A3 = 132 * MiB, WS_A4 = 164 * MiB, WS_A5 = 196 * MiB, WS_A6 = 228 * MiB, WS_END = 260 * MiB;

__device__ __forceinline__ float wave_sum(float v) {
#pragma unroll
    for (int o = 1; o < 64; o <<= 1) v += __shfl_xor(v, o);
    return v;
}
__device__ __forceinline__ float wave_max(float v) {
#pragma unroll
    for (int o = 1; o < 64; o <<= 1) v = fmaxf(v, __shfl_xor(v, o));
    return v;
}
__device__ __forceinline__ int opaque_tid(int wv) { int t; asm volatile("v_mbcnt_lo_u32_b32 %0, -1, 0\n\tv_mbcnt_hi_u32_b32 %0, -1, %0" : "=v"(t)); return t + wv * 64; }
__device__ __forceinline__ unsigned f2bf(float f) { unsigned u = __builtin_bit_cast(unsigned, f); return (u + 0x7fffu + ((u >> 16) & 1u)) >> 16; }
__device__ __forceinline__ unsigned pk2(float lo, float hi) { return pg8::cvt_pk_bf16(lo, hi); }
__device__ __forceinline__ float bflo(unsigned w) { return __builtin_bit_cast(float, w << 16); }
__device__ __forceinline__ float bfhi(unsigned w) { return __builtin_bit_cast(float, w & 0xffff0000u); }
__device__ __forceinline__ float sigmoidf_(float x) { return __builtin_amdgcn_rcpf(1.0f + __builtin_amdgcn_exp2f(x * -1.4426950408889634f)); }

struct Args { const float* in[25]; float* out; unsigned char* ws; int ph_lo, ph_hi; };
enum { I_X = 0, I_MEM, I_NORM_MIX_G, I_W_IN, I_CONV_W, I_W_CONV_OUT, I_LQ1, I_LK1, I_LQ2, I_LK2, I_SUBLN_G, I_W_ATTN_OUT, I_W_MIX_OUT, I_REL_BIAS, I_NORM_CROSS_G, I_NORM_MEM_G,
       I_W_CQ, I_W_CKV, I_W_CO, I_NORM_FFN_G, I_W_PQ, I_SUB_KEYS, I_PEER_U, I_PEER_V, I_FINAL_G };

namespace pg8 {
template <int CTRL> __device__ __forceinline__ float dppf(float x) { return __builtin_bit_cast(float, __builtin_amdgcn_mov_dpp(__builtin_bit_cast(int, x), CTRL, 0xf, 0xf, true)); }
__device__ __forceinline__ float row16_max(float v) { v = fmaxf(v, dppf<0xB1>(v)); v = fmaxf(v, dppf<0x4E>(v)); v = fmaxf(v, dppf<0x141>(v)); return fmaxf(v, dppf<0x140>(v)); }
__device__ __forceinline__ float xrow16_max(float x) {
    auto s = __builtin_amdgcn_permlane16_swap(__float_as_uint(x), __float_as_uint(x), false, false); x = fmaxf(__uint_as_float(s[0]), __uint_as_float(s[1]));
    auto t = __builtin_amdgcn_permlane32_swap(__float_as_uint(x), __float_as_uint(x), false, false); return fmaxf(__uint_as_float(t[0]), __uint_as_float(t[1])); }
__device__ __forceinline__ float xrow16_sum(float x) {
    auto s = __builtin_amdgcn_permlane16_swap(__float_as_uint(x), __float_as_uint(x), false, false); x = __uint_as_float(s[0]) + __uint_as_float(s[1]);
    auto t = __builtin_amdgcn_permlane32_swap(__float_as_uint(x), __float_as_uint(x), false, false); return __uint_as_float(t[0]) + __uint_as_float(t[1]); }
__device__ __forceinline__ u32x4 pack8(const f32x4& v0, const f32x4& v1) { u32x4 w; w.x = cvt_pk_bf16(v0[0], v0[1]); w.y = cvt_pk_bf16(v0[2], v0[3]); w.z = cvt_pk_bf16(v1[0], v1[1]); w.w = cvt_pk_bf16(v1[2], v1[3]); return w; }
struct EpiProj {
    static constexpr bool PERM = true, AFTER_DRAIN = false;
    const float* rstd_g; bf16_t *CB, *U, *Q, *K, *V, *SGC, *SGA; float qscale; unsigned* KMAX; PG8_LAS float* rl;
    __device__ __forceinline__ void prefetch(const Unit& u, PG8_LAS unsigned char* lds, int wid) const {
        if (wid == 0) { int ln; asm volatile("v_mbcnt_lo_u32_b32 %0, -1, 0\n\tv_mbcnt_hi_u32_b32 %0, -1, %0" : "=v"(ln));
            __builtin_amdgcn_global_load_lds((const unsigned*)(rstd_g + u.pm * BM + ln * 4), (PG8_LAS unsigned*)rl, 16, 0, 0); }
    }
    __device__ __forceinline__ void operator()(const f32x4 (&acc)[2][2][4][2], const Unit& u, int wr, int wc, int fr0, int fq) const {
        int fr = fr0; asm volatile("" : "+v"(fr));
        const int row0 = u.pm * BM + wr * 64 + fr, pn = u.pn, colw = wc * 32 + 8 * fq;
        const PG8_LAS float* rstd = rl - u.pm * BM;
        if (pn >= 4 && pn < 12) {
            const int col = 128 * (pn - 4) + colw;
#pragma unroll
            for (int ai = 0; ai < 2; ++ai)
#pragma unroll
                for (int m = 0; m < 4; ++m) { const int row = row0 + ai * HALF + m * 16; const float rs = rstd[row], r2 = rs * rs;
                    const f32x4 v0 = acc[ai][0][m][0] * acc[ai][1][m][0] * r2, v1 = acc[ai][0][m][1] * acc[ai][1][m][1] * r2;
                    *(u32x4*)(U + (size_t)row * 1024 + col) = pack8(v0, v1); }
            return;
        }
        bf16_t* base; int cbase; float sc = 1.f; bool gate = false;
        if (pn < 4) { base = CB; cbase = pn * 256; }
        else if (pn < 16) { base = Q; cbase = (pn - 12) * 256; sc = qscale; }
        else if (pn < 20) { base = K; cbase = (pn - 16) * 256; }
        else if (pn < 24) { base = V; cbase = (pn - 20) * 256; }
        else if (pn < 28) { base = SGC; cbase = (pn - 24) * 256; gate = true; }
        else { base = SGA; cbase = (pn - 28) * 256; gate = true; }
#pragma unroll
        for (int ai = 0; ai < 2; ++ai)
#pragma unroll
            for (int m = 0; m < 4; ++m) { const int row = row0 + ai * HALF + m * 16; const float rs = rstd[row] * sc;
#pragma unroll
                for (int bj = 0; bj < 2; ++bj) { f32x4 v0 = acc[ai][bj][m][0] * rs, v1 = acc[ai][bj][m][1] * rs;
                    if (gate) {
#pragma unroll
                        for (int e = 0; e < 4; ++e) { v0[e] = sigmoidf_(v0[e]); v1[e] = sigmoidf_(v1[e]); } }
                    *(u32x4*)(base + (size_t)row * 1024 + cbase + bj * HALF + colw) = pack8(v0, v1); } }
        if (pn >= 16 && pn < 20) {
            float mx[2] = {0.f, 0.f};
#pragma unroll
            for (int ai = 0; ai < 2; ++ai)
#pragma unroll
                for (int m = 0; m < 4; ++m) { const float rs = rstd[row0 + ai * HALF + m * 16];
#pragma unroll
                    for (int bj = 0; bj < 2; ++bj) { const f32x4 v0 = acc[ai][bj][m][0] * rs, v1 = acc[ai][bj][m][1] * rs;
                        const float s = xrow16_sum(((v0[0] * v0[0] + v0[1] * v0[1]) + (v0[2] * v0[2] + v0[3] * v0[3])) + ((v1[0] * v1[0] + v1[1] * v1[1]) + (v1[2] * v1[2] + v1[3] * v1[3])));
                        mx[bj] = fmaxf(mx[bj], s); } }
#pragma unroll
            for (int bj = 0; bj < 2; ++bj) { float v = mx[bj];
                v = row16_max(v);
                if (fr == 0 && fq == 0) atomicMax(KMAX + (((pn - 16) * 2 + bj) * 2 + (wc >> 1)) * 2 + (wc & 1), __float_as_uint(v)); }
        }
    }
};
struct EpiGateT {
    static constexpr bool PERM = true, AFTER_DRAIN = false;
    const bf16_t* SG; float* T;
    __device__ __forceinline__ void operator()(const f32x4 (&acc)[2][2][4][2], const Unit& u, int wr, int wc, int fr0, int fq) const {
        int fr = fr0; asm volatile("" : "+v"(fr));
        const int row0 = u.pm * BM + wr * 64 + fr, col0 = u.pn * BM + wc * 32 + 8 * fq;
#pragma unroll
        for (int ai = 0; ai < 2; ++ai)
#pragma unroll
            for (int m = 0; m < 4; ++m) { const size_t off = (size_t)(row0 + ai * HALF + m * 16) * 1024 + col0;
#pragma unroll
                for (int bj = 0; bj < 2; ++bj) { const u32x4 g = *(const u32x4*)(SG + off + bj * HALF);
                    f32x4 g0 = {bflo(g.x), bfhi(g.x), bflo(g.y), bfhi(g.y)}, g1 = {bflo(g.z), bfhi(g.z), bflo(g.w), bfhi(g.w)};
                    *(f32x4*)(T + off + bj * HALF) = g0 * acc[ai][bj][m][0]; *(f32x4*)(T + off + bj * HALF + 4) = g1 * acc[ai][bj][m][1]; } }
    }
};
struct EpiMerge {
    static constexpr bool PERM = true, AFTER_DRAIN = false;
    const float* T; const bf16_t* SG; bf16_t* O;
    __device__ __forceinline__ void operator()(const f32x4 (&acc)[2][2][4][2], const Unit& u, int wr, int wc, int fr0, int fq) const {
        int fr = fr0; asm volatile("" : "+v"(fr));
        const int row0 = u.pm * BM + wr * 64 + fr, col0 = u.pn * BM + wc * 32 + 8 * fq;
#pragma unroll
        for (int ai = 0; ai < 2; ++ai)
#pragma unroll
            for (int m = 0; m < 4; ++m) { const size_t off = (size_t)(row0 + ai * HALF + m * 16) * 1024 + col0;
#pragma unroll
                for (int bj = 0; bj < 2; ++bj) { const u32x4 g = *(const u32x4*)(SG + off + bj * HALF);
                    f32x4 g0 = {bflo(g.x), bfhi(g.x), bflo(g.y), bfhi(g.y)}, g1 = {bflo(g.z), bfhi(g.z), bflo(g.w), bfhi(g.w)};
                    const f32x4 t0 = *(const f32x4*)(T + off + bj * HALF), t1 = *(const f32x4*)(T + off + bj * HALF + 4);
                    *(u32x4*)(O + off + bj * HALF) = pack8(t0 + g0 * acc[ai][bj][m][0], t1 + g1 * acc[ai][bj][m][1]); } }
    }
};
struct EpiMergeK {
    static constexpr bool PERM = true, AFTER_DRAIN = false;
    const bf16_t* SGc; const bf16_t* SGa; bf16_t* O;
    __device__ __forceinline__ void mid(f32x4 (&acc)[2][2][4][2], const Unit& u, int wr, int wc, int fr0, int fq) const {
        int fr = fr0; asm volatile("" : "+v"(fr));
        const int row0 = u.pm * BM + wr * 64 + fr, col0 = u.pn * BM + wc * 32 + 8 * fq;
#pragma unroll
        for (int ai = 0; ai < 2; ++ai)
#pragma unroll
            for (int m = 0; m < 4; ++m) { const size_t off = (size_t)(row0 + ai * HALF + m * 16) * 1024 + col0;
#pragma unroll
                for (int bj = 0; bj < 2; ++bj) { const u32x4 c = *(const u32x4*)(SGc + off + bj * HALF), g = *(const u32x4*)(SGa + off + bj * HALF);
                    const f32x4 c0 = {bflo(c.x), bfhi(c.x), bflo(c.y), bfhi(c.y)}, c1 = {bflo(c.z), bfhi(c.z), bflo(c.w), bfhi(c.w)};
                    f32x4 g0 = {bflo(g.x), bfhi(g.x), bflo(g.y), bfhi(g.y)}, g1 = {bflo(g.z), bfhi(g.z), bflo(g.w), bfhi(g.w)};
#pragma unroll
                    for (int e = 0; e < 4; ++e) { g0[e] = c0[e] * __builtin_amdgcn_rcpf(fmaxf(g0[e], 1e-20f)); g1[e] = c1[e] * __builtin_amdgcn_rcpf(fmaxf(g1[e], 1e-20f)); }
                    acc[ai][bj][m][0] *= g0; acc[ai][bj][m][1] *= g1; } }
    }
    __device__ __forceinline__ void operator()(const f32x4 (&acc)[2][2][4][2], const Unit& u, int wr, int wc, int fr0, int fq) const {
        int fr = fr0; asm volatile("" : "+v"(fr));
        const int row0 = u.pm * BM + wr * 64 + fr, col0 = u.pn * BM + wc * 32 + 8 * fq;
#pragma unroll
        for (int ai = 0; ai < 2; ++ai)
#pragma unroll
            for (int m = 0; m < 4; ++m) { const size_t off = (size_t)(row0 + ai * HALF + m * 16) * 1024 + col0;
#pragma unroll
                for (int bj = 0; bj < 2; ++bj) { const u32x4 g = *(const u32x4*)(SGa + off + bj * HALF);
                    f32x4 g0 = {bflo(g.x), bfhi(g.x), bflo(g.y), bfhi(g.y)}, g1 = {bflo(g.z), bfhi(g.z), bflo(g.w), bfhi(g.w)};
#pragma unroll
                    for (int e = 0; e < 4; ++e) { g0[e] = fmaxf(g0[e], 1e-20f); g1[e] = fmaxf(g1[e], 1e-20f); }
                    st16wt(O + off + bj * HALF, pack8(g0 * acc[ai][bj][m][0], g1 * acc[ai][bj][m][1])); } }
    }
};
struct EpiResid {
    static constexpr bool PERM = true, AFTER_DRAIN = false;
    const float* R; bf16_t* XB; float* SS;
    __device__ __forceinline__ void operator()(const f32x4 (&acc)[2][2][4][2], const Unit& u, int wr, int wc, int fr0, int fq) const {
        int fr = fr0; asm volatile("" : "+v"(fr));
        const int row0 = u.pm * BM + wr * 64 + fr, col0 = u.pn * BM + wc * 32 + 8 * fq;
#pragma unroll
        for (int ai = 0; ai < 2; ++ai)
#pragma unroll
            for (int m = 0; m < 4; ++m) { const int row = row0 + ai * HALF + m * 16; const size_t off = (size_t)row * 1024 + col0; float ss = 0.f;
#pragma unroll
                for (int bj = 0; bj < 2; ++bj) {
                    const f32x4 x0 = *(const f32x4*)(R + off + bj * HALF) + acc[ai][bj][m][0], x1 = *(const f32x4*)(R + off + bj * HALF + 4) + acc[ai][bj][m][1];
                    st16wt(XB + off + bj * HALF, pack8(x0, x1));
                    ss += (x0[0] * x0[0] + x0[1] * x0[1]) + (x0[2] * x0[2] + x0[3] * x0[3]) + (x1[0] * x1[0] + x1[1] * x1[1]) + (x1[2] * x1[2] + x1[3] * x1[3]); }
                ss = xrow16_sum(ss);
                if (fq == 0) SS[(size_t)row * 16 + u.pn * 4 + wc] = ss; }
    }
};
struct EpiResidB {
    static constexpr bool PERM = true, AFTER_DRAIN = false;
    bf16_t* XB; float* SS;
    __device__ __forceinline__ void operator()(const f32x4 (&acc)[2][2][4][2], const Unit& u, int wr, int wc, int fr0, int fq) const {
        int fr = fr0; asm volatile("" : "+v"(fr));
        const int row0 = u.pm * BM + wr * 64 + fr, col0 = u.pn * BM + wc * 32 + 8 * fq;
#pragma unroll
        for (int ai = 0; ai < 2; ++ai)
#pragma unroll
            for (int m = 0; m < 4; ++m) { const int row = row0 + ai * HALF + m * 16; const size_t off = (size_t)row * 1024 + col0; float ss = 0.f;
#pragma unroll
                for (int bj = 0; bj < 2; ++bj) { const u32x4 g = *(const u32x4*)(XB + off + bj * HALF);
                    const f32x4 r0 = {bflo(g.x), bfhi(g.x), bflo(g.y), bfhi(g.y)}, r1 = {bflo(g.z), bfhi(g.z), bflo(g.w), bfhi(g.w)};
                    const f32x4 x0 = r0 + acc[ai][bj][m][0], x1 = r1 + acc[ai][bj][m][1];
                    st16wt(XB + off + bj * HALF, pack8(x0, x1));
                    ss += (x0[0] * x0[0] + x0[1] * x0[1]) + (x0[2] * x0[2] + x0[3] * x0[3]) + (x1[0] * x1[0] + x1[1] * x1[1]) + (x1[2] * x1[2] + x1[3] * x1[3]); }
                ss = xrow16_sum(ss);
                if (fq == 0) SS[(size_t)row * 16 + u.pn * 4 + wc] = ss; }
    }
};
struct EpiRowScale {
    static constexpr bool PERM = true, AFTER_DRAIN = false;
    const float* SS; bf16_t* O; int ldc; float sc;
    __device__ __forceinline__ void operator()(const f32x4 (&acc)[2][2][4][2], const Unit& u, int wr, int wc, int fr0, int fq) const {
        int fr = fr0; asm volatile("" : "+v"(fr));
        const int row0 = u.pm * BM + wr * 64 + fr, col0 = u.pn * BM + wc * 32 + 8 * fq;
#pragma unroll
        for (int ai = 0; ai < 2; ++ai)
#pragma unroll
            for (int m = 0; m < 4; ++m) { const int row = row0 + ai * HALF + m * 16;
                const f32x4* sp = (const f32x4*)(SS + (size_t)row * 16); const f32x4 s4 = (sp[0] + sp[1]) + (sp[2] + sp[3]);
                const float rs = sc / sqrtf(((s4[0] + s4[1]) + (s4[2] + s4[3])) * (1.0f / 1024.0f) + 1e-6f);
#pragma unroll
                for (int bj = 0; bj < 2; ++bj) *(u32x4*)(O + (size_t)row * ldc + col0 + bj * HALF) = pack8(acc[ai][bj][m][0] * rs, acc[ai][bj][m][1] * rs); }
    }
};

__device__ __forceinline__ unsigned f2ord(float f) { const unsigned u = __builtin_bit_cast(unsigned, f); return u ^ ((unsigned)((int)u >> 31) | 0x80000000u); }
__device__ __forceinline__ float ord2f(unsigned k) { const unsigned u = (k & 0x80000000u) ? (k ^ 0x80000000u) : ~k; return __builtin_bit_cast(float, u); }
#define PG8_CSWAP(a, b) do { const unsigned hi_ = (a) > (b) ? (a) : (b), lo_ = (a) > (b) ? (b) : (a); (a) = hi_; (b) = lo_; } while (0)
__device__ __forceinline__ void sort16_desc(unsigned (&k)[16]) {
#pragma unroll
    for (int sz = 2; sz <= 16; sz <<= 1)
#pragma unroll
        for (int st = sz >> 1; st > 0; st >>= 1)
#pragma unroll
            for (int i = 0; i < 16; ++i) { const int l = i ^ st; if (l > i) { if ((i & sz) == 0) PG8_CSWAP(k[i], k[l]); else PG8_CSWAP(k[l], k[i]); } }
}
__device__ __forceinline__ void merge16_desc(unsigned (&a)[16], const unsigned (&b)[16]) {
#pragma unroll
    for (int i = 0; i < 16; ++i) a[i] = a[i] > b[15 - i] ? a[i] : b[15 - i];
#pragma unroll
    for (int st = 8; st > 0; st >>= 1)
#pragma unroll
        for (int i = 0; i < 16; ++i) { const int l = i ^ st; if (l > i) PG8_CSWAP(a[i], a[l]); }
}
struct EpiKeys {
    static constexpr bool PERM = true, AFTER_DRAIN = false;
    const float* SS; unsigned* KS;
    __device__ __forceinline__ void operator()(const f32x4 (&acc)[2][2][4][2], const Unit& u, int wr, int wc, int fr0, int fq) const {
        int fr = fr0; asm volatile("" : "+v"(fr));
#pragma unroll
        for (int ai = 0; ai < 2; ++ai)
#pragma unroll
            for (int m = 0; m < 4; ++m) { const int row = ai * HALF + wr * 64 + m * 16 + fr;
                const f32x4* sp = (const f32x4*)(SS + (size_t)(u.pm * BM + row) * 16); const f32x4 s4 = (sp[0] + sp[1]) + (sp[2] + sp[3]);
                const float rs = 1.0f / sqrtf(((s4[0] + s4[1]) + (s4[2] + s4[3])) * (1.0f / 1024.0f) + 1e-6f);
#pragma unroll
                for (int bj = 0; bj < 2; ++bj)
#pragma unroll
                    for (int n = 0; n < 2; ++n) { const int cw = wc * 32 + 8 * fq + 4 * n; u32x4 k;
#pragma unroll
                        for (int e = 0; e < 4; ++e) k[e] = (f2ord(acc[ai][bj][m][n][e] * rs) & ~0x7Fu) | (unsigned)(127 - (cw + e));
                        *(u32x4*)(KS + row * 256 + bj * HALF + cw) = k; } }
    }
};
__device__ __forceinline__ void topk_from_keys(int tid, const unsigned* KS, unsigned* TOPK, int tok0, int h) {
#pragma unroll 1
    for (int ai = 0; ai < 2; ++ai) {
        const int j = tid & 1, rl = (tid >> 1) & 127, c = tid >> 8;
        const unsigned* src = KS + (ai * 128 + rl) * 256 + c * 128 + j * 64;
        unsigned best[16], cur[16];
        { const u32x4 a0 = *(const u32x4*)src, a1 = *(const u32x4*)(src + 4), a2 = *(const u32x4*)(src + 8), a3 = *(const u32x4*)(src + 12);
#pragma unroll
          for (int e = 0; e < 4; ++e) { best[e] = a0[e]; best[4 + e] = a1[e]; best[8 + e] = a2[e]; best[12 + e] = a3[e]; } }
        sort16_desc(best);
#pragma unroll 1
        for (int gq = 1; gq < 4; ++gq) {
            const u32x4 a0 = *(const u32x4*)(src + gq * 16), a1 = *(const u32x4*)(src + gq * 16 + 4), a2 = *(const u32x4*)(src + gq * 16 + 8), a3 = *(const u32x4*)(src + gq * 16 + 12);
#pragma unroll
            for (int e = 0; e < 4; ++e) { cur[e] = a0[e]; cur[4 + e] = a1[e]; cur[8 + e] = a2[e]; cur[12 + e] = a3[e]; }
            sort16_desc(cur); merge16_desc(best, cur); }
#pragma unroll
        for (int i = 0; i < 16; ++i) cur[i] = (unsigned)__shfl_xor((int)best[i], 1);
        merge16_desc(best, cur);
        unsigned* dst = TOPK + ((size_t)(tok0 + ai * 128 + rl) * 8 + h) * 32 + c * 16 + j * 8;
        u32x4 w0, w1;
        if (j == 0) { w0 = (u32x4){best[0], best[1], best[2], best[3]}; w1 = (u32x4){best[4], best[5], best[6], best[7]}; }
        else { w0 = (u32x4){best[8], best[9], best[10], best[11]}; w1 = (u32x4){best[12], best[13], best[14], best[15]}; }
        st16wt(dst, w0); st16wt(dst + 4, w1);
    }
}
struct EpiKeysTopk {
    static constexpr bool PERM = true, AFTER_DRAIN = true;
    const float* SS; unsigned* TOPK; const float* CS; unsigned* CD; int cid, cstep, clim;
    __device__ __forceinline__ void fused(f32x4 (&acc)[2][2][4][2], const Unit& u, int wr, int wc, int fr0, int fq, PG8_LAS unsigned char* lds, int wid, int lane) const {
        int fr = fr0; asm volatile("" : "+v"(fr));
        const int tid = wid * 64 + lane;
#pragma unroll
        for (int ai = 0; ai < 2; ++ai) {
#pragma unroll
            for (int m = 0; m < 4; ++m) { const int lr = wr * 64 + m * 16 + fr;
                const f32x4* sp = (const f32x4*)(SS + (size_t)(u.pm * BM + ai * HALF + lr) * 16); const f32x4 s4 = (sp[0] + sp[1]) + (sp[2] + sp[3]);
                const float rs = 1.0f / sqrtf(((s4[0] + s4[1]) + (s4[2] + s4[3])) * (1.0f / 1024.0f) + 1e-6f);
#pragma unroll
                for (int bj = 0; bj < 2; ++bj)
#pragma unroll
                    for (int n = 0; n < 2; ++n) { const int cw = wc * 32 + 8 * fq + 4 * n, col = bj * HALF + cw; u32x4 k;
#pragma unroll
                        for (int e = 0; e < 4; ++e) k[e] = (f2ord(acc[ai][bj][m][n][e] * rs) & ~0x7Fu) | (unsigned)(127 - (cw + e));
                        *(PG8_LAS u32x4*)(lds + lr * 1024 + (((col >> 2) ^ ((2 * lr + ((col >> 6) & 1)) & 15)) << 4)) = k; } }
            asm volatile("s_waitcnt lgkmcnt(0)\n\ts_barrier" ::: "memory");
            f32x4 cva[4], cvb[4]; const int ra = cid + wid + (2 * ai) * cstep, rb = ra + cstep;
            if (ra < clim) {
#pragma unroll
                for (int j = 0; j < 4; ++j) cva[j] = __builtin_nontemporal_load((const f32x4*)(CS + (size_t)ra * 1024 + 4 * lane + 256 * j)); }
            if (rb < clim) {
#pragma unroll
                for (int j = 0; j < 4; ++j) cvb[j] = __builtin_nontemporal_load((const f32x4*)(CS + (size_t)rb * 1024 + 4 * lane + 256 * j)); }
            { const int j = tid & 1, rl = (tid >> 1) & 127, c = tid >> 8, sw = (2 * rl + j) & 15;
              const PG8_LAS unsigned char* src = lds + rl * 1024 + (2 * c + j) * 256;
              unsigned best[16], cur[16];
              u32x4 kk[16];
#pragma unroll
              for (int q = 0; q < 16; ++q) kk[q] = *(const PG8_LAS u32x4*)(src + ((q ^ sw) << 4));
#pragma unroll
              for (int e = 0; e < 4; ++e) { best[e] = kk[0][e]; best[4 + e] = kk[1][e]; best[8 + e] = kk[2][e]; best[12 + e] = kk[3][e]; }
              sort16_desc(best);
#pragma unroll
              for (int gq = 1; gq < 4; ++gq) {
#pragma unroll
                  for (int e = 0; e < 4; ++e) { cur[e] = kk[4 * gq][e]; cur[4 + e] = kk[4 * gq + 1][e]; cur[8 + e] = kk[4 * gq + 2][e]; cur[12 + e] = kk[4 * gq + 3][e]; }
                  sort16_desc(cur); merge16_desc(best, cur); }
#pragma unroll
              for (int i = 0; i < 16; ++i) cur[i] = (unsigned)__shfl_xor((int)best[i], 1);
              merge16_desc(best, cur);
              unsigned* dst = TOPK + ((size_t)(u.pm * BM + ai * HALF + rl) * 8 + u.pn) * 32 + c * 16 + j * 8;
              u32x4 w0, w1;
              if (j == 0) { w0 = (u32x4){best[0], best[1], best[2], best[3]}; w1 = (u32x4){best[4], best[5], best[6], best[7]}; }
              else { w0 = (u32x4){best[8], best[9], best[10], best[11]}; w1 = (u32x4){best[12], best[13], best[14], best[15]}; }
              st16wt(dst, w0); st16wt(dst + 4, w1); }
            if (ra < clim) {
#pragma unroll
                for (int j = 0; j < 4; ++j) { const f32x4 x_ = cva[j] * 128.0f; int w_ = __builtin_amdgcn_cvt_pk_fp8_f32(x_[0], x_[1], 0, false); w_ = __builtin_amdgcn_cvt_pk_fp8_f32(x_[2], x_[3], w_, true);
                    CD[((size_t)(2 * j + (lane >> 5)) * 16384 + (size_t)ra) * 32 + (lane & 31)] = (unsigned)w_; } }
            if (rb < clim) {
#pragma unroll
                for (int j = 0; j < 4; ++j) { const f32x4 x_ = cvb[j] * 128.0f; int w_ = __builtin_amdgcn_cvt_pk_fp8_f32(x_[0], x_[1], 0, false); w_ = __builtin_amdgcn_cvt_pk_fp8_f32(x_[2], x_[3], w_, true);
                    CD[((size_t)(2 * j + (lane >> 5)) * 16384 + (size_t)rb) * 32 + (lane & 31)] = (unsigned)w_; } }
            asm volatile("s_waitcnt lgkmcnt(0)\n\ts_barrier" ::: "memory");
        }
    }
};
struct EpiSoftmaxP {
    static constexpr bool PERM = true, AFTER_DRAIN = true;
    bf16_t* P; PG8_LAS float* lrow;
    __device__ __forceinline__ void fused(f32x4 (&acc)[2][2][4][2], const Unit& u, int wr, int wc, int fr0, int fq, PG8_LAS unsigned char* lds, int wid, int lane) const {
        int fr = fr0; asm volatile("" : "+v"(fr));
        PG8_LAS float* MX = (PG8_LAS float*)lds; PG8_LAS float* SM = MX + 1024;
#pragma unroll
        for (int ai = 0; ai < 2; ++ai)
#pragma unroll
            for (int m = 0; m < 4; ++m) { float mx = -INFINITY;
#pragma unroll
                for (int bj = 0; bj < 2; ++bj)
#pragma unroll
                    for (int n = 0; n < 2; ++n)
#pragma unroll
                        for (int e = 0; e < 4; ++e) mx = fmaxf(mx, acc[ai][bj][m][n][e]);
                mx = xrow16_max(mx);
                if (fq == 0) MX[(ai * HALF + wr * 64 + m * 16 + fr) * 4 + wc] = mx; }
        asm volatile("s_waitcnt lgkmcnt(0)\n\ts_barrier" ::: "memory");
#pragma unroll
        for (int ai = 0; ai < 2; ++ai)
#pragma unroll
            for (int m = 0; m < 4; ++m) { const int row = ai * HALF + wr * 64 + m * 16 + fr;
                const f32x4 m4 = *(const PG8_LAS f32x4*)(MX + row * 4); const float rm = fmaxf(fmaxf(m4[0], m4[1]), fmaxf(m4[2], m4[3])); float s = 0.f;
#pragma unroll
                for (int bj = 0; bj < 2; ++bj) { f32x4 p0, p1;
#pragma unroll
                    for (int e = 0; e < 4; ++e) { p0[e] = __builtin_amdgcn_exp2f(acc[ai][bj][m][0][e] - rm); p1[e] = __builtin_amdgcn_exp2f(acc[ai][bj][m][1][e] - rm); }
                    s += ((p0[0] + p0[1]) + (p0[2] + p0[3])) + ((p1[0] + p1[1]) + (p1[2] + p1[3]));
                    *(u32x4*)(P + (size_t)row * 256 + bj * HALF + wc * 32 + 8 * fq) = pack8(p0, p1); }
                s = xrow16_sum(s);
                if (fq == 0) SM[row * 4 + wc] = s; }
        asm volatile("s_waitcnt lgkmcnt(0)\n\ts_barrier" ::: "memory");
        const int tid = wid * 64 + lane;
        if (tid < 256) { const f32x4 s4 = *(const PG8_LAS f32x4*)(SM + tid * 4); lrow[tid] = (s4[0] + s4[1]) + (s4[2] + s4[3]); }
    }
};
struct EpiSoftmaxFull {
    static constexpr bool PERM = true, AFTER_DRAIN = true;
    const float* SS; bf16_t* P; float sc;
    __device__ __forceinline__ void fused(f32x4 (&acc)[2][2][4][2], const Unit& u, int wr, int wc, int fr0, int fq, PG8_LAS unsigned char* lds, int wid, int lane) const {
        int fr = fr0; asm volatile("" : "+v"(fr));
        PG8_LAS float* MX = (PG8_LAS float*)lds; PG8_LAS float* SM = MX + 1024;
#pragma unroll
        for (int ai = 0; ai < 2; ++ai)
#pragma unroll
            for (int m = 0; m < 4; ++m) { const int lr = ai * HALF + wr * 64 + m * 16 + fr, row = u.pm * BM + lr; float mx = -INFINITY;
                const f32x4* sp = (const f32x4*)(SS + (size_t)row * 16); const f32x4 s4 = (sp[0] + sp[1]) + (sp[2] + sp[3]);
                const float rs = sc / sqrtf(((s4[0] + s4[1]) + (s4[2] + s4[3])) * (1.0f / 1024.0f) + 1e-6f);
#pragma unroll
                for (int bj = 0; bj < 2; ++bj)
#pragma unroll
                    for (int n = 0; n < 2; ++n) { acc[ai][bj][m][n] *= rs;
#pragma unroll
                        for (int e = 0; e < 4; ++e) mx = fmaxf(mx, acc[ai][bj][m][n][e]); }
                mx = xrow16_max(mx);
                if (fq == 0) MX[lr * 4 + wc] = mx; }
        asm volatile("s_waitcnt lgkmcnt(0)\n\ts_barrier" ::: "memory");
#pragma unroll
        for (int ai = 0; ai < 2; ++ai)
#pragma unroll
            for (int m = 0; m < 4; ++m) { const int lr = ai * HALF + wr * 64 + m * 16 + fr;
                const f32x4 m4 = *(const PG8_LAS f32x4*)(MX + lr * 4); const float rm = fmaxf(fmaxf(m4[0], m4[1]), fmaxf(m4[2], m4[3])); float s = 0.f;
#pragma unroll
                for (int bj = 0; bj < 2; ++bj)
#pragma unroll
                    for (int n = 0; n < 2; ++n) {
#pragma unroll
                        for (int e = 0; e < 4; ++e) acc[ai][bj][m][n][e] = __builtin_amdgcn_exp2f(acc[ai][bj][m][n][e] - rm);
                        s += (acc[ai][bj][m][n][0] + acc[ai][bj][m][n][1]) + (acc[ai][bj][m][n][2] + acc[ai][bj][m][n][3]); }
                s = xrow16_sum(s);
                if (fq == 0) SM[lr * 4 + wc] = s; }
        asm volatile("s_waitcnt lgkmcnt(0)\n\ts_barrier" ::: "memory");
#pragma unroll
        for (int ai = 0; ai < 2; ++ai)
#pragma unroll
            for (int m = 0; m < 4; ++m) { const int lr = ai * HALF + wr * 64 + m * 16 + fr;
                const f32x4 s4 = *(const PG8_LAS f32x4*)(SM + lr * 4); const float inv = 1.0f / ((s4[0] + s4[1]) + (s4[2] + s4[3]));
#pragma unroll
                for (int bj = 0; bj < 2; ++bj)
                    st16wt(P + (size_t)(u.pm * BM + lr) * 1024 + u.pn * BM + bj * HALF + wc * 32 + 8 * fq, pack8(acc[ai][bj][m][0] * inv, acc[ai][bj][m][1] * inv)); }
    }
};
struct EpiCO {
    static constexpr bool PERM = true, AFTER_DRAIN = false;
    bf16_t* O; const PG8_LAS float* lrow;
    __device__ __forceinline__ void operator()(const f32x4 (&acc)[2][2][4][2], const Unit& u, int wr, int wc, int fr0, int fq) const {
        int fr = fr0; asm volatile("" : "+v"(fr));
#pragma unroll
        for (int ai = 0; ai < 2; ++ai)
#pragma unroll
            for (int m = 0; m < 4; ++m) { const int row = ai * HALF + wr * 64 + m * 16 + fr; const float inv = 1.0f / lrow[row];
#pragma unroll
                for (int bj = 0; bj < 2; ++bj) *(u32x4*)(O + (size_t)row * 1024 + bj * HALF + wc * 32 + 8 * fq) = pack8(acc[ai][bj][m][0] * inv, acc[ai][bj][m][1] * inv); }
    }
};
struct OneUnit {
    int pm, pn;
    __device__ __forceinline__ bool next(int i, Unit& u) const { if (i) return false; u.pm = pm; u.pn = pn; return true; }
    __device__ __forceinline__ void a_ready(const Unit&) const {}
    __device__ __forceinline__ void done(const Unit&) const {}
};
}

__device__ __forceinline__ int win_src_col(int n) {
    if (n < 1024 || n >= 3072) return n;
    const int t = (n - 1024) >> 8, j = (n - 1024) & 255;
    return j < 128 ? 1024 + 128 * t + j : 2048 + 128 * t + (j - 128);
}
__device__ __forceinline__ void p0_bw(int wv, const Args& a, LAS unsigned char* lds, int blk, int G) {
    const int tid = opaque_tid(wv), lane = tid & 63, wave = tid >> 6;
    unsigned char* ws = a.ws;
    LAS float* tl = (LAS float*)lds;
    {
        f32x4 cur[8], nxt[8]; const float* gcur = nullptr; const float* gnxt = nullptr;
#define P0_DECODE(job, W, ldw, nb, kb, Wt, gain, perm) do { \
            if ((job) < 512) { W = a.in[I_W_IN]; ldw = NCOLS; kb = (job) >> 5; nb = (job) & 31; Wt = (bf16*)(ws + WS_WT_IN); gain = a.in[I_NORM_MIX_G]; perm = true; } \
            else { const int mat = ((job) - 512) >> 6, idx = ((job) - 512) & 63; kb = idx >> 2; nb = idx & 3; ldw = 1024; gain = nullptr; perm = false; \
                if (mat == 0) { W = a.in[I_W_CONV_OUT]; Wt = (bf16*)(ws + WS_WT_CONV); } \
                else if (mat == 1) { W = a.in[I_W_ATTN_OUT]; Wt = (bf16*)(ws + WS_WT_ATTN); } \
                else if (mat == 2) { W = a.in[I_W_MIX_OUT]; Wt = (bf16*)(ws + WS_WT_MIX); } \
                else { W = a.in[I_W_CO]; Wt = (bf16*)(ws + WS_WT_CO); } } } while (0)
#define P0_LOAD(dst, gv, job) do { const float* W; int ldw, nb, kb; bf16* Wt; const float* gain; bool perm; P0_DECODE(job, W, ldw, nb, kb, Wt, gain, perm); (void)Wt; \
            const int k0 = kb * 64, c = tid & 63, nd0 = nb * 256 + 64 * (c >> 4), ns0 = (perm ? win_src_col(nd0) : nd0) + 4 * (c & 15); gv = gain ? gain + k0 : nullptr; \
            _Pragma("unroll") for (int i = 0; i < 8; ++i) dst[i] = *(const f32x4*)(W + (size_t)(k0 + (tid >> 6) + 8 * i) * ldw + ns0); } while (0)
        if (blk < 768) P0_LOAD(cur, gcur, blk);
        for (int job = blk; job < 768; job += G) {
            if (job + G < 768) P0_LOAD(nxt, gnxt, job + G);
#pragma unroll
            for (int i = 0; i < 8; ++i) { const int kk = (tid >> 6) + 8 * i, c = tid & 63; const float gk = gcur ? gcur[kk] : 1.0f; LAS float* d = tl + kk * 257 + 4 * c;
                d[0] = cur[i][0] * gk; d[1] = cur[i][1] * gk; d[2] = cur[i][2] * gk; d[3] = cur[i][3] * gk; }
            __syncthreads();
            { const float* W; int ldw, nb, kb; bf16* Wt; const float* gain; bool perm; P0_DECODE(job, W, ldw, nb, kb, Wt, gain, perm); (void)W; (void)ldw; (void)gain; (void)perm;
#pragma unroll
              for (int r = 0; r < 4; ++r) { const int idx = tid + 512 * r, nn = idx >> 3, kq = idx & 7; const LAS float* s = tl + (kq * 8) * 257 + nn;
                  u32x4 o; o.x = pk2(s[0], s[257]); o.y = pk2(s[2 * 257], s[3 * 257]); o.z = pk2(s[4 * 257], s[5 * 257]); o.w = pk2(s[6 * 257], s[7 * 257]);
                  st16wt(Wt + (size_t)(nb * 256 + nn) * 1024 + kb * 64 + kq * 8, o); } }
            __syncthreads();
#pragma unroll
            for (int i = 0; i < 8; ++i) cur[i] = nxt[i];
            gcur = gnxt;
        }
#undef P0_DECODE
#undef P0_LOAD
    }
    { const float* x = a.in[I_X]; bf16* XB = (bf16*)(ws + WS_A0); float* rstd0 = (float*)(ws + WS_RSTD0);
      f32x4 v[4], w4[4]; int row = blk * 8 + wave;
#define P0_XLOAD(dst, r) do { const f32x4* xr = (const f32x4*)(x + (size_t)(r) * D) + 2 * lane; dst[0] = xr[0]; dst[1] = xr[1]; dst[2] = xr[128]; dst[3] = xr[129]; } while (0)
      if (row < S) P0_XLOAD(v, row);
      for (; row < S; row += G * 8) {
          if (row + G * 8 < S) P0_XLOAD(w4, row + G * 8);
          float s = 0.f;
#pragma unroll
          for (int j = 0; j < 4; ++j) s += (v[j][0] * v[j][0] + v[j][1] * v[j][1]) + (v[j][2] * v[j][2] + v[j][3] * v[j][3]);
          s = wave_sum(s);
          if (lane == 0) rstd0[row] = 1.0f / sqrtf(s * (1.0f / D) + 1e-6f);
          bf16* o = XB + (size_t)row * D + 8 * lane;
#pragma unroll
          for (int j = 0; j < 2; ++j) { u32x4 w; w.x = pk2(v[2 * j][0], v[2 * j][1]); w.y = pk2(v[2 * j][2], v[2 * j][3]); w.z = pk2(v[2 * j + 1][0], v[2 * j + 1][1]); w.w = pk2(v[2 * j + 1][2], v[2 * j + 1][3]);
              st16wt(o + 512 * j, w); }
#pragma unroll
          for (int j = 0; j < 4; ++j) v[j] = w4[j];
      }
#undef P0_XLOAD
    }
}
__device__ __forceinline__ void p0_peerfold(int wv, const Args& a, int blk, int G) {
    const int tid = opaque_tid(wv), lane = tid & 63, wave = tid >> 6;
    unsigned char* ws = a.ws;
    { typedef short bf16x8_t __attribute__((ext_vector_type(8))); typedef float f32x16_t __attribute__((ext_vector_type(16)));
      const float* sk = a.in[I_SUB_KEYS]; const float* wpq = a.in[I_W_PQ]; const float* gf = a.in[I_NORM_FFN_G]; bf16* WT = (bf16*)(ws + WS_WT_PQ);
      const int r32 = lane & 31, kg = lane >> 5;
      for (int item = blk * 8 + wave; item < 2048; item += G * 8) {
          const int hc = item >> 7, h = hc >> 1, c = hc & 1, kt = (item >> 2) & 31, nt = item & 3;
          const float* ap = wpq + (size_t)(kt * 32 + r32) * 2048 + hc * 128 + 8 * kg;
          const float* bp = sk + ((size_t)((c * 8 + h) * 128 + nt * 32 + r32)) * 128 + 8 * kg;
          const float gk = gf[kt * 32 + r32];
          f32x4 av[8][2], bv[8][2];
#pragma unroll
          for (int s = 0; s < 8; ++s) { av[s][0] = *(const f32x4*)(ap + 16 * s); av[s][1] = *(const f32x4*)(ap + 16 * s + 4); bv[s][0] = *(const f32x4*)(bp + 16 * s); bv[s][1] = *(const f32x4*)(bp + 16 * s + 4); }
          f32x16_t acc;
#pragma unroll
          for (int r = 0; r < 16; ++r) acc[r] = 0.f;
#pragma unroll
          for (int s = 0; s < 8; ++s) {
              const f32x4 a0 = av[s][0] * gk, a1 = av[s][1] * gk;
              u32x4 aw, bw; aw.x = pk2(a0[0], a0[1]); aw.y = pk2(a0[2], a0[3]); aw.z = pk2(a1[0], a1[1]); aw.w = pk2(a1[2], a1[3]);
              bw.x = pk2(bv[s][0][0], bv[s][0][1]); bw.y = pk2(bv[s][0][2], bv[s][0][3]); bw.z = pk2(bv[s][1][0], bv[s][1][1]); bw.w = pk2(bv[s][1][2], bv[s][1][3]);
              acc = __builtin_amdgcn_mfma_f32_32x32x16_bf16(__builtin_bit_cast(bf16x8_t, aw), __builtin_bit_cast(bf16x8_t, bw), acc, 0, 0, 0); }
          bf16* dst = WT + (size_t)(hc * 128 + nt * 32 + r32) * 1024 + kt * 32 + 4 * kg;
#pragma unroll
          for (int q = 0; q < 4; ++q) { u32x2 w; w.x = pk2(acc[4 * q], acc[4 * q + 1]); w.y = pk2(acc[4 * q + 2], acc[4 * q + 3]); *(u32x2*)(dst + 8 * q) = w; }
      } }
}
__device__ __forceinline__ void p0_tables(int wv, const Args& a, int blk, int G) {
    const int tid = opaque_tid(wv), lane = tid & 63, wave = tid >> 6;
    unsigned char* ws = a.ws;
    { float* BT = (float*)(ws + WS_BTAB); const float* rb = a.in[I_REL_BIAS];
      for (int it = blk; it < 9; it += G) {
          if (it < 8) { const int h = it;
              if (tid < 131) { const int j = tid; float v;
                  if (j < 129) { const int b = j < 128 ? (int)T5_BUCKET[j] : 31; v = (rb[b * 8 + h] - rb[31 * 8 + h]) * 1.4426950408889634f; }
                  else if (j == 129) { float m[32];
#pragma unroll
                      for (int b = 0; b < 32; ++b) m[b] = rb[b * 8 + h];
#pragma unroll
                      for (int st = 16; st >= 1; st >>= 1)
#pragma unroll
                          for (int b = 0; b < st; ++b) m[b] = fmaxf(m[b], m[b + st]);
                      v = m[0] * 1.4426950408889634f; }
                  else v = rb[31 * 8 + h] * 1.4426950408889634f;
                  BT[h * 132 + j] = v; }
          } else if (wave == 0) {
              const float p1 = a.in[I_LQ1][lane] * a.in[I_LK1][lane], p2 = a.in[I_LQ2][lane] * a.in[I_LK2][lane];
              const float s1 = wave_sum(p1), s2 = wave_sum(p2);
              if (lane == 0) BT[8 * 132] = expf(s1) - expf(s2) + 0.2f; }
      } }
}
__device__ __forceinline__ void p0_small(int wv, const Args& a, LAS unsigned char* lds, int blk, int G) {
    const int tid = opaque_tid(wv), lane = tid & 63, wave = tid >> 6;
    unsigned char* ws = a.ws;
    { typedef short bf16x8_t __attribute__((ext_vector_type(8))); typedef float f32x16_t __attribute__((ext_vector_type(16)));
      LAS bf16* mnb = (LAS bf16*)lds;
      LAS float* red = (LAS float*)(lds + 32 * 1032 * 2);
      const float* mem = a.in[I_MEM]; const float* g = a.in[I_NORM_MEM_G]; const float* Wc = a.in[I_W_CKV]; bf16* KC = (bf16*)(ws + WS_KV); bf16* VC = KC + 4 * 256 * 256;
      const int r32 = lane & 31, kg = lane >> 5;
      for (int wb = blk; wb < 256; wb += G) {
          const int m0 = (wb >> 5) * 32, n0 = (wb & 31) * 64;
          __syncthreads();
#pragma unroll
          for (int r = 0; r < 4; ++r) { const int rr = wave * 4 + r; const f32x4* mr = (const f32x4*)(mem + (size_t)(m0 + rr) * D) + lane; f32x4 v[4]; float s = 0.f;
#pragma unroll
              for (int j = 0; j < 4; ++j) { v[j] = mr[64 * j]; s += (v[j][0] * v[j][0] + v[j][1] * v[j][1]) + (v[j][2] * v[j][2] + v[j][3] * v[j][3]); }
              s = wave_sum(s); const float rs = 1.0f / sqrtf(s * (1.0f / D) + 1e-6f);
#pragma unroll
              for (int j = 0; j < 4; ++j) { const f32x4 gg = ((const f32x4*)g)[lane + 64 * j]; const f32x4 y = v[j] * rs * gg; u32x2 w; w.x = pk2(y[0], y[1]); w.y = pk2(y[2], y[3]);
                  *(LAS u32x2*)(mnb + rr * 1032 + 4 * (lane + 64 * j)) = w; } }
          __syncthreads();
          const int it = wave & 1, kq = wave >> 1, ncol = n0 + 32 * it + r32;
          f32x16_t acc;
#pragma unroll
          for (int r = 0; r < 16; ++r) acc[r] = 0.f;
#pragma unroll 1
          for (int half = 0; half < 2; ++half) {
              float wv_[8][8];
#pragma unroll
              for (int s = 0; s < 8; ++s)
#pragma unroll
                  for (int j = 0; j < 8; ++j) wv_[s][j] = Wc[(size_t)(256 * kq + 128 * half + 16 * s + 8 * kg + j) * 2048 + ncol];
#pragma unroll
              for (int s = 0; s < 8; ++s) {
                  u32x4 bw; bw.x = pk2(wv_[s][0], wv_[s][1]); bw.y = pk2(wv_[s][2], wv_[s][3]); bw.z = pk2(wv_[s][4], wv_[s][5]); bw.w = pk2(wv_[s][6], wv_[s][7]);
                  const bf16x8_t af = *(const LAS bf16x8_t*)(mnb + r32 * 1032 + 256 * kq + 128 * half + 16 * s + 8 * kg);
                  acc = __builtin_amdgcn_mfma_f32_32x32x16_bf16(af, __builtin_bit_cast(bf16x8_t, bw), acc, 0, 0, 0); }
          }
#pragma unroll
          for (int r = 0; r < 16; ++r) red[((it * 4 + kq) * 16 + r) * 64 + lane] = acc[r];
          __syncthreads();
          if (kq == 0) {
#pragma unroll
              for (int r = 0; r < 16; ++r) acc[r] = (red[((it * 4 + 0) * 16 + r) * 64 + lane] + red[((it * 4 + 1) * 16 + r) * 64 + lane]) + (red[((it * 4 + 2) * 16 + r) * 64 + lane] + red[((it * 4 + 3) * 16 + r) * 64 + lane]);
              if (ncol < 1024) {
#pragma unroll
                  for (int r = 0; r < 16; ++r) KC[((size_t)(ncol >> 8) * 256 + (m0 + (r & 3) + 8 * (r >> 2) + 4 * kg)) * 256 + (ncol & 255)] = (bf16)f2bf(acc[r]);
              } else {
#pragma unroll
                  for (int r = 0; r < 16; ++r) VC[((size_t)((ncol - 1024) >> 8) * 256 + (m0 + (r & 3) + 8 * (r >> 2) + 4 * kg)) * 256 + (ncol & 255)] = (bf16)f2bf(acc[r]);
              }
          }
      }
      __syncthreads(); }
}

__device__ __forceinline__ void cross_fold(int wv, const Args& a, int blk, int G) {
    typedef short bf16x8_t __attribute__((ext_vector_type(8))); typedef float f32x16_t __attribute__((ext_vector_type(16)));
    const int tid = opaque_tid(wv), lane = tid & 63, wave = tid >> 6, r32 = lane & 31, kg = lane >> 5;
    const bf16* KC = (const bf16*)(a.ws + WS_KV); const bf16* VC = KC + 4 * 256 * 256;
    for (int item = blk * 8 + wave; item < 2048; item += G * 8) {
        f32x16_t acc;
#pragma unroll
        for (int r = 0; r < 16; ++r) acc[r] = 0.f;
        bf16* dst;
        if (item < 1024) {
            const int h = item >> 8, kt = (item >> 3) & 31, mt = item & 7;
            const float* ap = a.in[I_W_CQ] + (size_t)(kt * 32 + r32) * 1024 + h * 256 + 8 * kg;
            const bf16* bp = KC + ((size_t)h * 256 + mt * 32 + r32) * 256 + 8 * kg;
            const float gk = a.in[I_NORM_CROSS_G][kt * 32 + r32];
#pragma unroll 1
            for (int half = 0; half < 2; ++half) {
                f32x4 av[8][2]; u32x4 bv[8];
#pragma unroll
                for (int s = 0; s < 8; ++s) { av[s][0] = *(const f32x4*)(ap + 128 * half + 16 * s); av[s][1] = *(const f32x4*)(ap + 128 * half + 16 * s + 4); bv[s] = *(const u32x4*)(bp + 128 * half + 16 * s); }
#pragma unroll
                for (int s = 0; s < 8; ++s) { const f32x4 a0 = av[s][0] * gk, a1 = av[s][1] * gk;
                    u32x4 aw; aw.x = pk2(a0[0], a0[1]); aw.y = pk2(a0[2], a0[3]); aw.z = pk2(a1[0], a1[1]); aw.w = pk2(a1[2], a1[3]);
                    acc = __builtin_amdgcn_mfma_f32_32x32x16_bf16(__builtin_bit_cast(bf16x8_t, aw), __builtin_bit_cast(bf16x8_t, bv[s]), acc, 0, 0, 0); }
            }
            dst = (bf16*)(a.ws + WS_WQK) + (size_t)(h * 256 + mt * 32 + r32) * 1024 + kt * 32 + 4 * kg;
        } else {
            const int it = item - 1024, h = it >> 8, mt = (it >> 5) & 7, nt = it & 31;
            const bf16* ap = VC + ((size_t)h * 256 + mt * 32 + r32) * 256 + 8 * kg;
            const bf16* bp = (const bf16*)(a.ws + WS_WT_CO) + (size_t)(nt * 32 + r32) * 1024 + h * 256 + 8 * kg;
            u32x4 av[16], bv[16];
#pragma unroll
            for (int s = 0; s < 16; ++s) { av[s] = *(const u32x4*)(ap + 16 * s); bv[s] = *(const u32x4*)(bp + 16 * s); }
#pragma unroll
            for (int s = 0; s < 16; ++s) acc = __builtin_amdgcn_mfma_f32_32x32x16_bf16(__builtin_bit_cast(bf16x8_t, av[s]), __builtin_bit_cast(bf16x8_t, bv[s]), acc, 0, 0, 0);
            dst = (bf16*)((unsigned char*)a.out + OUT_VW) + (size_t)(nt * 32 + r32) * 1024 + h * 256 + mt * 32 + 4 * kg;
        }
#pragma unroll
        for (int q = 0; q < 4; ++q) { u32x2 w; w.x = pk2(acc[4 * q], acc[4 * q + 1]); w.y = pk2(acc[4 * q + 2], acc[4 * q + 3]); *(u32x2*)(dst + 8 * q) = w; }
    }
}

__device__ __forceinline__ void conv_phase(int wv, const Args& a, int blk, int G) {
    bf16* CB = (bf16*)(a.ws + WS_A1); const bf16* U = (const bf16*)(a.ws + WS_A2); const float* cw = a.in[I_CONV_W];
    const int tid = opaque_tid(wv);
    const int c = (tid & 127) * 8;
    float w0[8], w1[8], w2[8];
#pragma unroll
    for (int e = 0; e < 8; ++e) { w0[e] = cw[c + e]; w1[e] = cw[D + c + e]; w2[e] = cw[2 * D + c + e]; }
    const size_t step = (size_t)G * 512, total = (size_t)S * D / 8;
    for (size_t i0 = (size_t)blk * 512 + tid; i0 < total; i0 += 4 * step) {
        u32x4 cb[4], u2[4], u1[4], u0[4];
#pragma unroll
        for (int q = 0; q < 4; ++q) { const size_t i = i0 + q * step; const int r = (int)(i >> 7);
            cb[q] = u2[q] = u1[q] = u0[q] = (u32x4){0, 0, 0, 0};
            if (i < total) { cb[q] = *(const u32x4*)(CB + i * 8); u2[q] = *(const u32x4*)(U + i * 8);
                if (r >= 1) u1[q] = *(const u32x4*)(U + i * 8 - D);
                if (r >= 2) u0[q] = *(const u32x4*)(U + i * 8 - 2 * D); } }
#pragma unroll
        for (int q = 0; q < 4; ++q) { const size_t i = i0 + q * step;
            u32x4 o;
#pragma unroll
            for (int e = 0; e < 4; ++e) {
                const float lo = bflo(cb[q][e]) * (w0[2 * e] * bflo(u0[q][e]) + w1[2 * e] * bflo(u1[q][e]) + w2[2 * e] * bflo(u2[q][e]));
                const float hi = bfhi(cb[q][e]) * (w0[2 * e + 1] * bfhi(u0[q][e]) + w1[2 * e + 1] * bfhi(u1[q][e]) + w2[2 * e + 1] * bfhi(u2[q][e]));
                o[e] = pk2(lo, hi);
            }
            if (i < total) st16wt(CB + i * 8, o); }
    }
}


namespace att {
typedef short bf16x8 __attribute__((ext_vector_type(8)));
typedef short s16x4 __attribute__((ext_vector_type(4)));
typedef float f32x16 __attribute__((ext_vector_type(16)));
typedef short v4i16_t __attribute__((ext_vector_type(4)));
typedef LAS const char* lds_cptr;
constexpr int SLOT = 16384, LDS_K = 0, LDS_V = 4 * SLOT, LDS_WSF = 8 * SLOT, LDS_BT = LDS_WSF + 2048, LDS_TOTAL = LDS_BT + 1024;
constexpr int LDS_XCH = 0, LDS_OST = 65536;
constexpr float LOG2E = 1.4426950408889634f, THR = 8.0f;
__device__ __forceinline__ int crow(int r, int hi) { return (r & 3) + 8 * (r >> 2) + 4 * hi; }
typedef float f32x2_t __attribute__((ext_vector_type(2))); typedef __bf16 bf16x2_t __attribute__((ext_vector_type(2)));
__device__ __forceinline__ unsigned cvtpk(float lo, float hi) { const f32x2_t v = {lo, hi}; const bf16x2_t b = __builtin_convertvector(v, bf16x2_t); return __builtin_bit_cast(unsigned, b); }
__device__ __forceinline__ void glds16(const void* g, unsigned lds_base) {
    unsigned sv; asm volatile("s_mov_b32 %0, m0\n\ts_mov_b32 m0, %2\n\ts_nop 0\n\tglobal_load_lds_dwordx4 %1, off\n\ts_mov_b32 m0, %0" : "=&s"(sv) : "v"(g), "s"(lds_base) : "memory"); }
template <int IMM> __device__ __forceinline__ void glds16s(unsigned voff, const void* sbase, unsigned lds_base) {
    unsigned sv; asm volatile("s_mov_b32 %0, m0\n\ts_mov_b32 m0, %3\n\ts_nop 0\n\tglobal_load_lds_dwordx4 %1, %2 offset:%c4\n\ts_mov_b32 m0, %0" : "=&s"(sv) : "v"(voff), "s"(sbase), "s"(lds_base), "i"(IMM) : "memory"); }
__device__ __forceinline__ s16x4 vtr(lds_cptr p) { return __builtin_bit_cast(s16x4, __builtin_amdgcn_ds_read_tr16_b64_v4i16((LAS v4i16_t*)p)); }
#define ATT_MX3(a, b, c) __builtin_fmaxf(__builtin_fmaxf((a), (b)), (c))
__device__ __forceinline__ float rowmax(const f32x16& p0, const f32x16& p1) {
    float a = ATT_MX3(p0[0], p0[1], p1[0]), b = ATT_MX3(p0[2], p0[3], p1[1]); a = ATT_MX3(a, p1[2], p1[3]);
#pragma unroll
    for (int r = 4; r < 16; r += 4) { a = ATT_MX3(a, p0[r], p0[r + 1]); b = ATT_MX3(b, p0[r + 2], p0[r + 3]); a = ATT_MX3(a, p1[r], p1[r + 1]); b = ATT_MX3(b, p1[r + 2], p1[r + 3]); }
    float m = __builtin_fmaxf(a, b); auto rr = __builtin_amdgcn_permlane32_swap(__float_as_uint(m), __float_as_uint(m), false, false);
    return __builtin_fmaxf(__uint_as_float(rr[0]), __uint_as_float(rr[1])); }
#define ATT_WAIT_BAR(N) asm volatile("s_waitcnt vmcnt(" #N ") lgkmcnt(0)\n\ts_barrier" ::: "memory")
#define ATT_LBAR() asm volatile("s_waitcnt lgkmcnt(0)\n\ts_barrier" ::: "memory")
#define ATT_MFMA(a, b, c) __builtin_amdgcn_mfma_f32_32x32x16_bf16(a, b, c, 0, 0, 0)

__device__ __forceinline__ void attn_unit_pipe(int wv, int h, int qb, const bf16* Q, const bf16* __restrict__ K, const bf16* __restrict__ V, bf16* O, LAS unsigned char* lds,
                                               float lam, const float* BTAB, const float* subln_g, const unsigned* KMAX) {
    const int tid = opaque_tid(wv), lane = tid & 63, r32 = lane & 31, hi = lane >> 5;
    const int wid = __builtin_amdgcn_readfirstlane(tid >> 6), comp = wid >> 2, rg = wid & 3;
    const int q0 = qb * 128, qw0 = q0 + 32 * rg, NT = 2 * qb + 2;
    const unsigned lds0 = (unsigned)(unsigned long long)lds;
    LAS float* wsf = (LAS float*)(lds + LDS_WSF) + wid * 64;
    LAS float* bt = (LAS float*)(lds + LDS_BT);
    const unsigned kvoff = (unsigned)lane * 2048u + (unsigned)wid * 16u;
    const unsigned vvoff = (unsigned)(16 * (wid & 3) + (lane >> 2)) * 2048u + (unsigned)((wid >> 2) * 32 + (lane & 3) * 8) * 2u;
    const char* kbase = (const char*)(K + h * 128); const char* vbase = (const char*)(V + h * 128);
    const unsigned kdst = lds0 + LDS_K + wid * 1024, vdst = lds0 + LDS_V + wid * 1024;
#define ATT_RFL(x) ((unsigned)__builtin_amdgcn_readfirstlane((int)(x)))
#define DMA_K(t, so) do { const char* b_ = kbase + (size_t)(t) * 131072; glds16s<0>(kvoff, b_, ATT_RFL(kdst + (so))); glds16s<128>(kvoff, b_, ATT_RFL(kdst + (so) + 8192 - 128)); } while (0)
#define DMA_V(t, so) do { const char* b_ = vbase + (size_t)(t) * 131072; glds16s<0>(vvoff, b_, ATT_RFL(vdst + (so))); glds16s<128>(vvoff, b_, ATT_RFL(vdst + (so) + 8192 - 128)); } while (0)
#define DMA_K0(t, so) do { const char* b_ = kbase + (size_t)(t) * 131072; glds16s<0>(kvoff, b_, ATT_RFL(kdst + (so))); } while (0)
#define DMA_K1(t, so) do { const char* b_ = kbase + (size_t)(t) * 131072; glds16s<128>(kvoff, b_, ATT_RFL(kdst + (so) + 8192 - 128)); } while (0)
#define DMA_V0(t, so) do { const char* b_ = vbase + (size_t)(t) * 131072; glds16s<0>(vvoff, b_, ATT_RFL(vdst + (so))); } while (0)
#define DMA_V1(t, so) do { const char* b_ = vbase + (size_t)(t) * 131072; glds16s<128>(vvoff, b_, ATT_RFL(vdst + (so) + 8192 - 128)); } while (0)
    DMA_K(0, 0); DMA_K(1, SLOT); DMA_V(0, 0); if (NT > 2) DMA_K(2, 2 * SLOT);
    const float* bth = BTAB + h * 132;
    bf16x8 qr[4];
    float cfar;
    { const bf16* Qw = Q + (size_t)(qw0 + r32) * 1024 + h * 128 + comp * 64 + hi * 8;
#pragma unroll
      for (int d0 = 0; d0 < 4; ++d0) qr[d0] = *(const bf16x8*)(Qw + d0 * 16);
      float btv = 0.f; if (tid < 129) btv = bth[tid];
      const float bmax = bth[129], bfar = bth[130];
      const float kmx = sqrtf(__uint_as_float(KMAX[(h * 2 + comp) * 2]) + __uint_as_float(KMAX[(h * 2 + comp) * 2 + 1])) * 1.02f;
      if (tid < 129) bt[tid] = btv;
      float s = 0.f;
#pragma unroll
      for (int d0 = 0; d0 < 4; ++d0)
#pragma unroll
          for (int e2 = 0; e2 < 8; ++e2) { const float f = __builtin_bit_cast(float, (unsigned)(unsigned short)qr[d0][e2] << 16); s += f * f; }
      auto rr = __builtin_amdgcn_permlane32_swap(__float_as_uint(s), __float_as_uint(s), false, false); s = __uint_as_float(rr[0]) + __uint_as_float(rr[1]);
      cfar = bfar - (sqrtf(s) * 1.01f * kmx + bmax); }
    f32x16 cf;
#pragma unroll
    for (int r = 0; r < 16; ++r) cf[r] = cfar;
    asm volatile("" : "+v"(cf));
    const lds_cptr kp0 = (lds_cptr)(lds + LDS_K) + comp * 8192 + hi * 1024 + r32 * 16;
    const lds_cptr vp0 = (lds_cptr)(lds + LDS_V) + ((lane >> 4) & 1) * 32 + (lane & 3) * 8 + (4 * hi + ((lane & 15) >> 2)) * 64;
    float l_reg = 0.f;
    f32x16 o[4];
#pragma unroll
    for (int d0 = 0; d0 < 4; ++d0)
#pragma unroll
        for (int r = 0; r < 16; ++r) o[d0][r] = 0.f;
    bf16x8 kf[8];
    f32x16 pA0, pA1, pB0, pB1;
    u32x4 pw0, pw1, pw2, pw3;
    s16x4 vl0, vh0, vl1, vh1;
#define SBAR() __builtin_amdgcn_sched_barrier(0)
#define PIN(x) asm volatile("" : "+v"(x))
#define PKW(P, B) cvtpk(P[B], P[B + 1])
#define PAF(k) __builtin_bit_cast(bf16x8, pw##k)
#define EX(v) __builtin_amdgcn_exp2f(v)
#define ROT3() do { const int t_ = s0; s0 = s1; s1 = s2; s2 = t_; } while (0)
#define ENDW(t) do { if ((t) + 3 < NT) { ATT_WAIT_BAR(4); } else if ((t) + 1 < NT) { ATT_WAIT_BAR(2); } else { ATT_WAIT_BAR(0); } } while (0)
#define KLD(f, kp_) kf[f] = *(LAS const bf16x8*)((kp_) + ((f) >> 1) * 2048 + ((f) & 1) * 512)
#define BANDFIX(C0, C1, t) do { if (__builtin_expect(64 * (t) + 63 + 128 > qw0, 0)) { const int ln_ = opaque_tid(0);   \
        const int dq = qw0 + (ln_ & 31) - 64 * (t) - 4 * (ln_ >> 5); \
        _Pragma("unroll") for (int r = 0; r < 16; ++r) { const int d0_ = dq - ((r & 3) + 8 * (r >> 2)), d1_ = d0_ - 32; \
            const float b0 = bt[min(max(d0_, 0), 128)], b1 = bt[min(max(d1_, 0), 128)]; \
            C0[r] = d0_ < 0 ? -INFINITY : C0[r] + b0; C1[r] = d1_ < 0 ? -INFINITY : C1[r] + b1; } } } while (0)
#define VRD(j, i, vp_) do { vl##j = vtr((vp_) + ((i) & 3) * 4096 + ((i) >> 2) * 1024); vh##j = vtr((vp_) + ((i) & 3) * 4096 + ((i) >> 2) * 1024 + 512); } while (0)
#define VFR(j) (bf16x8){vl##j[0], vl##j[1], vl##j[2], vl##j[3], vh##j[0], vh##j[1], vh##j[2], vh##j[3]}
#define KSL(t) ((((t) & 3)) * SLOT)
#define GAPA(MF, A0, A1, A2, A3, W0, W1, PWX) do { MF; sacc += A0; sacc += A1; sacc += A2; sacc += A3; PIN(sacc); W0; W1; PIN(PWX); SBAR(); } while (0)
#define PHASE_A(C0, C1, P0, P1, vp_, t) do { float sacc = P0[0] + P0[1]; \
        GAPA(C0 = ATT_MFMA(kf[0], qr[0], cf), P0[2], P0[3], P0[4], P0[5],     pw0[0] = PKW(P0, 0), pw0[1] = PKW(P0, 2), pw0); \
        GAPA(C1 = ATT_MFMA(kf[1], qr[0], cf), P0[6], P0[7], P0[8], P0[9],     pw0[2] = PKW(P0, 4), pw0[3] = PKW(P0, 6), pw0); \
        if ((t) + 3 < NT) DMA_K0((t) + 3, KSL((t) + 3)); SBAR(); \
        GAPA(C0 = ATT_MFMA(kf[2], qr[1], C0), P0[10], P0[11], P0[12], P0[13], pw1[0] = PKW(P0, 8), pw1[1] = PKW(P0, 10), pw1); \
        GAPA(C1 = ATT_MFMA(kf[3], qr[1], C1), P0[14], P0[15], P1[0], P1[1],   pw1[2] = PKW(P0, 12), pw1[3] = PKW(P0, 14), pw1); \
        if ((t) + 3 < NT) DMA_K1((t) + 3, KSL((t) + 3)); SBAR(); \
        GAPA(C0 = ATT_MFMA(kf[4], qr[2], C0), P1[2], P1[3], P1[4], P1[5],     pw2[0] = PKW(P1, 0), pw2[1] = PKW(P1, 2), pw2); \
        GAPA(C1 = ATT_MFMA(kf[5], qr[2], C1), P1[6], P1[7], P1[8], P1[9],     pw2[2] = PKW(P1, 4), pw2[3] = PKW(P1, 6), pw2); \
        if ((t) + 1 < NT) DMA_V0((t) + 1, KSL((t) + 1)); SBAR(); \
        GAPA(C0 = ATT_MFMA(kf[6], qr[3], C0), P1[10], P1[11], P1[12], P1[13], pw3[0] = PKW(P1, 8), pw3[1] = PKW(P1, 10), pw3); \
        VRD(0, 0, vp_); SBAR(); \
        GAPA(C1 = ATT_MFMA(kf[7], qr[3], C1), P1[14], P1[15], 0.f, 0.f,       pw3[2] = PKW(P1, 12), pw3[3] = PKW(P1, 14), pw3); \
        if ((t) + 1 < NT) DMA_V1((t) + 1, KSL((t) + 1)); SBAR(); \
        l_reg += sacc; } while (0)
#define GAPB(i, j, jn, X, XB, DOEX, GL, vp_, kp_, N0, N1, DOSP) do { if ((i) + 1 < 16) { VRD(jn, (i) + 1, vp_); } \
        if ((GL) && ((i) & 1)) { KLD((i) >> 1, kp_); } SBAR(); \
        o[(i) & 3] = ATT_MFMA(PAF_SEL((i) >> 2), VFR(j), o[(i) & 3]); \
        if (DOEX) { X[XB] = EX(X[XB]); X[XB + 1] = EX(X[XB + 1]); PIN(X); } \
        SBAR(); } while (0)
#define PAF_SEL(k) ((k) == 0 ? PAF(0) : (k) == 1 ? PAF(1) : (k) == 2 ? PAF(2) : PAF(3))
#define PHASE_B(C0, C1, DOEX, GL, vp_, kp_, N0, N1, DOSP) do { \
        GAPB(0, 0, 1, C0, 0, DOEX, GL, vp_, kp_, N0, N1, DOSP); GAPB(1, 1, 0, C0, 2, DOEX, GL, vp_, kp_, N0, N1, DOSP); GAPB(2, 0, 1, C0, 4, DOEX, GL, vp_, kp_, N0, N1, DOSP); GAPB(3, 1, 0, C0, 6, DOEX, GL, vp_, kp_, N0, N1, DOSP); \
        GAPB(4, 0, 1, C0, 8, DOEX, GL, vp_, kp_, N0, N1, DOSP); GAPB(5, 1, 0, C0, 10, DOEX, GL, vp_, kp_, N0, N1, DOSP); GAPB(6, 0, 1, C0, 12, DOEX, GL, vp_, kp_, N0, N1, DOSP); GAPB(7, 1, 0, C0, 14, DOEX, GL, vp_, kp_, N0, N1, DOSP); \
        GAPB(8, 0, 1, C1, 0, DOEX, GL, vp_, kp_, N0, N1, DOSP); GAPB(9, 1, 0, C1, 2, DOEX, GL, vp_, kp_, N0, N1, DOSP); GAPB(10, 0, 1, C1, 4, DOEX, GL, vp_, kp_, N0, N1, DOSP); GAPB(11, 1, 0, C1, 6, DOEX, GL, vp_, kp_, N0, N1, DOSP); \
        GAPB(12, 0, 1, C1, 8, DOEX, GL, vp_, kp_, N0, N1, DOSP); GAPB(13, 1, 0, C1, 10, DOEX, GL, vp_, kp_, N0, N1, DOSP); GAPB(14, 0, 1, C1, 12, DOEX, GL, vp_, kp_, N0, N1, DOSP); GAPB(15, 1, 0, C1, 14, DOEX, GL, vp_, kp_, N0, N1, DOSP); \
        } while (0)
#define DMA_GROUP(t) do { if ((t) + 3 < NT) DMA_K((t) + 3, KSL((t) + 3)); if ((t) + 1 < NT) DMA_V((t) + 1, KSL((t) + 1)); } while (0)
#define STEP(C0, C1, P0, P1, t) do { const lds_cptr vpp = vp0 + KSL((t) - 1); const lds_cptr kpn = kp0 + KSL((t) + 1); \
        PHASE_A(C0, C1, P0, P1, vpp, t); \
        BANDFIX(C0, C1, t); \
        if (comp != 0) { ENDW(t); } \
        SBAR(); \
        PHASE_B(C0, C1, true, true, vpp, kpn, P0, P1, true); PIN(P0); PIN(P1); \
        if (comp == 0) { ENDW(t); } } while (0)
#define PACKSUM(P0, P1) do { float sacc = 0.f; _Pragma("unroll") for (int r = 0; r < 16; ++r) sacc += P0[r] + P1[r]; l_reg += sacc; \
        pw0 = (u32x4){PKW(P0, 0), PKW(P0, 2), PKW(P0, 4), PKW(P0, 6)}; pw1 = (u32x4){PKW(P0, 8), PKW(P0, 10), PKW(P0, 12), PKW(P0, 14)}; \
        pw2 = (u32x4){PKW(P1, 0), PKW(P1, 2), PKW(P1, 4), PKW(P1, 6)}; pw3 = (u32x4){PKW(P1, 8), PKW(P1, 10), PKW(P1, 12), PKW(P1, 14)}; } while (0)

    if (NT > 2) { ATT_WAIT_BAR(4); } else { ATT_WAIT_BAR(2); }
    if (comp != 0) { DMA_GROUP(0); }
    {
#pragma unroll
      for (int f = 0; f < 8; ++f) KLD(f, kp0);
      pA0 = ATT_MFMA(kf[0], qr[0], cf); pA1 = ATT_MFMA(kf[1], qr[0], cf);
#pragma unroll
      for (int d0 = 1; d0 < 4; ++d0) { pA0 = ATT_MFMA(kf[2 * d0], qr[d0], pA0); pA1 = ATT_MFMA(kf[2 * d0 + 1], qr[d0], pA1); } }
    SBAR();
    BANDFIX(pA0, pA1, 0);
    if (comp == 0) { DMA_GROUP(0); } else { ENDW(0); }
    {
#pragma unroll
        for (int r = 0; r < 16; ++r) { pA0[r] = EX(pA0[r]); pA1[r] = EX(pA1[r]); }
#pragma unroll
        for (int f = 0; f < 8; ++f) KLD(f, kp0 + KSL(1));
    }
    if (comp == 0) { ENDW(0); }
    {
        int t = 1;
        for (; t + 2 < NT; t += 2) { STEP(pB0, pB1, pA0, pA1, t); STEP(pA0, pA1, pB0, pB1, t + 1); }
        STEP(pB0, pB1, pA0, pA1, t);
        PACKSUM(pB0, pB1);
        VRD(0, 0, vp0 + KSL(NT - 1)); SBAR();
        PHASE_B(pA0, pA1, false, false, vp0 + KSL(NT - 1), kp0, pA0, pA1, false);
    }
    float l = l_reg;
    { auto rr = __builtin_amdgcn_permlane32_swap(__float_as_uint(l), __float_as_uint(l), false, false); l = __uint_as_float(rr[0]) + __uint_as_float(rr[1]); }
    if (hi == 0) wsf[32 + r32] = l;
    float rli[16];
#pragma unroll
    for (int r = 0; r < 16; ++r) rli[r] = __builtin_amdgcn_rcpf(wsf[32 + crow(r, hi)]);
    ATT_LBAR();
    LAS float* xch = (LAS float*)(lds + LDS_XCH) + rg * 4096;
    if (comp == 1) {
#pragma unroll
        for (int d0 = 0; d0 < 4; ++d0)
#pragma unroll
            for (int r = 0; r < 16; ++r) xch[(d0 * 16 + r) * 64 + lane] = o[d0][r] * rli[r] * lam;
    }
    ATT_LBAR();
    if (comp == 0) {
        float ss[16];
#pragma unroll
        for (int r = 0; r < 16; ++r) { float s_ = 0.f;
#pragma unroll
            for (int d0 = 0; d0 < 4; ++d0) { const float v = o[d0][r] * rli[r] - xch[(d0 * 16 + r) * 64 + lane]; o[d0][r] = v; s_ += v * v; }
            ss[r] = s_; }
#pragma unroll
        for (int r = 0; r < 16; ++r) {
            float v = ss[r]; v += pg8::dppf<0xB1>(v); v += pg8::dppf<0x4E>(v); v += pg8::dppf<0x141>(v); v += pg8::dppf<0x140>(v);
            auto sw = __builtin_amdgcn_permlane16_swap(__float_as_uint(v), __float_as_uint(v), false, false); ss[r] = __uint_as_float(sw[0]) + __uint_as_float(sw[1]); }
        LAS bf16* stg = (LAS bf16*)(lds + LDS_OST) + rg * 4096;
        float g4[4];
#pragma unroll
        for (int d0 = 0; d0 < 4; ++d0) g4[d0] = subln_g[d0 * 32 + r32];
#pragma unroll
        for (int r = 0; r < 16; ++r) { const float rs = 0.8f * __builtin_amdgcn_rsqf(ss[r] * (1.0f / 128.0f) + 1e-5f); const int orow = crow(r, hi);
#pragma unroll
            for (int d0 = 0; d0 < 4; ++d0) stg[orow * 128 + d0 * 32 + r32] = (bf16)f2bf(o[d0][r] * rs * g4[d0]); }
#pragma unroll
        for (int i = 0; i < 8; ++i) { const int row = i * 4 + (lane >> 4), ch = lane & 15;
            const u32x4 v = *(LAS const u32x4*)(stg + row * 128 + ch * 8);
            st16wt(O + (size_t)(qw0 + row) * 1024 + h * 128 + ch * 8, v); }
    }
    ATT_LBAR();
#undef ATT_RFL
#undef DMA_K
#undef DMA_V
#undef SBAR
#undef PIN
#undef PKW
#undef PAF
#undef EX
#undef ROT3
#undef ENDW
#undef KLD
#undef BANDFIX
#undef VRD
#undef VFR
#undef GAPA
#undef PHASE_A
#undef GAPB
#undef PAF_SEL
#undef PHASE_B
#undef STEP
#undef PACKSUM
#undef KSL
#undef DMA_GROUP
}

__device__ __forceinline__ void attn_phase(int wv, const Args& a, LAS unsigned char* lds, int blk, int G, bf16* Odst) {
    const float* BTAB = (const float*)(a.ws + WS_BTAB);
    const float lam = __builtin_bit_cast(float, __builtin_amdgcn_readfirstlane(__builtin_bit_cast(int, BTAB[8 * 132])));
    const bf16* Q = (const bf16*)(a.ws + WS_A3); const bf16* K = (const bf16*)(a.ws + WS_A4); const bf16* V = (const bf16*)(a.ws + WS_A5);
    const bool snake = (1024 % G) == 0;
    for (int j = 0;; ++j) {
        const int idx = j * G + blk; if (idx >= 1024) break;
        const int rank = (snake && (j & 1)) ? (j * G + (G - 1 - blk)) : idx;
        attn_unit_pipe(wv, rank & 7, 127 - (rank >> 3), Q, K, V, Odst, lds, lam, BTAB, a.in[I_SUBLN_G], (const unsigned*)(a.ws + WS_KMAX));
    }
}
}


__device__ __forceinline__ void peer_convert(int wv, const Args& a, int blk, int G) {
    const int tid = opaque_tid(wv), lane = tid & 63, gw = blk * 8 + (tid >> 6);
    for (int which = 0; which < 2; ++which) {
        const float* src = a.in[which ? I_PEER_V : I_PEER_U]; unsigned* dst = (unsigned*)(a.ws + (which ? WS_PV : WS_PU));
        const size_t nchunk = (size_t)16384 * 1024 / 1024, stride = (size_t)G * 8;
        for (size_t c = gw; c < nchunk; c += 2 * stride) {
            const size_t c1 = c + stride; const bool two = c1 < nchunk;
            f32x4 v[8];
#pragma unroll
            for (int j = 0; j < 4; ++j) v[j] = __builtin_nontemporal_load((const f32x4*)(src + c * 1024 + 256 * j + 4 * lane));
            if (two) {
#pragma unroll
                for (int j = 0; j < 4; ++j) v[4 + j] = __builtin_nontemporal_load((const f32x4*)(src + c1 * 1024 + 256 * j + 4 * lane)); }
#pragma unroll
            for (int j = 0; j < 4; ++j) { const f32x4 x = v[j] * 128.0f; int w = __builtin_amdgcn_cvt_pk_fp8_f32(x[0], x[1], 0, false); w = __builtin_amdgcn_cvt_pk_fp8_f32(x[2], x[3], w, true);
                dst[((size_t)(2 * j + (lane >> 5)) * 16384 + c) * 32 + (lane & 31)] = (unsigned)w; }
            if (two) {
#pragma unroll
                for (int j = 0; j < 4; ++j) { const f32x4 x = v[4 + j] * 128.0f; int w = __builtin_amdgcn_cvt_pk_fp8_f32(x[0], x[1], 0, false); w = __builtin_amdgcn_cvt_pk_fp8_f32(x[2], x[3], w, true);
                    dst[((size_t)(2 * j + (lane >> 5)) * 16384 + c1) * 32 + (lane & 31)] = (unsigned)w; } }
        } }
}
namespace peer {
typedef float f32x2v __attribute__((ext_vector_type(2)));
template <int CTRL> __device__ __forceinline__ float dpp(float x) { return __builtin_bit_cast(float, __builtin_amdgcn_mov_dpp(__builtin_bit_cast(int, x), CTRL, 0xf, 0xf, true)); }
template <int CTRL> __device__ __forceinline__ unsigned dppu(unsigned x) { return (unsigned)__builtin_amdgcn_mov_dpp((int)x, CTRL, 0xf, 0xf, true); }
template <int J> __device__ __forceinline__ unsigned shx(unsigned x, int lane) {
    if constexpr (J == 1) return dppu<0xB1>(x);
    else if constexpr (J == 2) return dppu<0x4E>(x);
    else if constexpr (J == 4) { const unsigned up = dppu<0x104>(x), dn = dppu<0x114>(x); return (lane & 4) ? dn : up; }
    else if constexpr (J == 8) return dppu<0x128>(x);
    else { auto s = __builtin_amdgcn_permlane16_swap(x, x, false, false); return (lane & 16) ? s[0] : s[1]; }
}
__device__ __forceinline__ unsigned half32_umax(unsigned m) {
    unsigned t = dppu<0xB1>(m); m = t > m ? t : m; t = dppu<0x4E>(m); m = t > m ? t : m; t = dppu<0x141>(m); m = t > m ? t : m; t = dppu<0x140>(m); m = t > m ? t : m;
    auto s = __builtin_amdgcn_permlane16_swap(m, m, false, false); return s[0] > s[1] ? s[0] : s[1]; }
__device__ __forceinline__ float row16_sum(float x) { x += dpp<0xB1>(x); x += dpp<0x4E>(x); x += dpp<0x141>(x); x += dpp<0x140>(x); return x; }
__device__ __forceinline__ float wsum(float x) {
    x += dpp<0xB1>(x); x += dpp<0x4E>(x); x += dpp<0x141>(x); x += dpp<0x140>(x);
    auto s = __builtin_amdgcn_permlane16_swap(__float_as_uint(x), __float_as_uint(x), false, false); x = __uint_as_float(s[0]) + __uint_as_float(s[1]);
    auto t = __builtin_amdgcn_permlane32_swap(__float_as_uint(x), __float_as_uint(x), false, false); return __uint_as_float(t[0]) + __uint_as_float(t[1]);
}
__device__ __forceinline__ void peer_p0(int wv, const Args& a, int blk, int G, int pre) {
    const int tid = opaque_tid(wv), lane = tid & 63, wave = tid >> 6, hh = lane >> 5, l32 = lane & 31;
    const unsigned* TK = (const unsigned*)(a.ws + WS_TOPK); const unsigned char* PU = (const unsigned char*)(a.ws + WS_PU); const unsigned char* PVt = (const unsigned char*)(a.ws + WS_PV);
    const float* gF = a.in[I_NORM_FFN_G]; const float* gO = a.in[I_FINAL_G];
    int ci0 = 0, cj0 = 0, ci1 = 0, cj1 = 0; bool valid1 = false;
    { int p = 0;
      for (int i = 0; i < 16; ++i) for (int j = 0; j < 16; ++j) if ((i + 1) * (j + 1) <= 16) { if (p == l32) { ci0 = i; cj0 = j; } if (p == l32 + 32) { ci1 = i; cj1 = j; valid1 = true; } ++p; } }
    const int gwv = blk * 8 + wave, nwv = G * 8; int crow = pre + gwv;
#define P0_CLOAD(DST, id_) do { const float* s_ = a.in[((id_) >> 14) ? I_PEER_V : I_PEER_U] + (size_t)((id_) & 16383) * 1024 + 4 * lane; \
        _Pragma("unroll") for (int j = 0; j < 4; ++j) DST[j] = __builtin_nontemporal_load((const f32x4*)(s_ + 256 * j)); } while (0)
#define P0_CSTORE(SRC, id_) do { unsigned* d_ = (unsigned*)(a.ws + (((id_) >> 14) ? WS_PV : WS_PU)); const size_t c_ = (size_t)((id_) & 16383); \
        _Pragma("unroll") for (int j = 0; j < 4; ++j) { const f32x4 x_ = SRC[j] * 128.0f; int w_ = __builtin_amdgcn_cvt_pk_fp8_f32(x_[0], x_[1], 0, false); w_ = __builtin_amdgcn_cvt_pk_fp8_f32(x_[2], x_[3], w_, true); \
            d_[((size_t)(2 * j + (lane >> 5)) * 16384 + c_) * 32 + (lane & 31)] = (unsigned)w_; } } while (0)
    unsigned keyn[4];
    if (blk * 8 + wave < S) {
#pragma unroll
        for (int i = 0; i < 4; ++i) keyn[i] = TK[(size_t)(blk * 8 + wave) * 256 + lane + 64 * i]; }
    for (int tok = blk * 8 + wave; tok < S; tok += G * 8) {
        f32x4 cva[4], cvb[4]; const int ca = crow, cb = pre ? 32768 : crow + nwv; crow += pre ? nwv : 2 * nwv;
        unsigned key[4];
#pragma unroll
        for (int i = 0; i < 4; ++i) key[i] = keyn[i];
        if (tok + G * 8 < S) {
#pragma unroll
            for (int i = 0; i < 4; ++i) keyn[i] = TK[(size_t)(tok + G * 8) * 256 + lane + 64 * i]; }
        const f32x4* sp = (const f32x4*)((const float*)(a.ws + WS_SS2) + (size_t)tok * 16); const f32x4 sq0 = sp[0], sq1 = sp[1], sq2 = sp[2], sq3 = sp[3];
        if (ca < 32768) P0_CLOAD(cva, ca);
        if (cb < 32768) P0_CLOAD(cvb, cb);
        int ex[4]; float gw[4];
#pragma unroll
        for (int i = 0; i < 4; ++i) {
            const unsigned k = key[i];
            const float v = pg8::ord2f(k & ~0x7Fu); const int ix = 127 - (int)(k & 0x7Fu);
            const float s0 = __shfl(v, hh * 32 + ci0) + __shfl(v, hh * 32 + 16 + cj0);
            const float s1 = __shfl(v, hh * 32 + ci1) + __shfl(v, hh * 32 + 16 + cj1);
            unsigned ck0 = (pg8::f2ord(s0) & ~0xFFu) | (unsigned)(255 - (ci0 * 16 + cj0));
            unsigned ck1 = valid1 ? ((pg8::f2ord(s1) & ~0xFFu) | (unsigned)(255 - (ci1 * 16 + cj1))) : 0u;
#define P0_CX(J, K) do { const bool low_ = (l32 & (J)) == 0; \
                { const unsigned pr = shx<J>(ck0, lane); const bool up_ = (K) >= 64 ? true : (K) == 32 ? true : ((l32 & (K)) == 0); const unsigned hi_ = ck0 > pr ? ck0 : pr, lo_ = ck0 > pr ? pr : ck0; ck0 = (up_ == low_) ? hi_ : lo_; } \
                { const unsigned pr = shx<J>(ck1, lane); const bool up_ = (K) >= 64 ? true : (K) == 32 ? false : ((l32 & (K)) == 0); const unsigned hi_ = ck1 > pr ? ck1 : pr, lo_ = ck1 > pr ? pr : ck1; ck1 = (up_ == low_) ? hi_ : lo_; } } while (0)
            P0_CX(1, 2);
            P0_CX(2, 4); P0_CX(1, 4);
            P0_CX(4, 8); P0_CX(2, 8); P0_CX(1, 8);
            P0_CX(8, 16); P0_CX(4, 16); P0_CX(2, 16); P0_CX(1, 16);
            P0_CX(16, 32); P0_CX(8, 32); P0_CX(4, 32); P0_CX(2, 32); P0_CX(1, 32);
            { const unsigned hi_ = ck0 > ck1 ? ck0 : ck1, lo_ = ck0 > ck1 ? ck1 : ck0; ck0 = hi_; ck1 = lo_; }
            P0_CX(16, 64); P0_CX(8, 64); P0_CX(4, 64); P0_CX(2, 64); P0_CX(1, 64);
#undef P0_CX
            const unsigned win = ck0;
            const float ts = pg8::ord2f(win & ~0xFFu); const int flat = 255 - (int)(win & 0xFFu);
            const float mx = __shfl(ts, hh * 32);
            const float e = (l32 < 16) ? __expf(ts - mx) : 0.f;
            const float sum = row16_sum(e);
            gw[i] = e / sum;
            const int e0 = __shfl(ix, hh * 32 + ((flat >> 4) & 15)), e1 = __shfl(ix, hh * 32 + 16 + (flat & 15));
            ex[i] = e0 * 128 + e1;
        }
        if (l32 < 16) {
#pragma unroll
            for (int i = 0; i < 4; ++i) { const int q_ = (2 * i + hh) * 16 + l32; const size_t o_ = (size_t)tok * 128 + q_;
                ((unsigned short*)(a.ws + WS_IDG))[(size_t)tok * 128 + (q_ & 7) * 16 + (q_ >> 3)] = (unsigned short)ex[i];
                ((float*)(a.ws + WS_GW))[o_] = gw[i]; } }
        { const f32x4 s4 = (sq0 + sq1) + (sq2 + sq3); const float rstd = 1.0f / sqrtf(((s4[0] + s4[1]) + (s4[2] + s4[3])) * (1.0f / D) + 1e-6f);
          if (lane == 0) ((float*)(a.ws + WS_RS))[tok] = rstd; }
        if (ca < 32768) P0_CSTORE(cva, ca);
        if (cb < 32768) P0_CSTORE(cvb, cb);
    }
    for (; crow < 32768; crow += nwv) { f32x4 cva[4]; P0_CLOAD(cva, crow); P0_CSTORE(cva, crow); }
#undef P0_CLOAD
#undef P0_CSTORE
}
__device__ __forceinline__ f32x2v fp8lo(unsigned w) { return __builtin_amdgcn_cvt_pk_f32_fp8((int)w, false); }
__device__ __forceinline__ f32x2v fp8hi(unsigned w) { return __builtin_amdgcn_cvt_pk_f32_fp8((int)w, true); }
__device__ __forceinline__ void peer_pa(int wv, const Args& a, int j, int r0, int nw) {
    const int tid = opaque_tid(wv), lane = tid & 63, wave = tid >> 6, p = lane >> 3, c = lane & 7;
    const int w0 = r0 + wave;
    const unsigned char* PUs = (const unsigned char*)(a.ws + WS_PU) + (size_t)j * (16384 * 128) + c * 16;
    const unsigned short* IDH = (const unsigned short*)(a.ws + WS_IDG); const float* RS = (const float*)(a.ws + WS_RS); unsigned short* PART = (unsigned short*)(a.ws + WS_PART);
    const unsigned short* XB = (const unsigned short*)(a.ws + WS_A2);
    if (w0 >= nw) return;
    float gc[16];
#pragma unroll
    for (int e = 0; e < 16; ++e) gc[e] = a.in[I_NORM_FFN_G][128 * j + 16 * c + e];
#define PA_GATHER(DST, EID) do { _Pragma("unroll") for (int q = 0; q < 16; ++q) { const unsigned w_ = EID[q >> 3][(q >> 1) & 3]; DST[q] = *(const u32x4*)(PUs + (size_t)((q & 1) ? (w_ >> 16) : (w_ & 0xffffu)) * 128); } } while (0)
#define PA_TOKEN(SRC, X0, X1, RSV, t_) do { f32x2v hp[8]; \
        hp[0] = (f32x2v){bflo(X0.x) * RSV * gc[0], bfhi(X0.x) * RSV * gc[1]};   hp[1] = (f32x2v){bflo(X0.y) * RSV * gc[2], bfhi(X0.y) * RSV * gc[3]}; \
        hp[2] = (f32x2v){bflo(X0.z) * RSV * gc[4], bfhi(X0.z) * RSV * gc[5]};   hp[3] = (f32x2v){bflo(X0.w) * RSV * gc[6], bfhi(X0.w) * RSV * gc[7]}; \
        hp[4] = (f32x2v){bflo(X1.x) * RSV * gc[8], bfhi(X1.x) * RSV * gc[9]};   hp[5] = (f32x2v){bflo(X1.y) * RSV * gc[10], bfhi(X1.y) * RSV * gc[11]}; \
        hp[6] = (f32x2v){bflo(X1.z) * RSV * gc[12], bfhi(X1.z) * RSV * gc[13]}; hp[7] = (f32x2v){bflo(X1.w) * RSV * gc[14], bfhi(X1.w) * RSV * gc[15]}; \
        float dd[16]; \
        _Pragma("unroll") for (int q = 0; q < 16; ++q) { \
            f32x2v s2 = fp8lo(SRC[q].x) * hp[0]; \
            s2 = __builtin_elementwise_fma(fp8hi(SRC[q].x), hp[1], s2); s2 = __builtin_elementwise_fma(fp8lo(SRC[q].y), hp[2], s2); s2 = __builtin_elementwise_fma(fp8hi(SRC[q].y), hp[3], s2); \
            s2 = __builtin_elementwise_fma(fp8lo(SRC[q].z), hp[4], s2); s2 = __builtin_elementwise_fma(fp8hi(SRC[q].z), hp[5], s2); \
            s2 = __builtin_elementwise_fma(fp8lo(SRC[q].w), hp[6], s2); s2 = __builtin_elementwise_fma(fp8hi(SRC[q].w), hp[7], s2); \
            dd[q] = s2[0] + s2[1]; } \
          \
        float r8[8], r4[4], r2[2]; \
        _Pragma("unroll") for (int k = 0; k < 8; ++k) { const float keep = b0 ? dd[k + 8] : dd[k], give = b0 ? dd[k] : dd[k + 8]; r8[k] = keep + dpp<0xB1>(give); } \
        _Pragma("unroll") for (int k = 0; k < 4; ++k) { const float keep = b1 ? r8[k + 4] : r8[k], give = b1 ? r8[k] : r8[k + 4]; r4[k] = keep + dpp<0x4E>(give); } \
        _Pragma("unroll") for (int k = 0; k < 2; ++k) { const float keep = b2 ? r4[k + 2] : r4[k], give = b2 ? r4[k] : r4[k + 2]; \
            const float up = dpp<0x104>(give), dn = dpp<0x114>(give); r2[k] = keep + (b2 ? dn : up); } \
        unsigned short* pp = PART + ((size_t)(t_) * 8 + j) * 128 + p; pp[8 * itb] = (unsigned short)f2bf(r2[0]); pp[8 * (itb + 1)] = (unsigned short)f2bf(r2[1]); } while (0)
    const bool b0 = c & 1, b1 = c & 2, b2 = c & 4; const int itb = 8 * (c & 1) + 4 * ((c >> 1) & 1) + 2 * (c >> 2);
#define PA_LOADX(X0, X1, RSV, t_) do { const unsigned short* xp_ = XB + (size_t)(t_) * D + 128 * j + 16 * c; X0 = *(const u32x4*)xp_; X1 = *(const u32x4*)(xp_ + 8); RSV = RS[t_]; } while (0)
#define PA_LOADI(EID, t_) do { const u32x4* ip_ = (const u32x4*)(IDH + (size_t)(t_) * 128 + p * 16); EID[0] = ip_[0]; EID[1] = ip_[1]; } while (0)
    u32x4 eid[2]; u32x4 xa0, xa1, xb0, xb1; float rsa, rsb; u32x4 ga[16], gb[16];
    PA_LOADI(eid, w0); PA_LOADX(xa0, xa1, rsa, w0);
    PA_GATHER(ga, eid);
    if (w0 + nw < S) PA_LOADI(eid, w0 + nw);
    for (int tok = w0; tok < S; tok += 2 * nw) {
        const int t1 = tok + nw, t2 = tok + 2 * nw, t3 = tok + 3 * nw;
        if (t1 < S) { PA_GATHER(gb, eid); PA_LOADX(xb0, xb1, rsb, t1); }
        if (t2 < S) PA_LOADI(eid, t2);
        PA_TOKEN(ga, xa0, xa1, rsa, tok);
        if (t1 < S) {
            if (t2 < S) { PA_GATHER(ga, eid); PA_LOADX(xa0, xa1, rsa, t2); }
            if (t3 < S) PA_LOADI(eid, t3);
            PA_TOKEN(gb, xb0, xb1, rsb, t1); }
    }
#undef PA_LOADX
#undef PA_LOADI
#undef PA_GATHER
#undef PA_TOKEN
}
__device__ __forceinline__ void peer_pa2(int wv, const Args& a, int blk, int G) {
    const int tid = opaque_tid(wv);
    const unsigned* PART = (const unsigned*)(a.ws + WS_PART); const f32x2v* GW = (const f32x2v*)(a.ws + WS_GW); f32x2v* WW = (f32x2v*)(a.ws + WS_WW);
    for (size_t i = (size_t)blk * 512 + tid; i < (size_t)S * 64; i += (size_t)G * 512) {
        const size_t tok = i >> 6; const int q2 = (int)(i & 63); const unsigned* pp = PART + tok * 512 + q2;
        unsigned w[8];
#pragma unroll
        for (int k = 0; k < 8; ++k) w[k] = pp[64 * k];
        float z0 = ((bflo(w[0]) + bflo(w[1])) + (bflo(w[2]) + bflo(w[3]))) + ((bflo(w[4]) + bflo(w[5])) + (bflo(w[6]) + bflo(w[7])));
        float z1 = ((bfhi(w[0]) + bfhi(w[1])) + (bfhi(w[2]) + bfhi(w[3]))) + ((bfhi(w[4]) + bfhi(w[5])) + (bfhi(w[6]) + bfhi(w[7])));
        z0 *= (1.0f / 128.0f); z1 *= (1.0f / 128.0f);
        const f32x2v g = GW[i];
        WW[i] = (f32x2v){g[0] * 0.5f * z0 * (1.0f + erff(z0 * 0.70710678118654752f)) * (1.0f / 128.0f), g[1] * 0.5f * z1 * (1.0f + erff(z1 * 0.70710678118654752f)) * (1.0f / 128.0f)};
    }
}
__device__ __forceinline__ void peer_pb(int wv, const Args& a, int j, int r0, int nw, float* OUTP) {
    const int tid = opaque_tid(wv), lane = tid & 63, wave = tid >> 6, p = lane >> 3, c = lane & 7;
    const int w0 = r0 + wave;
    const unsigned char* PVs = (const unsigned char*)(a.ws + WS_PV) + (size_t)j * (16384 * 128) + c * 16;
    const unsigned short* IDH = (const unsigned short*)(a.ws + WS_IDG); const float* WW = (const float*)(a.ws + WS_WW); float* SSP = (float*)(a.ws + WS_SSP);
    const unsigned short* XB = (const unsigned short*)(a.ws + WS_A2);
    if (w0 >= nw) return;
    const bool b3 = lane & 8, b4 = lane & 16, b5 = lane & 32;
    const int cidx = 128 * j + 16 * c + (b3 ? 8 : 0) + (b4 ? 4 : 0) + (b5 ? 2 : 0);
#define PB_LOADI(EID, t_) do { const u32x4* ip_ = (const u32x4*)(IDH + (size_t)(t_) * 128 + p * 16); EID[0] = ip_[0]; EID[1] = ip_[1]; } while (0)
#define PB_LOADW(WQ, XP, t_) do { _Pragma("unroll") for (int it = 0; it < 16; ++it) WQ[it] = WW[(size_t)(t_) * 128 + 8 * it + p]; XP = *(const unsigned*)(XB + (size_t)(t_) * D + cidx); } while (0)
#define PB_GATHER(DST, EID) do { _Pragma("unroll") for (int q = 0; q < 16; ++q) { const unsigned w_ = EID[q >> 3][(q >> 1) & 3]; DST[q] = *(const u32x4*)(PVs + (size_t)((q & 1) ? (w_ >> 16) : (w_ & 0xffffu)) * 128); } } while (0)
#define PB_TOKEN(SRC, WQ, XP, t_) do { f32x2v acc[8]; \
        _Pragma("unroll") for (int e2 = 0; e2 < 8; ++e2) acc[e2] = (f32x2v){0.f, 0.f}; \
        _Pragma("unroll") for (int q = 0; q < 16; ++q) { const float w = WQ[q]; const f32x2v w2 = {w, w}; \
            acc[0] = __builtin_elementwise_fma(fp8lo(SRC[q].x), w2, acc[0]); acc[1] = __builtin_elementwise_fma(fp8hi(SRC[q].x), w2, acc[1]); \
            acc[2] = __builtin_elementwise_fma(fp8lo(SRC[q].y), w2, acc[2]); acc[3] = __builtin_elementwise_fma(fp8hi(SRC[q].y), w2, acc[3]); \
            acc[4] = __builtin_elementwise_fma(fp8lo(SRC[q].z), w2, acc[4]); acc[5] = __builtin_elementwise_fma(fp8hi(SRC[q].z), w2, acc[5]); \
            acc[6] = __builtin_elementwise_fma(fp8lo(SRC[q].w), w2, acc[6]); acc[7] = __builtin_elementwise_fma(fp8hi(SRC[q].w), w2, acc[7]); } \
        float r8[8], r4[4], r2[2]; \
        _Pragma("unroll") for (int k = 0; k < 8; ++k) { const float lo_ = acc[k >> 1][k & 1], hi_ = acc[4 + (k >> 1)][k & 1]; \
            const float keep = b3 ? hi_ : lo_, give = b3 ? lo_ : hi_; r8[k] = keep + dpp<0x128>(give); }                                      \
        _Pragma("unroll") for (int k = 0; k < 4; ++k) { const float keep = b4 ? r8[k + 4] : r8[k], give = b4 ? r8[k] : r8[k + 4]; \
            auto sw = __builtin_amdgcn_permlane16_swap(__float_as_uint(give), __float_as_uint(give), false, false);                          \
            r4[k] = keep + __uint_as_float(b4 ? sw[0] : sw[1]); } \
        _Pragma("unroll") for (int k = 0; k < 2; ++k) { const float keep = b5 ? r4[k + 2] : r4[k], give = b5 ? r4[k] : r4[k + 2]; \
            auto sw = __builtin_amdgcn_permlane32_swap(__float_as_uint(give), __float_as_uint(give), false, false);                          \
            r2[k] = keep + __uint_as_float(b5 ? sw[0] : sw[1]); } \
        const float y0 = r2[0] + bflo(XP), y1 = r2[1] + bfhi(XP); \
        const float ss = wsum(y0 * y0 + y1 * y1); \
        *(f32x2v*)(OUTP + (size_t)(t_) * D + cidx) = (f32x2v){y0, y1}; \
        if (lane == 0) SSP[(size_t)(t_) * 8 + j] = ss; } while (0)
    u32x4 eid[2]; float wqa[16], wqb[16]; unsigned xpa, xpb; u32x4 ga[16], gb[16];
    PB_LOADI(eid, w0); PB_LOADW(wqa, xpa, w0);
    PB_GATHER(ga, eid);
    if (w0 + nw < S) PB_LOADI(eid, w0 + nw);
    for (int tok = w0; tok < S; tok += 2 * nw) {
        const int t1 = tok + nw, t2 = tok + 2 * nw, t3 = tok + 3 * nw;
        if (t1 < S) { PB_GATHER(gb, eid); PB_LOADW(wqb, xpb, t1); }
        if (t2 < S) PB_LOADI(eid, t2);
        PB_TOKEN(ga, wqa, xpa, tok);
        if (t1 < S) {
            if (t2 < S) { PB_GATHER(ga, eid); PB_LOADW(wqa, xpa, t2); }
            if (t3 < S) PB_LOADI(eid, t3);
            PB_TOKEN(gb, wqb, xpb, t1); }
    }
#undef PB_LOADI
#undef PB_LOADW
#undef PB_GATHER
#undef PB_TOKEN
}
__device__ __forceinline__ void peer_pc(int wv, const Args& a, int blk, int G, float* OUTP) {
    const int tid = opaque_tid(wv), lane = tid & 63, wave = tid >> 6;
    const float* SSP = (const float*)(a.ws + WS_SSP); const float* gO = a.in[I_FINAL_G];
    f32x4 gg[4];
#pragma unroll
    for (int q = 0; q < 4; ++q) gg[q] = *(const f32x4*)(gO + 16 * lane + 4 * q);
    f32x4 xa[4], xn[4], s0, s1, s0n, s1n; int tok = blk * 8 + wave;
#define PC_LOAD(X, A0, A1, t_) do { const float* r_ = OUTP + (size_t)(t_) * D + 16 * lane; _Pragma("unroll") for (int q = 0; q < 4; ++q) X[q] = *(const f32x4*)(r_ + 4 * q); \
        A0 = *(const f32x4*)(SSP + (size_t)(t_) * 8); A1 = *(const f32x4*)(SSP + (size_t)(t_) * 8 + 4); } while (0)
    if (tok < S) PC_LOAD(xa, s0, s1, tok);
    for (; tok < S; tok += G * 8) {
        if (tok + G * 8 < S) PC_LOAD(xn, s0n, s1n, tok + G * 8);
        float* orow = OUTP + (size_t)tok * D + 16 * lane;
        const float s3 = ((s0[0] + s0[1]) + (s0[2] + s0[3])) + ((s1[0] + s1[1]) + (s1[2] + s1[3]));
        const float r3 = 1.0f / sqrtf(s3 * (1.0f / D) + 1e-6f);
#pragma unroll
        for (int q = 0; q < 4; ++q) *(f32x4*)(orow + 4 * q) = xa[q] * r3 * gg[q];
#pragma unroll
        for (int q = 0; q < 4; ++q) xa[q] = xn[q];
        s0 = s0n; s1 = s1n;
    }
#undef PC_LOAD
}
__device__ __forceinline__ void peer_phase(int wv, const Args& a, int blk, int G, float* OUTP) {
    const int tid = opaque_tid(wv), lane = tid & 63, wave = tid >> 6, hh = lane >> 5, l32 = lane & 31;
    const unsigned* TK = (const unsigned*)(a.ws + WS_TOPK); const unsigned char* PU = (const unsigned char*)(a.ws + WS_PU); const unsigned char* PVt = (const unsigned char*)(a.ws + WS_PV);
    const float* gF = a.in[I_NORM_FFN_G]; const float* gO = a.in[I_FINAL_G];
    int ci0 = 0, cj0 = 0, ci1 = 0, cj1 = 0; bool valid1 = false;
    { int p = 0;
      for (int i = 0; i < 16; ++i) for (int j = 0; j < 16; ++j) if ((i + 1) * (j + 1) <= 16) { if (p == l32) { ci0 = i; cj0 = j; } if (p == l32 + 32) { ci1 = i; cj1 = j; valid1 = true; } ++p; } }
    for (int tok = blk * 8 + wave; tok < S; tok += G * 8) {
        const unsigned short* xrow = (const unsigned short*)(a.ws + WS_A2) + (size_t)tok * D + 16 * lane;
        f32x4 xa[4];
        { const u32x4 r0 = *(const u32x4*)xrow, r1 = *(const u32x4*)(xrow + 8);
          xa[0] = (f32x4){bflo(r0.x), bfhi(r0.x), bflo(r0.y), bfhi(r0.y)}; xa[1] = (f32x4){bflo(r0.z), bfhi(r0.z), bflo(r0.w), bfhi(r0.w)};
          xa[2] = (f32x4){bflo(r1.x), bfhi(r1.x), bflo(r1.y), bfhi(r1.y)}; xa[3] = (f32x4){bflo(r1.z), bfhi(r1.z), bflo(r1.w), bfhi(r1.w)}; }
        unsigned key[4];
#pragma unroll
        for (int i = 0; i < 4; ++i) key[i] = TK[(size_t)tok * 256 + lane + 64 * i];
        float ss = 0.f;
#pragma unroll
        for (int j = 0; j < 4; ++j) ss += (xa[j][0] * xa[j][0] + xa[j][1] * xa[j][1]) + (xa[j][2] * xa[j][2] + xa[j][3] * xa[j][3]);
        ss = wsum(ss);
        const float rstd = 1.0f / sqrtf(ss * (1.0f / D) + 1e-6f);
        float hf[16];
#pragma unroll
        for (int j = 0; j < 4; ++j) { const f32x4 gg = *(const f32x4*)(gF + 16 * lane + 4 * j);
#pragma unroll
            for (int e = 0; e < 4; ++e) hf[4 * j + e] = xa[j][e] * rstd * gg[e]; }
        int ex[4]; float gw[4];
#pragma unroll
        for (int i = 0; i < 4; ++i) {
            const unsigned k = key[i];
            const float v = pg8::ord2f(k & ~0x7Fu); const int ix = 127 - (int)(k & 0x7Fu);
            const float s0 = __shfl(v, hh * 32 + ci0) + __shfl(v, hh * 32 + 16 + cj0);
            const float s1 = __shfl(v, hh * 32 + ci1) + __shfl(v, hh * 32 + 16 + cj1);
            unsigned ck0 = (pg8::f2ord(s0) & ~0xFFu) | (unsigned)(255 - (ci0 * 16 + cj0));
            unsigned ck1 = valid1 ? ((pg8::f2ord(s1) & ~0xFFu) | (unsigned)(255 - (ci1 * 16 + cj1))) : 0u;
            unsigned win = 0u;
#pragma unroll
            for (int r = 0; r < 16; ++r) {
                const unsigned m = half32_umax(ck0 > ck1 ? ck0 : ck1);
                if (l32 == r) win = m;
                if (ck0 == m) ck0 = 0u;
                if (ck1 == m) ck1 = 0u;
            }
            const float ts = pg8::ord2f(win & ~0xFFu); const int flat = 255 - (int)(win & 0xFFu);
            const float mx = __shfl(ts, hh * 32);
            const float e = (l32 < 16) ? __expf(ts - mx) : 0.f;
            const float sum = row16_sum(e);
            gw[i] = e / sum;
            const int e0 = __shfl(ix, hh * 32 + ((flat >> 4) & 15)), e1 = __shfl(ix, hh * 32 + 16 + (flat & 15));
            ex[i] = e0 * 128 + e1;
        }
        float acc[16];
#pragma unroll
        for (int j = 0; j < 16; ++j) acc[j] = 0.f;
#pragma unroll 1
        for (int b = 0; b < 16; ++b) {
            const int i = b >> 2, sl = ((b >> 1) & 1) * 32 + (b & 1) * 8;
            const int exv = i == 0 ? ex[0] : i == 1 ? ex[1] : i == 2 ? ex[2] : ex[3];
            const float gwv = i == 0 ? gw[0] : i == 1 ? gw[1] : i == 2 ? gw[2] : gw[3];
            u32x4 uu[8], vv[8];
#pragma unroll
            for (int q = 0; q < 8; ++q) { const int eid = __builtin_amdgcn_readlane(exv, sl + q); uu[q] = *(const u32x4*)(PU + (size_t)eid * 1024 + 16 * lane); vv[q] = *(const u32x4*)(PVt + (size_t)eid * 1024 + 16 * lane); }
            float d[8];
#pragma unroll
            for (int q = 0; q < 8; ++q) { float s_ = 0.f;
#pragma unroll
                for (int e = 0; e < 4; ++e) { const f32x2v lo = __builtin_amdgcn_cvt_pk_f32_fp8((int)uu[q][e], false), hi2 = __builtin_amdgcn_cvt_pk_f32_fp8((int)uu[q][e], true);
                    s_ += (lo[0] * hf[4 * e] + lo[1] * hf[4 * e + 1]) + (hi2[0] * hf[4 * e + 2] + hi2[1] * hf[4 * e + 3]); }
                d[q] = s_; }
            float z;
            { const bool b0 = lane & 1, b1 = lane & 2, b2 = lane & 4;
              float r4[4], r2[2];
#pragma unroll
              for (int q = 0; q < 4; ++q) { const float keep = b0 ? d[q + 4] : d[q], give = b0 ? d[q] : d[q + 4]; r4[q] = keep + dpp<0xB1>(give); }
#pragma unroll
              for (int q = 0; q < 2; ++q) { const float keep = b1 ? r4[q + 2] : r4[q], give = b1 ? r4[q] : r4[q + 2]; r2[q] = keep + dpp<0x4E>(give); }
              { const float keep = b2 ? r2[1] : r2[0], give = b2 ? r2[0] : r2[1];
                const float up = dpp<0x104>(give), dn = dpp<0x114>(give);
                z = keep + (b2 ? dn : up); }
              z += dpp<0x128>(z);
              auto s16 = __builtin_amdgcn_permlane16_swap(__float_as_uint(z), __float_as_uint(z), false, false); z = __uint_as_float(s16[0]) + __uint_as_float(s16[1]);
              auto s32 = __builtin_amdgcn_permlane32_swap(__float_as_uint(z), __float_as_uint(z), false, false); z = __uint_as_float(s32[0]) + __uint_as_float(s32[1]); }
            const int myq = 4 * (lane & 1) + 2 * ((lane >> 1) & 1) + ((lane >> 2) & 1);
            const float gmine = __shfl(gwv, sl + myq);
            z *= (1.0f / 128.0f);
            const float wl = gmine * 0.5f * z * (1.0f + erff(z * 0.70710678118654752f)) * (1.0f / 128.0f);
#pragma unroll
            for (int q = 0; q < 8; ++q) { const float w = __builtin_bit_cast(float, __builtin_amdgcn_readlane(__builtin_bit_cast(int, wl), ((q >> 2) & 1) | (((q >> 1) & 1) << 1) | ((q & 1) << 2)));
#pragma unroll
                for (int e = 0; e < 4; ++e) { const f32x2v lo = __builtin_amdgcn_cvt_pk_f32_fp8((int)vv[q][e], false), hi2 = __builtin_amdgcn_cvt_pk_f32_fp8((int)vv[q][e], true);
                    acc[4 * e] += w * lo[0]; acc[4 * e + 1] += w * lo[1]; acc[4 * e + 2] += w * hi2[0]; acc[4 * e + 3] += w * hi2[1]; } }
        }
        float s3 = 0.f;
#pragma unroll
        for (int j = 0; j < 4; ++j)
#pragma unroll
            for (int e = 0; e < 4; ++e) { xa[j][e] += acc[4 * j + e]; s3 += xa[j][e] * xa[j][e]; }
        s3 = wsum(s3);
        const float r3 = 1.0f / sqrtf(s3 * (1.0f / D) + 1e-6f);
        float* orow = OUTP + (size_t)tok * D + 16 * lane;
#pragma unroll
        for (int j = 0; j < 4; ++j) { const f32x4 gg = *(const f32x4*)(gO + 16 * lane + 4 * j); *(f32x4*)(orow + 4 * j) = xa[j] * r3 * gg; }
    }
}
}

#define XB_TMO      128
#define XB_XCNT(j)  (256  + 64 * (j))
#define XB_XSUB(j)  (1280 + 64 * (j))
#define XB_XGEN(j)  (2304 + 64 * (j))
#define XB_TOP      3328
#define XB_TOPGEN   3392
#define XCD_BAR_WORDS 3456
#define XB_SPIN_CAP (1u << 18)

__device__ __forceinline__ unsigned xb_ld(unsigned* p)              { return __hip_atomic_load(p, __ATOMIC_RELAXED, __HIP_MEMORY_SCOPE_AGENT); }
__device__ __forceinline__ unsigned xb_add(unsigned* p, unsigned v) { return __hip_atomic_fetch_add(p, v, __ATOMIC_RELAXED, __HIP_MEMORY_SCOPE_AGENT); }
__device__ __forceinline__ unsigned xb_xcc_id() { return (unsigned)__builtin_amdgcn_s_getreg((3 << 11) | 20) & 0xFu; }
#define XB_SPIN(cond, bar) do { unsigned _sp = 0; while (cond) { __builtin_amdgcn_s_sleep(1); \
    if ((++_sp & 255u) == 0u) { if (xb_ld(&(bar)[XB_TMO])) break; if (_sp > XB_SPIN_CAP) { atomicAdd(&(bar)[XB_TMO], 1u); break; } } } } while (0)

struct XcdBarrier {
    unsigned* bar; unsigned x;
    volatile LAS unsigned* st;
};

__device__ __forceinline__ XcdBarrier xcd_barrier_post(unsigned* bar, volatile LAS unsigned* st, int tid) {
    XcdBarrier b; b.bar = bar; b.x = xb_xcc_id(); b.st = st;
    if (tid == 0) { const unsigned rk = xb_add(&bar[XB_XCNT(b.x)], 1u); st[6] = rk; st[7] = b.x; }
    return b;
}
__device__ __forceinline__ void xcd_barrier_complete(unsigned* bar, unsigned x, unsigned& nloc, unsigned& nx) {
    const unsigned G = gridDim.x * gridDim.y * gridDim.z;
    unsigned sum, cnt, mine, sp = 0u;
    for (;;) {
        sum = 0u; cnt = 0u; mine = 0u;
#pragma unroll
        for (unsigned j = 0; j < 16; ++j) { const unsigned c = xb_ld(&bar[XB_XCNT(j)]); sum += c; cnt += (c > 0u) ? 1u : 0u; mine = (j == x) ? c : mine; }
        if (sum == G) break;
        __builtin_amdgcn_s_sleep(1);
        if ((++sp & 255u) == 0u) { if (xb_ld(&bar[XB_TMO])) break; if (sp > XB_SPIN_CAP) { atomicAdd(&bar[XB_TMO], 1u); break; } }
    }
    nloc = mine > 0u ? mine : 1u; nx = cnt > 0u ? cnt : 1u;
}

__device__ __forceinline__ void xcd_barrier(const XcdBarrier& b, int tid) {
    asm volatile("s_waitcnt vmcnt(0)" ::: "memory");
    __syncthreads();
    if (tid == 0) {
        unsigned* bar = b.bar;
        __builtin_amdgcn_s_waitcnt(0);
        unsigned nloc = b.st[0], nx = b.st[1];
        if (nloc == 0u) { xcd_barrier_complete(bar, b.x, nloc, nx); b.st[0] = nloc; b.st[1] = nx; }
        const unsigned old = xb_add(&bar[XB_XSUB(b.x)], 1u);
        const unsigned gen = old / nloc;
        if (old + 1u == (gen + 1u) * nloc) {
            __builtin_amdgcn_fence(__ATOMIC_RELEASE, "agent");
            asm volatile("s_waitcnt vmcnt(0)" ::: "memory");
            const unsigned og = xb_add(&bar[XB_TOP], 1u);
            const unsigned tg = og / nx;
            if (og + 1u == (tg + 1u) * nx) xb_add(&bar[XB_TOPGEN], 1u);
            else XB_SPIN(xb_ld(&bar[XB_TOPGEN]) == tg, bar);
            __builtin_amdgcn_fence(__ATOMIC_ACQUIRE, "agent");
            xb_add(&bar[XB_XGEN(b.x)], 1u);
            asm volatile("s_waitcnt vmcnt(0)" ::: "memory");
        } else {
            XB_SPIN(xb_ld(&bar[XB_XGEN(b.x)]) == gen, bar);
            __builtin_amdgcn_fence(__ATOMIC_ACQUIRE, "agent");
            asm volatile("s_waitcnt vmcnt(0)" ::: "memory");
        }
    }
    __syncthreads();
}

constexpr int LDS_BYTES = 147456, LDS_MISC = 139264;
__global__ void __launch_bounds__(512, 2) mk_fwd(Args a) {
    extern __shared__ __attribute__((aligned(16))) unsigned char lds_raw[];
    LAS unsigned char* lds = (LAS unsigned char*)lds_raw;
    unsigned char* ws = a.ws;
    const int G = gridDim.x, blk = blockIdx.x, wv = __builtin_amdgcn_readfirstlane(threadIdx.x >> 6);
    { const int t0 = opaque_tid(wv); if (t0 < 16) ((volatile LAS unsigned*)(lds + LDS_MISC))[t0] = 0u; }
    __syncthreads();
    XcdBarrier bar = xcd_barrier_post((unsigned*)(ws + WS_CTL), (volatile LAS unsigned*)(lds + LDS_MISC), opaque_tid(wv));
#define IN(k) (a.ph_lo <= (k) && (k) < a.ph_hi)
#define SEAM(k) do { if (IN(k) && IN((k) + 1)) xcd_barrier(bar, opaque_tid(wv)); } while (0)
    if (IN(0)) { const bool smallfirst = ((blk >> 3) & 1) != 0;
        if (smallfirst) p0_small(wv, a, lds, blk, G);
        p0_bw(wv, a, lds, blk, G);
        if (!smallfirst) p0_small(wv, a, lds, blk, G);
        if (G != 256) { p0_peerfold(wv, a, blk, G); p0_tables(wv, a, blk, G); } }
    SEAM(0);
    if (IN(1)) {
        pg8::Gemm g{(const bf16*)(ws + WS_A0), (const bf16*)(ws + WS_WT_IN), S, NCOLS, D, D, D}; pg8::StaticOrder So; So.init(S, NCOLS, G, blk);
        pg8::EpiProj E{(const float*)(ws + WS_RSTD0), (bf16*)(ws + WS_A1), (bf16*)(ws + WS_A2), (bf16*)(ws + WS_A3), (bf16*)(ws + WS_A4), (bf16*)(ws + WS_A5), (bf16*)(ws + WS_A6), (bf16*)a.out, 0.125f * 1.4426950408889634f, (unsigned*)(ws + WS_KMAX), (PG8_LAS float*)(lds + 131072)};
        if (G == 256 && ((blk >> 3) & 1)) cross_fold(wv, a, (blk >> 4) * 8 + (blk & 7), 128);
        pg8::gemm_phase<pg8::EpiProj, pg8::StaticOrder, true, true>(wv, lds, g, So, E);
        if (G == 256 && !((blk >> 3) & 1)) { __syncthreads(); p0_peerfold(wv, a, (blk >> 4) * 8 + (blk & 7), 128); p0_tables(wv, a, (blk >> 4) * 8 + (blk & 7), 128); }
    }
    SEAM(1);
    if (IN(2)) { const bool convfirst = ((blk >> 3) & 1) == 0;
        if (convfirst) conv_phase(wv, a, blk, G);
        att::attn_phase(wv, a, lds, blk, G, (bf16*)(ws + WS_A3));
        if (!convfirst) conv_phase(wv, a, blk, G); }
    SEAM(2);
    if (IN(3)) {
        pg8::StaticOrder So; So.init(S, D, G, blk);
        { pg8::Gemm g{(const bf16*)(ws + WS_A1), (const bf16*)(ws + WS_WT_CONV), S, D, 2 * D, D, D};
          const pg8::Split sp{16, (long long)WS_A3 - (long long)WS_A1 - 16 * 128, (long long)WS_WT_ATTN - (long long)WS_WT_CONV - 16 * 128};
          pg8::EpiMergeK E{(const bf16*)(ws + WS_A6), (const bf16*)a.out, (bf16*)(ws + WS_A0)};
          pg8::gemm_phase<pg8::EpiMergeK, pg8::StaticOrder, true, true, true>(wv, lds, g, So, E, sp); }
    }
    SEAM(3);
    if (IN(4)) {
        if (G != 256) cross_fold(wv, a, blk, G);
        pg8::Gemm g{(const bf16*)(ws + WS_A0), (const bf16*)(ws + WS_WT_MIX), S, D, D, D, D}; pg8::StaticOrder So; So.init(S, D, G, blk);
        pg8::EpiResid E{a.in[I_X], (bf16*)(ws + WS_A2), (float*)(ws + WS_SS1)};
        pg8::gemm_phase<pg8::EpiResid, pg8::StaticOrder, true, true>(wv, lds, g, So, E);
    }
    SEAM(4);
    if (IN(5)) {
        pg8::Gemm g{(const bf16*)(ws + WS_A2), (const bf16*)(ws + WS_WQK), S, D, D, D, D}; pg8::StaticOrder So; So.init(S, D, G, blk);
        pg8::EpiSoftmaxFull E{(const float*)(ws + WS_SS1), (bf16*)(ws + WS_A1), 0.0625f * 1.4426950408889634f};
        pg8::gemm_phase<pg8::EpiSoftmaxFull, pg8::StaticOrder, false, true>(wv, lds, g, So, E);
    }
    SEAM(5);
    if (IN(6)) {
        pg8::Gemm g{(const bf16*)(ws + WS_A1), (const bf16*)((const unsigned char*)a.out + OUT_VW), S, D, D, D, D}; pg8::StaticOrder So; So.init(S, D, G, blk);
        pg8::EpiResidB E{(bf16*)(ws + WS_A2), (float*)(ws + WS_SS2)};
        pg8::gemm_phase<pg8::EpiResidB, pg8::StaticOrder, true, true>(wv, lds, g, So, E);
    }
    SEAM(6);
    if (IN(7)) {
        pg8::StaticOrder So; So.init(S, 2048, G, blk);
        for (int i = 0;; ++i) { pg8::Unit u; if (!So.next(i, u)) break;
            { pg8::Gemm g{(const bf16*)(ws + WS_A2), (const bf16*)(ws + WS_WT_PQ), S, 2048, D, D, D}; pg8::OneUnit S1{u.pm, u.pn};
              pg8::EpiKeysTopk E{(const float*)(ws + WS_SS2), (unsigned*)(ws + WS_TOPK), a.in[I_PEER_U], (unsigned*)(ws + WS_PU), (i * 4 * G + blk) * 8, G * 8, G == 256 ? 16384 : 0};
              pg8::gemm_phase<pg8::EpiKeysTopk, pg8::OneUnit, false, true>(wv, lds, g, S1, E); }
            __syncthreads(); }
    }
    SEAM(7);
    if (IN(8)) peer::peer_p0(wv, a, blk, G, G == 256 ? 16384 : 0);
    SEAM(8);
    int pj = blk & 7, pr0 = (blk >> 3) * 8, pnw = (G >> 3) * 8;
    if (IN(9) || IN(11)) { unsigned cn[16]; bool phys = true;
#pragma unroll
        for (int q = 0; q < 16; ++q) { cn[q] = xb_ld(&bar.bar[XB_XCNT(q)]); phys = phys && ((q < 8) == (cn[q] > 0u)); }
        unsigned tot = 0u;
#pragma unroll
        for (int q = 0; q < 8; ++q) tot += cn[q];
        phys = phys && tot == (unsigned)G;
        if (phys) { const unsigned x_ = bar.st[7] & 7u; pj = (int)x_; pr0 = (int)bar.st[6] * 8; pnw = (int)cn[x_] * 8;
            pj = __builtin_amdgcn_readfirstlane(pj); pr0 = __builtin_amdgcn_readfirstlane(pr0); pnw = __builtin_amdgcn_readfirstlane(pnw); } }
    if (IN(9)) peer::peer_pa(wv, a, pj, pr0, pnw);
    SEAM(9);
    if (IN(10)) peer::peer_pa2(wv, a, blk, G);
    SEAM(10);
    if (IN(11)) peer::peer_pb(wv, a, pj, pr0, pnw, a.out);
    SEAM(11);
    if (IN(12)) peer::peer_pc(wv, a, blk, G, a.out);
#undef IN
#undef SEAM
}

extern "C" void kernel_launch(void* const* d_in, const int* in_sizes, int n_in, void* d_out, int out_size, void* d_ws, size_t ws_size, hipStream_t stream) {
    static int grid = 0;
    if (grid == 0) {
        if (ws_size < WS_END || n_in != 25 || out_size != S * D) { fprintf(stderr, "kernel_launch: unexpected ws_size %zu / n_in %d / out_size %d\n", ws_size, n_in, out_size); grid = -1; return; }
        if (hipFuncSetAttribute((const void*)mk_fwd, hipFuncAttributeMaxDynamicSharedMemorySize, LDS_BYTES) != hipSuccess) { fprintf(stderr, "kernel_launch: hipFuncSetAttribute failed\n"); grid = -1; return; }
        int dev = 0, cus = 0, per_cu = 0;
        if (hipGetDevice(&dev) != hipSuccess || hipDeviceGetAttribute(&cus, hipDeviceAttributeMultiprocessorCount, dev) != hipSuccess) { grid = -1; return; }
        if (hipOccupancyMaxActiveBlocksPerMultiprocessor(&per_cu, (const void*)mk_fwd, 512, LDS_BYTES) != hipSuccess || per_cu < 1) { fprintf(stderr, "kernel_launch: occupancy query says %d blocks per CU\n", per_cu); grid = -1; return; }
        grid = cus;
    }
    if (grid < 0) return;
    Args a{};
    for (int i = 0; i < 25; ++i) a.in[i] = (const float*)d_in[i];
    a.out = (float*)d_out; a.ws = (unsigned char*)d_ws; a.ph_lo = 0; a.ph_hi = 13;
    if (hipMemsetAsync(d_ws, 0, 65536, stream) != hipSuccess) { fprintf(stderr, "kernel_launch: hipMemsetAsync failed\n"); return; }
    void* kargs[] = {&a};
    hipError_t e = hipLaunchCooperativeKernel((const void*)mk_fwd, dim3(grid), dim3(512), kargs, LDS_BYTES, stream);
    if (e != hipSuccess) fprintf(stderr, "kernel_launch: cooperative launch failed: %s (grid %d)\n", hipGetErrorString(e), grid);
}
```
